# Optimizing an MI355X kernel written in HIP

```python
import jax, jax.numpy as jnp
from jax import lax
import numpy as np

D_MODEL = 1024
BATCH = 4
SEQ = 8192
DEPTH = 2

BRANCH_WIDTH = D_MODEL // 2
N_BRANCH = 3
LN_EPS = 1e-5
RW_HEAD_DIM = 64
RW_HEADS = BRANCH_WIDTH // RW_HEAD_DIM
RW_DECAY_RANK = 64
RW_ICLR_RANK = 64
RW_GN_EPS = 64e-5
M2_HEAD_DIM = 64
M2_HEADS = BRANCH_WIDTH // M2_HEAD_DIM
M2_GROUPS = 2
M2_STATE = 128
M2_CONV = 4
M2_CHUNK = 128
M2_EPS = 1e-5
GLA_HEADS = 4
GLA_KEY_DIM = BRANCH_WIDTH // 2
GLA_VAL_DIM = BRANCH_WIDTH
GLA_GATE_RANK = 16
GLA_GATE_TAU = 16.0
GLA_CHUNK = 64
GLA_EPS = 1e-5
DEEPNORM_ALPHA = (2.0 * DEPTH) ** 0.25
DEEPNORM_BETA = (8.0 * DEPTH) ** -0.25
RW_SHIFT_WIDTH = 3 * BRANCH_WIDTH + RW_DECAY_RANK + RW_ICLR_RANK
M2_XBC_WIDTH = BRANCH_WIDTH + 2 * M2_GROUPS * M2_STATE
IN_SIZES = (RW_SHIFT_WIDTH, BRANCH_WIDTH,
            M2_XBC_WIDTH, M2_HEADS, BRANCH_WIDTH,
            GLA_KEY_DIM, GLA_KEY_DIM, GLA_VAL_DIM, GLA_GATE_RANK, BRANCH_WIDTH,
            N_BRANCH * D_MODEL)
IN_WIDTH = sum(IN_SIZES)

kernel_name = "hybrid_rwkv7_mamba2_gla_deepnorm_adaln"


def _layer_norm(x, eps):
    xf = x.astype(jnp.float32)
    mu = jnp.mean(xf, axis=-1, keepdims=True)
    var = jnp.mean(jnp.square(xf - mu), axis=-1, keepdims=True)
    return ((xf - mu) * lax.rsqrt(var + eps)).astype(x.dtype)


def _rms_norm(x, eps):
    xf = x.astype(jnp.float32)
    return (xf * lax.rsqrt(jnp.mean(jnp.square(xf), axis=-1, keepdims=True) + eps)).astype(x.dtype)


def _token_shift(x):
    return jnp.pad(x, ((0, 0), (1, 0), (0, 0)))[:, :-1]


def _causal_mask(n):
    return jnp.arange(n)[:, None] >= jnp.arange(n)[None, :]


def _rwkv7_mixer(r, k, v, wd, ad, w0, w_up, a0, a_up, k_k, k_a, r_k, ln_g, ln_b):
    out_dtype = r.dtype
    bsz, seq, _ = r.shape
    f32 = lambda t: t.astype(jnp.float32)
    heads = lambda t: f32(t).reshape(bsz, seq, RW_HEADS, RW_HEAD_DIM)
    w = f32(w0 + jnp.tanh(wd) @ w_up)
    decay = jnp.exp(-jnp.exp(-jax.nn.softplus(-w) - 0.5))
    a = jax.nn.sigmoid(f32(a0 + ad @ a_up))
    kk = heads(k * k_k)
    kk = kk / jnp.maximum(jnp.sqrt(jnp.sum(kk * kk, axis=-1, keepdims=True)), 1e-12)
    k = f32(k) * (1.0 + (a - 1.0) * f32(k_a))
    r, k, v, a, decay = heads(r), heads(k), heads(v), heads(a), heads(decay)

    def step(state, inp):
        r_t, w_t, k_t, v_t, kk_t, a_t = inp
        sa = jnp.einsum('bhij,bhj->bhi', state, -kk_t)
        state = (state * w_t[:, :, None, :]
                 + sa[..., None] * (kk_t * a_t)[:, :, None, :]
                 + v_t[..., None] * k_t[:, :, None, :])
        return state, jnp.einsum('bhij,bhj->bhi', state, r_t)

    state0 = jnp.zeros((bsz, RW_HEADS, RW_HEAD_DIM, RW_HEAD_DIM), jnp.float32)
    sm = lambda t: jnp.moveaxis(t, 1, 0)
    _, y = lax.scan(step, state0, (sm(r), sm(decay), sm(k), sm(v), sm(kk), sm(a)))
    y = jnp.moveaxis(y, 0, 1)
    y = _layer_norm(y, RW_GN_EPS).reshape(bsz, seq, BRANCH_WIDTH) * f32(ln_g) + f32(ln_b)
    bonus = jnp.sum(r * k * f32(r_k), axis=-1, keepdims=True) * v
    return (y + bonus.reshape(bsz, seq, BRANCH_WIDTH)).astype(out_dtype)


def _causal_depthwise_conv(x, w, b):
    y = lax.conv_general_dilated(x, w[:, None, :].astype(x.dtype), (1,), ((w.shape[0] - 1, 0),),
                                 dimension_numbers=('NWC', 'WIO', 'NWC'),
                                 feature_group_count=x.shape[-1])
    return y + b


def _mamba2_mixer(xbc, dt_raw, z, conv_w, conv_b, dt_bias, a_log, d_skip, norm_w):
    out_dtype = z.dtype
    bsz, seq, _ = xbc.shape
    f32 = lambda t: t.astype(jnp.float32)
    nc, hpg = seq // M2_CHUNK, M2_HEADS // M2_GROUPS
    xbc = jax.nn.silu(f32(_causal_depthwise_conv(xbc, conv_w, conv_b)))
    xs, bm, cm = jnp.split(xbc, [BRANCH_WIDTH, BRANCH_WIDTH + M2_GROUPS * M2_STATE], axis=-1)
    xs = xs.reshape(bsz, nc, M2_CHUNK, M2_GROUPS, hpg, M2_HEAD_DIM)
    bm = bm.reshape(bsz, nc, M2_CHUNK, M2_GROUPS, M2_STATE)
    cm = cm.reshape(bsz, nc, M2_CHUNK, M2_GROUPS, M2_STATE)
    dt = jax.nn.softplus(f32(dt_raw) + f32(dt_bias)).reshape(bsz, nc, M2_CHUNK, M2_GROUPS, hpg)
    a_head = -jnp.exp(f32(a_log)).reshape(M2_GROUPS, hpg)
    a_cs = jnp.moveaxis(jnp.cumsum(dt * a_head, axis=2), 2, -1)
    xdt = xs * dt[..., None]
    diff = a_cs[..., :, None] - a_cs[..., None, :]
    decay_in = jnp.exp(jnp.where(_causal_mask(M2_CHUNK), diff, -jnp.inf))
    cb = jnp.einsum('bclgn,bcsgn->bcgls', cm, bm)
    y_diag = jnp.einsum('bcghls,bcsghp->bclghp', cb[:, :, :, None] * decay_in, xdt)
    decay_to_end = jnp.exp(a_cs[..., -1:] - a_cs)
    chunk_states = jnp.einsum('bclgn,bcghl,bclghp->bcghpn', bm, decay_to_end, xdt)
    chunk_decay = jnp.exp(a_cs[..., -1])

    def step(state, inp):
        s_c, d_c = inp
        return state * d_c[..., None, None] + s_c, state

    state0 = jnp.zeros((bsz, M2_GROUPS, hpg, M2_HEAD_DIM, M2_STATE), jnp.float32)
    _, prev = lax.scan(step, state0, (jnp.moveaxis(chunk_states, 1, 0), jnp.moveaxis(chunk_decay, 1, 0)))
    prev = jnp.moveaxis(prev, 0, 1)
    y_off = jnp.einsum('bclgn,bcghpn,bcghl->bclghp', cm, prev, jnp.exp(a_cs))
    y = y_diag + y_off + xs * f32(d_skip).reshape(M2_GROUPS, hpg)[:, :, None]
    y = y.reshape(bsz, seq, BRANCH_WIDTH) * jax.nn.silu(f32(z))
    y = _rms_norm(y.reshape(bsz, seq, M2_GROUPS, BRANCH_WIDTH // M2_GROUPS), M2_EPS)
    return (y.reshape(bsz, seq, BRANCH_WIDTH) * f32(norm_w)).astype(out_dtype)


def _gla_mixer(q, k, v, gk_down, g, gk_up, gk_b, norm_w):
    out_dtype = q.dtype
    bsz, seq, _ = q.shape
    f32 = lambda t: t.astype(jnp.float32)
    nc = seq // GLA_CHUNK
    dk, dv = GLA_KEY_DIM // GLA_HEADS, GLA_VAL_DIM // GLA_HEADS
    log_alpha = jax.nn.log_sigmoid(f32(gk_down @ gk_up + gk_b)) / GLA_GATE_TAU
    chunk = lambda t, d: f32(t).reshape(bsz, nc, GLA_CHUNK, GLA_HEADS, d)
    q = chunk(q, dk) * (dk ** -0.5)
    k = chunk(k, dk)
    v = chunk(v, dv)
    g_cs = jnp.cumsum(chunk(log_alpha, dk), axis=2)
    g_last = g_cs[:, :, -1:]
    q_g = q * jnp.exp(g_cs)
    att = jnp.einsum('bclhd,bcshd->bchls', q_g, k * jnp.exp(-g_cs))
    att = jnp.where(_causal_mask(GLA_CHUNK), att, 0.0)
    o_intra = jnp.einsum('bchls,bcshe->bclhe', att, v)
    chunk_kv = jnp.einsum('bclhd,bclhe->bchde', k * jnp.exp(g_last - g_cs), v)
    chunk_decay = jnp.exp(g_last[:, :, 0])

    def step(state, inp):
        kv_c, d_c = inp
        return state * d_c[..., None] + kv_c, state

    state0 = jnp.zeros((bsz, GLA_HEADS, dk, dv), jnp.float32)
    _, prev = lax.scan(step, state0, (jnp.moveaxis(chunk_kv, 1, 0), jnp.moveaxis(chunk_decay, 1, 0)))
    prev = jnp.moveaxis(prev, 0, 1)
    o = o_intra + jnp.einsum('bclhd,bchde->bclhe', q_g, prev)
    o = _rms_norm(o.reshape(bsz, seq, GLA_HEADS, dv), GLA_EPS) * f32(norm_w)
    return (o.reshape(bsz, seq, GLA_VAL_DIM) * jax.nn.silu(f32(g))).astype(out_dtype)


def _hybrid_layer(x, c, ada_w, ada_b, w_in, rw_mu, rw_w0, rw_w_up, rw_a0, rw_a_up, rw_k_k,
                  rw_k_a, rw_r_k, rw_ln_g, rw_ln_b, m2_conv_w, m2_conv_b, m2_dt_bias, m2_a_log,
                  m2_d_skip, m2_norm_w, gla_gk_up, gla_gk_b, gla_norm_w, w_branch, w_out,
                  post_g, post_b):
    bsz, seq, _ = x.shape
    shift, scale, gate = jnp.split(jax.nn.silu(c) @ ada_w + ada_b, 3, axis=-1)
    h = _layer_norm(x, LN_EPS) * (1.0 + scale[:, None, :]) + shift[:, None, :]
    proj = h @ w_in
    (rw_in, rw_gate, m2_xbc, m2_dt, m2_z, gla_q, gla_k, gla_v, gla_gk, gla_gate,
     merge_logits) = jnp.split(proj, np.cumsum(IN_SIZES)[:-1].tolist(), axis=-1)
    rw_in = rw_in + rw_mu * (_token_shift(rw_in) - rw_in)
    r, k, v, wd, ad = jnp.split(
        rw_in, np.cumsum([BRANCH_WIDTH, BRANCH_WIDTH, BRANCH_WIDTH, RW_DECAY_RANK]).tolist(), axis=-1)
    y_rw = _rwkv7_mixer(r, k, v, wd, ad, rw_w0, rw_w_up, rw_a0, rw_a_up, rw_k_k, rw_k_a, rw_r_k,
                        rw_ln_g, rw_ln_b) * jax.nn.silu(rw_gate)
    y_m2 = _mamba2_mixer(m2_xbc, m2_dt, m2_z, m2_conv_w, m2_conv_b, m2_dt_bias, m2_a_log,
                         m2_d_skip, m2_norm_w)
    y_gla = _gla_mixer(gla_q, gla_k, gla_v, gla_gk, gla_gate, gla_gk_up, gla_gk_b, gla_norm_w)
    gates = jax.nn.sigmoid(merge_logits.astype(jnp.float32)).astype(x.dtype)
    gates = gates.reshape(bsz, seq, N_BRANCH, D_MODEL)
    merged = (gates[:, :, 0] * (y_rw @ w_branch[0])
              + gates[:, :, 1] * (y_m2 @ w_branch[1])
              + gates[:, :, 2] * (y_gla @ w_branch[2]))
    y = merged @ w_out
    res = DEEPNORM_ALPHA * x + (1.0 + gate[:, None, :]) * y
    return _layer_norm(res, LN_EPS) * post_g + post_b


def setup_inputs(seed: int = 0) -> dict:
    key = jax.random.key(seed)
    ks = iter(jax.random.split(key, 32))
    nrm = lambda shape, s: jax.random.normal(next(ks), shape, jnp.float32) * s
    uni = lambda shape, lo, hi: jax.random.uniform(next(ks), shape, jnp.float32, lo, hi)
    L, D, W = DEPTH, D_MODEL, BRANCH_WIDTH
    x = nrm((BATCH, SEQ, D), 1.0)
    c = nrm((BATCH, D), 1.0)
    ada_w = nrm((L, D, 3 * D), 0.5 * D ** -0.5)
    ada_b = nrm((L, 3 * D), 0.01)
    w_in = nrm((L, D, IN_WIDTH), D ** -0.5)
    rw_mu = uni((L, RW_SHIFT_WIDTH), 0.0, 1.0)
    rw_w0 = uni((L, W), -6.0, -1.0)
    rw_w_up = nrm((L, RW_DECAY_RANK, W), RW_DECAY_RANK ** -0.5)
    rw_a0 = nrm((L, W), 0.1)
    rw_a_up = nrm((L, RW_ICLR_RANK, W), RW_ICLR_RANK ** -0.5)
    rw_k_k = 0.85 + nrm((L, W), 0.05)
    rw_k_a = 1.0 + nrm((L, W), 0.05)
    rw_r_k = nrm((L, RW_HEADS, RW_HEAD_DIM), 0.1)
    rw_ln_g = 1.0 + nrm((L, W), 0.02)
    rw_ln_b = nrm((L, W), 0.02)
    m2_conv_w = nrm((L, M2_CONV, M2_XBC_WIDTH), M2_CONV ** -0.5)
    m2_conv_b = nrm((L, M2_XBC_WIDTH), 0.01)
    dt0 = jnp.exp(uni((L, M2_HEADS), float(np.log(1e-3)), float(np.log(1e-1))))
    m2_dt_bias = dt0 + jnp.log(-jnp.expm1(-dt0))
    m2_a_log = jnp.log(uni((L, M2_HEADS), 1.0, 16.0))
    m2_d_skip = 1.0 + nrm((L, M2_HEADS), 0.02)
    m2_norm_w = 1.0 + nrm((L, W), 0.02)
    gla_gk_up = nrm((L, GLA_GATE_RANK, GLA_KEY_DIM), GLA_GATE_RANK ** -0.5)
    gla_gk_b = nrm((L, GLA_KEY_DIM), 0.1)
    gla_norm_w = 1.0 + nrm((L, GLA_VAL_DIM // GLA_HEADS), 0.02)
    w_branch = nrm((L, N_BRANCH, W, D), DEEPNORM_BETA * W ** -0.5)
    w_out = nrm((L, D, D), DEEPNORM_BETA * D ** -0.5)
    post_g = 1.0 + nrm((L, D), 0.02)
    post_b = nrm((L, D), 0.02)
    return {"x": x, "c": c, "ada_w": ada_w, "ada_b": ada_b, "w_in": w_in, "rw_mu": rw_mu,
            "rw_w0": rw_w0, "rw_w_up": rw_w_up, "rw_a0": rw_a0, "rw_a_up": rw_a_up,
            "rw_k_k": rw_k_k, "rw_k_a": rw_k_a, "rw_r_k": rw_r_k, "rw_ln_g": rw_ln_g,
            "rw_ln_b": rw_ln_b, "m2_conv_w": m2_conv_w, "m2_conv_b": m2_conv_b,
            "m2_dt_bias": m2_dt_bias, "m2_a_log": m2_a_log, "m2_d_skip": m2_d_skip,
            "m2_norm_w": m2_norm_w, "gla_gk_up": gla_gk_up, "gla_gk_b": gla_gk_b,
            "gla_norm_w": gla_norm_w, "w_branch": w_branch, "w_out": w_out,
            "post_g": post_g, "post_b": post_b}


def reference(x, c, ada_w, ada_b, w_in, rw_mu, rw_w0, rw_w_up, rw_a0, rw_a_up, rw_k_k, rw_k_a,
              rw_r_k, rw_ln_g, rw_ln_b, m2_conv_w, m2_conv_b, m2_dt_bias, m2_a_log, m2_d_skip,
              m2_norm_w, gla_gk_up, gla_gk_b, gla_norm_w, w_branch, w_out, post_g, post_b):
    for l in range(DEPTH):
        x = _hybrid_layer(x, c, ada_w[l], ada_b[l], w_in[l], rw_mu[l], rw_w0[l], rw_w_up[l],
                          rw_a0[l], rw_a_up[l], rw_k_k[l], rw_k_a[l], rw_r_k[l], rw_ln_g[l],
                          rw_ln_b[l], m2_conv_w[l], m2_conv_b[l], m2_dt_bias[l], m2_a_log[l],
                          m2_d_skip[l], m2_norm_w[l], gla_gk_up[l], gla_gk_b[l], gla_norm_w[l],
                          w_branch[l], w_out[l], post_g[l], post_b[l])
    return x
```

```cpp
#include <hip/hip_runtime.h>
#include <hip/hip_cooperative_groups.h>
#include <cstdio>
namespace cg = cooperative_groups;

#ifndef N_LAUNCH_MODE
#define N_LAUNCH_MODE 1
#endif

#define LAS __attribute__((address_space(3)))
typedef unsigned short bf16_t;
typedef short bf16x8 __attribute__((ext_vector_type(8)));
typedef float f32x4 __attribute__((ext_vector_type(4)));
typedef unsigned u32x4 __attribute__((ext_vector_type(4)));
typedef unsigned u32x2 __attribute__((ext_vector_type(2)));

constexpr int T = 32768, SEQ = 8192, DM = 1024, NB = 4;
constexpr int INW = 8344;
constexpr float ALPHA_DN = 1.4142135623730951f;

constexpr size_t SZ_WT1 = (size_t)8448 * 1024 * 2, SZ_WT2 = (size_t)3072 * 512 * 2, SZ_WT3 = (size_t)1024 * 3072 * 2, SZ_MOD = (size_t)2 * 4 * 3072 * 4;
constexpr size_t OFF_WT1 = 0, OFF_WT2 = OFF_WT1 + SZ_WT1, OFF_WT3 = OFF_WT2 + SZ_WT2, OFF_MOD = OFF_WT3 + SZ_WT3;
constexpr size_t OFF_H = OFF_MOD + SZ_MOD;
constexpr size_t OFF_Y3 = OFF_H + (size_t)T * 1024 * 2;
constexpr size_t OFF_RKV = OFF_Y3 + (size_t)3 * T * 512 * 2;
constexpr size_t OFF_XBC = OFF_RKV + (size_t)T * 1536 * 2;
constexpr size_t OFF_GQ = OFF_XBC + (size_t)T * 1024 * 2;
constexpr size_t OFF_GK = OFF_GQ + (size_t)T * 256 * 2;
constexpr size_t OFF_SMALL = OFF_GK + (size_t)T * 256 * 2;
constexpr size_t OFF_A = OFF_SMALL + (size_t)T * 160 * 4;
constexpr size_t OFF_DEC = OFF_A + (size_t)T * 512 * 2;
constexpr size_t WS_END = OFF_DEC + (size_t)T * 512 * 4;
constexpr size_t OFF_GATES = OFF_RKV;
static_assert(OFF_GK + (size_t)T * 256 * 2 - OFF_RKV == (size_t)T * 3072 * 2, "gates alias");

struct Params { const float* in[28]; float* out; unsigned char* ws; int ph_lo, ph_hi; };
enum { I_X = 0, I_C, I_ADAW, I_ADAB, I_WIN, I_MU, I_W0, I_WUP, I_A0, I_AUP, I_KK, I_KA, I_RK, I_LNG, I_LNB, I_CONVW, I_CONVB, I_DTB, I_ALOG, I_DSKIP,
       I_M2NW, I_GKUP, I_GKB, I_GNW, I_WBR, I_WOUT, I_PG, I_PB };

__device__ __forceinline__ float bf2f(bf16_t v) { return __uint_as_float(((unsigned)v) << 16); }
__device__ __forceinline__ bf16_t f2bf(float f) { unsigned u = __float_as_uint(f); u += 0x7FFFu + ((u >> 16) & 1u); return (bf16_t)(u >> 16); }
__device__ __forceinline__ unsigned pk2(float lo, float hi) { return (unsigned)f2bf(lo) | ((unsigned)f2bf(hi) << 16); }
__device__ __forceinline__ float lo_bf(unsigned w) { return __uint_as_float(w << 16); }
__device__ __forceinline__ float hi_bf(unsigned w) { return __uint_as_float(w & 0xFFFF0000u); }
__device__ __forceinline__ float sigmoidf_(float x) { return 1.0f / (1.0f + __expf(-x)); }
__device__ __forceinline__ float siluf_(float x) { return x / (1.0f + __expf(-x)); }
__device__ __forceinline__ float softplusf_(float x) { return x > 20.f ? x : log1pf(__expf(x)); }
__device__ __forceinline__ float wave_sum(float v) {
#pragma unroll
    for (int o = 1; o < 64; o <<= 1) v += __shfl_xor(v, o);
    return v;
}
__device__ __forceinline__ int tid_opaque() { int t = threadIdx.x; asm volatile("" : "+v"(t)); return t; }
__device__ __forceinline__ int bid_opaque() { int t = blockIdx.x; asm volatile("" : "+s"(t)); return t; }
#define WAVE_LDS_SYNC() do { asm volatile("s_waitcnt lgkmcnt(0)" ::: "memory"); __builtin_amdgcn_wave_barrier(); } while (0)

namespace pg8 {
constexpr int BM = 256, BK = 64, HALF = 128, HTB = HALF * BK * 2, STAGE_BYTES = 8 * HTB, NXCD = 8, WGM = 8;
__host__ __device__ __forceinline__ int lds_byte(int r, int c) { const int st = (r >> 4) * 2 + (c >> 5), rr = r & 15, cc = c & 31, ob = rr * 64 + cc * 2; return st * 1024 + (ob ^ (((ob >> 9) & 1) << 5)); }
__host__ __device__ __forceinline__ void stage_rc(int b, int& R, int& C) { const int st = b / 1024, sb = b % 1024, swz = sb ^ (((sb >> 9) & 1) << 5); R = (st >> 1) * 16 + swz / 64; C = (st & 1) * 32 + (swz % 64) / 2; }
__host__ __device__ __forceinline__ int perm32(int rho) { const int n = rho >> 4, i = rho & 15; return 8 * (i >> 2) + 4 * n + (i & 3); }
struct Unit { int pm, pn; };
struct Gemm { const bf16_t* A; const bf16_t* Bt; int M, N, K; int adiv; size_t astride; };
struct StaticOrder {
    int nM, nN, nwg, G, c;
    __device__ void init(int M, int N, int G_, int c_) { nM = M / BM; nN = N / BM; nwg = nM * nN; G = G_; c = c_; }
    __device__ bool next(int i, Unit& u) const {
        const long L = (long)i * G + c; if (L >= nwg) return false;
        int wgid = (int)L; { const int q = nwg / NXCD, r = nwg % NXCD, xcd = wgid % NXCD, off = wgid / NXCD; wgid = (xcd < r ? xcd * (q + 1) : r * (q + 1) + (xcd - r) * q) + off; }
        const int nig = WGM * nN, gid = wgid / nig, fm = gid * WGM, gsz = (nM - fm) < WGM ? (nM - fm) : WGM;
        u.pm = fm + ((wgid % nig) % gsz); u.pn = (wgid % nig) / gsz; return true;
    }
};
__device__ __forceinline__ unsigned cvt_pk_bf16(float lo, float hi) { unsigned r; asm volatile("v_cvt_pk_bf16_f32 %0, %1, %2" : "=v"(r) : "v"(lo), "v"(hi)); return r; }

template <class Epi>
__device__ __forceinline__ void gemm_phase(LAS unsigned char* lds, const Gemm g, const StaticOrder& S, const Epi& E, int TIDX) {
    const int tid = TIDX, wid = __builtin_amdgcn_readfirstlane(tid >> 6), lane = tid & 63, wr = wid >> 2, wc = wid & 3, fr = lane & 15, fq = lane >> 4;
    const int K = g.K, nt = K / BK;
    unsigned voffA[2], voffB[2];
#pragma unroll
    for (int i = 0; i < 2; ++i) { int R, C; stage_rc(tid * 16 + i * 8192, R, C); const int Rb = (R & ~31) + perm32(R & 31);
        voffA[i] = (unsigned)(R * K + C) * 2u; voffB[i] = (unsigned)(Rb * K + C) * 2u; }
    const size_t kstep = (size_t)(BK * 2);
    const size_t hstep = (size_t)HALF * K * 2;
    const size_t tstep = 2 * hstep;
    const unsigned ldsw = (unsigned)wid * 1024u;
    const int aoff = lds_byte(wr * 64 + fr, fq * 8), boff = lds_byte(wc * 32 + fr, fq * 8);
#define PG8_SA(b, h) (((b) * 2 + (h)) * HTB)
#define PG8_SB(b, h) ((4 + (b) * 2 + (h)) * HTB)
#define PG8_STAGE(bufoff, gbase, voff) do { _Pragma("unroll") for (int _i = 0; _i < 2; ++_i) \
        __builtin_amdgcn_global_load_lds((const unsigned*)((const char*)(gbase) + (voff)[_i]), (LAS unsigned*)(lds + (bufoff) + ldsw + _i * 8192), 16, 0, 0); } while (0)
#define PG8_LDA(dst, b, h) do { _Pragma("unroll") for (int m = 0; m < 4; ++m) _Pragma("unroll") for (int k = 0; k < 2; ++k) dst[m][k] = *(const LAS bf16x8*)(lds + PG8_SA(b, h) + aoff + m * 2048 + k * 1024); } while (0)
#define PG8_LDB(dst, b, h) do { _Pragma("unroll") for (int n = 0; n < 2; ++n) _Pragma("unroll") for (int k = 0; k < 2; ++k) dst[n][k] = *(const LAS bf16x8*)(lds + PG8_SB(b, h) + boff + n * 2048 + k * 1024); } while (0)
#define PG8_MMA(ai, bj, At, Bt) do { __builtin_amdgcn_s_setprio(1); _Pragma("unroll") for (int m = 0; m < 4; ++m) _Pragma("unroll") for (int n = 0; n < 2; ++n) _Pragma("unroll") for (int k = 0; k < 2; ++k) \
        acc[ai][bj][m][n] = __builtin_amdgcn_mfma_f32_16x16x32_bf16(Bt[n][k], At[m][k], acc[ai][bj][m][n], 0, 0, 0); __builtin_amdgcn_s_setprio(0); } while (0)
#define PG8_WAIT_V(n) asm volatile("s_waitcnt vmcnt(" #n ")" ::: "memory")
#define PG8_WAIT_L(n) asm volatile("s_waitcnt lgkmcnt(" #n ")" ::: "memory")
#define PG8_BAR __builtin_amdgcn_s_barrier()
#define PG8_SCHED __builtin_amdgcn_sched_barrier(0)
    Unit cur, nxt; int ui = 0;
    if (!S.next(0, cur)) return;
    f32x4 acc[2][2][4][2];
#pragma unroll
    for (int a = 0; a < 2; ++a)
#pragma unroll
        for (int b = 0; b < 2; ++b)
#pragma unroll
            for (int m = 0; m < 4; ++m)
#pragma unroll
                for (int n = 0; n < 2; ++n) acc[a][b][m][n] = (f32x4){0.f, 0.f, 0.f, 0.f};
    bf16x8 At[4][2], B0[2][2], B1[2][2];
    const char* cA = (const char*)g.A + (size_t)(cur.pn / g.adiv) * g.astride + (size_t)cur.pm * tstep; const char* cB = (const char*)g.Bt + (size_t)cur.pn * tstep;
    PG8_STAGE(PG8_SB(0, 0), cB, voffB); PG8_STAGE(PG8_SA(0, 0), cA, voffA); PG8_STAGE(PG8_SB(0, 1), cB + hstep, voffB); PG8_STAGE(PG8_SA(0, 1), cA + hstep, voffA);
    if (wr == 1) PG8_BAR;
    PG8_WAIT_V(4); PG8_BAR;
    PG8_STAGE(PG8_SB(1, 0), cB + kstep, voffB); PG8_STAGE(PG8_SA(1, 0), cA + kstep, voffA); PG8_STAGE(PG8_SB(1, 1), cB + hstep + kstep, voffB);
    PG8_WAIT_V(6); PG8_BAR;
    for (;;) {
        const bool has_next = S.next(ui + 1, nxt);
        const char* nA = has_next ? (const char*)g.A + (size_t)(nxt.pn / g.adiv) * g.astride + (size_t)nxt.pm * tstep : cA; const char* nB = has_next ? (const char*)g.Bt + (size_t)nxt.pn * tstep : cB;
        for (int t = 0; t < nt; t += 2) {
            const bool last = (t == nt - 2);
            const char* a1 = cA + (size_t)(t + 1) * kstep;
            const char* a2 = last ? nA : cA + (size_t)(t + 2) * kstep; const char* b2 = last ? nB : cB + (size_t)(t + 2) * kstep;
            const char* a3 = a2 + kstep; const char* b3 = b2 + kstep;
            PG8_LDB(B0, 0, 0); PG8_SCHED; PG8_LDA(At, 0, 0); PG8_STAGE(PG8_SA(1, 1), a1 + hstep, voffA);
            PG8_WAIT_L(8); PG8_BAR; PG8_WAIT_L(0); PG8_MMA(0, 0, At, B0); PG8_BAR; PG8_SCHED;
            PG8_LDB(B1, 0, 1); PG8_STAGE(PG8_SB(0, 0), b2, voffB);
            PG8_BAR; PG8_WAIT_L(0); PG8_MMA(0, 1, At, B1); PG8_BAR;
            PG8_LDA(At, 0, 1); PG8_STAGE(PG8_SA(0, 0), a2, voffA);
            PG8_BAR; PG8_WAIT_L(0); PG8_MMA(1, 0, At, B0); PG8_BAR; PG8_SCHED;
            PG8_STAGE(PG8_SB(0, 1), b2 + hstep, voffB);
            PG8_WAIT_V(6); PG8_BAR; PG8_MMA(1, 1, At, B1); PG8_BAR;
            PG8_LDB(B0, 1, 0); PG8_SCHED; PG8_LDA(At, 1, 0); PG8_STAGE(PG8_SA(0, 1), a2 + hstep, voffA);
            PG8_WAIT_L(8); PG8_BAR; PG8_WAIT_L(0); PG8_MMA(0, 0, At, B0); PG8_BAR; PG8_SCHED;
            PG8_LDB(B1, 1, 1); PG8_STAGE(PG8_SB(1, 0), b3, voffB);
            PG8_BAR; PG8_WAIT_L(0); PG8_MMA(0, 1, At, B1); PG8_BAR;
            PG8_LDA(At, 1, 1); PG8_STAGE(PG8_SA(1, 0), a3, voffA);
            PG8_BAR; PG8_WAIT_L(0); PG8_MMA(1, 0, At, B0); PG8_BAR; PG8_SCHED;
            PG8_STAGE(PG8_SB(1, 1), b3 + hstep, voffB);
            PG8_WAIT_V(6); PG8_BAR; PG8_MMA(1, 1, At, B1); PG8_BAR;
        }
        E(acc, cur, wr, wc, fr, fq);
        if (!has_next) break;
#pragma unroll
        for (int a = 0; a < 2; ++a)
#pragma unroll
            for (int b = 0; b < 2; ++b)
#pragma unroll
                for (int m = 0; m < 4; ++m)
#pragma unroll
                    for (int n = 0; n < 2; ++n) acc[a][b][m][n] = (f32x4){0.f, 0.f, 0.f, 0.f};
        cur = nxt; cA = nA; cB = nB; ++ui;
    }
    PG8_WAIT_V(0);
    if (wr == 0) PG8_BAR;
    PG8_BAR;
#undef PG8_SA
#undef PG8_SB
#undef PG8_STAGE
#undef PG8_LDA
#undef PG8_LDB
#undef PG8_MMA
#undef PG8_WAIT_V
#undef PG8_WAIT_L
#undef PG8_BAR
#undef PG8_SCHED
}
}

template <int MODE> struct Epi {
    unsigned char* ws; const float* xin; const float* gate; float* out;
    __device__ __forceinline__ void operator()(const f32x4 (&acc)[2][2][4][2], const pg8::Unit& u, int wr, int wc, int fr, int fq) const {
        const int pn = u.pn;
        bf16_t* base = nullptr; int ld = 0, c0 = 0;
        if (MODE == 0) {
            if (pn < 6) { base = (bf16_t*)(ws + OFF_RKV); ld = 1536; c0 = pn * 256; }
            else if (pn < 10) { base = (bf16_t*)(ws + OFF_XBC); ld = 1024; c0 = (pn - 6) * 256; }
            else if (pn < 12) { base = (bf16_t*)(ws + OFF_Y3) + (size_t)T * 512; ld = 512; c0 = (pn - 10) * 256; }
            else if (pn == 12) { base = (bf16_t*)(ws + OFF_GQ); ld = 256; c0 = 0; }
            else if (pn == 13) { base = (bf16_t*)(ws + OFF_GK); ld = 256; c0 = 0; }
            else if (pn < 16) { base = (bf16_t*)(ws + OFF_Y3) + (size_t)2 * T * 512; ld = 512; c0 = (pn - 14) * 256; }
        } else if (MODE == 1) {
            if (pn < 2) { base = (bf16_t*)(ws + OFF_Y3); ld = 512; c0 = pn * 256; }
            else if (pn < 4) { base = (bf16_t*)(ws + OFF_Y3) + (size_t)2 * T * 512; ld = 512; c0 = (pn - 2) * 256; }
            else { base = (bf16_t*)(ws + OFF_GATES); ld = 3072; c0 = (pn - 4) * 256; }
        } else if (MODE == 2) { base = (bf16_t*)(ws + OFF_GATES); ld = 3072; c0 = pn * 256; }
#pragma unroll
        for (int ai = 0; ai < 2; ++ai)
#pragma unroll
            for (int m = 0; m < 4; ++m) {
                const int row = u.pm * 256 + ai * 128 + wr * 64 + m * 16 + fr;
#pragma unroll
                for (int bj = 0; bj < 2; ++bj) {
                    const int cl = bj * 128 + wc * 32 + 8 * fq;
                    f32x4 v0 = acc[ai][bj][m][0], v1 = acc[ai][bj][m][1];
                    if (MODE == 0) {
                        if (pn < 16) {
                            u32x4 w; w.x = pg8::cvt_pk_bf16(v0[0], v0[1]); w.y = pg8::cvt_pk_bf16(v0[2], v0[3]); w.z = pg8::cvt_pk_bf16(v1[0], v1[1]); w.w = pg8::cvt_pk_bf16(v1[2], v1[3]);
                            *(u32x4*)(base + (size_t)row * ld + c0 + cl) = w;
                        } else if (cl < 160) {
                            float* d = (float*)(ws + OFF_SMALL) + (size_t)row * 160 + cl;
                            *(f32x4*)d = v0; *(f32x4*)(d + 4) = v1;
                        }
                    } else if (MODE == 1) {
                        bf16_t* d = base + (size_t)row * ld + c0 + cl;
                        if (pn < 4) {
                            const u32x4 o = *(const u32x4*)d;
                            u32x4 w;
                            w.x = pg8::cvt_pk_bf16(lo_bf(o.x) * siluf_(v0[0]), hi_bf(o.x) * siluf_(v0[1]));
                            w.y = pg8::cvt_pk_bf16(lo_bf(o.y) * siluf_(v0[2]), hi_bf(o.y) * siluf_(v0[3]));
                            w.z = pg8::cvt_pk_bf16(lo_bf(o.z) * siluf_(v1[0]), hi_bf(o.z) * siluf_(v1[1]));
                            w.w = pg8::cvt_pk_bf16(lo_bf(o.w) * siluf_(v1[2]), hi_bf(o.w) * siluf_(v1[3]));
                            *(u32x4*)d = w;
                        } else {
                            u32x4 w;
                            w.x = pg8::cvt_pk_bf16(sigmoidf_(v0[0]), sigmoidf_(v0[1])); w.y = pg8::cvt_pk_bf16(sigmoidf_(v0[2]), sigmoidf_(v0[3]));
                            w.z = pg8::cvt_pk_bf16(sigmoidf_(v1[0]), sigmoidf_(v1[1])); w.w = pg8::cvt_pk_bf16(sigmoidf_(v1[2]), sigmoidf_(v1[3]));
                            *(u32x4*)d = w;
                        }
                    } else if (MODE == 2) {
                        bf16_t* d = base + (size_t)row * ld + c0 + cl;
                        const u32x4 o = *(const u32x4*)d;
                        u32x4 w;
                        w.x = pg8::cvt_pk_bf16(lo_bf(o.x) * v0[0], hi_bf(o.x) * v0[1]); w.y = pg8::cvt_pk_bf16(lo_bf(o.y) * v0[2], hi_bf(o.y) * v0[3]);
                        w.z = pg8::cvt_pk_bf16(lo_bf(o.z) * v1[0], hi_bf(o.z) * v1[1]); w.w = pg8::cvt_pk_bf16(lo_bf(o.w) * v1[2], hi_bf(o.w) * v1[3]);
                        *(u32x4*)d = w;
                    } else {
                        const int col = pn * 256 + cl; const int b = row >> 13;
                        const f32x4 x0 = *(const f32x4*)(xin + (size_t)row * 1024 + col), x1 = *(const f32x4*)(xin + (size_t)row * 1024 + col + 4);
                        const f32x4 g0 = *(const f32x4*)(gate + b * 3072 + 2048 + col), g1 = *(const f32x4*)(gate + b * 3072 + 2048 + col + 4);
                        f32x4 r0, r1;
#pragma unroll
                        for (int j = 0; j < 4; ++j) { r0[j] = ALPHA_DN * x0[j] + (1.f + g0[j]) * v0[j]; r1[j] = ALPHA_DN * x1[j] + (1.f + g1[j]) * v1[j]; }
                        *(f32x4*)(out + (size_t)row * 1024 + col) = r0; *(f32x4*)(out + (size_t)row * 1024 + col + 4) = r1;
                    }
                }
            }
    }
};

__device__ __forceinline__ int wt1_src(int n) {
    if (n < 1536) return n;
    if (n < 2560) return 2176 + (n - 1536);
    if (n < 3072) return 3208 + (n - 2560);
    if (n < 3328) return 3720 + (n - 3072);
    if (n < 3584) return 3976 + (n - 3328);
    if (n < 4096) return 4232 + (n - 3584);
    if (n < 4352) { const int s = n - 4096; if (s < 128) return 1536 + s; if (s < 136) return 3200 + (s - 128); if (s < 152) return 4744 + (s - 136); return -1; }
    const int m = n - 4352;
    if (m < 512) return 1664 + m;
    if (m < 1024) return 4760 + (m - 512);
    return 5272 + (m - 1024);
}
template <bool MAP>
__device__ __forceinline__ void transpose_item(const float* W, int ldw, bf16_t* WT, int ldt, int row_off, int col_off, int nblk, LAS float* scr, int item, int lane) {
    const int kb = item / nblk, nb = item % nblk, k0 = 64 * kb, n0 = 32 * nb;
    int sc = n0 + (lane & 31); if (MAP) sc = wt1_src(sc);
#pragma unroll 8
    for (int i = 0; i < 32; ++i) { const int kk = 2 * i + (lane >> 5); scr[kk * 33 + (lane & 31)] = sc >= 0 ? W[(size_t)(k0 + kk) * ldw + sc] : 0.f; }
    WAVE_LDS_SYNC();
    const int c = lane & 7;
#pragma unroll
    for (int j = 0; j < 4; ++j) { const int n = (lane >> 3) + 8 * j; const LAS float* s = scr + (8 * c) * 33 + n;
        u32x4 o; o.x = pk2(s[0 * 33], s[1 * 33]); o.y = pk2(s[2 * 33], s[3 * 33]); o.z = pk2(s[4 * 33], s[5 * 33]); o.w = pk2(s[6 * 33], s[7 * 33]);
        *(u32x4*)(WT + (size_t)(row_off + n0 + n) * ldt + col_off + k0 + 8 * c) = o; }
    WAVE_LDS_SYNC();
}
__device__ void wprep(const Params& p, int l, LAS unsigned char* lds, int TIDX, int BIDX) {
    const int lane = TIDX & 63, wave = TIDX >> 6;
    LAS float* scr = (LAS float*)(lds + wave * 16384);
    const int gw = BIDX * 8 + wave, NGW = gridDim.x * 8;
    constexpr int I1 = (1024 / 64) * (8448 / 32), I2 = 3 * (512 / 64) * (1024 / 32), I3 = 3 * (1024 / 64) * (1024 / 32);
    bf16_t* WT1 = (bf16_t*)(p.ws + OFF_WT1); bf16_t* WT2 = (bf16_t*)(p.ws + OFF_WT2); bf16_t* WT3 = (bf16_t*)(p.ws + OFF_WT3);
    for (int it = gw; it < I1 + I2 + I3; it += NGW) {
        int r = it;
        if (r < I1) { transpose_item<true>(p.in[I_WIN] + (size_t)l * 1024 * INW, INW, WT1, 1024, 0, 0, 8448 / 32, scr, r, lane); continue; }
        r -= I1;
        if (r < I2) { const int b = r / (I2 / 3), rr = r % (I2 / 3); transpose_item<false>(p.in[I_WBR] + ((size_t)l * 3 + b) * 512 * 1024, 1024, WT2, 512, b * 1024, 0, 1024 / 32, scr, rr, lane); continue; }
        r -= I2;
        { const int j = r / (I3 / 3), rr = r % (I3 / 3); transpose_item<false>(p.in[I_WOUT] + (size_t)l * 1024 * 1024, 1024, WT3, 3072, 0, j * 1024, 1024 / 32, scr, rr, lane); }
    }
}
__device__ void ada_phase(const Params& p, LAS unsigned char* lds, int TIDX, int BIDX) {
    LAS float* red = (LAS float*)lds;
    const int tid = TIDX, kg = tid >> 5, cj = tid & 31;
    float* mod = (float*)(p.ws + OFF_MOD);
    for (int it = BIDX; it < 2 * 96; it += gridDim.x) {
        const int l = it / 96, col = (it % 96) * 32 + cj;
        const float* W = p.in[I_ADAW] + (size_t)l * 1024 * 3072;
        float a0 = 0.f, a1 = 0.f, a2 = 0.f, a3 = 0.f;
        for (int k = kg * 64; k < kg * 64 + 64; ++k) {
            const float w = W[(size_t)k * 3072 + col];
            a0 += siluf_(p.in[I_C][k]) * w; a1 += siluf_(p.in[I_C][1024 + k]) * w; a2 += siluf_(p.in[I_C][2048 + k]) * w; a3 += siluf_(p.in[I_C][3072 + k]) * w;
        }
        red[(kg * 32 + cj) * 4 + 0] = a0; red[(kg * 32 + cj) * 4 + 1] = a1; red[(kg * 32 + cj) * 4 + 2] = a2; red[(kg * 32 + cj) * 4 + 3] = a3;
        __syncthreads();
        if (tid < 128) { const int c2 = tid >> 2, b = tid & 3; float s = 0.f;
            for (int g = 0; g < 16; ++g) s += red[(g * 32 + c2) * 4 + b];
            const int cc = (it % 96) * 32 + c2;
            mod[((size_t)l * 4 + b) * 3072 + cc] = s + p.in[I_ADAB][(size_t)l * 3072 + cc]; }
        __syncthreads();
    }
}
__device__ __forceinline__ void ln_stats(const f32x4 (&v)[4], float& mean, float& rstd, float eps) {
    float s = 0.f;
#pragma unroll
    for (int j = 0; j < 4; ++j) s += (v[j][0] + v[j][1]) + (v[j][2] + v[j][3]);
    mean = wave_sum(s) * (1.f / 1024.f); float s2 = 0.f;
#pragma unroll
    for (int j = 0; j < 4; ++j) { const f32x4 d = v[j] - mean; s2 += (d[0] * d[0] + d[1] * d[1]) + (d[2] * d[2] + d[3] * d[3]); }
    rstd = rsqrtf(wave_sum(s2) * (1.f / 1024.f) + eps);
}
__device__ __forceinline__ void mod_row_to_h(const Params& p, const f32x4 (&v)[4], int row, int l, int lane) {
    float mean, rstd; ln_stats(v, mean, rstd, 1e-5f);
    const float* mod = (const float*)(p.ws + OFF_MOD) + ((size_t)l * 4 + (row >> 13)) * 3072;
    bf16_t* H = (bf16_t*)(p.ws + OFF_H) + (size_t)row * 1024;
#pragma unroll
    for (int j = 0; j < 4; ++j) { const int c = 256 * j + 4 * lane;
        const f32x4 sh = *(const f32x4*)(mod + c), sc = *(const f32x4*)(mod + 1024 + c);
        f32x4 h;
#pragma unroll
        for (int e = 0; e < 4; ++e) h[e] = (v[j][e] - mean) * rstd * (1.f + sc[e]) + sh[e];
        u32x2 o; o.x = pk2(h[0], h[1]); o.y = pk2(h[2], h[3]);
        *(u32x2*)(H + c) = o; }
}
__device__ void ln1_phase(const Params& p, int l, const float* xin, int TIDX, int BIDX) {
    const int lane = TIDX & 63, gw = BIDX * 8 + (TIDX >> 6), NGW = gridDim.x * 8;
    for (int row = gw; row < T; row += NGW) {
        f32x4 v[4];
#pragma unroll
        for (int j = 0; j < 4; ++j) v[j] = *(const f32x4*)(xin + (size_t)row * 1024 + 256 * j + 4 * lane);
        mod_row_to_h(p, v, row, l, lane);
    }
}
__device__ void lnpost_phase(const Params& p, int l, int TIDX, int BIDX) {
    const int lane = TIDX & 63, gw = BIDX * 8 + (TIDX >> 6), NGW = gridDim.x * 8;
    const float* pg = p.in[I_PG] + l * 1024; const float* pb = p.in[I_PB] + l * 1024;
    for (int row = gw; row < T; row += NGW) {
        f32x4 v[4];
#pragma unroll
        for (int j = 0; j < 4; ++j) v[j] = *(const f32x4*)(p.out + (size_t)row * 1024 + 256 * j + 4 * lane);
        float mean, rstd; ln_stats(v, mean, rstd, 1e-5f);
#pragma unroll
        for (int j = 0; j < 4; ++j) { const int c = 256 * j + 4 * lane; const f32x4 g = *(const f32x4*)(pg + c), b = *(const f32x4*)(pb + c);
#pragma unroll
            for (int e = 0; e < 4; ++e) v[j][e] = (v[j][e] - mean) * rstd * g[e] + b[e];
            *(f32x4*)(p.out + (size_t)row * 1024 + c) = v[j]; }
        if (l == 0) mod_row_to_h(p, v, row, 1, lane);
    }
}

__device__ void rwkv_prep_phase(const Params& p, int l, LAS unsigned char* lds, int TIDX, int BIDX) {
    LAS float* s = (LAS float*)lds;
    const int c = TIDX;
    float wu[64], au[64];
#pragma unroll
    for (int j = 0; j < 64; ++j) { wu[j] = p.in[I_WUP][((size_t)l * 64 + j) * 512 + c]; au[j] = p.in[I_AUP][((size_t)l * 64 + j) * 512 + c]; }
    const float w0 = p.in[I_W0][l * 512 + c], a0 = p.in[I_A0][l * 512 + c];
    const float* SM = (const float*)(p.ws + OFF_SMALL);
    const float* mu = p.in[I_MU] + l * 1664 + 1536;
    bf16_t* A = (bf16_t*)(p.ws + OFF_A); float* DEC = (float*)(p.ws + OFF_DEC);
    const int tpb = T / gridDim.x;
    for (int t0 = BIDX * tpb; t0 < (BIDX + 1) * tpb; t0 += 4) {
        { const int tt = c >> 7, j = c & 127; const int row = t0 + tt;
          const float cur = SM[(size_t)row * 160 + j]; const float prev = (row & (SEQ - 1)) ? SM[(size_t)(row - 1) * 160 + j] : 0.f;
          const float v = cur + mu[j] * (prev - cur);
          s[tt * 128 + j] = j < 64 ? tanhf(v) : v; }
        __syncthreads();
#pragma unroll
        for (int tt = 0; tt < 4; ++tt) {
            float w = w0, a = a0;
#pragma unroll
            for (int j = 0; j < 64; ++j) { w += s[tt * 128 + j] * wu[j]; a += s[tt * 128 + 64 + j] * au[j]; }
            const size_t o = (size_t)(t0 + tt) * 512 + c;
            A[o] = f2bf(sigmoidf_(a)); DEC[o] = __expf(-0.6065306597126334f * sigmoidf_(w));
        }
        __syncthreads();
    }
}

__device__ void rwkv_scan_naive(const Params& p, int l, int bh, LAS float* lds, int TIDX) {
    const int b = bh >> 3, h = bh & 7, lane = TIDX & 63, ch = h * 64 + lane;
    const bf16_t* RKV = (const bf16_t*)(p.ws + OFF_RKV); const bf16_t* A = (const bf16_t*)(p.ws + OFF_A); const float* DEC = (const float*)(p.ws + OFF_DEC);
    bf16_t* Y = (bf16_t*)(p.ws + OFF_Y3);
    const float mu_r = p.in[I_MU][l * 1664 + ch], mu_k = p.in[I_MU][l * 1664 + 512 + ch], mu_v = p.in[I_MU][l * 1664 + 1024 + ch];
    const float k_k = p.in[I_KK][l * 512 + ch], k_a = p.in[I_KA][l * 512 + ch];
    float S[64];
#pragma unroll
    for (int j = 0; j < 64; ++j) S[j] = 0.f;
    float pr = 0.f, pk = 0.f, pv = 0.f;
    const size_t r0 = (size_t)b * SEQ;
    float nr = bf2f(RKV[r0 * 1536 + ch]), nk = bf2f(RKV[r0 * 1536 + 512 + ch]), nv = bf2f(RKV[r0 * 1536 + 1024 + ch]), na = bf2f(A[r0 * 512 + ch]), nw = DEC[r0 * 512 + ch];
    for (int t = 0; t < SEQ; ++t) {
        const size_t row = r0 + t;
        const float cr = nr, ck = nk, cv = nv, a = na, w = nw;
        if (t + 1 < SEQ) { const size_t rn = row + 1; nr = bf2f(RKV[rn * 1536 + ch]); nk = bf2f(RKV[rn * 1536 + 512 + ch]); nv = bf2f(RKV[rn * 1536 + 1024 + ch]); na = bf2f(A[rn * 512 + ch]); nw = DEC[rn * 512 + ch]; }
        const float r = cr + mu_r * (pr - cr), k = ck + mu_k * (pk - ck), v = cv + mu_v * (pv - cv);
        pr = cr; pk = ck; pv = cv;
        const float kkj = k * k_k; const float n2 = wave_sum(kkj * kkj); const float kkn = kkj / fmaxf(sqrtf(n2), 1e-12f);
        const float kt = k * (1.f + (a - 1.f) * k_a), bb = kkn * a;
        lds[lane] = w; lds[64 + lane] = kkn; lds[128 + lane] = bb; lds[192 + lane] = kt; lds[256 + lane] = r;
        WAVE_LDS_SYNC();
        float sa = 0.f;
#pragma unroll
        for (int j = 0; j < 64; ++j) sa += S[j] * lds[64 + j];
        sa = -sa;
        float y = 0.f;
#pragma unroll
        for (int j = 0; j < 64; ++j) { S[j] = S[j] * lds[j] + sa * lds[128 + j] + v * lds[192 + j]; y += S[j] * lds[256 + j]; }
        Y[row * 512 + ch] = f2bf(y);
        WAVE_LDS_SYNC();
    }
}
__device__ void mamba2_scan_naive(const Params& p, int l, int bh, LAS float* lds, int TIDX) {
    const int b = bh >> 3, h = bh & 7, g = h >> 2, lane = TIDX & 63;
    const bf16_t* XBC = (const bf16_t*)(p.ws + OFF_XBC); const float* SM = (const float*)(p.ws + OFF_SMALL);
    bf16_t* Z = (bf16_t*)(p.ws + OFF_Y3) + (size_t)T * 512;
    int chn[5]; chn[0] = h * 64 + lane; chn[1] = 512 + g * 128 + lane; chn[2] = chn[1] + 64; chn[3] = 768 + g * 128 + lane; chn[4] = chn[3] + 64;
    float cw[5][4], cb[5], h1[5], h2[5], h3[5];
#pragma unroll
    for (int q = 0; q < 5; ++q) { for (int j = 0; j < 4; ++j) cw[q][j] = p.in[I_CONVW][((size_t)l * 4 + j) * 1024 + chn[q]]; cb[q] = p.in[I_CONVB][l * 1024 + chn[q]]; h1[q] = h2[q] = h3[q] = 0.f; }
    const float dtb = p.in[I_DTB][l * 8 + h], ah = -__expf(p.in[I_ALOG][l * 8 + h]), dsk = p.in[I_DSKIP][l * 8 + h];
    float S[128];
#pragma unroll
    for (int n = 0; n < 128; ++n) S[n] = 0.f;
    const size_t r0 = (size_t)b * SEQ;
    for (int t = 0; t < SEQ; ++t) {
        const size_t row = r0 + t;
        float cv[5];
#pragma unroll
        for (int q = 0; q < 5; ++q) { const float x0 = bf2f(XBC[row * 1024 + chn[q]]);
            const float y = cw[q][0] * h3[q] + cw[q][1] * h2[q] + cw[q][2] * h1[q] + cw[q][3] * x0 + cb[q];
            h3[q] = h2[q]; h2[q] = h1[q]; h1[q] = x0; cv[q] = siluf_(y); }
        const float dt = softplusf_(SM[row * 160 + 128 + h] + dtb), dA = __expf(dt * ah);
        const float zz = bf2f(Z[row * 512 + h * 64 + lane]);
        lds[lane] = cv[1]; lds[64 + lane] = cv[2]; lds[128 + lane] = cv[3]; lds[192 + lane] = cv[4];
        WAVE_LDS_SYNC();
        const float xd = cv[0] * dt; float y = 0.f;
#pragma unroll
        for (int n = 0; n < 128; ++n) { S[n] = S[n] * dA + xd * lds[n]; y += S[n] * lds[128 + n]; }
        y += dsk * cv[0];
        Z[row * 512 + h * 64 + lane] = f2bf(y * siluf_(zz));
        WAVE_LDS_SYNC();
    }
}
__device__ void gla_scan_naive(const Params& p, int l, int unit, LAS float* lds, int TIDX) {
    const int eh = unit & 1, bh = unit >> 1, b = bh >> 2, h = bh & 3, lane = TIDX & 63;
    const bf16_t* GQ = (const bf16_t*)(p.ws + OFF_GQ); const bf16_t* GK = (const bf16_t*)(p.ws + OFF_GK); const float* SM = (const float*)(p.ws + OFF_SMALL);
    bf16_t* GV = (bf16_t*)(p.ws + OFF_Y3) + (size_t)2 * T * 512;
    float up[16];
#pragma unroll
    for (int r = 0; r < 16; ++r) up[r] = p.in[I_GKUP][((size_t)l * 16 + r) * 256 + h * 64 + lane];
    const float gb = p.in[I_GKB][l * 256 + h * 64 + lane];
    float S[64];
#pragma unroll
    for (int d = 0; d < 64; ++d) S[d] = 0.f;
    const size_t r0 = (size_t)b * SEQ; const int e = h * 128 + eh * 64 + lane;
    for (int t = 0; t < SEQ; ++t) {
        const size_t row = r0 + t;
        float gp = gb;
#pragma unroll
        for (int r = 0; r < 16; ++r) gp += SM[row * 160 + 136 + r] * up[r];
        const float ls = fminf(gp, 0.f) - log1pf(__expf(-fabsf(gp)));
        const float alpha = __expf(ls * (1.f / 16.f));
        const float q = bf2f(GQ[row * 256 + h * 64 + lane]) * 0.125f, k = bf2f(GK[row * 256 + h * 64 + lane]);
        const float v = bf2f(GV[row * 512 + e]);
        lds[lane] = alpha; lds[64 + lane] = k; lds[128 + lane] = q;
        WAVE_LDS_SYNC();
        float o = 0.f;
#pragma unroll
        for (int d = 0; d < 64; ++d) { S[d] = S[d] * lds[d] + lds[64 + d] * v; o += S[d] * lds[128 + d]; }
        GV[row * 512 + e] = f2bf(o);
        WAVE_LDS_SYNC();
    }
}
__device__ void scans_naive_phase(const Params& p, int l, LAS unsigned char* lds, int TIDX, int BIDX) {
    const int wave = TIDX >> 6;
    LAS float* wl = (LAS float*)(lds + wave * 4096);
    for (int u = BIDX; u < 96; u += gridDim.x) {
        if (wave != 0) continue;
        if (u < 32) rwkv_scan_naive(p, l, u, wl, TIDX);
        else if (u < 64) mamba2_scan_naive(p, l, u - 32, wl, TIDX);
        else gla_scan_naive(p, l, u - 64, wl, TIDX);
    }
}
__device__ void post_phase(const Params& p, int l, int TIDX, int BIDX) {
    const int lane = TIDX & 63, gw = BIDX * 8 + (TIDX >> 6), NGW = gridDim.x * 8;
    const bf16_t* RKV = (const bf16_t*)(p.ws + OFF_RKV); const bf16_t* A = (const bf16_t*)(p.ws + OFF_A);
    bf16_t* Y0 = (bf16_t*)(p.ws + OFF_Y3); bf16_t* Y1 = Y0 + (size_t)T * 512; bf16_t* Y2 = Y1 + (size_t)T * 512;
    const int c0 = lane * 8;
    float mur[8], muk[8], muv[8], kA[8], rk[8], lg[8], lb[8], nw1[8], nw2[8];
#pragma unroll
    for (int e = 0; e < 8; ++e) { const int c = c0 + e;
        mur[e] = p.in[I_MU][l * 1664 + c]; muk[e] = p.in[I_MU][l * 1664 + 512 + c]; muv[e] = p.in[I_MU][l * 1664 + 1024 + c];
        kA[e] = p.in[I_KA][l * 512 + c]; rk[e] = p.in[I_RK][l * 512 + c]; lg[e] = p.in[I_LNG][l * 512 + c]; lb[e] = p.in[I_LNB][l * 512 + c];
        nw1[e] = p.in[I_M2NW][l * 512 + c]; nw2[e] = p.in[I_GNW][l * 128 + (c & 127)]; }
    for (int row = gw; row < T; row += NGW) {
        const bool first = (row & (SEQ - 1)) == 0;
        float y[8], r[8], k[8], v[8], a[8];
        { const u32x4 yy = *(const u32x4*)(Y0 + (size_t)row * 512 + c0); const u32x4 aa = *(const u32x4*)(A + (size_t)row * 512 + c0);
          const u32x4 rr = *(const u32x4*)(RKV + (size_t)row * 1536 + c0), kk = *(const u32x4*)(RKV + (size_t)row * 1536 + 512 + c0), vv = *(const u32x4*)(RKV + (size_t)row * 1536 + 1024 + c0);
          u32x4 rp = (u32x4){0, 0, 0, 0}, kp = rp, vp = rp;
          if (!first) { rp = *(const u32x4*)(RKV + (size_t)(row - 1) * 1536 + c0); kp = *(const u32x4*)(RKV + (size_t)(row - 1) * 1536 + 512 + c0); vp = *(const u32x4*)(RKV + (size_t)(row - 1) * 1536 + 1024 + c0); }
#pragma unroll
          for (int q = 0; q < 4; ++q) {
              y[2 * q] = lo_bf(yy[q]); y[2 * q + 1] = hi_bf(yy[q]); a[2 * q] = lo_bf(aa[q]); a[2 * q + 1] = hi_bf(aa[q]);
              float x0 = lo_bf(rr[q]), x1 = hi_bf(rr[q]); r[2 * q] = x0 + mur[2 * q] * (lo_bf(rp[q]) - x0); r[2 * q + 1] = x1 + mur[2 * q + 1] * (hi_bf(rp[q]) - x1);
              x0 = lo_bf(kk[q]); x1 = hi_bf(kk[q]); k[2 * q] = x0 + muk[2 * q] * (lo_bf(kp[q]) - x0); k[2 * q + 1] = x1 + muk[2 * q + 1] * (hi_bf(kp[q]) - x1);
              x0 = lo_bf(vv[q]); x1 = hi_bf(vv[q]); v[2 * q] = x0 + muv[2 * q] * (lo_bf(vp[q]) - x0); v[2 * q + 1] = x1 + muv[2 * q + 1] * (hi_bf(vp[q]) - x1); } }
        float s = 0.f, bs = 0.f;
#pragma unroll
        for (int e = 0; e < 8; ++e) { s += y[e]; bs += r[e] * (k[e] * (1.f + (a[e] - 1.f) * kA[e])) * rk[e]; }
        s += __shfl_xor(s, 1); s += __shfl_xor(s, 2); s += __shfl_xor(s, 4);
        bs += __shfl_xor(bs, 1); bs += __shfl_xor(bs, 2); bs += __shfl_xor(bs, 4);
        const float mean = s * (1.f / 64.f); float s2 = 0.f;
#pragma unroll
        for (int e = 0; e < 8; ++e) { const float d = y[e] - mean; s2 += d * d; }
        s2 += __shfl_xor(s2, 1); s2 += __shfl_xor(s2, 2); s2 += __shfl_xor(s2, 4);
        const float rstd = rsqrtf(s2 * (1.f / 64.f) + 64e-5f);
        { float o[8];
#pragma unroll
          for (int e = 0; e < 8; ++e) o[e] = (y[e] - mean) * rstd * lg[e] + lb[e] + bs * v[e];
          u32x4 w; w.x = pk2(o[0], o[1]); w.y = pk2(o[2], o[3]); w.z = pk2(o[4], o[5]); w.w = pk2(o[6], o[7]);
          *(u32x4*)(Y0 + (size_t)row * 512 + c0) = w; }
        { const u32x4 yy = *(const u32x4*)(Y1 + (size_t)row * 512 + c0); float q2 = 0.f;
#pragma unroll
          for (int q = 0; q < 4; ++q) { y[2 * q] = lo_bf(yy[q]); y[2 * q + 1] = hi_bf(yy[q]); q2 += y[2 * q] * y[2 * q] + y[2 * q + 1] * y[2 * q + 1]; }
          q2 += __shfl_xor(q2, 1); q2 += __shfl_xor(q2, 2); q2 += __shfl_xor(q2, 4); q2 += __shfl_xor(q2, 8); q2 += __shfl_xor(q2, 16);
          const float rs = rsqrtf(q2 * (1.f / 256.f) + 1e-5f);
          u32x4 w; w.x = pk2(y[0] * rs * nw1[0], y[1] * rs * nw1[1]); w.y = pk2(y[2] * rs * nw1[2], y[3] * rs * nw1[3]); w.z = pk2(y[4] * rs * nw1[4], y[5] * rs * nw1[5]); w.w = pk2(y[6] * rs * nw1[6], y[7] * rs * nw1[7]);
          *(u32x4*)(Y1 + (size_t)row * 512 + c0) = w; }
        { const u32x4 yy = *(const u32x4*)(Y2 + (size_t)row * 512 + c0); float q2 = 0.f;
#pragma unroll
          for (int q = 0; q < 4; ++q) { y[2 * q] = lo_bf(yy[q]); y[2 * q + 1] = hi_bf(yy[q]); q2 += y[2 * q] * y[2 * q] + y[2 * q + 1] * y[2 * q + 1]; }
          q2 += __shfl_xor(q2, 1); q2 += __shfl_xor(q2, 2); q2 += __shfl_xor(q2, 4); q2 += __shfl_xor(q2, 8);
          const float rs = rsqrtf(q2 * (1.f / 128.f) + 1e-5f);
          u32x4 w; w.x = pk2(y[0] * rs * nw2[0], y[1] * rs * nw2[1]); w.y = pk2(y[2] * rs * nw2[2], y[3] * rs * nw2[3]); w.z = pk2(y[4] * rs * nw2[4], y[5] * rs * nw2[5]); w.w = pk2(y[6] * rs * nw2[6], y[7] * rs * nw2[7]);
          *(u32x4*)(Y2 + (size_t)row * 512 + c0) = w; }
    }
}

constexpr int NPHASE = 18;
#ifndef PHM
#define PHM 1023
#endif
__global__ __launch_bounds__(512, 2) void mega(Params p) {
    extern __shared__ __attribute__((aligned(16))) unsigned char shm[];
    LAS unsigned char* lds = (LAS unsigned char*)shm;
    cg::grid_group grid = cg::this_grid();
    for (int ph = p.ph_lo; ph < p.ph_hi; ++ph) {
        const int TIDX = tid_opaque(), BIDX = bid_opaque();
        if (ph == 0) { if (PHM & 1) { wprep(p, 0, lds, TIDX, BIDX); ada_phase(p, lds, TIDX, BIDX); } }
        else if (ph == 1) { if (PHM & 2) ln1_phase(p, 0, p.in[I_X], TIDX, BIDX); }
        else {
            const int l = (ph - 2) >> 3, s = (ph - 2) & 7;
            const float* xin = l == 0 ? p.in[I_X] : p.out;
            pg8::StaticOrder S;
            if (s == 0 && (PHM & 4)) { pg8::Gemm g{(const bf16_t*)(p.ws + OFF_H), (const bf16_t*)(p.ws + OFF_WT1), T, 4352, 1024, 1 << 30, 0};
                S.init(g.M, g.N, gridDim.x, BIDX); Epi<0> E{p.ws, nullptr, nullptr, nullptr}; pg8::gemm_phase(lds, g, S, E, TIDX); }
            else if (s == 1 && (PHM & 8)) { rwkv_prep_phase(p, l, lds, TIDX, BIDX); }
            else if (s == 2 && (PHM & 16)) { scans_naive_phase(p, l, lds, TIDX, BIDX); }
            else if (s == 3 && (PHM & 32)) { post_phase(p, l, TIDX, BIDX); }
            else if (s == 4 && (PHM & 64)) { pg8::Gemm g{(const bf16_t*)(p.ws + OFF_H), (const bf16_t*)(p.ws + OFF_WT1) + (size_t)4352 * 1024, T, 4096, 1024, 1 << 30, 0};
                S.init(g.M, g.N, gridDim.x, BIDX); Epi<1> E{p.ws, nullptr, nullptr, nullptr}; pg8::gemm_phase(lds, g, S, E, TIDX); }
            else if (s == 5 && (PHM & 128)) { pg8::Gemm g{(const bf16_t*)(p.ws + OFF_Y3), (const bf16_t*)(p.ws + OFF_WT2), T, 3072, 512, 4, (size_t)T * 512 * 2};
                S.init(g.M, g.N, gridDim.x, BIDX); Epi<2> E{p.ws, nullptr, nullptr, nullptr}; pg8::gemm_phase(lds, g, S, E, TIDX); }
            else if (s == 6 && (PHM & 256)) { pg8::Gemm g{(const bf16_t*)(p.ws + OFF_GATES), (const bf16_t*)(p.ws + OFF_WT3), T, 1024, 3072, 1 << 30, 0};
                S.init(g.M, g.N, gridDim.x, BIDX); Epi<3> E{p.ws, xin, (const float*)(p.ws + OFF_MOD) + (size_t)l * 4 * 3072, p.out}; pg8::gemm_phase(lds, g, S, E, TIDX); }
            else if (s == 7 && (PHM & 512)) { lnpost_phase(p, l, TIDX, BIDX); if (l == 0) wprep(p, 1, lds, TIDX, BIDX); }
        }
        if (ph + 1 < p.ph_hi) grid.sync();
    }
}

extern "C" void kernel_launch(void* const* d_in, const int* in_sizes, int n_in, void* d_out, int out_size, void* d_ws, size_t ws_size, hipStream_t stream) {
    constexpr int LDS_BYTES = 131072;
    static int grid = 0;
    if (grid == 0) {
        if (n_in != 28 || out_size != T * DM || ws_size < WS_END) { fprintf(stderr, "kernel_launch: unexpected shapes / workspace (%zu < %zu)\n", ws_size, (size_t)WS_END); grid = -1; return; }
        int dev = 0, cus = 0, per_cu = 0;
        hipGetDevice(&dev); hipDeviceGetAttribute(&cus, hipDeviceAttributeMultiprocessorCount, dev);
        if (hipFuncSetAttribute((const void*)mega, hipFuncAttributeMaxDynamicSharedMemorySize, LDS_BYTES) != hipSuccess) { fprintf(stderr, "hipFuncSetAttribute failed\n"); grid = -1; return; }
        if (hipOccupancyMaxActiveBlocksPerMultiprocessor(&per_cu, (const void*)mega, 512, LDS_BYTES) != hipSuccess || per_cu < 1) per_cu = 1;
        (void)hipGetLastError();
        grid = cus * 1;
        if (grid > 256) grid = 256;
    }
    if (grid < 0) return;
    Params p{};
    for (int i = 0; i < 28; ++i) p.in[i] = (const float*)d_in[i];
    p.out = (float*)d_out; p.ws = (unsigned char*)d_ws;
#if N_LAUNCH_MODE == 1
    p.ph_lo = 0; p.ph_hi = NPHASE;
    void* args[] = {&p};
    hipError_t e = hipLaunchCooperativeKernel((const void*)mega, dim3(grid), dim3(512), args, LDS_BYTES, stream);
    if (e != hipSuccess) fprintf(stderr, "cooperative launch failed: %s (grid %d)\n", hipGetErrorString(e), grid);
#else
    for (int ph = 0; ph < NPHASE; ++ph) { p.ph_lo = ph; p.ph_hi = ph + 1; hipLaunchKernelGGL(mega, dim3(grid), dim3(512), LDS_BYTES, stream, p); }
#endif
}
```

```cpp
#include <hip/hip_runtime.h>
#include <hip/hip_cooperative_groups.h>
#include <cstdio>
namespace cg = cooperative_groups;

#ifndef N_LAUNCH_MODE
#define N_LAUNCH_MODE 1
#endif

#define LAS __attribute__((address_space(3)))
typedef unsigned short bf16_t;
typedef short bf16x8 __attribute__((ext_vector_type(8)));
typedef float f32x4 __attribute__((ext_vector_type(4)));
typedef unsigned u32x4 __attribute__((ext_vector_type(4)));
typedef unsigned u32x2 __attribute__((ext_vector_type(2)));

constexpr int T = 32768, SEQ = 8192, DM = 1024, NB = 4;
constexpr int INW = 8344;
constexpr float ALPHA_DN = 1.4142135623730951f;

constexpr size_t SZ_WT1 = (size_t)8448 * 1024 * 2, SZ_WT2 = (size_t)3072 * 512 * 2, SZ_WT3 = (size_t)1024 * 3072 * 2, SZ_MOD = (size_t)2 * 4 * 3072 * 4;
constexpr size_t OFF_WT1 = 0, OFF_WT2 = OFF_WT1 + SZ_WT1, OFF_WT3 = OFF_WT2 + SZ_WT2, OFF_MOD = OFF_WT3 + SZ_WT3;
constexpr size_t OFF_H = OFF_MOD + SZ_MOD;
constexpr size_t OFF_Y3 = OFF_H + (size_t)T * 1024 * 2;
constexpr size_t OFF_RKV = OFF_Y3 + (size_t)3 * T * 512 * 2;
constexpr size_t OFF_XBC = OFF_RKV + (size_t)T * 1536 * 2;
constexpr size_t OFF_GQ = OFF_XBC + (size_t)T * 1024 * 2;
constexpr size_t OFF_GK = OFF_GQ + (size_t)T * 256 * 2;
constexpr size_t OFF_SMALL = OFF_GK + (size_t)T * 256 * 2;
constexpr size_t OFF_A = OFF_SMALL + (size_t)T * 160 * 4;
constexpr size_t OFF_DEC = OFF_A + (size_t)T * 512 * 2;
constexpr size_t WS_END = OFF_DEC + (size_t)T * 512 * 4;
constexpr size_t OFF_GATES = OFF_RKV;
static_assert(OFF_GK + (size_t)T * 256 * 2 - OFF_RKV == (size_t)T * 3072 * 2, "gates alias");

struct Params { const float* in[28]; float* out; unsigned char* ws; int ph_lo, ph_hi; };
enum { I_X = 0, I_C, I_ADAW, I_ADAB, I_WIN, I_MU, I_W0, I_WUP, I_A0, I_AUP, I_KK, I_KA, I_RK, I_LNG, I_LNB, I_CONVW, I_CONVB, I_DTB, I_ALOG, I_DSKIP,
       I_M2NW, I_GKUP, I_GKB, I_GNW, I_WBR, I_WOUT, I_PG, I_PB };

__device__ __forceinline__ float bf2f(bf16_t v) { return __uint_as_float(((unsigned)v) << 16); }
__device__ __forceinline__ bf16_t f2bf(float f) { unsigned u = __float_as_uint(f); u += 0x7FFFu + ((u >> 16) & 1u); return (bf16_t)(u >> 16); }
__device__ __forceinline__ unsigned pk2(float lo, float hi) { return (unsigned)f2bf(lo) | ((unsigned)f2bf(hi) << 16); }
__device__ __forceinline__ float lo_bf(unsigned w) { return __uint_as_float(w << 16); }
__device__ __forceinline__ float hi_bf(unsigned w) { return __uint_as_float(w & 0xFFFF0000u); }
__device__ __forceinline__ float sigmoidf_(float x) { return 1.0f / (1.0f + __expf(-x)); }
__device__ __forceinline__ float siluf_(float x) { return x / (1.0f + __expf(-x)); }
__device__ __forceinline__ float softplusf_(float x) { return x > 20.f ? x : log1pf(__expf(x)); }
__device__ __forceinline__ float wave_sum(float v) {
#pragma unroll
    for (int o = 1; o < 64; o <<= 1) v += __shfl_xor(v, o);
    return v;
}
__device__ __forceinline__ int tid_opaque() { int t = threadIdx.x; asm volatile("" : "+v"(t)); return t; }
__device__ __forceinline__ int bid_opaque() { int t = blockIdx.x; asm volatile("" : "+s"(t)); return t; }
#define WAVE_LDS_SYNC() do { asm volatile("s_waitcnt lgkmcnt(0)" ::: "memory"); __builtin_amdgcn_wave_barrier(); } while (0)

namespace pg8 {
constexpr int BM = 256, BK = 64, HALF = 128, HTB = HALF * BK * 2, STAGE_BYTES = 8 * HTB, NXCD = 8, WGM = 8;
__host__ __device__ __forceinline__ int lds_byte(int r, int c) { const int st = (r >> 4) * 2 + (c >> 5), rr = r & 15, cc = c & 31, ob = rr * 64 + cc * 2; return st * 1024 + (ob ^ (((ob >> 9) & 1) << 5)); }
__host__ __device__ __forceinline__ void stage_rc(int b, int& R, int& C) { const int st = b / 1024, sb = b % 1024, swz = sb ^ (((sb >> 9) & 1) << 5); R = (st >> 1) * 16 + swz / 64; C = (st & 1) * 32 + (swz % 64) / 2; }
__host__ __device__ __forceinline__ int perm32(int rho) { const int n = rho >> 4, i = rho & 15; return 8 * (i >> 2) + 4 * n + (i & 3); }
struct Unit { int pm, pn; };
struct Gemm { const bf16_t* A; const bf16_t* Bt; int M, N, K; int adiv; size_t astride; };
struct StaticOrder {
    int nM, nN, nwg, G, c;
    __device__ void init(int M, int N, int G_, int c_) { nM = M / BM; nN = N / BM; nwg = nM * nN; G = G_; c = c_; }
    __device__ bool next(int i, Unit& u) const {
        const long L = (long)i * G + c; if (L >= nwg) return false;
        int wgid = (int)L; { const int q = nwg / NXCD, r = nwg % NXCD, xcd = wgid % NXCD, off = wgid / NXCD; wgid = (xcd < r ? xcd * (q + 1) : r * (q + 1) + (xcd - r) * q) + off; }
        const int nig = WGM * nN, gid = wgid / nig, fm = gid * WGM, gsz = (nM - fm) < WGM ? (nM - fm) : WGM;
        u.pm = fm + ((wgid % nig) % gsz); u.pn = (wgid % nig) / gsz; return true;
    }
};
__device__ __forceinline__ unsigned cvt_pk_bf16(float lo, float hi) { unsigned r; asm volatile("v_cvt_pk_bf16_f32 %0, %1, %2" : "=v"(r) : "v"(lo), "v"(hi)); return r; }

template <class Epi>
__device__ __forceinline__ void gemm_phase(LAS unsigned char* lds, const Gemm g, const StaticOrder& S, const Epi& E, int TIDX) {
    const int tid = TIDX, wid = __builtin_amdgcn_readfirstlane(tid >> 6), lane = tid & 63, wr = wid >> 2, wc = wid & 3, fr = lane & 15, fq = lane >> 4;
    const int K = g.K, nt = K / BK;
    unsigned voffA[2], voffB[2];
#pragma unroll
    for (int i = 0; i < 2; ++i) { int R, C; stage_rc(tid * 16 + i * 8192, R, C); const int Rb = (R & ~31) + perm32(R & 31);
        voffA[i] = (unsigned)(R * K + C) * 2u; voffB[i] = (unsigned)(Rb * K + C) * 2u; }
    const size_t kstep = (size_t)(BK * 2);
    const size_t hstep = (size_t)HALF * K * 2;
    const size_t tstep = 2 * hstep;
    const unsigned ldsw = (unsigned)wid * 1024u;
    const int aoff = lds_byte(wr * 64 + fr, fq * 8), boff = lds_byte(wc * 32 + fr, fq * 8);
#define PG8_SA(b, h) (((b) * 2 + (h)) * HTB)
#define PG8_SB(b, h) ((4 + (b) * 2 + (h)) * HTB)
#define PG8_STAGE(bufoff, gbase, voff) do { _Pragma("unroll") for (int _i = 0; _i < 2; ++_i) \
        __builtin_amdgcn_global_load_lds((const unsigned*)((const char*)(gbase) + (voff)[_i]), (LAS unsigned*)(lds + (bufoff) + ldsw + _i * 8192), 16, 0, 0); } while (0)
#define PG8_LDA(dst, b, h) do { _Pragma("unroll") for (int m = 0; m < 4; ++m) _Pragma("unroll") for (int k = 0; k < 2; ++k) dst[m][k] = *(const LAS bf16x8*)(lds + PG8_SA(b, h) + aoff + m * 2048 + k * 1024); } while (0)
#define PG8_LDB(dst, b, h) do { _Pragma("unroll") for (int n = 0; n < 2; ++n) _Pragma("unroll") for (int k = 0; k < 2; ++k) dst[n][k] = *(const LAS bf16x8*)(lds + PG8_SB(b, h) + boff + n * 2048 + k * 1024); } while (0)
#define PG8_MMA(ai, bj, At, Bt) do { __builtin_amdgcn_s_setprio(1); _Pragma("unroll") for (int m = 0; m < 4; ++m) _Pragma("unroll") for (int n = 0; n < 2; ++n) _Pragma("unroll") for (int k = 0; k < 2; ++k) \
        acc[ai][bj][m][n] = __builtin_amdgcn_mfma_f32_16x16x32_bf16(Bt[n][k], At[m][k], acc[ai][bj][m][n], 0, 0, 0); __builtin_amdgcn_s_setprio(0); } while (0)
#define PG8_WAIT_V(n) asm volatile("s_waitcnt vmcnt(" #n ")" ::: "memory")
#define PG8_WAIT_L(n) asm volatile("s_waitcnt lgkmcnt(" #n ")" ::: "memory")
#define PG8_BAR __builtin_amdgcn_s_barrier()
#define PG8_SCHED __builtin_amdgcn_sched_barrier(0)
    Unit cur, nxt; int ui = 0;
    if (!S.next(0, cur)) return;
    f32x4 acc[2][2][4][2];
#pragma unroll
    for (int a = 0; a < 2; ++a)
#pragma unroll
        for (int b = 0; b < 2; ++b)
#pragma unroll
            for (int m = 0; m < 4; ++m)
#pragma unroll
                for (int n = 0; n < 2; ++n) acc[a][b][m][n] = (f32x4){0.f, 0.f, 0.f, 0.f};
    bf16x8 At[4][2], B0[2][2], B1[2][2];
    const char* cA = (const char*)g.A + (size_t)(cur.pn / g.adiv) * g.astride + (size_t)cur.pm * tstep; const char* cB = (const char*)g.Bt + (size_t)cur.pn * tstep;
    PG8_STAGE(PG8_SB(0, 0), cB, voffB); PG8_STAGE(PG8_SA(0, 0), cA, voffA); PG8_STAGE(PG8_SB(0, 1), cB + hstep, voffB); PG8_STAGE(PG8_SA(0, 1), cA + hstep, voffA);
    if (wr == 1) PG8_BAR;
    PG8_WAIT_V(4); PG8_BAR;
    PG8_STAGE(PG8_SB(1, 0), cB + kstep, voffB); PG8_STAGE(PG8_SA(1, 0), cA + kstep, voffA); PG8_STAGE(PG8_SB(1, 1), cB + hstep + kstep, voffB);
    PG8_WAIT_V(6); PG8_BAR;
    for (;;) {
        const bool has_next = S.next(ui + 1, nxt);
        const char* nA = has_next ? (const char*)g.A + (size_t)(nxt.pn / g.adiv) * g.astride + (size_t)nxt.pm * tstep : cA; const char* nB = has_next ? (const char*)g.Bt + (size_t)nxt.pn * tstep : cB;
        for (int t = 0; t < nt; t += 2) {
            const bool last = (t == nt - 2);
            const char* a1 = cA + (size_t)(t + 1) * kstep;
            const char* a2 = last ? nA : cA + (size_t)(t + 2) * kstep; const char* b2 = last ? nB : cB + (size_t)(t + 2) * kstep;
            const char* a3 = a2 + kstep; const char* b3 = b2 + kstep;
            PG8_LDB(B0, 0, 0); PG8_SCHED; PG8_LDA(At, 0, 0); PG8_STAGE(PG8_SA(1, 1), a1 + hstep, voffA);
            PG8_WAIT_L(8); PG8_BAR; PG8_WAIT_L(0); PG8_MMA(0, 0, At, B0); PG8_BAR; PG8_SCHED;
            PG8_LDB(B1, 0, 1); PG8_STAGE(PG8_SB(0, 0), b2, voffB);
            PG8_BAR; PG8_WAIT_L(0); PG8_MMA(0, 1, At, B1); PG8_BAR;
            PG8_LDA(At, 0, 1); PG8_STAGE(PG8_SA(0, 0), a2, voffA);
            PG8_BAR; PG8_WAIT_L(0); PG8_MMA(1, 0, At, B0); PG8_BAR; PG8_SCHED;
            PG8_STAGE(PG8_SB(0, 1), b2 + hstep, voffB);
            PG8_WAIT_V(6); PG8_BAR; PG8_MMA(1, 1, At, B1); PG8_BAR;
            PG8_LDB(B0, 1, 0); PG8_SCHED; PG8_LDA(At, 1, 0); PG8_STAGE(PG8_SA(0, 1), a2 + hstep, voffA);
            PG8_WAIT_L(8); PG8_BAR; PG8_WAIT_L(0); PG8_MMA(0, 0, At, B0); PG8_BAR; PG8_SCHED;
            PG8_LDB(B1, 1, 1); PG8_STAGE(PG8_SB(1, 0), b3, voffB);
            PG8_BAR; PG8_WAIT_L(0); PG8_MMA(0, 1, At, B1); PG8_BAR;
            PG8_LDA(At, 1, 1); PG8_STAGE(PG8_SA(1, 0), a3, voffA);
            PG8_BAR; PG8_WAIT_L(0); PG8_MMA(1, 0, At, B0); PG8_BAR; PG8_SCHED;
            PG8_STAGE(PG8_SB(1, 1), b3 + hstep, voffB);
            PG8_WAIT_V(6); PG8_BAR; PG8_MMA(1, 1, At, B1); PG8_BAR;
        }
        E(acc, cur, wr, wc, fr, fq);
        if (!has_next) break;
#pragma unroll
        for (int a = 0; a < 2; ++a)
#pragma unroll
            for (int b = 0; b < 2; ++b)
#pragma unroll
                for (int m = 0; m < 4; ++m)
#pragma unroll
                    for (int n = 0; n < 2; ++n) acc[a][b][m][n] = (f32x4){0.f, 0.f, 0.f, 0.f};
        cur = nxt; cA = nA; cB = nB; ++ui;
    }
    PG8_WAIT_V(0);
    if (wr == 0) PG8_BAR;
    PG8_BAR;
#undef PG8_SA
#undef PG8_SB
#undef PG8_STAGE
#undef PG8_LDA
#undef PG8_LDB
#undef PG8_MMA
#undef PG8_WAIT_V
#undef PG8_WAIT_L
#undef PG8_BAR
#undef PG8_SCHED
}
}

template <int MODE> struct Epi {
    unsigned char* ws; const float* xin; const float* gate; float* out;
    __device__ __forceinline__ void operator()(const f32x4 (&acc)[2][2][4][2], const pg8::Unit& u, int wr, int wc, int fr, int fq) const {
        const int pn = u.pn;
        bf16_t* base = nullptr; int ld = 0, c0 = 0;
        if (MODE == 0) {
            if (pn < 6) { base = (bf16_t*)(ws + OFF_RKV); ld = 1536; c0 = pn * 256; }
            else if (pn < 10) { base = (bf16_t*)(ws + OFF_XBC); ld = 1024; c0 = (pn - 6) * 256; }
            else if (pn < 12) { base = (bf16_t*)(ws + OFF_Y3) + (size_t)T * 512; ld = 512; c0 = (pn - 10) * 256; }
            else if (pn == 12) { base = (bf16_t*)(ws + OFF_GQ); ld = 256; c0 = 0; }
            else if (pn == 13) { base = (bf16_t*)(ws + OFF_GK); ld = 256; c0 = 0; }
            else if (pn < 16) { base = (bf16_t*)(ws + OFF_Y3) + (size_t)2 * T * 512; ld = 512; c0 = (pn - 14) * 256; }
        } else if (MODE == 1) {
            if (pn < 2) { base = (bf16_t*)(ws + OFF_Y3); ld = 512; c0 = pn * 256; }
            else if (pn < 4) { base = (bf16_t*)(ws + OFF_Y3) + (size_t)2 * T * 512; ld = 512; c0 = (pn - 2) * 256; }
            else { base = (bf16_t*)(ws + OFF_GATES); ld = 3072; c0 = (pn - 4) * 256; }
        } else if (MODE == 2) { base = (bf16_t*)(ws + OFF_GATES); ld = 3072; c0 = pn * 256; }
#pragma unroll
        for (int ai = 0; ai < 2; ++ai)
#pragma unroll
            for (int m = 0; m < 4; ++m) {
                const int row = u.pm * 256 + ai * 128 + wr * 64 + m * 16 + fr;
#pragma unroll
                for (int bj = 0; bj < 2; ++bj) {
                    const int cl = bj * 128 + wc * 32 + 8 * fq;
                    f32x4 v0 = acc[ai][bj][m][0], v1 = acc[ai][bj][m][1];
                    if (MODE == 0) {
                        if (pn < 16) {
                            u32x4 w; w.x = pg8::cvt_pk_bf16(v0[0], v0[1]); w.y = pg8::cvt_pk_bf16(v0[2], v0[3]); w.z = pg8::cvt_pk_bf16(v1[0], v1[1]); w.w = pg8::cvt_pk_bf16(v1[2], v1[3]);
                            *(u32x4*)(base + (size_t)row * ld + c0 + cl) = w;
                        } else if (cl < 160) {
                            float* d = (float*)(ws + OFF_SMALL) + (size_t)row * 160 + cl;
                            *(f32x4*)d = v0; *(f32x4*)(d + 4) = v1;
                        }
                    } else if (MODE == 1) {
                        bf16_t* d = base + (size_t)row * ld + c0 + cl;
                        if (pn < 4) {
                            const u32x4 o = *(const u32x4*)d;
                            u32x4 w;
                            w.x = pg8::cvt_pk_bf16(lo_bf(o.x) * siluf_(v0[0]), hi_bf(o.x) * siluf_(v0[1]));
                            w.y = pg8::cvt_pk_bf16(lo_bf(o.y) * siluf_(v0[2]), hi_bf(o.y) * siluf_(v0[3]));
                            w.z = pg8::cvt_pk_bf16(lo_bf(o.z) * siluf_(v1[0]), hi_bf(o.z) * siluf_(v1[1]));
                            w.w = pg8::cvt_pk_bf16(lo_bf(o.w) * siluf_(v1[2]), hi_bf(o.w) * siluf_(v1[3]));
                            *(u32x4*)d = w;
                        } else {
                            u32x4 w;
                            w.x = pg8::cvt_pk_bf16(sigmoidf_(v0[0]), sigmoidf_(v0[1])); w.y = pg8::cvt_pk_bf16(sigmoidf_(v0[2]), sigmoidf_(v0[3]));
                            w.z = pg8::cvt_pk_bf16(sigmoidf_(v1[0]), sigmoidf_(v1[1])); w.w = pg8::cvt_pk_bf16(sigmoidf_(v1[2]), sigmoidf_(v1[3]));
                            *(u32x4*)d = w;
                        }
                    } else if (MODE == 2) {
                        bf16_t* d = base + (size_t)row * ld + c0 + cl;
                        const u32x4 o = *(const u32x4*)d;
                        u32x4 w;
                        w.x = pg8::cvt_pk_bf16(lo_bf(o.x) * v0[0], hi_bf(o.x) * v0[1]); w.y = pg8::cvt_pk_bf16(lo_bf(o.y) * v0[2], hi_bf(o.y) * v0[3]);
                        w.z = pg8::cvt_pk_bf16(lo_bf(o.z) * v1[0], hi_bf(o.z) * v1[1]); w.w = pg8::cvt_pk_bf16(lo_bf(o.w) * v1[2], hi_bf(o.w) * v1[3]);
                        *(u32x4*)d = w;
                    } else {
                        const int col = pn * 256 + cl; const int b = row >> 13;
                        const f32x4 x0 = *(const f32x4*)(xin + (size_t)row * 1024 + col), x1 = *(const f32x4*)(xin + (size_t)row * 1024 + col + 4);
                        const f32x4 g0 = *(const f32x4*)(gate + b * 3072 + 2048 + col), g1 = *(const f32x4*)(gate + b * 3072 + 2048 + col + 4);
                        f32x4 r0, r1;
#pragma unroll
                        for (int j = 0; j < 4; ++j) { r0[j] = ALPHA_DN * x0[j] + (1.f + g0[j]) * v0[j]; r1[j] = ALPHA_DN * x1[j] + (1.f + g1[j]) * v1[j]; }
                        *(f32x4*)(out + (size_t)row * 1024 + col) = r0; *(f32x4*)(out + (size_t)row * 1024 + col + 4) = r1;
                    }
                }
            }
    }
};

__device__ __forceinline__ int wt1_src(int n) {
    if (n < 1536) return n;
    if (n < 2560) return 2176 + (n - 1536);
    if (n < 3072) return 3208 + (n - 2560);
    if (n < 3328) return 3720 + (n - 3072);
    if (n < 3584) return 3976 + (n - 3328);
    if (n < 4096) return 4232 + (n - 3584);
    if (n < 4352) { const int s = n - 4096; if (s < 128) return 1536 + s; if (s < 136) return 3200 + (s - 128); if (s < 152) return 4744 + (s - 136); return -1; }
    const int m = n - 4352;
    if (m < 512) return 1664 + m;
    if (m < 1024) return 4760 + (m - 512);
    return 5272 + (m - 1024);
}
template <bool MAP>
__device__ __forceinline__ void transpose_item(const float* W, int ldw, bf16_t* WT, int ldt, int row_off, int col_off, int nblk, LAS float* scr, int item, int lane) {
    const int kb = item / nblk, nb = item % nblk, k0 = 64 * kb, n0 = 32 * nb;
    int sc = n0 + (lane & 31); if (MAP) sc = wt1_src(sc);
#pragma unroll 8
    for (int i = 0; i < 32; ++i) { const int kk = 2 * i + (lane >> 5); scr[kk * 33 + (lane & 31)] = sc >= 0 ? W[(size_t)(k0 + kk) * ldw + sc] : 0.f; }
    WAVE_LDS_SYNC();
    const int c = lane & 7;
#pragma unroll
    for (int j = 0; j < 4; ++j) { const int n = (lane >> 3) + 8 * j; const LAS float* s = scr + (8 * c) * 33 + n;
        u32x4 o; o.x = pk2(s[0 * 33], s[1 * 33]); o.y = pk2(s[2 * 33], s[3 * 33]); o.z = pk2(s[4 * 33], s[5 * 33]); o.w = pk2(s[6 * 33], s[7 * 33]);
        *(u32x4*)(WT + (size_t)(row_off + n0 + n) * ldt + col_off + k0 + 8 * c) = o; }
    WAVE_LDS_SYNC();
}
__device__ void wprep(const Params& p, int l, LAS unsigned char* lds, int TIDX, int BIDX) {
    const int lane = TIDX & 63, wave = TIDX >> 6;
    LAS float* scr = (LAS float*)(lds + wave * 16384);
    const int gw = BIDX * 8 + wave, NGW = gridDim.x * 8;
    constexpr int I1 = (1024 / 64) * (8448 / 32), I2 = 3 * (512 / 64) * (1024 / 32), I3 = 3 * (1024 / 64) * (1024 / 32);
    bf16_t* WT1 = (bf16_t*)(p.ws + OFF_WT1); bf16_t* WT2 = (bf16_t*)(p.ws + OFF_WT2); bf16_t* WT3 = (bf16_t*)(p.ws + OFF_WT3);
    for (int it = gw; it < I1 + I2 + I3; it += NGW) {
        int r = it;
        if (r < I1) { transpose_item<true>(p.in[I_WIN] + (size_t)l * 1024 * INW, INW, WT1, 1024, 0, 0, 8448 / 32, scr, r, lane); continue; }
        r -= I1;
        if (r < I2) { const int b = r / (I2 / 3), rr = r % (I2 / 3); transpose_item<false>(p.in[I_WBR] + ((size_t)l * 3 + b) * 512 * 1024, 1024, WT2, 512, b * 1024, 0, 1024 / 32, scr, rr, lane); continue; }
        r -= I2;
        { const int j = r / (I3 / 3), rr = r % (I3 / 3); transpose_item<false>(p.in[I_WOUT] + (size_t)l * 1024 * 1024, 1024, WT3, 3072, 0, j * 1024, 1024 / 32, scr, rr, lane); }
    }
}
__device__ void ada_phase(const Params& p, LAS unsigned char* lds, int TIDX, int BIDX) {
    LAS float* red = (LAS float*)lds;
    const int tid = TIDX, kg = tid >> 5, cj = tid & 31;
    float* mod = (float*)(p.ws + OFF_MOD);
    for (int it = BIDX; it < 2 * 96; it += gridDim.x) {
        const int l = it / 96, col = (it % 96) * 32 + cj;
        const float* W = p.in[I_ADAW] + (size_t)l * 1024 * 3072;
        float a0 = 0.f, a1 = 0.f, a2 = 0.f, a3 = 0.f;
        for (int k = kg * 64; k < kg * 64 + 64; ++k) {
            const float w = W[(size_t)k * 3072 + col];
            a0 += siluf_(p.in[I_C][k]) * w; a1 += siluf_(p.in[I_C][1024 + k]) * w; a2 += siluf_(p.in[I_C][2048 + k]) * w; a3 += siluf_(p.in[I_C][3072 + k]) * w;
        }
        red[(kg * 32 + cj) * 4 + 0] = a0; red[(kg * 32 + cj) * 4 + 1] = a1; red[(kg * 32 + cj) * 4 + 2] = a2; red[(kg * 32 + cj) * 4 + 3] = a3;
        __syncthreads();
        if (tid < 128) { const int c2 = tid >> 2, b = tid & 3; float s = 0.f;
            for (int g = 0; g < 16; ++g) s += red[(g * 32 + c2) * 4 + b];
            const int cc = (it % 96) * 32 + c2;
            mod[((size_t)l * 4 + b) * 3072 + cc] = s + p.in[I_ADAB][(size_t)l * 3072 + cc]; }
        __syncthreads();
    }
}
__device__ __forceinline__ void ln_stats(const f32x4 (&v)[4], float& mean, float& rstd, float eps) {
    float s = 0.f;
#pragma unroll
    for (int j = 0; j < 4; ++j) s += (v[j][0] + v[j][1]) + (v[j][2] + v[j][3]);
    mean = wave_sum(s) * (1.f / 1024.f); float s2 = 0.f;
#pragma unroll
    for (int j = 0; j < 4; ++j) { const f32x4 d = v[j] - mean; s2 += (d[0] * d[0] + d[1] * d[1]) + (d[2] * d[2] + d[3] * d[3]); }
    rstd = rsqrtf(wave_sum(s2) * (1.f / 1024.f) + eps);
}
__device__ __forceinline__ void mod_row_to_h(const Params& p, const f32x4 (&v)[4], int row, int l, int lane) {
    float mean, rstd; ln_stats(v, mean, rstd, 1e-5f);
    const float* mod = (const float*)(p.ws + OFF_MOD) + ((size_t)l * 4 + (row >> 13)) * 3072;
    bf16_t* H = (bf16_t*)(p.ws + OFF_H) + (size_t)row * 1024;
#pragma unroll
    for (int j = 0; j < 4; ++j) { const int c = 256 * j + 4 * lane;
        const f32x4 sh = *(const f32x4*)(mod + c), sc = *(const f32x4*)(mod + 1024 + c);
        f32x4 h;
#pragma unroll
        for (int e = 0; e < 4; ++e) h[e] = (v[j][e] - mean) * rstd * (1.f + sc[e]) + sh[e];
        u32x2 o; o.x = pk2(h[0], h[1]); o.y = pk2(h[2], h[3]);
        *(u32x2*)(H + c) = o; }
}
__device__ void ln1_phase(const Params& p, int l, const float* xin, int TIDX, int BIDX) {
    const int lane = TIDX & 63, gw = BIDX * 8 + (TIDX >> 6), NGW = gridDim.x * 8;
    for (int row = gw; row < T; row += NGW) {
        f32x4 v[4];
#pragma unroll
        for (int j = 0; j < 4; ++j) v[j] = *(const f32x4*)(xin + (size_t)row * 1024 + 256 * j + 4 * lane);
        mod_row_to_h(p, v, row, l, lane);
    }
}
__device__ void lnpost_phase(const Params& p, int l, int TIDX, int BIDX) {
    const int lane = TIDX & 63, gw = BIDX * 8 + (TIDX >> 6), NGW = gridDim.x * 8;
    const float* pg = p.in[I_PG] + l * 1024; const float* pb = p.in[I_PB] + l * 1024;
    for (int row = gw; row < T; row += NGW) {
        f32x4 v[4];
#pragma unroll
        for (int j = 0; j < 4; ++j) v[j] = *(const f32x4*)(p.out + (size_t)row * 1024 + 256 * j + 4 * lane);
        float mean, rstd; ln_stats(v, mean, rstd, 1e-5f);
#pragma unroll
        for (int j = 0; j < 4; ++j) { const int c = 256 * j + 4 * lane; const f32x4 g = *(const f32x4*)(pg + c), b = *(const f32x4*)(pb + c);
#pragma unroll
            for (int e = 0; e < 4; ++e) v[j][e] = (v[j][e] - mean) * rstd * g[e] + b[e];
            *(f32x4*)(p.out + (size_t)row * 1024 + c) = v[j]; }
        if (l == 0) mod_row_to_h(p, v, row, 1, lane);
    }
}

__device__ void rwkv_prep_phase(const Params& p, int l, LAS unsigned char* lds, int TIDX, int BIDX) {
    LAS float* s = (LAS float*)lds;
    const int c = TIDX;
    float wu[64], au[64];
#pragma unroll
    for (int j = 0; j < 64; ++j) { wu[j] = p.in[I_WUP][((size_t)l * 64 + j) * 512 + c]; au[j] = p.in[I_AUP][((size_t)l * 64 + j) * 512 + c]; }
    const float w0 = p.in[I_W0][l * 512 + c], a0 = p.in[I_A0][l * 512 + c];
    const float* SM = (const float*)(p.ws + OFF_SMALL);
    const float* mu = p.in[I_MU] + l * 1664 + 1536;
    bf16_t* A = (bf16_t*)(p.ws + OFF_A); float* DEC = (float*)(p.ws + OFF_DEC);
    const int tpb = T / gridDim.x;
    for (int t0 = BIDX * tpb; t0 < (BIDX + 1) * tpb; t0 += 4) {
        { const int tt = c >> 7, j = c & 127; const int row = t0 + tt;
          const float cur = SM[(size_t)row * 160 + j]; const float prev = (row & (SEQ - 1)) ? SM[(size_t)(row - 1) * 160 + j] : 0.f;
          const float v = cur + mu[j] * (prev - cur);
          s[tt * 128 + j] = j < 64 ? tanhf(v) : v; }
        __syncthreads();
#pragma unroll
        for (int tt = 0; tt < 4; ++tt) {
            float w = w0, a = a0;
#pragma unroll
            for (int j = 0; j < 64; ++j) { w += s[tt * 128 + j] * wu[j]; a += s[tt * 128 + 64 + j] * au[j]; }
            const size_t o = (size_t)(t0 + tt) * 512 + c;
            A[o] = f2bf(sigmoidf_(a)); DEC[o] = __expf(-0.6065306597126334f * sigmoidf_(w));
        }
        __syncthreads();
    }
}

__device__ void rwkv_scan_naive(const Params& p, int l, int bh, LAS float* lds, int TIDX) {
    const int b = bh >> 3, h = bh & 7, lane = TIDX & 63, ch = h * 64 + lane;
    const bf16_t* RKV = (const bf16_t*)(p.ws + OFF_RKV); const bf16_t* A = (const bf16_t*)(p.ws + OFF_A); const float* DEC = (const float*)(p.ws + OFF_DEC);
    bf16_t* Y = (bf16_t*)(p.ws + OFF_Y3);
    const float mu_r = p.in[I_MU][l * 1664 + ch], mu_k = p.in[I_MU][l * 1664 + 512 + ch], mu_v = p.in[I_MU][l * 1664 + 1024 + ch];
    const float k_k = p.in[I_KK][l * 512 + ch], k_a = p.in[I_KA][l * 512 + ch];
    float S[64];
#pragma unroll
    for (int j = 0; j < 64; ++j) S[j] = 0.f;
    float pr = 0.f, pk = 0.f, pv = 0.f;
    const size_t r0 = (size_t)b * SEQ;
    float nr = bf2f(RKV[r0 * 1536 + ch]), nk = bf2f(RKV[r0 * 1536 + 512 + ch]), nv = bf2f(RKV[r0 * 1536 + 1024 + ch]), na = bf2f(A[r0 * 512 + ch]), nw = DEC[r0 * 512 + ch];
    for (int t = 0; t < SEQ; ++t) {
        const size_t row = r0 + t;
        const float cr = nr, ck = nk, cv = nv, a = na, w = nw;
        if (t + 1 < SEQ) { const size_t rn = row + 1; nr = bf2f(RKV[rn * 1536 + ch]); nk = bf2f(RKV[rn * 1536 + 512 + ch]); nv = bf2f(RKV[rn * 1536 + 1024 + ch]); na = bf2f(A[rn * 512 + ch]); nw = DEC[rn * 512 + ch]; }
        const float r = cr + mu_r * (pr - cr), k = ck + mu_k * (pk - ck), v = cv + mu_v * (pv - cv);
        pr = cr; pk = ck; pv = cv;
        const float kkj = k * k_k; const float n2 = wave_sum(kkj * kkj); const float kkn = kkj / fmaxf(sqrtf(n2), 1e-12f);
        const float kt = k * (1.f + (a - 1.f) * k_a), bb = kkn * a;
        lds[lane] = w; lds[64 + lane] = kkn; lds[128 + lane] = bb; lds[192 + lane] = kt; lds[256 + lane] = r;
        WAVE_LDS_SYNC();
        float sa = 0.f;
#pragma unroll
        for (int j = 0; j < 64; ++j) sa += S[j] * lds[64 + j];
        sa = -sa;
        float y = 0.f;
#pragma unroll
        for (int j = 0; j < 64; ++j) { S[j] = S[j] * lds[j] + sa * lds[128 + j] + v * lds[192 + j]; y += S[j] * lds[256 + j]; }
        Y[row * 512 + ch] = f2bf(y);
        WAVE_LDS_SYNC();
    }
}
__device__ void mamba2_scan_naive(const Params& p, int l, int bh, LAS float* lds, int TIDX) {
    const int b = bh >> 3, h = bh & 7, g = h >> 2, lane = TIDX & 63;
    const bf16_t* XBC = (const bf16_t*)(p.ws + OFF_XBC); const float* SM = (const float*)(p.ws + OFF_SMALL);
    bf16_t* Z = (bf16_t*)(p.ws + OFF_Y3) + (size_t)T * 512;
    int chn[5]; chn[0] = h * 64 + lane; chn[1] = 512 + g * 128 + lane; chn[2] = chn[1] + 64; chn[3] = 768 + g * 128 + lane; chn[4] = chn[3] + 64;
    float cw[5][4], cb[5], h1[5], h2[5], h3[5];
#pragma unroll
    for (int q = 0; q < 5; ++q) { for (int j = 0; j < 4; ++j) cw[q][j] = p.in[I_CONVW][((size_t)l * 4 + j) * 1024 + chn[q]]; cb[q] = p.in[I_CONVB][l * 1024 + chn[q]]; h1[q] = h2[q] = h3[q] = 0.f; }
    const float dtb = p.in[I_DTB][l * 8 + h], ah = -__expf(p.in[I_ALOG][l * 8 + h]), dsk = p.in[I_DSKIP][l * 8 + h];
    float S[128];
#pragma unroll
    for (int n = 0; n < 128; ++n) S[n] = 0.f;
    const size_t r0 = (size_t)b * SEQ;
    for (int t = 0; t < SEQ; ++t) {
        const size_t row = r0 + t;
        float cv[5];
#pragma unroll
        for (int q = 0; q < 5; ++q) { const float x0 = bf2f(XBC[row * 1024 + chn[q]]);
            const float y = cw[q][0] * h3[q] + cw[q][1] * h2[q] + cw[q][2] * h1[q] + cw[q][3] * x0 + cb[q];
            h3[q] = h2[q]; h2[q] = h1[q]; h1[q] = x0; cv[q] = siluf_(y); }
        const float dt = softplusf_(SM[row * 160 + 128 + h] + dtb), dA = __expf(dt * ah);
        const float zz = bf2f(Z[row * 512 + h * 64 + lane]);
        lds[lane] = cv[1]; lds[64 + lane] = cv[2]; lds[128 + lane] = cv[3]; lds[192 + lane] = cv[4];
        WAVE_LDS_SYNC();
        const float xd = cv[0] * dt; float y = 0.f;
#pragma unroll
        for (int n = 0; n < 128; ++n) { S[n] = S[n] * dA + xd * lds[n]; y += S[n] * lds[128 + n]; }
        y += dsk * cv[0];
        Z[row * 512 + h * 64 + lane] = f2bf(y * siluf_(zz));
        WAVE_LDS_SYNC();
    }
}
__device__ void gla_scan_naive(const Params& p, int l, int unit, LAS float* lds, int TIDX) {
    const int eh = unit & 1, bh = unit >> 1, b = bh >> 2, h = bh & 3, lane = TIDX & 63;
    const bf16_t* GQ = (const bf16_t*)(p.ws + OFF_GQ); const bf16_t* GK = (const bf16_t*)(p.ws + OFF_GK); const float* SM = (const float*)(p.ws + OFF_SMALL);
    bf16_t* GV = (bf16_t*)(p.ws + OFF_Y3) + (size_t)2 * T * 512;
    float up[16];
#pragma unroll
    for (int r = 0; r < 16; ++r) up[r] = p.in[I_GKUP][((size_t)l * 16 + r) * 256 + h * 64 + lane];
    const float gb = p.in[I_GKB][l * 256 + h * 64 + lane];
    float S[64];
#pragma unroll
    for (int d = 0; d < 64; ++d) S[d] = 0.f;
    const size_t r0 = (size_t)b * SEQ; const int e = h * 128 + eh * 64 + lane;
    for (int t = 0; t < SEQ; ++t) {
        const size_t row = r0 + t;
        float gp = gb;
#pragma unroll
        for (int r = 0; r < 16; ++r) gp += SM[row * 160 + 136 + r] * up[r];
        const float ls = fminf(gp, 0.f) - log1pf(__expf(-fabsf(gp)));
        const float alpha = __expf(ls * (1.f / 16.f));
        const float q = bf2f(GQ[row * 256 + h * 64 + lane]) * 0.125f, k = bf2f(GK[row * 256 + h * 64 + lane]);
        const float v = bf2f(GV[row * 512 + e]);
        lds[lane] = alpha; lds[64 + lane] = k; lds[128 + lane] = q;
        WAVE_LDS_SYNC();
        float o = 0.f;
#pragma unroll
        for (int d = 0; d < 64; ++d) { S[d] = S[d] * lds[d] + lds[64 + d] * v; o += S[d] * lds[128 + d]; }
        GV[row * 512 + e] = f2bf(o);
        WAVE_LDS_SYNC();
    }
}

typedef float f32x2 __attribute__((ext_vector_type(2)));
template <int CTRL> __device__ __forceinline__ float dpp_f(float x) { return __builtin_bit_cast(float, __builtin_amdgcn_update_dpp(0, __builtin_bit_cast(int, x), CTRL, 0xF, 0xF, true)); }
__device__ __forceinline__ float row16_sum(float x) { x += dpp_f<0xB1>(x); x += dpp_f<0x4E>(x); x += dpp_f<0x141>(x); x += dpp_f<0x140>(x); return x; }
constexpr int RW_TC = 32, RW_VEC_B = RW_TC * 5 * 64 * 4, RW_V_B = RW_TC * 16 * 4, RW_BUF_B = RW_VEC_B + 2 * RW_V_B;
__device__ void rwkv_scan_fast(const Params& p, int l, int unit, LAS unsigned char* lds, int TIDX) {
    const int bh = unit >> 2, rq = unit & 3, b = bh >> 3, h = bh & 7, wave = TIDX >> 6, lane = TIDX & 63;
    const size_t r0 = (size_t)b * SEQ;
    bf16_t* Y = (bf16_t*)(p.ws + OFF_Y3);
    if (wave >= 4) {
        const int lw = wave - 4, ch = h * 64 + lane;
        const bf16_t* RKV = (const bf16_t*)(p.ws + OFF_RKV); const bf16_t* A = (const bf16_t*)(p.ws + OFF_A); const float* DEC = (const float*)(p.ws + OFF_DEC);
        const float mu_r = p.in[I_MU][l * 1664 + ch], mu_k = p.in[I_MU][l * 1664 + 512 + ch], mu_v = p.in[I_MU][l * 1664 + 1024 + ch];
        const float k_k = p.in[I_KK][l * 512 + ch], k_a = p.in[I_KA][l * 512 + ch];
        for (int c = -1; c < SEQ / RW_TC; ++c) {
            if (c >= 1) { LAS const float* yb = (LAS const float*)(lds + ((c - 1) & 1) * RW_BUF_B + RW_VEC_B + RW_V_B);
                const int idx = (lw * 64 + lane) * 2, s = idx >> 4, i = idx & 15;
                *(unsigned*)(Y + (r0 + (size_t)(c - 1) * RW_TC + s) * 512 + h * 64 + rq * 16 + i) = pk2(yb[idx], yb[idx + 1]); }
            if (c + 1 < SEQ / RW_TC) {
                LAS float* vec = (LAS float*)(lds + ((c + 1) & 1) * RW_BUF_B); LAS float* vb = (LAS float*)(lds + ((c + 1) & 1) * RW_BUF_B + RW_VEC_B);
                const int s0 = lw * 8; const size_t row0 = r0 + (size_t)(c + 1) * RW_TC + s0;
                float pr = 0.f, pk = 0.f, pv = 0.f;
                if ((row0 & (SEQ - 1)) != 0) { pr = bf2f(RKV[(row0 - 1) * 1536 + ch]); pk = bf2f(RKV[(row0 - 1) * 1536 + 512 + ch]); pv = bf2f(RKV[(row0 - 1) * 1536 + 1024 + ch]); }
                float cr[8], ck[8], cv[8], ca[8], cw[8];
#pragma unroll
                for (int i = 0; i < 8; ++i) { const size_t row = row0 + i; cr[i] = bf2f(RKV[row * 1536 + ch]); ck[i] = bf2f(RKV[row * 1536 + 512 + ch]); cv[i] = bf2f(RKV[row * 1536 + 1024 + ch]);
                    ca[i] = bf2f(A[row * 512 + ch]); cw[i] = DEC[row * 512 + ch]; }
#pragma unroll
                for (int i = 0; i < 8; ++i) {
                    const float r = cr[i] + mu_r * (pr - cr[i]), k = ck[i] + mu_k * (pk - ck[i]), v = cv[i] + mu_v * (pv - cv[i]);
                    pr = cr[i]; pk = ck[i]; pv = cv[i];
                    const float kkj = k * k_k; const float n2 = wave_sum(kkj * kkj); const float kkn = kkj / fmaxf(sqrtf(n2), 1e-12f);
                    const float a = ca[i]; const float kt = k * (1.f + (a - 1.f) * k_a), bb = kkn * a;
                    LAS float* d = vec + (s0 + i) * 320;
                    d[lane] = cw[i]; d[64 + lane] = kkn; d[128 + lane] = bb; d[192 + lane] = kt; d[256 + lane] = r;
                    if ((lane >> 4) == rq) vb[(s0 + i) * 16 + (lane & 15)] = v;
                }
            }
            __syncthreads();
        }
        { constexpr int c = SEQ / RW_TC; LAS const float* yb = (LAS const float*)(lds + ((c - 1) & 1) * RW_BUF_B + RW_VEC_B + RW_V_B);
          const int idx = (lw * 64 + lane) * 2, s = idx >> 4, i = idx & 15;
          *(unsigned*)(Y + (r0 + (size_t)(c - 1) * RW_TC + s) * 512 + h * 64 + rq * 16 + i) = pk2(yb[idx], yb[idx + 1]); }
    } else {
        const int rl = wave * 4 + (lane >> 4), cq = lane & 15;
        f32x2 S0 = (f32x2){0.f, 0.f}, S1 = (f32x2){0.f, 0.f};
        __syncthreads();
        for (int c = 0; c < SEQ / RW_TC; ++c) {
            LAS const unsigned char* buf = lds + (c & 1) * RW_BUF_B;
            LAS const float* vb = (LAS const float*)(buf + RW_VEC_B); LAS float* yb = (LAS float*)(buf + RW_VEC_B + RW_V_B);
#pragma unroll 4
            for (int s = 0; s < RW_TC; ++s) {
                LAS const f32x4* q = (LAS const f32x4*)(buf + s * 1280) + cq;
                const f32x4 w4 = q[0], k4 = q[16], b4 = q[32], t4 = q[48], r4 = q[64];
                const float v = vb[s * 16 + rl];
                f32x2 sp = S0 * (f32x2){k4[0], k4[1]} + S1 * (f32x2){k4[2], k4[3]};
                const float sa = -row16_sum(sp[0] + sp[1]);
                S0 = S0 * (f32x2){w4[0], w4[1]} + (f32x2){b4[0], b4[1]} * sa + (f32x2){t4[0], t4[1]} * v;
                S1 = S1 * (f32x2){w4[2], w4[3]} + (f32x2){b4[2], b4[3]} * sa + (f32x2){t4[2], t4[3]} * v;
                f32x2 yp = S0 * (f32x2){r4[0], r4[1]} + S1 * (f32x2){r4[2], r4[3]};
                const float y = row16_sum(yp[0] + yp[1]);
                if (cq == 0) yb[s * 16 + rl] = y;
            }
            __syncthreads();
        }
    }
}
__device__ void scans_naive_phase(const Params& p, int l, LAS unsigned char* lds, int TIDX, int BIDX) {
    const int wave = TIDX >> 6;
    LAS float* wl = (LAS float*)(lds + wave * 4096);
    if (BIDX < 128) { rwkv_scan_fast(p, l, BIDX, lds, TIDX); return; }
    const int u = BIDX - 128;
    if (wave != 0) return;
    if (u < 32) mamba2_scan_naive(p, l, u, wl, TIDX);
    else if (u < 64) gla_scan_naive(p, l, u - 32, wl, TIDX);
}
__device__ void post_phase(const Params& p, int l, int TIDX, int BIDX) {
    const int lane = TIDX & 63, gw = BIDX * 8 + (TIDX >> 6), NGW = gridDim.x * 8;
    const bf16_t* RKV = (const bf16_t*)(p.ws + OFF_RKV); const bf16_t* A = (const bf16_t*)(p.ws + OFF_A);
    bf16_t* Y0 = (bf16_t*)(p.ws + OFF_Y3); bf16_t* Y1 = Y0 + (size_t)T * 512; bf16_t* Y2 = Y1 + (size_t)T * 512;
    const int c0 = lane * 8;
    float mur[8], muk[8], muv[8], kA[8], rk[8], lg[8], lb[8], nw1[8], nw2[8];
#pragma unroll
    for (int e = 0; e < 8; ++e) { const int c = c0 + e;
        mur[e] = p.in[I_MU][l * 1664 + c]; muk[e] = p.in[I_MU][l * 1664 + 512 + c]; muv[e] = p.in[I_MU][l * 1664 + 1024 + c];
        kA[e] = p.in[I_KA][l * 512 + c]; rk[e] = p.in[I_RK][l * 512 + c]; lg[e] = p.in[I_LNG][l * 512 + c]; lb[e] = p.in[I_LNB][l * 512 + c];
        nw1[e] = p.in[I_M2NW][l * 512 + c]; nw2[e] = p.in[I_GNW][l * 128 + (c & 127)]; }
    for (int row = gw; row < T; row += NGW) {
        const bool first = (row & (SEQ - 1)) == 0;
        float y[8], r[8], k[8], v[8], a[8];
        { const u32x4 yy = *(const u32x4*)(Y0 + (size_t)row * 512 + c0); const u32x4 aa = *(const u32x4*)(A + (size_t)row * 512 + c0);
          const u32x4 rr = *(const u32x4*)(RKV + (size_t)row * 1536 + c0), kk = *(const u32x4*)(RKV + (size_t)row * 1536 + 512 + c0), vv = *(const u32x4*)(RKV + (size_t)row * 1536 + 1024 + c0);
          u32x4 rp = (u32x4){0, 0, 0, 0}, kp = rp, vp = rp;
          if (!first) { rp = *(const u32x4*)(RKV + (size_t)(row - 1) * 1536 + c0); kp = *(const u32x4*)(RKV + (size_t)(row - 1) * 1536 + 512 + c0); vp = *(const u32x4*)(RKV + (size_t)(row - 1) * 1536 + 1024 + c0); }
#pragma unroll
          for (int q = 0; q < 4; ++q) {
              y[2 * q] = lo_bf(yy[q]); y[2 * q + 1] = hi_bf(yy[q]); a[2 * q] = lo_bf(aa[q]); a[2 * q + 1] = hi_bf(aa[q]);
              float x0 = lo_bf(rr[q]), x1 = hi_bf(rr[q]); r[2 * q] = x0 + mur[2 * q] * (lo_bf(rp[q]) - x0); r[2 * q + 1] = x1 + mur[2 * q + 1] * (hi_bf(rp[q]) - x1);
              x0 = lo_bf(kk[q]); x1 = hi_bf(kk[q]); k[2 * q] = x0 + muk[2 * q] * (lo_bf(kp[q]) - x0); k[2 * q + 1] = x1 + muk[2 * q + 1] * (hi_bf(kp[q]) - x1);
              x0 = lo_bf(vv[q]); x1 = hi_bf(vv[q]); v[2 * q] = x0 + muv[2 * q] * (lo_bf(vp[q]) - x0); v[2 * q + 1] = x1 + muv[2 * q + 1] * (hi_bf(vp[q]) - x1); } }
        float s = 0.f, bs = 0.f;
#pragma unroll
        for (int e = 0; e < 8; ++e) { s += y[e]; bs += r[e] * (k[e] * (1.f + (a[e] - 1.f) * kA[e])) * rk[e]; }
        s += __shfl_xor(s, 1); s += __shfl_xor(s, 2); s += __shfl_xor(s, 4);
        bs += __shfl_xor(bs, 1); bs += __shfl_xor(bs, 2); bs += __shfl_xor(bs, 4);
        const float mean = s * (1.f / 64.f); float s2 = 0.f;
#pragma unroll
        for (int e = 0; e < 8; ++e) { const float d = y[e] - mean; s2 += d * d; }
        s2 += __shfl_xor(s2, 1); s2 += __shfl_xor(s2, 2); s2 += __shfl_xor(s2, 4);
        const float rstd = rsqrtf(s2 * (1.f / 64.f) + 64e-5f);
        { float o[8];
#pragma unroll
          for (int e = 0; e < 8; ++e) o[e] = (y[e] - mean) * rstd * lg[e] + lb[e] + bs * v[e];
          u32x4 w; w.x = pk2(o[0], o[1]); w.y = pk2(o[2], o[3]); w.z = pk2(o[4], o[5]); w.w = pk2(o[6], o[7]);
          *(u32x4*)(Y0 + (size_t)row * 512 + c0) = w; }
        { const u32x4 yy = *(const u32x4*)(Y1 + (size_t)row * 512 + c0); float q2 = 0.f;
#pragma unroll
          for (int q = 0; q < 4; ++q) { y[2 * q] = lo_bf(yy[q]); y[2 * q + 1] = hi_bf(yy[q]); q2 += y[2 * q] * y[2 * q] + y[2 * q + 1] * y[2 * q + 1]; }
          q2 += __shfl_xor(q2, 1); q2 += __shfl_xor(q2, 2); q2 += __shfl_xor(q2, 4); q2 += __shfl_xor(q2, 8); q2 += __shfl_xor(q2, 16);
          const float rs = rsqrtf(q2 * (1.f / 256.f) + 1e-5f);
          u32x4 w; w.x = pk2(y[0] * rs * nw1[0], y[1] * rs * nw1[1]); w.y = pk2(y[2] * rs * nw1[2], y[3] * rs * nw1[3]); w.z = pk2(y[4] * rs * nw1[4], y[5] * rs * nw1[5]); w.w = pk2(y[6] * rs * nw1[6], y[7] * rs * nw1[7]);
          *(u32x4*)(Y1 + (size_t)row * 512 + c0) = w; }
        { const u32x4 yy = *(const u32x4*)(Y2 + (size_t)row * 512 + c0); float q2 = 0.f;
#pragma unroll
          for (int q = 0; q < 4; ++q) { y[2 * q] = lo_bf(yy[q]); y[2 * q + 1] = hi_bf(yy[q]); q2 += y[2 * q] * y[2 * q] + y[2 * q + 1] * y[2 * q + 1]; }
          q2 += __shfl_xor(q2, 1); q2 += __shfl_xor(q2, 2); q2 += __shfl_xor(q2, 4); q2 += __shfl_xor(q2, 8);
          const float rs = rsqrtf(q2 * (1.f / 128.f) + 1e-5f);
          u32x4 w; w.x = pk2(y[0] * rs * nw2[0], y[1] * rs * nw2[1]); w.y = pk2(y[2] * rs * nw2[2], y[3] * rs * nw2[3]); w.z = pk2(y[4] * rs * nw2[4], y[5] * rs * nw2[5]); w.w = pk2(y[6] * rs * nw2[6], y[7] * rs * nw2[7]);
          *(u32x4*)(Y2 + (size_t)row * 512 + c0) = w; }
    }
}

constexpr int NPHASE = 18;
#ifndef PHM
#define PHM 1023
#endif
__global__ __launch_bounds__(512, 2) void mega(Params p) {
    extern __shared__ __attribute__((aligned(16))) unsigned char shm[];
    LAS unsigned char* lds = (LAS unsigned char*)shm;
    cg::grid_group grid = cg::this_grid();
    for (int ph = p.ph_lo; ph < p.ph_hi; ++ph) {
        const int TIDX = tid_opaque(), BIDX = bid_opaque();
        if (ph == 0) { if (PHM & 1) { wprep(p, 0, lds, TIDX, BIDX); ada_phase(p, lds, TIDX, BIDX); } }
        else if (ph == 1) { if (PHM & 2) ln1_phase(p, 0, p.in[I_X], TIDX, BIDX); }
        else {
            const int l = (ph - 2) >> 3, s = (ph - 2) & 7;
            const float* xin = l == 0 ? p.in[I_X] : p.out;
            pg8::StaticOrder S;
            if (s == 0 && (PHM & 4)) { pg8::Gemm g{(const bf16_t*)(p.ws + OFF_H), (const bf16_t*)(p.ws + OFF_WT1), T, 4352, 1024, 1 << 30, 0};
                S.init(g.M, g.N, gridDim.x, BIDX); Epi<0> E{p.ws, nullptr, nullptr, nullptr}; pg8::gemm_phase(lds, g, S, E, TIDX); }
            else if (s == 1 && (PHM & 8)) { rwkv_prep_phase(p, l, lds, TIDX, BIDX); }
            else if (s == 2 && (PHM & 16)) { scans_naive_phase(p, l, lds, TIDX, BIDX); }
            else if (s == 3 && (PHM & 32)) { post_phase(p, l, TIDX, BIDX); }
            else if (s == 4 && (PHM & 64)) { pg8::Gemm g{(const bf16_t*)(p.ws + OFF_H), (const bf16_t*)(p.ws + OFF_WT1) + (size_t)4352 * 1024, T, 4096, 1024, 1 << 30, 0};
                S.init(g.M, g.N, gridDim.x, BIDX); Epi<1> E{p.ws, nullptr, nullptr, nullptr}; pg8::gemm_phase(lds, g, S, E, TIDX); }
            else if (s == 5 && (PHM & 128)) { pg8::Gemm g{(const bf16_t*)(p.ws + OFF_Y3), (const bf16_t*)(p.ws + OFF_WT2), T, 3072, 512, 4, (size_t)T * 512 * 2};
                S.init(g.M, g.N, gridDim.x, BIDX); Epi<2> E{p.ws, nullptr, nullptr, nullptr}; pg8::gemm_phase(lds, g, S, E, TIDX); }
            else if (s == 6 && (PHM & 256)) { pg8::Gemm g{(const bf16_t*)(p.ws + OFF_GATES), (const bf16_t*)(p.ws + OFF_WT3), T, 1024, 3072, 1 << 30, 0};
                S.init(g.M, g.N, gridDim.x, BIDX); Epi<3> E{p.ws, xin, (const float*)(p.ws + OFF_MOD) + (size_t)l * 4 * 3072, p.out}; pg8::gemm_phase(lds, g, S, E, TIDX); }
            else if (s == 7 && (PHM & 512)) { lnpost_phase(p, l, TIDX, BIDX); if (l == 0) wprep(p, 1, lds, TIDX, BIDX); }
        }
        if (ph + 1 < p.ph_hi) grid.sync();
    }
}

extern "C" void kernel_launch(void* const* d_in, const int* in_sizes, int n_in, void* d_out, int out_size, void* d_ws, size_t ws_size, hipStream_t stream) {
    constexpr int LDS_BYTES = 131072;
    static int grid = 0;
    if (grid == 0) {
        if (n_in != 28 || out_size != T * DM || ws_size < WS_END) { fprintf(stderr, "kernel_launch: unexpected shapes / workspace (%zu < %zu)\n", ws_size, (size_t)WS_END); grid = -1; return; }
        int dev = 0, cus = 0, per_cu = 0;
        hipGetDevice(&dev); hipDeviceGetAttribute(&cus, hipDeviceAttributeMultiprocessorCount, dev);
        if (hipFuncSetAttribute((const void*)mega, hipFuncAttributeMaxDynamicSharedMemorySize, LDS_BYTES) != hipSuccess) { fprintf(stderr, "hipFuncSetAttribute failed\n"); grid = -1; return; }
        if (hipOccupancyMaxActiveBlocksPerMultiprocessor(&per_cu, (const void*)mega, 512, LDS_BYTES) != hipSuccess || per_cu < 1) per_cu = 1;
        (void)hipGetLastError();
        grid = cus * 1;
        if (grid != 256) { fprintf(stderr, "kernel_launch: built for 256 CUs\n"); grid = -1; return; }
    }
    if (grid < 0) return;
    Params p{};
    for (int i = 0; i < 28; ++i) p.in[i] = (const float*)d_in[i];
    p.out = (float*)d_out; p.ws = (unsigned char*)d_ws;
#if N_LAUNCH_MODE == 1
    p.ph_lo = 0; p.ph_hi = NPHASE;
    void* args[] = {&p};
    hipError_t e = hipLaunchCooperativeKernel((const void*)mega, dim3(grid), dim3(512), args, LDS_BYTES, stream);
    if (e != hipSuccess) fprintf(stderr, "cooperative launch failed: %s (grid %d)\n", hipGetErrorString(e), grid);
#else
    for (int ph = 0; ph < NPHASE; ++ph) { p.ph_lo = ph; p.ph_hi = ph + 1; hipLaunchKernelGGL(mega, dim3(grid), dim3(512), LDS_BYTES, stream, p); }
#endif
}
```

```cpp
#include <hip/hip_runtime.h>
#include <hip/hip_cooperative_groups.h>
#include <cstdio>
namespace cg = cooperative_groups;

#ifndef N_LAUNCH_MODE
#define N_LAUNCH_MODE 1
#endif

#define LAS __attribute__((address_space(3)))
typedef unsigned short bf16_t;
typedef short bf16x8 __attribute__((ext_vector_type(8)));
typedef float f32x4 __attribute__((ext_vector_type(4)));
typedef unsigned u32x4 __attribute__((ext_vector_type(4)));
typedef unsigned u32x2 __attribute__((ext_vector_type(2)));

constexpr int T = 32768, SEQ = 8192, DM = 1024, NB = 4;
constexpr int INW = 8344;
constexpr float ALPHA_DN = 1.4142135623730951f;

constexpr size_t SZ_WT1 = (size_t)8448 * 1024 * 2, SZ_WT2 = (size_t)3072 * 512 * 2, SZ_WT3 = (size_t)1024 * 3072 * 2, SZ_MOD = (size_t)2 * 4 * 3072 * 4;
constexpr size_t OFF_WT1 = 0, OFF_WT2 = OFF_WT1 + SZ_WT1, OFF_WT3 = OFF_WT2 + SZ_WT2, OFF_MOD = OFF_WT3 + SZ_WT3;
constexpr size_t OFF_H = OFF_MOD + SZ_MOD;
constexpr size_t OFF_Y3 = OFF_H + (size_t)T * 1024 * 2;
constexpr size_t OFF_RKV = OFF_Y3 + (size_t)3 * T * 512 * 2;
constexpr size_t OFF_XBC = OFF_RKV + (size_t)T * 1536 * 2;
constexpr size_t OFF_GQ = OFF_XBC + (size_t)T * 1024 * 2;
constexpr size_t OFF_GK = OFF_GQ + (size_t)T * 256 * 2;
constexpr size_t OFF_SMALL = OFF_GK + (size_t)T * 256 * 2;
constexpr size_t OFF_A = OFF_SMALL + (size_t)T * 160 * 4;
constexpr size_t OFF_DEC = OFF_A + (size_t)T * 512 * 2;
constexpr size_t WS_END = OFF_DEC + (size_t)T * 512 * 4;
constexpr size_t OFF_GATES = OFF_RKV;
static_assert(OFF_GK + (size_t)T * 256 * 2 - OFF_RKV == (size_t)T * 3072 * 2, "gates alias");

struct Params { const float* in[28]; float* out; unsigned char* ws; int ph_lo, ph_hi; };
enum { I_X = 0, I_C, I_ADAW, I_ADAB, I_WIN, I_MU, I_W0, I_WUP, I_A0, I_AUP, I_KK, I_KA, I_RK, I_LNG, I_LNB, I_CONVW, I_CONVB, I_DTB, I_ALOG, I_DSKIP,
       I_M2NW, I_GKUP, I_GKB, I_GNW, I_WBR, I_WOUT, I_PG, I_PB };

__device__ __forceinline__ float bf2f(bf16_t v) { return __uint_as_float(((unsigned)v) << 16); }
__device__ __forceinline__ bf16_t f2bf(float f) { unsigned u = __float_as_uint(f); u += 0x7FFFu + ((u >> 16) & 1u); return (bf16_t)(u >> 16); }
__device__ __forceinline__ unsigned pk2(float lo, float hi) { return (unsigned)f2bf(lo) | ((unsigned)f2bf(hi) << 16); }
__device__ __forceinline__ float lo_bf(unsigned w) { return __uint_as_float(w << 16); }
__device__ __forceinline__ float hi_bf(unsigned w) { return __uint_as_float(w & 0xFFFF0000u); }
__device__ __forceinline__ float sigmoidf_(float x) { return 1.0f / (1.0f + __expf(-x)); }
__device__ __forceinline__ float siluf_(float x) { return x / (1.0f + __expf(-x)); }
__device__ __forceinline__ float softplusf_(float x) { return x > 20.f ? x : log1pf(__expf(x)); }
__device__ __forceinline__ float wave_sum(float v) {
#pragma unroll
    for (int o = 1; o < 64; o <<= 1) v += __shfl_xor(v, o);
    return v;
}
__device__ __forceinline__ int tid_opaque() { int t = threadIdx.x; asm volatile("" : "+v"(t)); return t; }
__device__ __forceinline__ int bid_opaque() { int t = blockIdx.x; asm volatile("" : "+s"(t)); return t; }
#define WAVE_LDS_SYNC() do { asm volatile("s_waitcnt lgkmcnt(0)" ::: "memory"); __builtin_amdgcn_wave_barrier(); } while (0)

namespace pg8 {
constexpr int BM = 256, BK = 64, HALF = 128, HTB = HALF * BK * 2, STAGE_BYTES = 8 * HTB, NXCD = 8, WGM = 8;
__host__ __device__ __forceinline__ int lds_byte(int r, int c) { const int st = (r >> 4) * 2 + (c >> 5), rr = r & 15, cc = c & 31, ob = rr * 64 + cc * 2; return st * 1024 + (ob ^ (((ob >> 9) & 1) << 5)); }
__host__ __device__ __forceinline__ void stage_rc(int b, int& R, int& C) { const int st = b / 1024, sb = b % 1024, swz = sb ^ (((sb >> 9) & 1) << 5); R = (st >> 1) * 16 + swz / 64; C = (st & 1) * 32 + (swz % 64) / 2; }
__host__ __device__ __forceinline__ int perm32(int rho) { const int n = rho >> 4, i = rho & 15; return 8 * (i >> 2) + 4 * n + (i & 3); }
struct Unit { int pm, pn; };
struct Gemm { const bf16_t* A; const bf16_t* Bt; int M, N, K; int adiv; size_t astride; };
struct StaticOrder {
    int nM, nN, nwg, G, c;
    __device__ void init(int M, int N, int G_, int c_) { nM = M / BM; nN = N / BM; nwg = nM * nN; G = G_; c = c_; }
    __device__ bool next(int i, Unit& u) const {
        const long L = (long)i * G + c; if (L >= nwg) return false;
        int wgid = (int)L; { const int q = nwg / NXCD, r = nwg % NXCD, xcd = wgid % NXCD, off = wgid / NXCD; wgid = (xcd < r ? xcd * (q + 1) : r * (q + 1) + (xcd - r) * q) + off; }
        const int nig = WGM * nN, gid = wgid / nig, fm = gid * WGM, gsz = (nM - fm) < WGM ? (nM - fm) : WGM;
        u.pm = fm + ((wgid % nig) % gsz); u.pn = (wgid % nig) / gsz; return true;
    }
};
__device__ __forceinline__ unsigned cvt_pk_bf16(float lo, float hi) { unsigned r; asm volatile("v_cvt_pk_bf16_f32 %0, %1, %2" : "=v"(r) : "v"(lo), "v"(hi)); return r; }

template <class Epi>
__device__ __forceinline__ void gemm_phase(LAS unsigned char* lds, const Gemm g, const StaticOrder& S, const Epi& E, int TIDX) {
    const int tid = TIDX, wid = __builtin_amdgcn_readfirstlane(tid >> 6), lane = tid & 63, wr = wid >> 2, wc = wid & 3, fr = lane & 15, fq = lane >> 4;
    const int K = g.K, nt = K / BK;
    unsigned voffA[2], voffB[2];
#pragma unroll
    for (int i = 0; i < 2; ++i) { int R, C; stage_rc(tid * 16 + i * 8192, R, C); const int Rb = (R & ~31) + perm32(R & 31);
        voffA[i] = (unsigned)(R * K + C) * 2u; voffB[i] = (unsigned)(Rb * K + C) * 2u; }
    const size_t kstep = (size_t)(BK * 2);
    const size_t hstep = (size_t)HALF * K * 2;
    const size_t tstep = 2 * hstep;
    const unsigned ldsw = (unsigned)wid * 1024u;
    const int aoff = lds_byte(wr * 64 + fr, fq * 8), boff = lds_byte(wc * 32 + fr, fq * 8);
#define PG8_SA(b, h) (((b) * 2 + (h)) * HTB)
#define PG8_SB(b, h) ((4 + (b) * 2 + (h)) * HTB)
#define PG8_STAGE(bufoff, gbase, voff) do { _Pragma("unroll") for (int _i = 0; _i < 2; ++_i) \
        __builtin_amdgcn_global_load_lds((const unsigned*)((const char*)(gbase) + (voff)[_i]), (LAS unsigned*)(lds + (bufoff) + ldsw + _i * 8192), 16, 0, 0); } while (0)
#define PG8_LDA(dst, b, h) do { _Pragma("unroll") for (int m = 0; m < 4; ++m) _Pragma("unroll") for (int k = 0; k < 2; ++k) dst[m][k] = *(const LAS bf16x8*)(lds + PG8_SA(b, h) + aoff + m * 2048 + k * 1024); } while (0)
#define PG8_LDB(dst, b, h) do { _Pragma("unroll") for (int n = 0; n < 2; ++n) _Pragma("unroll") for (int k = 0; k < 2; ++k) dst[n][k] = *(const LAS bf16x8*)(lds + PG8_SB(b, h) + boff + n * 2048 + k * 1024); } while (0)
#define PG8_MMA(ai, bj, At, Bt) do { __builtin_amdgcn_s_setprio(1); _Pragma("unroll") for (int m = 0; m < 4; ++m) _Pragma("unroll") for (int n = 0; n < 2; ++n) _Pragma("unroll") for (int k = 0; k < 2; ++k) \
        acc[ai][bj][m][n] = __builtin_amdgcn_mfma_f32_16x16x32_bf16(Bt[n][k], At[m][k], acc[ai][bj][m][n], 0, 0, 0); __builtin_amdgcn_s_setprio(0); } while (0)
#define PG8_WAIT_V(n) asm volatile("s_waitcnt vmcnt(" #n ")" ::: "memory")
#define PG8_WAIT_L(n) asm volatile("s_waitcnt lgkmcnt(" #n ")" ::: "memory")
#define PG8_BAR __builtin_amdgcn_s_barrier()
#define PG8_SCHED __builtin_amdgcn_sched_barrier(0)
    Unit cur, nxt; int ui = 0;
    if (!S.next(0, cur)) return;
    f32x4 acc[2][2][4][2];
#pragma unroll
    for (int a = 0; a < 2; ++a)
#pragma unroll
        for (int b = 0; b < 2; ++b)
#pragma unroll
            for (int m = 0; m < 4; ++m)
#pragma unroll
                for (int n = 0; n < 2; ++n) acc[a][b][m][n] = (f32x4){0.f, 0.f, 0.f, 0.f};
    bf16x8 At[4][2], B0[2][2], B1[2][2];
    const char* cA = (const char*)g.A + (size_t)(cur.pn / g.adiv) * g.astride + (size_t)cur.pm * tstep; const char* cB = (const char*)g.Bt + (size_t)cur.pn * tstep;
    PG8_STAGE(PG8_SB(0, 0), cB, voffB); PG8_STAGE(PG8_SA(0, 0), cA, voffA); PG8_STAGE(PG8_SB(0, 1), cB + hstep, voffB); PG8_STAGE(PG8_SA(0, 1), cA + hstep, voffA);
    if (wr == 1) PG8_BAR;
    PG8_WAIT_V(4); PG8_BAR;
    PG8_STAGE(PG8_SB(1, 0), cB + kstep, voffB); PG8_STAGE(PG8_SA(1, 0), cA + kstep, voffA); PG8_STAGE(PG8_SB(1, 1), cB + hstep + kstep, voffB);
    PG8_WAIT_V(6); PG8_BAR;
    for (;;) {
        const bool has_next = S.next(ui + 1, nxt);
        const char* nA = has_next ? (const char*)g.A + (size_t)(nxt.pn / g.adiv) * g.astride + (size_t)nxt.pm * tstep : cA; const char* nB = has_next ? (const char*)g.Bt + (size_t)nxt.pn * tstep : cB;
        for (int t = 0; t < nt; t += 2) {
            const bool last = (t == nt - 2);
            const char* a1 = cA + (size_t)(t + 1) * kstep;
            const char* a2 = last ? nA : cA + (size_t)(t + 2) * kstep; const char* b2 = last ? nB : cB + (size_t)(t + 2) * kstep;
            const char* a3 = a2 + kstep; const char* b3 = b2 + kstep;
            PG8_LDB(B0, 0, 0); PG8_SCHED; PG8_LDA(At, 0, 0); PG8_STAGE(PG8_SA(1, 1), a1 + hstep, voffA);
            PG8_WAIT_L(8); PG8_BAR; PG8_WAIT_L(0); PG8_MMA(0, 0, At, B0); PG8_BAR; PG8_SCHED;
            PG8_LDB(B1, 0, 1); PG8_STAGE(PG8_SB(0, 0), b2, voffB);
            PG8_BAR; PG8_WAIT_L(0); PG8_MMA(0, 1, At, B1); PG8_BAR;
            PG8_LDA(At, 0, 1); PG8_STAGE(PG8_SA(0, 0), a2, voffA);
            PG8_BAR; PG8_WAIT_L(0); PG8_MMA(1, 0, At, B0); PG8_BAR; PG8_SCHED;
            PG8_STAGE(PG8_SB(0, 1), b2 + hstep, voffB);
            PG8_WAIT_V(6); PG8_BAR; PG8_MMA(1, 1, At, B1); PG8_BAR;
            PG8_LDB(B0, 1, 0); PG8_SCHED; PG8_LDA(At, 1, 0); PG8_STAGE(PG8_SA(0, 1), a2 + hstep, voffA);
            PG8_WAIT_L(8); PG8_BAR; PG8_WAIT_L(0); PG8_MMA(0, 0, At, B0); PG8_BAR; PG8_SCHED;
            PG8_LDB(B1, 1, 1); PG8_STAGE(PG8_SB(1, 0), b3, voffB);
            PG8_BAR; PG8_WAIT_L(0); PG8_MMA(0, 1, At, B1); PG8_BAR;
            PG8_LDA(At, 1, 1); PG8_STAGE(PG8_SA(1, 0), a3, voffA);
            PG8_BAR; PG8_WAIT_L(0); PG8_MMA(1, 0, At, B0); PG8_BAR; PG8_SCHED;
            PG8_STAGE(PG8_SB(1, 1), b3 + hstep, voffB);
            PG8_WAIT_V(6); PG8_BAR; PG8_MMA(1, 1, At, B1); PG8_BAR;
        }
        E(acc, cur, wr, wc, fr, fq);
        if (!has_next) break;
#pragma unroll
        for (int a = 0; a < 2; ++a)
#pragma unroll
            for (int b = 0; b < 2; ++b)
#pragma unroll
                for (int m = 0; m < 4; ++m)
#pragma unroll
                    for (int n = 0; n < 2; ++n) acc[a][b][m][n] = (f32x4){0.f, 0.f, 0.f, 0.f};
        cur = nxt; cA = nA; cB = nB; ++ui;
    }
    PG8_WAIT_V(0);
    if (wr == 0) PG8_BAR;
    PG8_BAR;
#undef PG8_SA
#undef PG8_SB
#undef PG8_STAGE
#undef PG8_LDA
#undef PG8_LDB
#undef PG8_MMA
#undef PG8_WAIT_V
#undef PG8_WAIT_L
#undef PG8_BAR
#undef PG8_SCHED
}
}

template <int MODE> struct Epi {
    unsigned char* ws; const float* xin; const float* gate; float* out;
    __device__ __forceinline__ void operator()(const f32x4 (&acc)[2][2][4][2], const pg8::Unit& u, int wr, int wc, int fr, int fq) const {
        const int pn = u.pn;
        bf16_t* base = nullptr; int ld = 0, c0 = 0;
        if (MODE == 0) {
            if (pn < 6) { base = (bf16_t*)(ws + OFF_RKV); ld = 1536; c0 = pn * 256; }
            else if (pn < 10) { base = (bf16_t*)(ws + OFF_XBC); ld = 1024; c0 = (pn - 6) * 256; }
            else if (pn < 12) { base = (bf16_t*)(ws + OFF_Y3) + (size_t)T * 512; ld = 512; c0 = (pn - 10) * 256; }
            else if (pn == 12) { base = (bf16_t*)(ws + OFF_GQ); ld = 256; c0 = 0; }
            else if (pn == 13) { base = (bf16_t*)(ws + OFF_GK); ld = 256; c0 = 0; }
            else if (pn < 16) { base = (bf16_t*)(ws + OFF_Y3) + (size_t)2 * T * 512; ld = 512; c0 = (pn - 14) * 256; }
        } else if (MODE == 1) {
            if (pn < 2) { base = (bf16_t*)(ws + OFF_Y3); ld = 512; c0 = pn * 256; }
            else if (pn < 4) { base = (bf16_t*)(ws + OFF_Y3) + (size_t)2 * T * 512; ld = 512; c0 = (pn - 2) * 256; }
            else { base = (bf16_t*)(ws + OFF_GATES); ld = 3072; c0 = (pn - 4) * 256; }
        } else if (MODE == 2) { base = (bf16_t*)(ws + OFF_GATES); ld = 3072; c0 = pn * 256; }
#pragma unroll
        for (int ai = 0; ai < 2; ++ai)
#pragma unroll
            for (int m = 0; m < 4; ++m) {
                const int row = u.pm * 256 + ai * 128 + wr * 64 + m * 16 + fr;
#pragma unroll
                for (int bj = 0; bj < 2; ++bj) {
                    const int cl = bj * 128 + wc * 32 + 8 * fq;
                    f32x4 v0 = acc[ai][bj][m][0], v1 = acc[ai][bj][m][1];
                    if (MODE == 0) {
                        if (pn < 16) {
                            u32x4 w; w.x = pg8::cvt_pk_bf16(v0[0], v0[1]); w.y = pg8::cvt_pk_bf16(v0[2], v0[3]); w.z = pg8::cvt_pk_bf16(v1[0], v1[1]); w.w = pg8::cvt_pk_bf16(v1[2], v1[3]);
                            *(u32x4*)(base + (size_t)row * ld + c0 + cl) = w;
                        } else if (cl < 160) {
                            float* d = (float*)(ws + OFF_SMALL) + (size_t)row * 160 + cl;
                            *(f32x4*)d = v0; *(f32x4*)(d + 4) = v1;
                        }
                    } else if (MODE == 1) {
                        bf16_t* d = base + (size_t)row * ld + c0 + cl;
                        if (pn < 4) {
                            const u32x4 o = *(const u32x4*)d;
                            u32x4 w;
                            w.x = pg8::cvt_pk_bf16(lo_bf(o.x) * siluf_(v0[0]), hi_bf(o.x) * siluf_(v0[1]));
                            w.y = pg8::cvt_pk_bf16(lo_bf(o.y) * siluf_(v0[2]), hi_bf(o.y) * siluf_(v0[3]));
                            w.z = pg8::cvt_pk_bf16(lo_bf(o.z) * siluf_(v1[0]), hi_bf(o.z) * siluf_(v1[1]));
                            w.w = pg8::cvt_pk_bf16(lo_bf(o.w) * siluf_(v1[2]), hi_bf(o.w) * siluf_(v1[3]));
                            *(u32x4*)d = w;
                        } else {
                            u32x4 w;
                            w.x = pg8::cvt_pk_bf16(sigmoidf_(v0[0]), sigmoidf_(v0[1])); w.y = pg8::cvt_pk_bf16(sigmoidf_(v0[2]), sigmoidf_(v0[3]));
                            w.z = pg8::cvt_pk_bf16(sigmoidf_(v1[0]), sigmoidf_(v1[1])); w.w = pg8::cvt_pk_bf16(sigmoidf_(v1[2]), sigmoidf_(v1[3]));
                            *(u32x4*)d = w;
                        }
                    } else if (MODE == 2) {
                        bf16_t* d = base + (size_t)row * ld + c0 + cl;
                        const u32x4 o = *(const u32x4*)d;
                        u32x4 w;
                        w.x = pg8::cvt_pk_bf16(lo_bf(o.x) * v0[0], hi_bf(o.x) * v0[1]); w.y = pg8::cvt_pk_bf16(lo_bf(o.y) * v0[2], hi_bf(o.y) * v0[3]);
                        w.z = pg8::cvt_pk_bf16(lo_bf(o.z) * v1[0], hi_bf(o.z) * v1[1]); w.w = pg8::cvt_pk_bf16(lo_bf(o.w) * v1[2], hi_bf(o.w) * v1[3]);
                        *(u32x4*)d = w;
                    } else {
                        const int col = pn * 256 + cl; const int b = row >> 13;
                        const f32x4 x0 = *(const f32x4*)(xin + (size_t)row * 1024 + col), x1 = *(const f32x4*)(xin + (size_t)row * 1024 + col + 4);
                        const f32x4 g0 = *(const f32x4*)(gate + b * 3072 + 2048 + col), g1 = *(const f32x4*)(gate + b * 3072 + 2048 + col + 4);
                        f32x4 r0, r1;
#pragma unroll
                        for (int j = 0; j < 4; ++j) { r0[j] = ALPHA_DN * x0[j] + (1.f + g0[j]) * v0[j]; r1[j] = ALPHA_DN * x1[j] + (1.f + g1[j]) * v1[j]; }
                        *(f32x4*)(out + (size_t)row * 1024 + col) = r0; *(f32x4*)(out + (size_t)row * 1024 + col + 4) = r1;
                    }
                }
            }
    }
};

__device__ __forceinline__ int wt1_src(int n) {
    if (n < 1536) return n;
    if (n < 2560) return 2176 + (n - 1536);
    if (n < 3072) return 3208 + (n - 2560);
    if (n < 3328) return 3720 + (n - 3072);
    if (n < 3584) return 3976 + (n - 3328);
    if (n < 4096) return 4232 + (n - 3584);
    if (n < 4352) { const int s = n - 4096; if (s < 128) return 1536 + s; if (s < 136) return 3200 + (s - 128); if (s < 152) return 4744 + (s - 136); return -1; }
    const int m = n - 4352;
    if (m < 512) return 1664 + m;
    if (m < 1024) return 4760 + (m - 512);
    return 5272 + (m - 1024);
}
template <bool MAP>
__device__ __forceinline__ void transpose_item(const float* W, int ldw, bf16_t* WT, int ldt, int row_off, int col_off, int nblk, LAS float* scr, int item, int lane) {
    const int kb = item / nblk, nb = item % nblk, k0 = 64 * kb, n0 = 32 * nb;
    int sc = n0 + (lane & 31); if (MAP) sc = wt1_src(sc);
#pragma unroll 8
    for (int i = 0; i < 32; ++i) { const int kk = 2 * i + (lane >> 5); scr[kk * 33 + (lane & 31)] = sc >= 0 ? W[(size_t)(k0 + kk) * ldw + sc] : 0.f; }
    WAVE_LDS_SYNC();
    const int c = lane & 7;
#pragma unroll
    for (int j = 0; j < 4; ++j) { const int n = (lane >> 3) + 8 * j; const LAS float* s = scr + (8 * c) * 33 + n;
        u32x4 o; o.x = pk2(s[0 * 33], s[1 * 33]); o.y = pk2(s[2 * 33], s[3 * 33]); o.z = pk2(s[4 * 33], s[5 * 33]); o.w = pk2(s[6 * 33], s[7 * 33]);
        *(u32x4*)(WT + (size_t)(row_off + n0 + n) * ldt + col_off + k0 + 8 * c) = o; }
    WAVE_LDS_SYNC();
}
__device__ void wprep(const Params& p, int l, LAS unsigned char* lds, int TIDX, int BIDX) {
    const int lane = TIDX & 63, wave = TIDX >> 6;
    LAS float* scr = (LAS float*)(lds + wave * 16384);
    const int gw = BIDX * 8 + wave, NGW = gridDim.x * 8;
    constexpr int I1 = (1024 / 64) * (8448 / 32), I2 = 3 * (512 / 64) * (1024 / 32), I3 = 3 * (1024 / 64) * (1024 / 32);
    bf16_t* WT1 = (bf16_t*)(p.ws + OFF_WT1); bf16_t* WT2 = (bf16_t*)(p.ws + OFF_WT2); bf16_t* WT3 = (bf16_t*)(p.ws + OFF_WT3);
    for (int it = gw; it < I1 + I2 + I3; it += NGW) {
        int r = it;
        if (r < I1) { transpose_item<true>(p.in[I_WIN] + (size_t)l * 1024 * INW, INW, WT1, 1024, 0, 0, 8448 / 32, scr, r, lane); continue; }
        r -= I1;
        if (r < I2) { const int b = r / (I2 / 3), rr = r % (I2 / 3); transpose_item<false>(p.in[I_WBR] + ((size_t)l * 3 + b) * 512 * 1024, 1024, WT2, 512, b * 1024, 0, 1024 / 32, scr, rr, lane); continue; }
        r -= I2;
        { const int j = r / (I3 / 3), rr = r % (I3 / 3); transpose_item<false>(p.in[I_WOUT] + (size_t)l * 1024 * 1024, 1024, WT3, 3072, 0, j * 1024, 1024 / 32, scr, rr, lane); }
    }
}
__device__ void ada_phase(const Params& p, LAS unsigned char* lds, int TIDX, int BIDX) {
    LAS float* red = (LAS float*)lds;
    const int tid = TIDX, kg = tid >> 5, cj = tid & 31;
    float* mod = (float*)(p.ws + OFF_MOD);
    for (int it = BIDX; it < 2 * 96; it += gridDim.x) {
        const int l = it / 96, col = (it % 96) * 32 + cj;
        const float* W = p.in[I_ADAW] + (size_t)l * 1024 * 3072;
        float a0 = 0.f, a1 = 0.f, a2 = 0.f, a3 = 0.f;
        for (int k = kg * 64; k < kg * 64 + 64; ++k) {
            const float w = W[(size_t)k * 3072 + col];
            a0 += siluf_(p.in[I_C][k]) * w; a1 += siluf_(p.in[I_C][1024 + k]) * w; a2 += siluf_(p.in[I_C][2048 + k]) * w; a3 += siluf_(p.in[I_C][3072 + k]) * w;
        }
        red[(kg * 32 + cj) * 4 + 0] = a0; red[(kg * 32 + cj) * 4 + 1] = a1; red[(kg * 32 + cj) * 4 + 2] = a2; red[(kg * 32 + cj) * 4 + 3] = a3;
        __syncthreads();
        if (tid < 128) { const int c2 = tid >> 2, b = tid & 3; float s = 0.f;
            for (int g = 0; g < 16; ++g) s += red[(g * 32 + c2) * 4 + b];
            const int cc = (it % 96) * 32 + c2;
            mod[((size_t)l * 4 + b) * 3072 + cc] = s + p.in[I_ADAB][(size_t)l * 3072 + cc]; }
        __syncthreads();
    }
}
__device__ __forceinline__ void ln_stats(const f32x4 (&v)[4], float& mean, float& rstd, float eps) {
    float s = 0.f;
#pragma unroll
    for (int j = 0; j < 4; ++j) s += (v[j][0] + v[j][1]) + (v[j][2] + v[j][3]);
    mean = wave_sum(s) * (1.f / 1024.f); float s2 = 0.f;
#pragma unroll
    for (int j = 0; j < 4; ++j) { const f32x4 d = v[j] - mean; s2 += (d[0] * d[0] + d[1] * d[1]) + (d[2] * d[2] + d[3] * d[3]); }
    rstd = rsqrtf(wave_sum(s2) * (1.f / 1024.f) + eps);
}
__device__ __forceinline__ void mod_row_to_h(const Params& p, const f32x4 (&v)[4], int row, int l, int lane) {
    float mean, rstd; ln_stats(v, mean, rstd, 1e-5f);
    const float* mod = (const float*)(p.ws + OFF_MOD) + ((size_t)l * 4 + (row >> 13)) * 3072;
    bf16_t* H = (bf16_t*)(p.ws + OFF_H) + (size_t)row * 1024;
#pragma unroll
    for (int j = 0; j < 4; ++j) { const int c = 256 * j + 4 * lane;
        const f32x4 sh = *(const f32x4*)(mod + c), sc = *(const f32x4*)(mod + 1024 + c);
        f32x4 h;
#pragma unroll
        for (int e = 0; e < 4; ++e) h[e] = (v[j][e] - mean) * rstd * (1.f + sc[e]) + sh[e];
        u32x2 o; o.x = pk2(h[0], h[1]); o.y = pk2(h[2], h[3]);
        *(u32x2*)(H + c) = o; }
}
__device__ void ln1_phase(const Params& p, int l, const float* xin, int TIDX, int BIDX) {
    const int lane = TIDX & 63, gw = BIDX * 8 + (TIDX >> 6), NGW = gridDim.x * 8;
    for (int row = gw; row < T; row += NGW) {
        f32x4 v[4];
#pragma unroll
        for (int j = 0; j < 4; ++j) v[j] = *(const f32x4*)(xin + (size_t)row * 1024 + 256 * j + 4 * lane);
        mod_row_to_h(p, v, row, l, lane);
    }
}
__device__ void lnpost_phase(const Params& p, int l, int TIDX, int BIDX) {
    const int lane = TIDX & 63, gw = BIDX * 8 + (TIDX >> 6), NGW = gridDim.x * 8;
    const float* pg = p.in[I_PG] + l * 1024; const float* pb = p.in[I_PB] + l * 1024;
    for (int row = gw; row < T; row += NGW) {
        f32x4 v[4];
#pragma unroll
        for (int j = 0; j < 4; ++j) v[j] = *(const f32x4*)(p.out + (size_t)row * 1024 + 256 * j + 4 * lane);
        float mean, rstd; ln_stats(v, mean, rstd, 1e-5f);
#pragma unroll
        for (int j = 0; j < 4; ++j) { const int c = 256 * j + 4 * lane; const f32x4 g = *(const f32x4*)(pg + c), b = *(const f32x4*)(pb + c);
#pragma unroll
            for (int e = 0; e < 4; ++e) v[j][e] = (v[j][e] - mean) * rstd * g[e] + b[e];
            *(f32x4*)(p.out + (size_t)row * 1024 + c) = v[j]; }
        if (l == 0) mod_row_to_h(p, v, row, 1, lane);
    }
}

__device__ __forceinline__ void conv_unpack(const u32x4 w, float (&x)[8]) {
#pragma unroll
    for (int q = 0; q < 4; ++q) { x[2 * q] = lo_bf(w[q]); x[2 * q + 1] = hi_bf(w[q]); }
}
__device__ void rwkv_prep_phase(const Params& p, int l, LAS unsigned char* lds, int TIDX, int BIDX, cg::grid_group& grid) {
    {
        bf16_t* XBC = (bf16_t*)(p.ws + OFF_XBC);
        const int cgp = TIDX & 127, qt = TIDX >> 7; const int q0 = BIDX * 128 + qt * 32; const int c8 = cgp * 8;
        float h1[8], h2[8], h3[8];
        if ((q0 & (SEQ - 1)) != 0) { conv_unpack(*(const u32x4*)(XBC + (size_t)(q0 - 1) * 1024 + c8), h1); conv_unpack(*(const u32x4*)(XBC + (size_t)(q0 - 2) * 1024 + c8), h2); conv_unpack(*(const u32x4*)(XBC + (size_t)(q0 - 3) * 1024 + c8), h3); }
        else {
#pragma unroll
            for (int e = 0; e < 8; ++e) h1[e] = h2[e] = h3[e] = 0.f; }
        grid.sync();
        float cw0[8], cw1[8], cw2[8], cw3[8], cb[8];
#pragma unroll
        for (int e = 0; e < 8; ++e) { cw0[e] = p.in[I_CONVW][((size_t)l * 4 + 0) * 1024 + c8 + e]; cw1[e] = p.in[I_CONVW][((size_t)l * 4 + 1) * 1024 + c8 + e];
            cw2[e] = p.in[I_CONVW][((size_t)l * 4 + 2) * 1024 + c8 + e]; cw3[e] = p.in[I_CONVW][((size_t)l * 4 + 3) * 1024 + c8 + e]; cb[e] = p.in[I_CONVB][l * 1024 + c8 + e]; }
#pragma unroll 4
        for (int i = 0; i < 32; ++i) {
            bf16_t* ptr = XBC + (size_t)(q0 + i) * 1024 + c8;
            float x0[8]; conv_unpack(*(const u32x4*)ptr, x0);
            float y[8];
#pragma unroll
            for (int e = 0; e < 8; ++e) { y[e] = siluf_(cw0[e] * h3[e] + cw1[e] * h2[e] + cw2[e] * h1[e] + cw3[e] * x0[e] + cb[e]); h3[e] = h2[e]; h2[e] = h1[e]; h1[e] = x0[e]; }
            u32x4 w; w.x = pk2(y[0], y[1]); w.y = pk2(y[2], y[3]); w.z = pk2(y[4], y[5]); w.w = pk2(y[6], y[7]);
            *(u32x4*)ptr = w;
        }
    }
    LAS float* s = (LAS float*)lds;
    const int c = TIDX;
    float wu[64], au[64];
#pragma unroll
    for (int j = 0; j < 64; ++j) { wu[j] = p.in[I_WUP][((size_t)l * 64 + j) * 512 + c]; au[j] = p.in[I_AUP][((size_t)l * 64 + j) * 512 + c]; }
    const float w0 = p.in[I_W0][l * 512 + c], a0 = p.in[I_A0][l * 512 + c];
    const float* SM = (const float*)(p.ws + OFF_SMALL);
    const float* mu = p.in[I_MU] + l * 1664 + 1536;
    bf16_t* A = (bf16_t*)(p.ws + OFF_A); float* DEC = (float*)(p.ws + OFF_DEC);
    const int tpb = T / gridDim.x;
    for (int t0 = BIDX * tpb; t0 < (BIDX + 1) * tpb; t0 += 4) {
        { const int tt = c >> 7, j = c & 127; const int row = t0 + tt;
          const float cur = SM[(size_t)row * 160 + j]; const float prev = (row & (SEQ - 1)) ? SM[(size_t)(row - 1) * 160 + j] : 0.f;
          const float v = cur + mu[j] * (prev - cur);
          s[tt * 128 + j] = j < 64 ? tanhf(v) : v; }
        __syncthreads();
#pragma unroll
        for (int tt = 0; tt < 4; ++tt) {
            float w = w0, a = a0;
#pragma unroll
            for (int j = 0; j < 64; ++j) { w += s[tt * 128 + j] * wu[j]; a += s[tt * 128 + 64 + j] * au[j]; }
            const size_t o = (size_t)(t0 + tt) * 512 + c;
            A[o] = f2bf(sigmoidf_(a)); DEC[o] = __expf(-0.6065306597126334f * sigmoidf_(w));
        }
        __syncthreads();
    }
}

typedef float f32x2 __attribute__((ext_vector_type(2)));
template <int CTRL> __device__ __forceinline__ float dpp_f(float x) { return __builtin_bit_cast(float, __builtin_amdgcn_update_dpp(0, __builtin_bit_cast(int, x), CTRL, 0xF, 0xF, true)); }
__device__ __forceinline__ float row16_sum(float x) { x += dpp_f<0xB1>(x); x += dpp_f<0x4E>(x); x += dpp_f<0x141>(x); x += dpp_f<0x140>(x); return x; }
constexpr int RW_TC = 32, RW_VEC_B = RW_TC * 5 * 64 * 4, RW_V_B = RW_TC * 16 * 4, RW_BUF_B = RW_VEC_B + 2 * RW_V_B;
__device__ void rwkv_scan_fast(const Params& p, int l, int unit, LAS unsigned char* lds, int TIDX) {
    const int bh = unit >> 2, rq = unit & 3, b = bh >> 3, h = bh & 7, wave = TIDX >> 6, lane = TIDX & 63;
    const size_t r0 = (size_t)b * SEQ;
    bf16_t* Y = (bf16_t*)(p.ws + OFF_Y3);
    if (wave >= 4) {
        const int lw = wave - 4, ch = h * 64 + lane;
        const bf16_t* RKV = (const bf16_t*)(p.ws + OFF_RKV); const bf16_t* A = (const bf16_t*)(p.ws + OFF_A); const float* DEC = (const float*)(p.ws + OFF_DEC);
        const float mu_r = p.in[I_MU][l * 1664 + ch], mu_k = p.in[I_MU][l * 1664 + 512 + ch], mu_v = p.in[I_MU][l * 1664 + 1024 + ch];
        const float k_k = p.in[I_KK][l * 512 + ch], k_a = p.in[I_KA][l * 512 + ch];
        for (int c = -1; c < SEQ / RW_TC; ++c) {
            if (c >= 1) { LAS const float* yb = (LAS const float*)(lds + ((c - 1) & 1) * RW_BUF_B + RW_VEC_B + RW_V_B);
                const int idx = (lw * 64 + lane) * 2, s = idx >> 4, i = idx & 15;
                *(unsigned*)(Y + (r0 + (size_t)(c - 1) * RW_TC + s) * 512 + h * 64 + rq * 16 + i) = pk2(yb[idx], yb[idx + 1]); }
            if (c + 1 < SEQ / RW_TC) {
                LAS float* vec = (LAS float*)(lds + ((c + 1) & 1) * RW_BUF_B); LAS float* vb = (LAS float*)(lds + ((c + 1) & 1) * RW_BUF_B + RW_VEC_B);
                const int s0 = lw * 8; const size_t row0 = r0 + (size_t)(c + 1) * RW_TC + s0;
                float pr = 0.f, pk = 0.f, pv = 0.f;
                if ((row0 & (SEQ - 1)) != 0) { pr = bf2f(RKV[(row0 - 1) * 1536 + ch]); pk = bf2f(RKV[(row0 - 1) * 1536 + 512 + ch]); pv = bf2f(RKV[(row0 - 1) * 1536 + 1024 + ch]); }
                float cr[8], ck[8], cv[8], ca[8], cw[8];
#pragma unroll
                for (int i = 0; i < 8; ++i) { const size_t row = row0 + i; cr[i] = bf2f(RKV[row * 1536 + ch]); ck[i] = bf2f(RKV[row * 1536 + 512 + ch]); cv[i] = bf2f(RKV[row * 1536 + 1024 + ch]);
                    ca[i] = bf2f(A[row * 512 + ch]); cw[i] = DEC[row * 512 + ch]; }
#pragma unroll
                for (int i = 0; i < 8; ++i) {
                    const float r = cr[i] + mu_r * (pr - cr[i]), k = ck[i] + mu_k * (pk - ck[i]), v = cv[i] + mu_v * (pv - cv[i]);
                    pr = cr[i]; pk = ck[i]; pv = cv[i];
                    const float kkj = k * k_k; const float n2 = wave_sum(kkj * kkj); const float kkn = kkj / fmaxf(sqrtf(n2), 1e-12f);
                    const float a = ca[i]; const float kt = k * (1.f + (a - 1.f) * k_a), bb = kkn * a;
                    LAS float* d = vec + (s0 + i) * 320;
                    d[lane] = cw[i]; d[64 + lane] = kkn; d[128 + lane] = bb; d[192 + lane] = kt; d[256 + lane] = r;
                    if ((lane >> 4) == rq) vb[(s0 + i) * 16 + (lane & 15)] = v;
                }
            }
            __syncthreads();
        }
        { constexpr int c = SEQ / RW_TC; LAS const float* yb = (LAS const float*)(lds + ((c - 1) & 1) * RW_BUF_B + RW_VEC_B + RW_V_B);
          const int idx = (lw * 64 + lane) * 2, s = idx >> 4, i = idx & 15;
          *(unsigned*)(Y + (r0 + (size_t)(c - 1) * RW_TC + s) * 512 + h * 64 + rq * 16 + i) = pk2(yb[idx], yb[idx + 1]); }
    } else {
        const int rl = wave * 4 + (lane >> 4), cq = lane & 15;
        f32x2 S0 = (f32x2){0.f, 0.f}, S1 = (f32x2){0.f, 0.f};
        __syncthreads();
        for (int c = 0; c < SEQ / RW_TC; ++c) {
            LAS const unsigned char* buf = lds + (c & 1) * RW_BUF_B;
            LAS const float* vb = (LAS const float*)(buf + RW_VEC_B); LAS float* yb = (LAS float*)(buf + RW_VEC_B + RW_V_B);
#pragma unroll 4
            for (int s = 0; s < RW_TC; ++s) {
                LAS const f32x4* q = (LAS const f32x4*)(buf + s * 1280) + cq;
                const f32x4 w4 = q[0], k4 = q[16], b4 = q[32], t4 = q[48], r4 = q[64];
                const float v = vb[s * 16 + rl];
                f32x2 sp = S0 * (f32x2){k4[0], k4[1]} + S1 * (f32x2){k4[2], k4[3]};
                const float sa = -row16_sum(sp[0] + sp[1]);
                S0 = S0 * (f32x2){w4[0], w4[1]} + (f32x2){b4[0], b4[1]} * sa + (f32x2){t4[0], t4[1]} * v;
                S1 = S1 * (f32x2){w4[2], w4[3]} + (f32x2){b4[2], b4[3]} * sa + (f32x2){t4[2], t4[3]} * v;
                f32x2 yp = S0 * (f32x2){r4[0], r4[1]} + S1 * (f32x2){r4[2], r4[3]};
                const float y = row16_sum(yp[0] + yp[1]);
                if (cq == 0) yb[s * 16 + rl] = y;
            }
            __syncthreads();
        }
    }
}

template <int K> __device__ __forceinline__ f32x4 mma_tile(LAS const bf16_t* A, int lda, LAS const bf16_t* Bt, int ldb, f32x4 acc, int lane) {
    const int r = lane & 15, kg = lane >> 4;
#pragma unroll
    for (int k0 = 0; k0 < K; k0 += 32) {
        const bf16x8 a = *(LAS const bf16x8*)(A + r * lda + k0 + kg * 8);
        const bf16x8 b = *(LAS const bf16x8*)(Bt + r * ldb + k0 + kg * 8);
        acc = __builtin_amdgcn_mfma_f32_16x16x32_bf16(a, b, acc, 0, 0, 0);
    }
    return acc;
}
__device__ void mamba2_chunk(const Params& p, int l, int bh, LAS unsigned char* lds, int TIDX) {
    const int b = bh >> 3, h = bh & 7, g = h >> 2, tid = TIDX, wave = tid >> 6, lane = tid & 63, r = lane & 15, kg = lane >> 4;
    LAS bf16_t* CB = (LAS bf16_t*)lds;
    LAS bf16_t* BB = (LAS bf16_t*)(lds + 17408);
    LAS bf16_t* AY = (LAS bf16_t*)(lds + 34816);
    LAS bf16_t* BY = (LAS bf16_t*)(lds + 60416);
    LAS bf16_t* XE = (LAS bf16_t*)(lds + 86016);
    LAS bf16_t* BT = (LAS bf16_t*)(lds + 95232);
    LAS bf16_t* XS = (LAS bf16_t*)(lds + 113664);
    LAS float* F = (LAS float*)(lds + 122880);
    const bf16_t* XBC = (const bf16_t*)(p.ws + OFF_XBC); const float* SM = (const float*)(p.ws + OFF_SMALL);
    bf16_t* Z = (bf16_t*)(p.ws + OFF_Y3) + (size_t)T * 512;
    const float dtb = p.in[I_DTB][l * 8 + h], ah = -__expf(p.in[I_ALOG][l * 8 + h]), dsk = p.in[I_DSKIP][l * 8 + h];
    const size_t rbase = (size_t)b * SEQ;
    f32x4 sacc[4];
#pragma unroll
    for (int i = 0; i < 4; ++i) sacc[i] = (f32x4){0.f, 0.f, 0.f, 0.f};
    for (int i = tid; i < 64 * 128; i += 512) BY[(i >> 7) * 200 + 64 + (i & 127)] = 0;
    u32x4 rc[2], rb[2], rx; float rdt = 0.f;
    auto prefetch = [&](int c) {
        const size_t row0 = rbase + (size_t)c * 64;
#pragma unroll
        for (int i = 0; i < 2; ++i) { const int item = tid + 512 * i, ll = item >> 4, ng = item & 15;
            rc[i] = *(const u32x4*)(XBC + (row0 + ll) * 1024 + 768 + g * 128 + ng * 8); rb[i] = *(const u32x4*)(XBC + (row0 + ll) * 1024 + 512 + g * 128 + ng * 8); }
        rx = *(const u32x4*)(XBC + (row0 + (tid >> 3)) * 1024 + h * 64 + (tid & 7) * 8);
        if (tid < 64) rdt = SM[(row0 + tid) * 160 + 128 + h];
    };
    prefetch(0);
    for (int c = 0; c < SEQ / 64; ++c) {
        const size_t row0 = rbase + (size_t)c * 64;
        if (tid < 64) { const float dt = softplusf_(rdt + dtb); float x = dt * ah;
#pragma unroll
            for (int o = 1; o < 64; o <<= 1) { const float y = __shfl_up(x, o); if (lane >= o) x += y; }
            F[tid] = x; F[64 + tid] = dt; }
        __syncthreads();
        const float acs_last = F[63];
#pragma unroll
        for (int i = 0; i < 2; ++i) { const int item = tid + 512 * i, ll = item >> 4, ng = item & 15;
            *(LAS u32x4*)(CB + ll * 136 + ng * 8) = rc[i]; *(LAS u32x4*)(BB + ll * 136 + ng * 8) = rb[i];
            const float ea = __expf(F[ll]); float cv[8], bv[8]; conv_unpack(rc[i], cv); conv_unpack(rb[i], bv);
            u32x4 w; w.x = pk2(cv[0] * ea, cv[1] * ea); w.y = pk2(cv[2] * ea, cv[3] * ea); w.z = pk2(cv[4] * ea, cv[5] * ea); w.w = pk2(cv[6] * ea, cv[7] * ea);
            *(LAS u32x4*)(AY + ll * 200 + 64 + ng * 8) = w;
#pragma unroll
            for (int e = 0; e < 8; ++e) BT[(ng * 8 + e) * 72 + ll] = f2bf(bv[e]); }
        { const int ll = tid >> 3, pg = tid & 7; float xv[8]; conv_unpack(rx, xv); const float dtl = F[64 + ll], ee = __expf(acs_last - F[ll]);
#pragma unroll
          for (int e = 0; e < 8; ++e) { const float xd = xv[e] * dtl; const int pp = pg * 8 + e; BY[pp * 200 + ll] = f2bf(xd); XE[pp * 72 + ll] = f2bf(xd * ee); XS[pp * 72 + ll] = f2bf(xv[e]); } }
        __syncthreads();
        if (c + 1 < SEQ / 64) prefetch(c + 1);
#pragma unroll
        for (int q = 0; q < 2; ++q) { const int tt = wave + 8 * q, tl = tt >> 2, ts = tt & 3;
            f32x4 acc = (f32x4){0.f, 0.f, 0.f, 0.f};
            if (ts <= tl) acc = mma_tile<128>(CB + tl * 16 * 136, 136, BB + ts * 16 * 136, 136, acc, lane);
            const int sc = ts * 16 + r; const float as = F[sc];
#pragma unroll
            for (int j = 0; j < 4; ++j) { const int ll = tl * 16 + kg * 4 + j; const float v = (sc <= ll) ? acc[j] * __expf(F[ll] - as) : 0.f; AY[ll * 200 + sc] = f2bf(v); } }
        __syncthreads();
#pragma unroll
        for (int q = 0; q < 2; ++q) { const int tt = wave + 8 * q, tl = tt >> 2, tp = tt & 3;
            f32x4 acc = (f32x4){0.f, 0.f, 0.f, 0.f};
            acc = mma_tile<192>(AY + tl * 16 * 200, 200, BY + tp * 16 * 200, 200, acc, lane);
            const int pp = tp * 16 + r;
#pragma unroll
            for (int j = 0; j < 4; ++j) { const int ll = tl * 16 + kg * 4 + j; bf16_t* zp = Z + (row0 + ll) * 512 + h * 64 + pp;
                const float y = acc[j] + dsk * bf2f(XS[pp * 72 + ll]); *zp = f2bf(y * siluf_(bf2f(*zp))); } }
        const float dl = __expf(acs_last);
#pragma unroll
        for (int i = 0; i < 4; ++i) { const int id = wave * 4 + i, tp = id >> 3, tn = id & 7;
            sacc[i] = sacc[i] * dl; sacc[i] = mma_tile<64>(XE + tp * 16 * 72, 72, BT + tn * 16 * 72, 72, sacc[i], lane); }
        __syncthreads();
#pragma unroll
        for (int i = 0; i < 4; ++i) { const int id = wave * 4 + i, tp = id >> 3, tn = id & 7;
#pragma unroll
            for (int j = 0; j < 4; ++j) BY[(tp * 16 + kg * 4 + j) * 200 + 64 + tn * 16 + r] = f2bf(sacc[i][j]); }
    }
}
__device__ void gla_chunk(const Params& p, int l, int unit, LAS unsigned char* lds, int TIDX) {
    const int bh = unit >> 1, eh = unit & 1, b = bh >> 2, h = bh & 3, tid = TIDX, wave = tid >> 6, lane = tid & 63, r = lane & 15, kg = lane >> 4;
    LAS bf16_t* KG = (LAS bf16_t*)lds;
    LAS bf16_t* AY = (LAS bf16_t*)(lds + 9216);
    LAS bf16_t* BY = (LAS bf16_t*)(lds + 26624);
    LAS bf16_t* KD = (LAS bf16_t*)(lds + 44032);
    LAS float* G = (LAS float*)(lds + 53248);
    LAS float* UP = (LAS float*)(lds + 69888);
    LAS float* GD = (LAS float*)(lds + 73984);
    const bf16_t* GQ = (const bf16_t*)(p.ws + OFF_GQ); const bf16_t* GK = (const bf16_t*)(p.ws + OFF_GK); const float* SM = (const float*)(p.ws + OFF_SMALL);
    bf16_t* GV = (bf16_t*)(p.ws + OFF_Y3) + (size_t)2 * T * 512;
    const size_t rbase = (size_t)b * SEQ;
    const int ll = tid >> 3, dg = tid & 7;
    for (int i = tid; i < 16 * 64; i += 512) UP[i] = p.in[I_GKUP][((size_t)l * 16 + (i >> 6)) * 256 + h * 64 + (i & 63)];
    float gkb[8];
#pragma unroll
    for (int e = 0; e < 8; ++e) gkb[e] = p.in[I_GKB][l * 256 + h * 64 + dg * 8 + e];
    f32x4 sacc[2];
    sacc[0] = sacc[1] = (f32x4){0.f, 0.f, 0.f, 0.f};
    for (int i = tid; i < 64 * 64; i += 512) BY[(i >> 6) * 136 + 64 + (i & 63)] = 0;
    u32x4 rq, rk, rv; f32x4 rg = (f32x4){0.f, 0.f, 0.f, 0.f};
    auto prefetch = [&](int c) {
        const size_t row0 = rbase + (size_t)c * 64;
        rq = *(const u32x4*)(GQ + (row0 + ll) * 256 + h * 64 + dg * 8); rk = *(const u32x4*)(GK + (row0 + ll) * 256 + h * 64 + dg * 8);
        rv = *(const u32x4*)(GV + (row0 + ll) * 512 + h * 128 + eh * 64 + dg * 8);
        if (tid < 256) rg = *(const f32x4*)(SM + (row0 + (tid >> 2)) * 160 + 136 + (tid & 3) * 4);
    };
    prefetch(0);
    for (int c = 0; c < SEQ / 64; ++c) {
        const size_t row0 = rbase + (size_t)c * 64;
        if (tid < 256) *(LAS f32x4*)(GD + (tid >> 2) * 16 + (tid & 3) * 4) = rg;
        __syncthreads();
        { float gp[8];
#pragma unroll
          for (int e = 0; e < 8; ++e) gp[e] = gkb[e];
#pragma unroll
          for (int q = 0; q < 16; ++q) { const float gd = GD[ll * 16 + q];
#pragma unroll
              for (int e = 0; e < 8; ++e) gp[e] += gd * UP[q * 64 + dg * 8 + e]; }
#pragma unroll
          for (int e = 0; e < 8; ++e) G[ll * 65 + dg * 8 + e] = (fminf(gp[e], 0.f) - log1pf(__expf(-fabsf(gp[e])))) * (1.f / 16.f); }
        __syncthreads();
        if (tid < 64) { float a = 0.f;
#pragma unroll 16
            for (int q = 0; q < 64; ++q) { a += G[q * 65 + tid]; G[q * 65 + tid] = a; } }
        __syncthreads();
        { float qv[8], kv[8], vv[8]; conv_unpack(rq, qv); conv_unpack(rk, kv); conv_unpack(rv, vv);
          float qg[8], ki[8];
#pragma unroll
          for (int e = 0; e < 8; ++e) { const int d = dg * 8 + e; const float gl = G[ll * 65 + d], glast = G[63 * 65 + d];
              qg[e] = qv[e] * 0.125f * __expf(gl); ki[e] = kv[e] * __expf(-gl);
              KD[d * 72 + ll] = f2bf(kv[e] * __expf(glast - gl)); BY[d * 136 + ll] = f2bf(vv[e]); }
          u32x4 w; w.x = pk2(qg[0], qg[1]); w.y = pk2(qg[2], qg[3]); w.z = pk2(qg[4], qg[5]); w.w = pk2(qg[6], qg[7]);
          *(LAS u32x4*)(AY + ll * 136 + 64 + dg * 8) = w;
          w.x = pk2(ki[0], ki[1]); w.y = pk2(ki[2], ki[3]); w.z = pk2(ki[4], ki[5]); w.w = pk2(ki[6], ki[7]);
          *(LAS u32x4*)(KG + ll * 72 + dg * 8) = w; }
        __syncthreads();
        if (c + 1 < SEQ / 64) prefetch(c + 1);
#pragma unroll
        for (int q = 0; q < 2; ++q) { const int tt = wave + 8 * q, tl = tt >> 2, ts = tt & 3;
            f32x4 acc = (f32x4){0.f, 0.f, 0.f, 0.f};
            if (ts <= tl) acc = mma_tile<64>(AY + tl * 16 * 136 + 64, 136, KG + ts * 16 * 72, 72, acc, lane);
            const int sc = ts * 16 + r;
#pragma unroll
            for (int j = 0; j < 4; ++j) { const int l2 = tl * 16 + kg * 4 + j; AY[l2 * 136 + sc] = f2bf((sc <= l2) ? acc[j] : 0.f); } }
        __syncthreads();
#pragma unroll
        for (int q = 0; q < 2; ++q) { const int tt = wave + 8 * q, tl = tt >> 2, te = tt & 3;
            f32x4 acc = (f32x4){0.f, 0.f, 0.f, 0.f};
            acc = mma_tile<128>(AY + tl * 16 * 136, 136, BY + te * 16 * 136, 136, acc, lane);
#pragma unroll
            for (int j = 0; j < 4; ++j) GV[(row0 + tl * 16 + kg * 4 + j) * 512 + h * 128 + eh * 64 + te * 16 + r] = f2bf(acc[j]); }
#pragma unroll
        for (int i = 0; i < 2; ++i) { const int id = wave * 2 + i, te = id >> 2, td = id & 3;
            const float dl = __expf(G[63 * 65 + td * 16 + r]);
            sacc[i] = sacc[i] * dl; sacc[i] = mma_tile<64>(BY + te * 16 * 136, 136, KD + td * 16 * 72, 72, sacc[i], lane); }
        __syncthreads();
#pragma unroll
        for (int i = 0; i < 2; ++i) { const int id = wave * 2 + i, te = id >> 2, td = id & 3;
#pragma unroll
            for (int j = 0; j < 4; ++j) BY[(te * 16 + kg * 4 + j) * 136 + 64 + td * 16 + r] = f2bf(sacc[i][j]); }
    }
}
__device__ void scans_naive_phase(const Params& p, int l, LAS unsigned char* lds, int TIDX, int BIDX) {
    const int wave = TIDX >> 6;
    LAS float* wl = (LAS float*)(lds + wave * 4096);
    if (BIDX < 128) { rwkv_scan_fast(p, l, BIDX, lds, TIDX); return; }
    const int u = BIDX - 128;
    if (u < 32) mamba2_chunk(p, l, u, lds, TIDX);
    else if (u < 64) gla_chunk(p, l, u - 32, lds, TIDX);
}
__device__ void post_phase(const Params& p, int l, int TIDX, int BIDX) {
    const int lane = TIDX & 63, gw = BIDX * 8 + (TIDX >> 6), NGW = gridDim.x * 8;
    const bf16_t* RKV = (const bf16_t*)(p.ws + OFF_RKV); const bf16_t* A = (const bf16_t*)(p.ws + OFF_A);
    bf16_t* Y0 = (bf16_t*)(p.ws + OFF_Y3); bf16_t* Y1 = Y0 + (size_t)T * 512; bf16_t* Y2 = Y1 + (size_t)T * 512;
    const int c0 = lane * 8;
    float mur[8], muk[8], muv[8], kA[8], rk[8], lg[8], lb[8], nw1[8], nw2[8];
#pragma unroll
    for (int e = 0; e < 8; ++e) { const int c = c0 + e;
        mur[e] = p.in[I_MU][l * 1664 + c]; muk[e] = p.in[I_MU][l * 1664 + 512 + c]; muv[e] = p.in[I_MU][l * 1664 + 1024 + c];
        kA[e] = p.in[I_KA][l * 512 + c]; rk[e] = p.in[I_RK][l * 512 + c]; lg[e] = p.in[I_LNG][l * 512 + c]; lb[e] = p.in[I_LNB][l * 512 + c];
        nw1[e] = p.in[I_M2NW][l * 512 + c]; nw2[e] = p.in[I_GNW][l * 128 + (c & 127)]; }
    for (int row = gw; row < T; row += NGW) {
        const bool first = (row & (SEQ - 1)) == 0;
        float y[8], r[8], k[8], v[8], a[8];
        { const u32x4 yy = *(const u32x4*)(Y0 + (size_t)row * 512 + c0); const u32x4 aa = *(const u32x4*)(A + (size_t)row * 512 + c0);
          const u32x4 rr = *(const u32x4*)(RKV + (size_t)row * 1536 + c0), kk = *(const u32x4*)(RKV + (size_t)row * 1536 + 512 + c0), vv = *(const u32x4*)(RKV + (size_t)row * 1536 + 1024 + c0);
          u32x4 rp = (u32x4){0, 0, 0, 0}, kp = rp, vp = rp;
          if (!first) { rp = *(const u32x4*)(RKV + (size_t)(row - 1) * 1536 + c0); kp = *(const u32x4*)(RKV + (size_t)(row - 1) * 1536 + 512 + c0); vp = *(const u32x4*)(RKV + (size_t)(row - 1) * 1536 + 1024 + c0); }
#pragma unroll
          for (int q = 0; q < 4; ++q) {
              y[2 * q] = lo_bf(yy[q]); y[2 * q + 1] = hi_bf(yy[q]); a[2 * q] = lo_bf(aa[q]); a[2 * q + 1] = hi_bf(aa[q]);
              float x0 = lo_bf(rr[q]), x1 = hi_bf(rr[q]); r[2 * q] = x0 + mur[2 * q] * (lo_bf(rp[q]) - x0); r[2 * q + 1] = x1 + mur[2 * q + 1] * (hi_bf(rp[q]) - x1);
              x0 = lo_bf(kk[q]); x1 = hi_bf(kk[q]); k[2 * q] = x0 + muk[2 * q] * (lo_bf(kp[q]) - x0); k[2 * q + 1] = x1 + muk[2 * q + 1] * (hi_bf(kp[q]) - x1);
              x0 = lo_bf(vv[q]); x1 = hi_bf(vv[q]); v[2 * q] = x0 + muv[2 * q] * (lo_bf(vp[q]) - x0); v[2 * q + 1] = x1 + muv[2 * q + 1] * (hi_bf(vp[q]) - x1); } }
        float s = 0.f, bs = 0.f;
#pragma unroll
        for (int e = 0; e < 8; ++e) { s += y[e]; bs += r[e] * (k[e] * (1.f + (a[e] - 1.f) * kA[e])) * rk[e]; }
        s += __shfl_xor(s, 1); s += __shfl_xor(s, 2); s += __shfl_xor(s, 4);
        bs += __shfl_xor(bs, 1); bs += __shfl_xor(bs, 2); bs += __shfl_xor(bs, 4);
        const float mean = s * (1.f / 64.f); float s2 = 0.f;
#pragma unroll
        for (int e = 0; e < 8; ++e) { const float d = y[e] - mean; s2 += d * d; }
        s2 += __shfl_xor(s2, 1); s2 += __shfl_xor(s2, 2); s2 += __shfl_xor(s2, 4);
        const float rstd = rsqrtf(s2 * (1.f / 64.f) + 64e-5f);
        { float o[8];
#pragma unroll
          for (int e = 0; e < 8; ++e) o[e] = (y[e] - mean) * rstd * lg[e] + lb[e] + bs * v[e];
          u32x4 w; w.x = pk2(o[0], o[1]); w.y = pk2(o[2], o[3]); w.z = pk2(o[4], o[5]); w.w = pk2(o[6], o[7]);
          *(u32x4*)(Y0 + (size_t)row * 512 + c0) = w; }
        { const u32x4 yy = *(const u32x4*)(Y1 + (size_t)row * 512 + c0); float q2 = 0.f;
#pragma unroll
          for (int q = 0; q < 4; ++q) { y[2 * q] = lo_bf(yy[q]); y[2 * q + 1] = hi_bf(yy[q]); q2 += y[2 * q] * y[2 * q] + y[2 * q + 1] * y[2 * q + 1]; }
          q2 += __shfl_xor(q2, 1); q2 += __shfl_xor(q2, 2); q2 += __shfl_xor(q2, 4); q2 += __shfl_xor(q2, 8); q2 += __shfl_xor(q2, 16);
          const float rs = rsqrtf(q2 * (1.f / 256.f) + 1e-5f);
          u32x4 w; w.x = pk2(y[0] * rs * nw1[0], y[1] * rs * nw1[1]); w.y = pk2(y[2] * rs * nw1[2], y[3] * rs * nw1[3]); w.z = pk2(y[4] * rs * nw1[4], y[5] * rs * nw1[5]); w.w = pk2(y[6] * rs * nw1[6], y[7] * rs * nw1[7]);
          *(u32x4*)(Y1 + (size_t)row * 512 + c0) = w; }
        { const u32x4 yy = *(const u32x4*)(Y2 + (size_t)row * 512 + c0); float q2 = 0.f;
#pragma unroll
          for (int q = 0; q < 4; ++q) { y[2 * q] = lo_bf(yy[q]); y[2 * q + 1] = hi_bf(yy[q]); q2 += y[2 * q] * y[2 * q] + y[2 * q + 1] * y[2 * q + 1]; }
          q2 += __shfl_xor(q2, 1); q2 += __shfl_xor(q2, 2); q2 += __shfl_xor(q2, 4); q2 += __shfl_xor(q2, 8);
          const float rs = rsqrtf(q2 * (1.f / 128.f) + 1e-5f);
          u32x4 w; w.x = pk2(y[0] * rs * nw2[0], y[1] * rs * nw2[1]); w.y = pk2(y[2] * rs * nw2[2], y[3] * rs * nw2[3]); w.z = pk2(y[4] * rs * nw2[4], y[5] * rs * nw2[5]); w.w = pk2(y[6] * rs * nw2[6], y[7] * rs * nw2[7]);
          *(u32x4*)(Y2 + (size_t)row * 512 + c0) = w; }
    }
}

constexpr int NPHASE = 18;
#ifndef PHM
#define PHM 1023
#endif
__global__ __launch_bounds__(512, 2) void mega(Params p) {
    extern __shared__ __attribute__((aligned(16))) unsigned char shm[];
    LAS unsigned char* lds = (LAS unsigned char*)shm;
    cg::grid_group grid = cg::this_grid();
    for (int ph = p.ph_lo; ph < p.ph_hi; ++ph) {
        const int TIDX = tid_opaque(), BIDX = bid_opaque();
        if (ph == 0) { if (PHM & 1) { wprep(p, 0, lds, TIDX, BIDX); ada_phase(p, lds, TIDX, BIDX); } }
        else if (ph == 1) { if (PHM & 2) ln1_phase(p, 0, p.in[I_X], TIDX, BIDX); }
        else {
            const int l = (ph - 2) >> 3, s = (ph - 2) & 7;
            const float* xin = l == 0 ? p.in[I_X] : p.out;
            pg8::StaticOrder S;
            if (s == 0 && (PHM & 4)) { pg8::Gemm g{(const bf16_t*)(p.ws + OFF_H), (const bf16_t*)(p.ws + OFF_WT1), T, 4352, 1024, 1 << 30, 0};
                S.init(g.M, g.N, gridDim.x, BIDX); Epi<0> E{p.ws, nullptr, nullptr, nullptr}; pg8::gemm_phase(lds, g, S, E, TIDX); }
            else if (s == 1 && (PHM & 8)) { rwkv_prep_phase(p, l, lds, TIDX, BIDX, grid); }
            else if (s == 2 && (PHM & 16)) { scans_naive_phase(p, l, lds, TIDX, BIDX); }
            else if (s == 3 && (PHM & 32)) { post_phase(p, l, TIDX, BIDX); }
            else if (s == 4 && (PHM & 64)) { pg8::Gemm g{(const bf16_t*)(p.ws + OFF_H), (const bf16_t*)(p.ws + OFF_WT1) + (size_t)4352 * 1024, T, 4096, 1024, 1 << 30, 0};
                S.init(g.M, g.N, gridDim.x, BIDX); Epi<1> E{p.ws, nullptr, nullptr, nullptr}; pg8::gemm_phase(lds, g, S, E, TIDX); }
            else if (s == 5 && (PHM & 128)) { pg8::Gemm g{(const bf16_t*)(p.ws + OFF_Y3), (const bf16_t*)(p.ws + OFF_WT2), T, 3072, 512, 4, (size_t)T * 512 * 2};
                S.init(g.M, g.N, gridDim.x, BIDX); Epi<2> E{p.ws, nullptr, nullptr, nullptr}; pg8::gemm_phase(lds, g, S, E, TIDX); }
            else if (s == 6 && (PHM & 256)) { pg8::Gemm g{(const bf16_t*)(p.ws + OFF_GATES), (const bf16_t*)(p.ws + OFF_WT3), T, 1024, 3072, 1 << 30, 0};
                S.init(g.M, g.N, gridDim.x, BIDX); Epi<3> E{p.ws, xin, (const float*)(p.ws + OFF_MOD) + (size_t)l * 4 * 3072, p.out}; pg8::gemm_phase(lds, g, S, E, TIDX); }
            else if (s == 7 && (PHM & 512)) { lnpost_phase(p, l, TIDX, BIDX); if (l == 0) wprep(p, 1, lds, TIDX, BIDX); }
        }
        if (ph + 1 < p.ph_hi) grid.sync();
    }
}

extern "C" void kernel_launch(void* const* d_in, const int* in_sizes, int n_in, void* d_out, int out_size, void* d_ws, size_t ws_size, hipStream_t stream) {
    constexpr int LDS_BYTES = 131072;
    static int grid = 0;
    if (grid == 0) {
        if (n_in != 28 || out_size != T * DM || ws_size < WS_END) { fprintf(stderr, "kernel_launch: unexpected shapes / workspace (%zu < %zu)\n", ws_size, (size_t)WS_END); grid = -1; return; }
        int dev = 0, cus = 0, per_cu = 0;
        hipGetDevice(&dev); hipDeviceGetAttribute(&cus, hipDeviceAttributeMultiprocessorCount, dev);
        if (hipFuncSetAttribute((const void*)mega, hipFuncAttributeMaxDynamicSharedMemorySize, LDS_BYTES) != hipSuccess) { fprintf(stderr, "hipFuncSetAttribute failed\n"); grid = -1; return; }
        if (hipOccupancyMaxActiveBlocksPerMultiprocessor(&per_cu, (const void*)mega, 512, LDS_BYTES) != hipSuccess || per_cu < 1) per_cu = 1;
        (void)hipGetLastError();
        grid = cus * 1;
        if (grid != 256) { fprintf(stderr, "kernel_launch: built for 256 CUs\n"); grid = -1; return; }
    }
    if (grid < 0) return;
    Params p{};
    for (int i = 0; i < 28; ++i) p.in[i] = (const float*)d_in[i];
    p.out = (float*)d_out; p.ws = (unsigned char*)d_ws;
#if N_LAUNCH_MODE == 1
    p.ph_lo = 0; p.ph_hi = NPHASE;
    void* args[] = {&p};
    hipError_t e = hipLaunchCooperativeKernel((const void*)mega, dim3(grid), dim3(512), args, LDS_BYTES, stream);
    if (e != hipSuccess) fprintf(stderr, "cooperative launch failed: %s (grid %d)\n", hipGetErrorString(e), grid);
#else
    for (int ph = 0; ph < NPHASE; ++ph) { p.ph_lo = ph; p.ph_hi = ph + 1; hipLaunchKernelGGL(mega, dim3(grid), dim3(512), LDS_BYTES, stream, p); }
#endif
}
```

```cpp
#include <hip/hip_runtime.h>
#include <hip/hip_cooperative_groups.h>
#include <cstdio>
namespace cg = cooperative_groups;

#ifndef N_LAUNCH_MODE
#define N_LAUNCH_MODE 1
#endif

#define LAS __attribute__((address_space(3)))
typedef unsigned short bf16_t;
typedef short bf16x8 __attribute__((ext_vector_type(8)));
typedef float f32x4 __attribute__((ext_vector_type(4)));
typedef unsigned u32x4 __attribute__((ext_vector_type(4)));
typedef unsigned u32x2 __attribute__((ext_vector_type(2)));

constexpr int T = 32768, SEQ = 8192, DM = 1024, NB = 4;
constexpr int INW = 8344;
constexpr float ALPHA_DN = 1.4142135623730951f;

constexpr size_t SZ_WT1 = (size_t)8448 * 1024 * 2, SZ_WT2 = (size_t)3072 * 512 * 2, SZ_WT3 = (size_t)1024 * 3072 * 2, SZ_MOD = (size_t)2 * 4 * 3072 * 4;
constexpr size_t OFF_WT1 = 0, OFF_WT2 = OFF_WT1 + SZ_WT1, OFF_WT3 = OFF_WT2 + SZ_WT2, OFF_MOD = OFF_WT3 + SZ_WT3;
constexpr size_t OFF_H = OFF_MOD + SZ_MOD;
constexpr size_t OFF_Y3 = OFF_H + (size_t)T * 1024 * 2;
constexpr size_t OFF_RKV = OFF_Y3 + (size_t)3 * T * 512 * 2;
constexpr size_t OFF_XBC = OFF_RKV + (size_t)T * 1536 * 2;
constexpr size_t OFF_GQ = OFF_XBC + (size_t)T * 1024 * 2;
constexpr size_t OFF_GK = OFF_GQ + (size_t)T * 256 * 2;
constexpr size_t OFF_SMALL = OFF_GK + (size_t)T * 256 * 2;
constexpr size_t OFF_A = OFF_SMALL + (size_t)T * 160 * 4;
constexpr size_t OFF_DEC = OFF_A + (size_t)T * 512 * 2;
constexpr size_t WS_END = OFF_DEC + (size_t)T * 512 * 4;
constexpr size_t OFF_GATES = OFF_RKV;
static_assert(OFF_GK + (size_t)T * 256 * 2 - OFF_RKV == (size_t)T * 3072 * 2, "gates alias");

struct Params { const float* in[28]; float* out; unsigned char* ws; int ph_lo, ph_hi; };
enum { I_X = 0, I_C, I_ADAW, I_ADAB, I_WIN, I_MU, I_W0, I_WUP, I_A0, I_AUP, I_KK, I_KA, I_RK, I_LNG, I_LNB, I_CONVW, I_CONVB, I_DTB, I_ALOG, I_DSKIP,
       I_M2NW, I_GKUP, I_GKB, I_GNW, I_WBR, I_WOUT, I_PG, I_PB };

__device__ __forceinline__ float bf2f(bf16_t v) { return __uint_as_float(((unsigned)v) << 16); }
__device__ __forceinline__ bf16_t f2bf(float f) { unsigned u = __float_as_uint(f); u += 0x7FFFu + ((u >> 16) & 1u); return (bf16_t)(u >> 16); }
__device__ __forceinline__ unsigned pk2(float lo, float hi) { return (unsigned)f2bf(lo) | ((unsigned)f2bf(hi) << 16); }
__device__ __forceinline__ float lo_bf(unsigned w) { return __uint_as_float(w << 16); }
__device__ __forceinline__ float hi_bf(unsigned w) { return __uint_as_float(w & 0xFFFF0000u); }
__device__ __forceinline__ float sigmoidf_(float x) { return 1.0f / (1.0f + __expf(-x)); }
__device__ __forceinline__ float siluf_(float x) { return x / (1.0f + __expf(-x)); }
__device__ __forceinline__ float softplusf_(float x) { return x > 20.f ? x : log1pf(__expf(x)); }
__device__ __forceinline__ float wave_sum(float v) {
#pragma unroll
    for (int o = 1; o < 64; o <<= 1) v += __shfl_xor(v, o);
    return v;
}
__device__ __forceinline__ int tid_opaque() { int t = threadIdx.x; asm volatile("" : "+v"(t)); return t; }
__device__ __forceinline__ int bid_opaque() { int t = blockIdx.x; asm volatile("" : "+s"(t)); return t; }
#define WAVE_LDS_SYNC() do { asm volatile("s_waitcnt lgkmcnt(0)" ::: "memory"); __builtin_amdgcn_wave_barrier(); } while (0)

namespace pg8 {
constexpr int BM = 256, BK = 64, HALF = 128, HTB = HALF * BK * 2, STAGE_BYTES = 8 * HTB, NXCD = 8, WGM = 8;
__host__ __device__ __forceinline__ int lds_byte(int r, int c) { const int st = (r >> 4) * 2 + (c >> 5), rr = r & 15, cc = c & 31, ob = rr * 64 + cc * 2; return st * 1024 + (ob ^ (((ob >> 9) & 1) << 5)); }
__host__ __device__ __forceinline__ void stage_rc(int b, int& R, int& C) { const int st = b / 1024, sb = b % 1024, swz = sb ^ (((sb >> 9) & 1) << 5); R = (st >> 1) * 16 + swz / 64; C = (st & 1) * 32 + (swz % 64) / 2; }
__host__ __device__ __forceinline__ int perm32(int rho) { const int n = rho >> 4, i = rho & 15; return 8 * (i >> 2) + 4 * n + (i & 3); }
struct Unit { int pm, pn; };
struct Gemm { const bf16_t* A; const bf16_t* Bt; int M, N, K; int adiv; size_t astride; };
struct StaticOrder {
    int nM, nN, nwg, G, c;
    __device__ void init(int M, int N, int G_, int c_) { nM = M / BM; nN = N / BM; nwg = nM * nN; G = G_; c = c_; }
    __device__ bool next(int i, Unit& u) const {
        const long L = (long)i * G + c; if (L >= nwg) return false;
        int wgid = (int)L; { const int q = nwg / NXCD, r = nwg % NXCD, xcd = wgid % NXCD, off = wgid / NXCD; wgid = (xcd < r ? xcd * (q + 1) : r * (q + 1) + (xcd - r) * q) + off; }
        const int nig = WGM * nN, gid = wgid / nig, fm = gid * WGM, gsz = (nM - fm) < WGM ? (nM - fm) : WGM;
        u.pm = fm + ((wgid % nig) % gsz); u.pn = (wgid % nig) / gsz; return true;
    }
};
__device__ __forceinline__ unsigned cvt_pk_bf16(float lo, float hi) { unsigned r; asm volatile("v_cvt_pk_bf16_f32 %0, %1, %2" : "=v"(r) : "v"(lo), "v"(hi)); return r; }

template <class Epi>
__device__ __forceinline__ void gemm_phase(LAS unsigned char* lds, const Gemm g, const StaticOrder& S, const Epi& E, int TIDX) {
    const int tid = TIDX, wid = __builtin_amdgcn_readfirstlane(tid >> 6), lane = tid & 63, wr = wid >> 2, wc = wid & 3, fr = lane & 15, fq = lane >> 4;
    const int K = g.K, nt = K / BK;
    unsigned voffA[2], voffB[2];
#pragma unroll
    for (int i = 0; i < 2; ++i) { int R, C; stage_rc(tid * 16 + i * 8192, R, C); const int Rb = (R & ~31) + perm32(R & 31);
        voffA[i] = (unsigned)(R * K + C) * 2u; voffB[i] = (unsigned)(Rb * K + C) * 2u; }
    const size_t kstep = (size_t)(BK * 2);
    const size_t hstep = (size_t)HALF * K * 2;
    const size_t tstep = 2 * hstep;
    const unsigned ldsw = (unsigned)wid * 1024u;
    const int aoff = lds_byte(wr * 64 + fr, fq * 8), boff = lds_byte(wc * 32 + fr, fq * 8);
#define PG8_SA(b, h) (((b) * 2 + (h)) * HTB)
#define PG8_SB(b, h) ((4 + (b) * 2 + (h)) * HTB)
#define PG8_STAGE(bufoff, gbase, voff) do { _Pragma("unroll") for (int _i = 0; _i < 2; ++_i) \
        __builtin_amdgcn_global_load_lds((const unsigned*)((const char*)(gbase) + (voff)[_i]), (LAS unsigned*)(lds + (bufoff) + ldsw + _i * 8192), 16, 0, 0); } while (0)
#define PG8_LDA(dst, b, h) do { _Pragma("unroll") for (int m = 0; m < 4; ++m) _Pragma("unroll") for (int k = 0; k < 2; ++k) dst[m][k] = *(const LAS bf16x8*)(lds + PG8_SA(b, h) + aoff + m * 2048 + k * 1024); } while (0)
#define PG8_LDB(dst, b, h) do { _Pragma("unroll") for (int n = 0; n < 2; ++n) _Pragma("unroll") for (int k = 0; k < 2; ++k) dst[n][k] = *(const LAS bf16x8*)(lds + PG8_SB(b, h) + boff + n * 2048 + k * 1024); } while (0)
#define PG8_MMA(ai, bj, At, Bt) do { __builtin_amdgcn_s_setprio(1); _Pragma("unroll") for (int m = 0; m < 4; ++m) _Pragma("unroll") for (int n = 0; n < 2; ++n) _Pragma("unroll") for (int k = 0; k < 2; ++k) \
        acc[ai][bj][m][n] = __builtin_amdgcn_mfma_f32_16x16x32_bf16(Bt[n][k], At[m][k], acc[ai][bj][m][n], 0, 0, 0); __builtin_amdgcn_s_setprio(0); } while (0)
#define PG8_WAIT_V(n) asm volatile("s_waitcnt vmcnt(" #n ")" ::: "memory")
#define PG8_WAIT_L(n) asm volatile("s_waitcnt lgkmcnt(" #n ")" ::: "memory")
#define PG8_BAR __builtin_amdgcn_s_barrier()
#define PG8_SCHED __builtin_amdgcn_sched_barrier(0)
    Unit cur, nxt; int ui = 0;
    if (!S.next(0, cur)) return;
    f32x4 acc[2][2][4][2];
#pragma unroll
    for (int a = 0; a < 2; ++a)
#pragma unroll
        for (int b = 0; b < 2; ++b)
#pragma unroll
            for (int m = 0; m < 4; ++m)
#pragma unroll
                for (int n = 0; n < 2; ++n) acc[a][b][m][n] = (f32x4){0.f, 0.f, 0.f, 0.f};
    bf16x8 At[4][2], B0[2][2], B1[2][2];
    const char* cA = (const char*)g.A + (size_t)(cur.pn / g.adiv) * g.astride + (size_t)cur.pm * tstep; const char* cB = (const char*)g.Bt + (size_t)cur.pn * tstep;
    PG8_STAGE(PG8_SB(0, 0), cB, voffB); PG8_STAGE(PG8_SA(0, 0), cA, voffA); PG8_STAGE(PG8_SB(0, 1), cB + hstep, voffB); PG8_STAGE(PG8_SA(0, 1), cA + hstep, voffA);
    if (wr == 1) PG8_BAR;
    PG8_WAIT_V(4); PG8_BAR;
    PG8_STAGE(PG8_SB(1, 0), cB + kstep, voffB); PG8_STAGE(PG8_SA(1, 0), cA + kstep, voffA); PG8_STAGE(PG8_SB(1, 1), cB + hstep + kstep, voffB);
    PG8_WAIT_V(6); PG8_BAR;
    for (;;) {
        const bool has_next = S.next(ui + 1, nxt);
        const char* nA = has_next ? (const char*)g.A + (size_t)(nxt.pn / g.adiv) * g.astride + (size_t)nxt.pm * tstep : cA; const char* nB = has_next ? (const char*)g.Bt + (size_t)nxt.pn * tstep : cB;
        for (int t = 0; t < nt; t += 2) {
            const bool last = (t == nt - 2);
            const char* a1 = cA + (size_t)(t + 1) * kstep;
            const char* a2 = last ? nA : cA + (size_t)(t + 2) * kstep; const char* b2 = last ? nB : cB + (size_t)(t + 2) * kstep;
            const char* a3 = a2 + kstep; const char* b3 = b2 + kstep;
            PG8_LDB(B0, 0, 0); PG8_SCHED; PG8_LDA(At, 0, 0); PG8_STAGE(PG8_SA(1, 1), a1 + hstep, voffA);
            PG8_WAIT_L(8); PG8_BAR; PG8_WAIT_L(0); PG8_MMA(0, 0, At, B0); PG8_BAR; PG8_SCHED;
            PG8_LDB(B1, 0, 1); PG8_STAGE(PG8_SB(0, 0), b2, voffB);
            PG8_BAR; PG8_WAIT_L(0); PG8_MMA(0, 1, At, B1); PG8_BAR;
            PG8_LDA(At, 0, 1); PG8_STAGE(PG8_SA(0, 0), a2, voffA);
            PG8_BAR; PG8_WAIT_L(0); PG8_MMA(1, 0, At, B0); PG8_BAR; PG8_SCHED;
            PG8_STAGE(PG8_SB(0, 1), b2 + hstep, voffB);
            PG8_WAIT_V(6); PG8_BAR; PG8_MMA(1, 1, At, B1); PG8_BAR;
            PG8_LDB(B0, 1, 0); PG8_SCHED; PG8_LDA(At, 1, 0); PG8_STAGE(PG8_SA(0, 1), a2 + hstep, voffA);
            PG8_WAIT_L(8); PG8_BAR; PG8_WAIT_L(0); PG8_MMA(0, 0, At, B0); PG8_BAR; PG8_SCHED;
            PG8_LDB(B1, 1, 1); PG8_STAGE(PG8_SB(1, 0), b3, voffB);
            PG8_BAR; PG8_WAIT_L(0); PG8_MMA(0, 1, At, B1); PG8_BAR;
            PG8_LDA(At, 1, 1); PG8_STAGE(PG8_SA(1, 0), a3, voffA);
            PG8_BAR; PG8_WAIT_L(0); PG8_MMA(1, 0, At, B0); PG8_BAR; PG8_SCHED;
            PG8_STAGE(PG8_SB(1, 1), b3 + hstep, voffB);
            PG8_WAIT_V(6); PG8_BAR; PG8_MMA(1, 1, At, B1); PG8_BAR;
        }
        E(acc, cur, wr, wc, fr, fq);
        if (!has_next) break;
#pragma unroll
        for (int a = 0; a < 2; ++a)
#pragma unroll
            for (int b = 0; b < 2; ++b)
#pragma unroll
                for (int m = 0; m < 4; ++m)
#pragma unroll
                    for (int n = 0; n < 2; ++n) acc[a][b][m][n] = (f32x4){0.f, 0.f, 0.f, 0.f};
        cur = nxt; cA = nA; cB = nB; ++ui;
    }
    PG8_WAIT_V(0);
    if (wr == 0) PG8_BAR;
    PG8_BAR;
#undef PG8_SA
#undef PG8_SB
#undef PG8_STAGE
#undef PG8_LDA
#undef PG8_LDB
#undef PG8_MMA
#undef PG8_WAIT_V
#undef PG8_WAIT_L
#undef PG8_BAR
#undef PG8_SCHED
}
}

template <int MODE> struct Epi {
    unsigned char* ws; const float* xin; const float* gate; float* out;
    __device__ __forceinline__ void operator()(const f32x4 (&acc)[2][2][4][2], const pg8::Unit& u, int wr, int wc, int fr, int fq) const {
        const int pn = u.pn;
        bf16_t* base = nullptr; int ld = 0, c0 = 0;
        if (MODE == 0) {
            if (pn < 6) { base = (bf16_t*)(ws + OFF_RKV); ld = 1536; c0 = pn * 256; }
            else if (pn < 10) { base = (bf16_t*)(ws + OFF_XBC); ld = 1024; c0 = (pn - 6) * 256; }
            else if (pn < 12) { base = (bf16_t*)(ws + OFF_Y3) + (size_t)T * 512; ld = 512; c0 = (pn - 10) * 256; }
            else if (pn == 12) { base = (bf16_t*)(ws + OFF_GQ); ld = 256; c0 = 0; }
            else if (pn == 13) { base = (bf16_t*)(ws + OFF_GK); ld = 256; c0 = 0; }
            else if (pn < 16) { base = (bf16_t*)(ws + OFF_Y3) + (size_t)2 * T * 512; ld = 512; c0 = (pn - 14) * 256; }
        } else if (MODE == 1) {
            if (pn < 2) { base = (bf16_t*)(ws + OFF_Y3); ld = 512; c0 = pn * 256; }
            else if (pn < 4) { base = (bf16_t*)(ws + OFF_Y3) + (size_t)2 * T * 512; ld = 512; c0 = (pn - 2) * 256; }
            else { base = (bf16_t*)(ws + OFF_GATES); ld = 3072; c0 = (pn - 4) * 256; }
        } else if (MODE == 2) { base = (bf16_t*)(ws + OFF_GATES); ld = 3072; c0 = pn * 256; }
#pragma unroll
        for (int ai = 0; ai < 2; ++ai)
#pragma unroll
            for (int m = 0; m < 4; ++m) {
                const int row = u.pm * 256 + ai * 128 + wr * 64 + m * 16 + fr;
#pragma unroll
                for (int bj = 0; bj < 2; ++bj) {
                    const int cl = bj * 128 + wc * 32 + 8 * fq;
                    f32x4 v0 = acc[ai][bj][m][0], v1 = acc[ai][bj][m][1];
                    if (MODE == 0) {
                        if (pn < 16) {
                            u32x4 w; w.x = pg8::cvt_pk_bf16(v0[0], v0[1]); w.y = pg8::cvt_pk_bf16(v0[2], v0[3]); w.z = pg8::cvt_pk_bf16(v1[0], v1[1]); w.w = pg8::cvt_pk_bf16(v1[2], v1[3]);
                            *(u32x4*)(base + (size_t)row * ld + c0 + cl) = w;
                        } else if (cl < 160) {
                            float* d = (float*)(ws + OFF_SMALL) + (size_t)row * 160 + cl;
                            *(f32x4*)d = v0; *(f32x4*)(d + 4) = v1;
                        }
                    } else if (MODE == 1) {
                        bf16_t* d = base + (size_t)row * ld + c0 + cl;
                        if (pn < 4) {
                            const u32x4 o = *(const u32x4*)d;
                            u32x4 w;
                            w.x = pg8::cvt_pk_bf16(lo_bf(o.x) * siluf_(v0[0]), hi_bf(o.x) * siluf_(v0[1]));
                            w.y = pg8::cvt_pk_bf16(lo_bf(o.y) * siluf_(v0[2]), hi_bf(o.y) * siluf_(v0[3]));
                            w.z = pg8::cvt_pk_bf16(lo_bf(o.z) * siluf_(v1[0]), hi_bf(o.z) * siluf_(v1[1]));
                            w.w = pg8::cvt_pk_bf16(lo_bf(o.w) * siluf_(v1[2]), hi_bf(o.w) * siluf_(v1[3]));
                            *(u32x4*)d = w;
                        } else {
                            u32x4 w;
                            w.x = pg8::cvt_pk_bf16(sigmoidf_(v0[0]), sigmoidf_(v0[1])); w.y = pg8::cvt_pk_bf16(sigmoidf_(v0[2]), sigmoidf_(v0[3]));
                            w.z = pg8::cvt_pk_bf16(sigmoidf_(v1[0]), sigmoidf_(v1[1])); w.w = pg8::cvt_pk_bf16(sigmoidf_(v1[2]), sigmoidf_(v1[3]));
                            *(u32x4*)d = w;
                        }
                    } else if (MODE == 2) {
                        bf16_t* d = base + (size_t)row * ld + c0 + cl;
                        const u32x4 o = *(const u32x4*)d;
                        u32x4 w;
                        w.x = pg8::cvt_pk_bf16(lo_bf(o.x) * v0[0], hi_bf(o.x) * v0[1]); w.y = pg8::cvt_pk_bf16(lo_bf(o.y) * v0[2], hi_bf(o.y) * v0[3]);
                        w.z = pg8::cvt_pk_bf16(lo_bf(o.z) * v1[0], hi_bf(o.z) * v1[1]); w.w = pg8::cvt_pk_bf16(lo_bf(o.w) * v1[2], hi_bf(o.w) * v1[3]);
                        *(u32x4*)d = w;
                    } else {
                        const int col = pn * 256 + cl; const int b = row >> 13;
                        const f32x4 x0 = *(const f32x4*)(xin + (size_t)row * 1024 + col), x1 = *(const f32x4*)(xin + (size_t)row * 1024 + col + 4);
                        const f32x4 g0 = *(const f32x4*)(gate + b * 3072 + 2048 + col), g1 = *(const f32x4*)(gate + b * 3072 + 2048 + col + 4);
                        f32x4 r0, r1;
#pragma unroll
                        for (int j = 0; j < 4; ++j) { r0[j] = ALPHA_DN * x0[j] + (1.f + g0[j]) * v0[j]; r1[j] = ALPHA_DN * x1[j] + (1.f + g1[j]) * v1[j]; }
                        *(f32x4*)(out + (size_t)row * 1024 + col) = r0; *(f32x4*)(out + (size_t)row * 1024 + col + 4) = r1;
                    }
                }
            }
    }
};

__device__ __forceinline__ int wt1_src(int n) {
    if (n < 1536) return n;
    if (n < 2560) return 2176 + (n - 1536);
    if (n < 3072) return 3208 + (n - 2560);
    if (n < 3328) return 3720 + (n - 3072);
    if (n < 3584) return 3976 + (n - 3328);
    if (n < 4096) return 4232 + (n - 3584);
    if (n < 4352) { const int s = n - 4096; if (s < 128) return 1536 + s; if (s < 136) return 3200 + (s - 128); if (s < 152) return 4744 + (s - 136); return -1; }
    const int m = n - 4352;
    if (m < 512) return 1664 + m;
    if (m < 1024) return 4760 + (m - 512);
    return 5272 + (m - 1024);
}
template <bool MAP>
__device__ __forceinline__ void transpose_item(const float* W, int ldw, bf16_t* WT, int ldt, int row_off, int col_off, int nblk, LAS float* scr, int item, int lane) {
    const int kb = item / nblk, nb = item % nblk, k0 = 64 * kb, n0 = 32 * nb;
    int sc = n0 + (lane & 31); if (MAP) sc = wt1_src(sc);
#pragma unroll 8
    for (int i = 0; i < 32; ++i) { const int kk = 2 * i + (lane >> 5); scr[kk * 33 + (lane & 31)] = sc >= 0 ? W[(size_t)(k0 + kk) * ldw + sc] : 0.f; }
    WAVE_LDS_SYNC();
    const int c = lane & 7;
#pragma unroll
    for (int j = 0; j < 4; ++j) { const int n = (lane >> 3) + 8 * j; const LAS float* s = scr + (8 * c) * 33 + n;
        u32x4 o; o.x = pk2(s[0 * 33], s[1 * 33]); o.y = pk2(s[2 * 33], s[3 * 33]); o.z = pk2(s[4 * 33], s[5 * 33]); o.w = pk2(s[6 * 33], s[7 * 33]);
        *(u32x4*)(WT + (size_t)(row_off + n0 + n) * ldt + col_off + k0 + 8 * c) = o; }
    WAVE_LDS_SYNC();
}
__device__ void wprep(const Params& p, int l, LAS unsigned char* lds, int TIDX, int BIDX) {
    const int lane = TIDX & 63, wave = TIDX >> 6;
    LAS float* scr = (LAS float*)(lds + wave * 16384);
    const int gw = BIDX * 8 + wave, NGW = gridDim.x * 8;
    constexpr int I1 = (1024 / 64) * (8448 / 32), I2 = 3 * (512 / 64) * (1024 / 32), I3 = 3 * (1024 / 64) * (1024 / 32);
    bf16_t* WT1 = (bf16_t*)(p.ws + OFF_WT1); bf16_t* WT2 = (bf16_t*)(p.ws + OFF_WT2); bf16_t* WT3 = (bf16_t*)(p.ws + OFF_WT3);
    for (int it = gw; it < I1 + I2 + I3; it += NGW) {
        int r = it;
        if (r < I1) { transpose_item<true>(p.in[I_WIN] + (size_t)l * 1024 * INW, INW, WT1, 1024, 0, 0, 8448 / 32, scr, r, lane); continue; }
        r -= I1;
        if (r < I2) { const int b = r / (I2 / 3), rr = r % (I2 / 3); transpose_item<false>(p.in[I_WBR] + ((size_t)l * 3 + b) * 512 * 1024, 1024, WT2, 512, b * 1024, 0, 1024 / 32, scr, rr, lane); continue; }
        r -= I2;
        { const int j = r / (I3 / 3), rr = r % (I3 / 3); transpose_item<false>(p.in[I_WOUT] + (size_t)l * 1024 * 1024, 1024, WT3, 3072, 0, j * 1024, 1024 / 32, scr, rr, lane); }
    }
}
__device__ void ada_phase(const Params& p, LAS unsigned char* lds, int TIDX, int BIDX) {
    LAS float* red = (LAS float*)lds;
    const int tid = TIDX, kg = tid >> 5, cj = tid & 31;
    float* mod = (float*)(p.ws + OFF_MOD);
    for (int it = BIDX; it < 2 * 96; it += gridDim.x) {
        const int l = it / 96, col = (it % 96) * 32 + cj;
        const float* W = p.in[I_ADAW] + (size_t)l * 1024 * 3072;
        float a0 = 0.f, a1 = 0.f, a2 = 0.f, a3 = 0.f;
        for (int k = kg * 64; k < kg * 64 + 64; ++k) {
            const float w = W[(size_t)k * 3072 + col];
            a0 += siluf_(p.in[I_C][k]) * w; a1 += siluf_(p.in[I_C][1024 + k]) * w; a2 += siluf_(p.in[I_C][2048 + k]) * w; a3 += siluf_(p.in[I_C][3072 + k]) * w;
        }
        red[(kg * 32 + cj) * 4 + 0] = a0; red[(kg * 32 + cj) * 4 + 1] = a1; red[(kg * 32 + cj) * 4 + 2] = a2; red[(kg * 32 + cj) * 4 + 3] = a3;
        __syncthreads();
        if (tid < 128) { const int c2 = tid >> 2, b = tid & 3; float s = 0.f;
            for (int g = 0; g < 16; ++g) s += red[(g * 32 + c2) * 4 + b];
            const int cc = (it % 96) * 32 + c2;
            mod[((size_t)l * 4 + b) * 3072 + cc] = s + p.in[I_ADAB][(size_t)l * 3072 + cc]; }
        __syncthreads();
    }
}
__device__ __forceinline__ void ln_stats(const f32x4 (&v)[4], float& mean, float& rstd, float eps) {
    float s = 0.f;
#pragma unroll
    for (int j = 0; j < 4; ++j) s += (v[j][0] + v[j][1]) + (v[j][2] + v[j][3]);
    mean = wave_sum(s) * (1.f / 1024.f); float s2 = 0.f;
#pragma unroll
    for (int j = 0; j < 4; ++j) { const f32x4 d = v[j] - mean; s2 += (d[0] * d[0] + d[1] * d[1]) + (d[2] * d[2] + d[3] * d[3]); }
    rstd = rsqrtf(wave_sum(s2) * (1.f / 1024.f) + eps);
}
__device__ __forceinline__ void mod_row_to_h(const Params& p, const f32x4 (&v)[4], int row, int l, int lane) {
    float mean, rstd; ln_stats(v, mean, rstd, 1e-5f);
    const float* mod = (const float*)(p.ws + OFF_MOD) + ((size_t)l * 4 + (row >> 13)) * 3072;
    bf16_t* H = (bf16_t*)(p.ws + OFF_H) + (size_t)row * 1024;
#pragma unroll
    for (int j = 0; j < 4; ++j) { const int c = 256 * j + 4 * lane;
        const f32x4 sh = *(const f32x4*)(mod + c), sc = *(const f32x4*)(mod + 1024 + c);
        f32x4 h;
#pragma unroll
        for (int e = 0; e < 4; ++e) h[e] = (v[j][e] - mean) * rstd * (1.f + sc[e]) + sh[e];
        u32x2 o; o.x = pk2(h[0], h[1]); o.y = pk2(h[2], h[3]);
        *(u32x2*)(H + c) = o; }
}
__device__ void ln1_phase(const Params& p, int l, const float* xin, int TIDX, int BIDX) {
    const int lane = TIDX & 63, gw = BIDX * 8 + (TIDX >> 6), NGW = gridDim.x * 8;
    for (int row = gw; row < T; row += NGW) {
        f32x4 v[4];
#pragma unroll
        for (int j = 0; j < 4; ++j) v[j] = *(const f32x4*)(xin + (size_t)row * 1024 + 256 * j + 4 * lane);
        mod_row_to_h(p, v, row, l, lane);
    }
}
__device__ void lnpost_phase(const Params& p, int l, int TIDX, int BIDX) {
    const int lane = TIDX & 63, gw = BIDX * 8 + (TIDX >> 6), NGW = gridDim.x * 8;
    const float* pg = p.in[I_PG] + l * 1024; const float* pb = p.in[I_PB] + l * 1024;
    for (int row = gw; row < T; row += NGW) {
        f32x4 v[4];
#pragma unroll
        for (int j = 0; j < 4; ++j) v[j] = *(const f32x4*)(p.out + (size_t)row * 1024 + 256 * j + 4 * lane);
        float mean, rstd; ln_stats(v, mean, rstd, 1e-5f);
#pragma unroll
        for (int j = 0; j < 4; ++j) { const int c = 256 * j + 4 * lane; const f32x4 g = *(const f32x4*)(pg + c), b = *(const f32x4*)(pb + c);
#pragma unroll
            for (int e = 0; e < 4; ++e) v[j][e] = (v[j][e] - mean) * rstd * g[e] + b[e];
            *(f32x4*)(p.out + (size_t)row * 1024 + c) = v[j]; }
        if (l == 0) mod_row_to_h(p, v, row, 1, lane);
    }
}

__device__ __forceinline__ void conv_unpack(const u32x4 w, float (&x)[8]) {
#pragma unroll
    for (int q = 0; q < 4; ++q) { x[2 * q] = lo_bf(w[q]); x[2 * q + 1] = hi_bf(w[q]); }
}
__device__ void rwkv_prep_phase(const Params& p, int l, LAS unsigned char* lds, int TIDX, int BIDX, cg::grid_group& grid) {
    {
        bf16_t* XBC = (bf16_t*)(p.ws + OFF_XBC);
        const int cgp = TIDX & 127, qt = TIDX >> 7; const int q0 = BIDX * 128 + qt * 32; const int c8 = cgp * 8;
        float h1[8], h2[8], h3[8];
        if ((q0 & (SEQ - 1)) != 0) { conv_unpack(*(const u32x4*)(XBC + (size_t)(q0 - 1) * 1024 + c8), h1); conv_unpack(*(const u32x4*)(XBC + (size_t)(q0 - 2) * 1024 + c8), h2); conv_unpack(*(const u32x4*)(XBC + (size_t)(q0 - 3) * 1024 + c8), h3); }
        else {
#pragma unroll
            for (int e = 0; e < 8; ++e) h1[e] = h2[e] = h3[e] = 0.f; }
        grid.sync();
        float cw0[8], cw1[8], cw2[8], cw3[8], cb[8];
#pragma unroll
        for (int e = 0; e < 8; ++e) { cw0[e] = p.in[I_CONVW][((size_t)l * 4 + 0) * 1024 + c8 + e]; cw1[e] = p.in[I_CONVW][((size_t)l * 4 + 1) * 1024 + c8 + e];
            cw2[e] = p.in[I_CONVW][((size_t)l * 4 + 2) * 1024 + c8 + e]; cw3[e] = p.in[I_CONVW][((size_t)l * 4 + 3) * 1024 + c8 + e]; cb[e] = p.in[I_CONVB][l * 1024 + c8 + e]; }
#pragma unroll 4
        for (int i = 0; i < 32; ++i) {
            bf16_t* ptr = XBC + (size_t)(q0 + i) * 1024 + c8;
            float x0[8]; conv_unpack(*(const u32x4*)ptr, x0);
            float y[8];
#pragma unroll
            for (int e = 0; e < 8; ++e) { y[e] = siluf_(cw0[e] * h3[e] + cw1[e] * h2[e] + cw2[e] * h1[e] + cw3[e] * x0[e] + cb[e]); h3[e] = h2[e]; h2[e] = h1[e]; h1[e] = x0[e]; }
            u32x4 w; w.x = pk2(y[0], y[1]); w.y = pk2(y[2], y[3]); w.z = pk2(y[4], y[5]); w.w = pk2(y[6], y[7]);
            *(u32x4*)ptr = w;
        }
    }
    LAS float* s = (LAS float*)lds;
    const int c = TIDX;
    float wu[64], au[64];
#pragma unroll
    for (int j = 0; j < 64; ++j) { wu[j] = p.in[I_WUP][((size_t)l * 64 + j) * 512 + c]; au[j] = p.in[I_AUP][((size_t)l * 64 + j) * 512 + c]; }
    const float w0 = p.in[I_W0][l * 512 + c], a0 = p.in[I_A0][l * 512 + c];
    const float* SM = (const float*)(p.ws + OFF_SMALL);
    const float* mu = p.in[I_MU] + l * 1664 + 1536;
    bf16_t* A = (bf16_t*)(p.ws + OFF_A); float* DEC = (float*)(p.ws + OFF_DEC);
    const int tpb = T / gridDim.x;
    for (int t0 = BIDX * tpb; t0 < (BIDX + 1) * tpb; t0 += 4) {
        { const int tt = c >> 7, j = c & 127; const int row = t0 + tt;
          const float cur = SM[(size_t)row * 160 + j]; const float prev = (row & (SEQ - 1)) ? SM[(size_t)(row - 1) * 160 + j] : 0.f;
          const float v = cur + mu[j] * (prev - cur);
          s[tt * 128 + j] = j < 64 ? tanhf(v) : v; }
        __syncthreads();
#pragma unroll
        for (int tt = 0; tt < 4; ++tt) {
            float w = w0, a = a0;
#pragma unroll
            for (int j = 0; j < 64; ++j) { w += s[tt * 128 + j] * wu[j]; a += s[tt * 128 + 64 + j] * au[j]; }
            const size_t o = (size_t)(t0 + tt) * 512 + c;
            A[o] = f2bf(sigmoidf_(a)); DEC[o] = __expf(-0.6065306597126334f * sigmoidf_(w));
        }
        __syncthreads();
    }
}

typedef float f32x2 __attribute__((ext_vector_type(2)));
template <int CTRL> __device__ __forceinline__ float dpp_f(float x) { return __builtin_bit_cast(float, __builtin_amdgcn_update_dpp(0, __builtin_bit_cast(int, x), CTRL, 0xF, 0xF, true)); }
__device__ __forceinline__ float row16_sum(float x) { x += dpp_f<0xB1>(x); x += dpp_f<0x4E>(x); x += dpp_f<0x141>(x); x += dpp_f<0x140>(x); return x; }
constexpr int RW_TC = 32, RW_VEC_B = RW_TC * 5 * 64 * 4, RW_V_B = RW_TC * 16 * 4, RW_BUF_B = RW_VEC_B + 2 * RW_V_B;
__device__ void rwkv_scan_fast(const Params& p, int l, int unit, LAS unsigned char* lds, int TIDX) {
    const int bh = unit >> 2, rq = unit & 3, b = bh >> 3, h = bh & 7, wave = TIDX >> 6, lane = TIDX & 63;
    const size_t r0 = (size_t)b * SEQ;
    bf16_t* Y = (bf16_t*)(p.ws + OFF_Y3);
    if (wave >= 4) {
        const int lw = wave - 4, sl = lane >> 3, c8 = (lane & 7) * 8, ch0 = h * 64 + c8;
        const bf16_t* RKV = (const bf16_t*)(p.ws + OFF_RKV); const bf16_t* A = (const bf16_t*)(p.ws + OFF_A); const float* DEC = (const float*)(p.ws + OFF_DEC);
        float mu_r[8], mu_k[8], mu_v[8], k_k[8], k_a[8];
#pragma unroll
        for (int e = 0; e < 8; ++e) { mu_r[e] = p.in[I_MU][l * 1664 + ch0 + e]; mu_k[e] = p.in[I_MU][l * 1664 + 512 + ch0 + e]; mu_v[e] = p.in[I_MU][l * 1664 + 1024 + ch0 + e];
            k_k[e] = p.in[I_KK][l * 512 + ch0 + e]; k_a[e] = p.in[I_KA][l * 512 + ch0 + e]; }
        u32x4 nR, nK, nV, nRp, nKp, nVp, nA; f32x4 nD0, nD1;
        auto issue = [&](int cc) {
            const size_t row = r0 + (size_t)cc * RW_TC + lw * 8 + sl;
            nR = *(const u32x4*)(RKV + row * 1536 + ch0); nK = *(const u32x4*)(RKV + row * 1536 + 512 + ch0); nV = *(const u32x4*)(RKV + row * 1536 + 1024 + ch0);
            nA = *(const u32x4*)(A + row * 512 + ch0); nD0 = *(const f32x4*)(DEC + row * 512 + ch0); nD1 = *(const f32x4*)(DEC + row * 512 + ch0 + 4);
            const size_t prow = (row & (SEQ - 1)) != 0 ? row - 1 : row;
            nRp = *(const u32x4*)(RKV + prow * 1536 + ch0); nKp = *(const u32x4*)(RKV + prow * 1536 + 512 + ch0); nVp = *(const u32x4*)(RKV + prow * 1536 + 1024 + ch0);
        };
        issue(0);
        for (int c = -1; c < SEQ / RW_TC; ++c) {
            if (c >= 1) { LAS const float* yb = (LAS const float*)(lds + ((c - 1) & 1) * RW_BUF_B + RW_VEC_B + RW_V_B);
                const int idx = (lw * 64 + lane) * 2, s = idx >> 4, i = idx & 15;
                *(unsigned*)(Y + (r0 + (size_t)(c - 1) * RW_TC + s) * 512 + h * 64 + rq * 16 + i) = pk2(yb[idx], yb[idx + 1]); }
            if (c + 1 < SEQ / RW_TC) {
                const u32x4 cR = nR, cK = nK, cV = nV, cRp = nRp, cKp = nKp, cVp = nVp, cA = nA; const f32x4 cD0 = nD0, cD1 = nD1;
                if (c + 2 < SEQ / RW_TC) issue(c + 2);
                LAS float* vec = (LAS float*)(lds + ((c + 1) & 1) * RW_BUF_B); LAS float* vb = (LAS float*)(lds + ((c + 1) & 1) * RW_BUF_B + RW_VEC_B);
                const int s = lw * 8 + sl;
                float cr[8], ck[8], cv[8], pr[8], pk[8], pv[8], ca[8];
                conv_unpack(cR, cr); conv_unpack(cK, ck); conv_unpack(cV, cv); conv_unpack(cRp, pr); conv_unpack(cKp, pk); conv_unpack(cVp, pv); conv_unpack(cA, ca);
                if ((((c + 1) * RW_TC + s) & (SEQ - 1)) == 0) {
#pragma unroll
                    for (int e = 0; e < 8; ++e) pr[e] = pk[e] = pv[e] = 0.f; }
                float rr[8], kk[8], vv[8], kkj[8]; float n2 = 0.f;
#pragma unroll
                for (int e = 0; e < 8; ++e) { rr[e] = cr[e] + mu_r[e] * (pr[e] - cr[e]); kk[e] = ck[e] + mu_k[e] * (pk[e] - ck[e]); vv[e] = cv[e] + mu_v[e] * (pv[e] - cv[e]);
                    kkj[e] = kk[e] * k_k[e]; n2 += kkj[e] * kkj[e]; }
                n2 += dpp_f<0xB1>(n2); n2 += dpp_f<0x4E>(n2); n2 += dpp_f<0x141>(n2);
                const float inv = 1.f / fmaxf(sqrtf(n2), 1e-12f);
                f32x4 o0, o1;
                LAS float* d = vec + s * 320 + c8;
                *(LAS f32x4*)(d) = cD0; *(LAS f32x4*)(d + 4) = cD1;
#pragma unroll
                for (int e = 0; e < 4; ++e) { o0[e] = kkj[e] * inv; o1[e] = kkj[4 + e] * inv; }
                *(LAS f32x4*)(d + 64) = o0; *(LAS f32x4*)(d + 68) = o1;
#pragma unroll
                for (int e = 0; e < 4; ++e) { o0[e] *= ca[e]; o1[e] *= ca[4 + e]; }
                *(LAS f32x4*)(d + 128) = o0; *(LAS f32x4*)(d + 132) = o1;
#pragma unroll
                for (int e = 0; e < 4; ++e) { o0[e] = kk[e] * (1.f + (ca[e] - 1.f) * k_a[e]); o1[e] = kk[4 + e] * (1.f + (ca[4 + e] - 1.f) * k_a[4 + e]); }
                *(LAS f32x4*)(d + 192) = o0; *(LAS f32x4*)(d + 196) = o1;
#pragma unroll
                for (int e = 0; e < 4; ++e) { o0[e] = rr[e]; o1[e] = rr[4 + e]; }
                *(LAS f32x4*)(d + 256) = o0; *(LAS f32x4*)(d + 260) = o1;
                if ((c8 >> 4) == rq) {
#pragma unroll
                    for (int e = 0; e < 4; ++e) { o0[e] = vv[e]; o1[e] = vv[4 + e]; }
                    *(LAS f32x4*)(vb + s * 16 + (c8 & 15)) = o0; *(LAS f32x4*)(vb + s * 16 + (c8 & 15) + 4) = o1; }
            }
            __syncthreads();
        }
        { constexpr int c = SEQ / RW_TC; LAS const float* yb = (LAS const float*)(lds + ((c - 1) & 1) * RW_BUF_B + RW_VEC_B + RW_V_B);
          const int idx = (lw * 64 + lane) * 2, s = idx >> 4, i = idx & 15;
          *(unsigned*)(Y + (r0 + (size_t)(c - 1) * RW_TC + s) * 512 + h * 64 + rq * 16 + i) = pk2(yb[idx], yb[idx + 1]); }
    } else {
        const int rl = wave * 4 + (lane >> 4), cq = lane & 15;
        f32x2 S0 = (f32x2){0.f, 0.f}, S1 = (f32x2){0.f, 0.f};
        __syncthreads();
        for (int c = 0; c < SEQ / RW_TC; ++c) {
            LAS const unsigned char* buf = lds + (c & 1) * RW_BUF_B;
            LAS const float* vb = (LAS const float*)(buf + RW_VEC_B); LAS float* yb = (LAS float*)(buf + RW_VEC_B + RW_V_B);
            LAS const f32x4* q = (LAS const f32x4*)buf + cq;
            f32x4 w4 = q[0], k4 = q[16], b4 = q[32], t4 = q[48], r4 = q[64]; float v = vb[rl];
            float ykeep = 0.f;
#pragma unroll
            for (int s = 0; s < RW_TC; ++s) {
                f32x4 nw = w4, nk = k4, nb = b4, nt = t4, nr = r4; float nv = v;
                if (s + 1 < RW_TC) { LAS const f32x4* qn = q + (s + 1) * 80; nw = qn[0]; nk = qn[16]; nb = qn[32]; nt = qn[48]; nr = qn[64]; nv = vb[(s + 1) * 16 + rl]; }
                f32x2 sp = S0 * (f32x2){k4[0], k4[1]} + S1 * (f32x2){k4[2], k4[3]};
                const float sa = -row16_sum(sp[0] + sp[1]);
                S0 = S0 * (f32x2){w4[0], w4[1]} + (f32x2){b4[0], b4[1]} * sa + (f32x2){t4[0], t4[1]} * v;
                S1 = S1 * (f32x2){w4[2], w4[3]} + (f32x2){b4[2], b4[3]} * sa + (f32x2){t4[2], t4[3]} * v;
                f32x2 yp = S0 * (f32x2){r4[0], r4[1]} + S1 * (f32x2){r4[2], r4[3]};
                const float y = row16_sum(yp[0] + yp[1]);
                ykeep = ((s & 15) == cq) ? y : ykeep;
                if ((s & 15) == 15) yb[((s & ~15) + cq) * 16 + rl] = ykeep;
                w4 = nw; k4 = nk; b4 = nb; t4 = nt; r4 = nr; v = nv;
            }
            __syncthreads();
        }
    }
}

__device__ __forceinline__ int tm_shift(int t) { return ((t >> 3) & 3) * 16; }
template <int K, int AM, int BMODE>
__device__ __forceinline__ f32x4 mma_t(LAS const bf16_t* A, int lda, int arow0, LAS const bf16_t* B, int ldb, int brow0, f32x4 acc, int lane) {
    const int r = lane & 15, kg = lane >> 4;
#pragma unroll
    for (int k0 = 0; k0 < K; k0 += 32) {
        bf16x8 a, b;
        if (AM == 0) a = *(LAS const bf16x8*)(A + (arow0 + r) * lda + k0 + kg * 8);
        else if (AM == 2) a = *(LAS const bf16x8*)(A + (arow0 + r) * lda + tm_shift(arow0 + r) + k0 + kg * 8);
        else { LAS const bf16_t* q = A + (k0 + kg * 8) * lda + tm_shift(k0 + kg * 8) + arow0 + r;
#pragma unroll
            for (int j = 0; j < 8; ++j) a[j] = (short)q[j * lda]; }
        if (BMODE == 0) b = *(LAS const bf16x8*)(B + (brow0 + r) * ldb + k0 + kg * 8);
        else if (BMODE == 2) b = *(LAS const bf16x8*)(B + (brow0 + r) * ldb + tm_shift(brow0 + r) + k0 + kg * 8);
        else { LAS const bf16_t* q = B + (k0 + kg * 8) * ldb + tm_shift(k0 + kg * 8) + brow0 + r;
#pragma unroll
            for (int j = 0; j < 8; ++j) b[j] = (short)q[j * ldb]; }
        acc = __builtin_amdgcn_mfma_f32_16x16x32_bf16(a, b, acc, 0, 0, 0);
    }
    return acc;
}
__device__ void mamba2_chunk(const Params& p, int l, int bh, LAS unsigned char* lds, int TIDX) {
    const int b = bh >> 3, h = bh & 7, g = h >> 2, tid = TIDX, wave = tid >> 6, lane = tid & 63, r = lane & 15, kg = lane >> 4;
    LAS bf16_t* CB = (LAS bf16_t*)lds;
    LAS bf16_t* BB = (LAS bf16_t*)(lds + 17408);
    LAS bf16_t* AY = (LAS bf16_t*)(lds + 41984);
    LAS bf16_t* SB = (LAS bf16_t*)(lds + 67584);
    LAS bf16_t* XD = (LAS bf16_t*)(lds + 84992);
    LAS bf16_t* XE = (LAS bf16_t*)(lds + 101376);
    LAS bf16_t* XS = (LAS bf16_t*)(lds + 117760);
    LAS float* F = (LAS float*)(lds + 126976);
    const bf16_t* XBC = (const bf16_t*)(p.ws + OFF_XBC); const float* SM = (const float*)(p.ws + OFF_SMALL);
    bf16_t* Z = (bf16_t*)(p.ws + OFF_Y3) + (size_t)T * 512;
    const float dtb = p.in[I_DTB][l * 8 + h], ah = -__expf(p.in[I_ALOG][l * 8 + h]), dsk = p.in[I_DSKIP][l * 8 + h];
    const size_t rbase = (size_t)b * SEQ;
    f32x4 sacc[4];
#pragma unroll
    for (int i = 0; i < 4; ++i) sacc[i] = (f32x4){0.f, 0.f, 0.f, 0.f};
    for (int i = tid; i < 64 * 128; i += 512) SB[(i >> 7) * 136 + (i & 127)] = 0;
    u32x4 rc[2], rb[2], rx; float rdt = 0.f;
    auto prefetch = [&](int c) {
        const size_t row0 = rbase + (size_t)c * 64;
#pragma unroll
        for (int i = 0; i < 2; ++i) { const int item = tid + 512 * i, ll = item >> 4, ng = item & 15;
            rc[i] = *(const u32x4*)(XBC + (row0 + ll) * 1024 + 768 + g * 128 + ng * 8); rb[i] = *(const u32x4*)(XBC + (row0 + ll) * 1024 + 512 + g * 128 + ng * 8); }
        rx = *(const u32x4*)(XBC + (row0 + (tid >> 3)) * 1024 + h * 64 + (tid & 7) * 8);
        if (tid < 64) rdt = SM[(row0 + tid) * 160 + 128 + h];
    };
    prefetch(0);
    for (int c = 0; c < SEQ / 64; ++c) {
        const size_t row0 = rbase + (size_t)c * 64;
        if (tid < 64) { const float dt = softplusf_(rdt + dtb); float x = dt * ah;
#pragma unroll
            for (int o = 1; o < 64; o <<= 1) { const float y = __shfl_up(x, o); if (lane >= o) x += y; }
            F[tid] = x; F[64 + tid] = dt; }
        __syncthreads();
        const float acs_last = F[63];
#pragma unroll
        for (int i = 0; i < 2; ++i) { const int item = tid + 512 * i, ll = item >> 4, ng = item & 15;
            *(LAS u32x4*)(CB + ll * 136 + ng * 8) = rc[i]; *(LAS u32x4*)(BB + ll * 192 + tm_shift(ll) + ng * 8) = rb[i];
            const float ea = __expf(F[ll]); float cv[8]; conv_unpack(rc[i], cv);
            u32x4 w; w.x = pk2(cv[0] * ea, cv[1] * ea); w.y = pk2(cv[2] * ea, cv[3] * ea); w.z = pk2(cv[4] * ea, cv[5] * ea); w.w = pk2(cv[6] * ea, cv[7] * ea);
            *(LAS u32x4*)(AY + ll * 200 + 64 + ng * 8) = w; }
        { const int ll = tid >> 3, pg = tid & 7; float xv[8]; conv_unpack(rx, xv); const float dtl = F[64 + ll], ee = __expf(acs_last - F[ll]);
          float xd[8];
#pragma unroll
          for (int e = 0; e < 8; ++e) xd[e] = xv[e] * dtl;
          u32x4 w; w.x = pk2(xd[0], xd[1]); w.y = pk2(xd[2], xd[3]); w.z = pk2(xd[4], xd[5]); w.w = pk2(xd[6], xd[7]);
          *(LAS u32x4*)(XD + ll * 128 + tm_shift(ll) + pg * 8) = w;
          w.x = pk2(xd[0] * ee, xd[1] * ee); w.y = pk2(xd[2] * ee, xd[3] * ee); w.z = pk2(xd[4] * ee, xd[5] * ee); w.w = pk2(xd[6] * ee, xd[7] * ee);
          *(LAS u32x4*)(XE + ll * 128 + tm_shift(ll) + pg * 8) = w;
          *(LAS u32x4*)(XS + ll * 72 + pg * 8) = rx; }
        __syncthreads();
        if (c + 1 < SEQ / 64) prefetch(c + 1);
#pragma unroll
        for (int q = 0; q < 2; ++q) { const int tt = wave + 8 * q, tl = tt >> 2, ts = tt & 3;
            f32x4 acc = (f32x4){0.f, 0.f, 0.f, 0.f};
            if (ts <= tl) acc = mma_t<128, 0, 2>(CB, 136, tl * 16, BB, 192, ts * 16, acc, lane);
            const int sc = ts * 16 + r; const float as = F[sc];
#pragma unroll
            for (int j = 0; j < 4; ++j) { const int ll = tl * 16 + kg * 4 + j; const float v = (sc <= ll) ? acc[j] * __expf(F[ll] - as) : 0.f; AY[ll * 200 + sc] = f2bf(v); } }
        __syncthreads();
#pragma unroll
        for (int q = 0; q < 2; ++q) { const int tt = wave + 8 * q, tl = tt >> 2, tp = tt & 3;
            f32x4 acc = (f32x4){0.f, 0.f, 0.f, 0.f};
            acc = mma_t<64, 0, 1>(AY, 200, tl * 16, XD, 128, tp * 16, acc, lane);
            acc = mma_t<128, 0, 0>(AY + 64, 200, tl * 16, SB, 136, tp * 16, acc, lane);
            const int pp = tp * 16 + r;
#pragma unroll
            for (int j = 0; j < 4; ++j) { const int ll = tl * 16 + kg * 4 + j; bf16_t* zp = Z + (row0 + ll) * 512 + h * 64 + pp;
                const float y = acc[j] + dsk * bf2f(XS[ll * 72 + pp]); *zp = f2bf(y * siluf_(bf2f(*zp))); } }
        const float dl = __expf(acs_last);
#pragma unroll
        for (int i = 0; i < 4; ++i) { const int id = wave * 4 + i, tp = id >> 3, tn = id & 7;
            sacc[i] = sacc[i] * dl; sacc[i] = mma_t<64, 1, 1>(XE, 128, tp * 16, BB, 192, tn * 16, sacc[i], lane); }
        __syncthreads();
#pragma unroll
        for (int i = 0; i < 4; ++i) { const int id = wave * 4 + i, tp = id >> 3, tn = id & 7;
#pragma unroll
            for (int j = 0; j < 4; ++j) SB[(tp * 16 + kg * 4 + j) * 136 + tn * 16 + r] = f2bf(sacc[i][j]); }
    }
}
__device__ void gla_chunk(const Params& p, int l, int unit, LAS unsigned char* lds, int TIDX) {
    const int bh = unit >> 1, eh = unit & 1, b = bh >> 2, h = bh & 3, tid = TIDX, wave = tid >> 6, lane = tid & 63, r = lane & 15, kg = lane >> 4;
    LAS bf16_t* KG = (LAS bf16_t*)lds;
    LAS bf16_t* AY = (LAS bf16_t*)(lds + 9216);
    LAS bf16_t* SB = (LAS bf16_t*)(lds + 26624);
    LAS bf16_t* VV = (LAS bf16_t*)(lds + 35840);
    LAS bf16_t* KD = (LAS bf16_t*)(lds + 52224);
    LAS float* G = (LAS float*)(lds + 68608);
    LAS float* UP = (LAS float*)(lds + 85248);
    LAS float* GD = (LAS float*)(lds + 89344);
    LAS float* SEG = (LAS float*)(lds + 93440);
    const bf16_t* GQ = (const bf16_t*)(p.ws + OFF_GQ); const bf16_t* GK = (const bf16_t*)(p.ws + OFF_GK); const float* SM = (const float*)(p.ws + OFF_SMALL);
    bf16_t* GV = (bf16_t*)(p.ws + OFF_Y3) + (size_t)2 * T * 512;
    const size_t rbase = (size_t)b * SEQ;
    const int ll = tid >> 3, dg = tid & 7;
    for (int i = tid; i < 16 * 64; i += 512) UP[i] = p.in[I_GKUP][((size_t)l * 16 + (i >> 6)) * 256 + h * 64 + (i & 63)];
    float gkb[8];
#pragma unroll
    for (int e = 0; e < 8; ++e) gkb[e] = p.in[I_GKB][l * 256 + h * 64 + dg * 8 + e];
    f32x4 sacc[2];
    sacc[0] = sacc[1] = (f32x4){0.f, 0.f, 0.f, 0.f};
    for (int i = tid; i < 64 * 64; i += 512) SB[(i >> 6) * 72 + (i & 63)] = 0;
    u32x4 rq, rk, rv; f32x4 rg = (f32x4){0.f, 0.f, 0.f, 0.f};
    auto prefetch = [&](int c) {
        const size_t row0 = rbase + (size_t)c * 64;
        rq = *(const u32x4*)(GQ + (row0 + ll) * 256 + h * 64 + dg * 8); rk = *(const u32x4*)(GK + (row0 + ll) * 256 + h * 64 + dg * 8);
        rv = *(const u32x4*)(GV + (row0 + ll) * 512 + h * 128 + eh * 64 + dg * 8);
        if (tid < 256) rg = *(const f32x4*)(SM + (row0 + (tid >> 2)) * 160 + 136 + (tid & 3) * 4);
    };
    prefetch(0);
    for (int c = 0; c < SEQ / 64; ++c) {
        const size_t row0 = rbase + (size_t)c * 64;
        if (tid < 256) *(LAS f32x4*)(GD + (tid >> 2) * 16 + (tid & 3) * 4) = rg;
        __syncthreads();
        { float gp[8];
#pragma unroll
          for (int e = 0; e < 8; ++e) gp[e] = gkb[e];
#pragma unroll
          for (int q = 0; q < 16; ++q) { const float gd = GD[ll * 16 + q];
#pragma unroll
              for (int e = 0; e < 8; ++e) gp[e] += gd * UP[q * 64 + dg * 8 + e]; }
#pragma unroll
          for (int e = 0; e < 8; ++e) G[ll * 65 + dg * 8 + e] = (fminf(gp[e], 0.f) - log1pf(__expf(-fabsf(gp[e])))) * (1.f / 16.f); }
        __syncthreads();
        { const int d = tid & 63, sg = tid >> 6; float gv[8]; float a = 0.f;
#pragma unroll
          for (int q = 0; q < 8; ++q) { a += G[(sg * 8 + q) * 65 + d]; gv[q] = a; }
          SEG[sg * 64 + d] = a;
          __syncthreads();
          float off = 0.f;
#pragma unroll
          for (int q = 0; q < 7; ++q) off += (q < sg) ? SEG[q * 64 + d] : 0.f;
#pragma unroll
          for (int q = 0; q < 8; ++q) G[(sg * 8 + q) * 65 + d] = gv[q] + off; }
        __syncthreads();
        { float qv[8], kv[8]; conv_unpack(rq, qv); conv_unpack(rk, kv);
          float qg[8], ki[8], kd[8];
#pragma unroll
          for (int e = 0; e < 8; ++e) { const int d = dg * 8 + e; const float gl = G[ll * 65 + d], glast = G[63 * 65 + d];
              qg[e] = qv[e] * 0.125f * __expf(gl); ki[e] = kv[e] * __expf(-gl); kd[e] = kv[e] * __expf(glast - gl); }
          u32x4 w; w.x = pk2(qg[0], qg[1]); w.y = pk2(qg[2], qg[3]); w.z = pk2(qg[4], qg[5]); w.w = pk2(qg[6], qg[7]);
          *(LAS u32x4*)(AY + ll * 136 + 64 + dg * 8) = w;
          w.x = pk2(ki[0], ki[1]); w.y = pk2(ki[2], ki[3]); w.z = pk2(ki[4], ki[5]); w.w = pk2(ki[6], ki[7]);
          *(LAS u32x4*)(KG + ll * 72 + dg * 8) = w;
          w.x = pk2(kd[0], kd[1]); w.y = pk2(kd[2], kd[3]); w.z = pk2(kd[4], kd[5]); w.w = pk2(kd[6], kd[7]);
          *(LAS u32x4*)(KD + ll * 128 + tm_shift(ll) + dg * 8) = w;
          *(LAS u32x4*)(VV + ll * 128 + tm_shift(ll) + dg * 8) = rv; }
        __syncthreads();
        if (c + 1 < SEQ / 64) prefetch(c + 1);
#pragma unroll
        for (int q = 0; q < 2; ++q) { const int tt = wave + 8 * q, tl = tt >> 2, ts = tt & 3;
            f32x4 acc = (f32x4){0.f, 0.f, 0.f, 0.f};
            if (ts <= tl) acc = mma_t<64, 0, 0>(AY + 64, 136, tl * 16, KG, 72, ts * 16, acc, lane);
            const int sc = ts * 16 + r;
#pragma unroll
            for (int j = 0; j < 4; ++j) { const int l2 = tl * 16 + kg * 4 + j; AY[l2 * 136 + sc] = f2bf((sc <= l2) ? acc[j] : 0.f); } }
        __syncthreads();
#pragma unroll
        for (int q = 0; q < 2; ++q) { const int tt = wave + 8 * q, tl = tt >> 2, te = tt & 3;
            f32x4 acc = (f32x4){0.f, 0.f, 0.f, 0.f};
            acc = mma_t<64, 0, 1>(AY, 136, tl * 16, VV, 128, te * 16, acc, lane);
            acc = mma_t<64, 0, 0>(AY + 64, 136, tl * 16, SB, 72, te * 16, acc, lane);
#pragma unroll
            for (int j = 0; j < 4; ++j) GV[(row0 + tl * 16 + kg * 4 + j) * 512 + h * 128 + eh * 64 + te * 16 + r] = f2bf(acc[j]); }
#pragma unroll
        for (int i = 0; i < 2; ++i) { const int id = wave * 2 + i, te = id >> 2, td = id & 3;
            const float dl = __expf(G[63 * 65 + td * 16 + r]);
            sacc[i] = sacc[i] * dl; sacc[i] = mma_t<64, 1, 1>(VV, 128, te * 16, KD, 128, td * 16, sacc[i], lane); }
        __syncthreads();
#pragma unroll
        for (int i = 0; i < 2; ++i) { const int id = wave * 2 + i, te = id >> 2, td = id & 3;
#pragma unroll
            for (int j = 0; j < 4; ++j) SB[(te * 16 + kg * 4 + j) * 72 + td * 16 + r] = f2bf(sacc[i][j]); }
    }
}
__device__ void scans_naive_phase(const Params& p, int l, LAS unsigned char* lds, int TIDX, int BIDX) {
    const int wave = TIDX >> 6;
    LAS float* wl = (LAS float*)(lds + wave * 4096);
    if (BIDX < 128) { rwkv_scan_fast(p, l, BIDX, lds, TIDX); return; }
    const int u = BIDX - 128;
    if (u < 32) mamba2_chunk(p, l, u, lds, TIDX);
    else if (u < 64) gla_chunk(p, l, u - 32, lds, TIDX);
}
__device__ void post_phase(const Params& p, int l, int TIDX, int BIDX) {
    const int lane = TIDX & 63, gw = BIDX * 8 + (TIDX >> 6), NGW = gridDim.x * 8;
    const bf16_t* RKV = (const bf16_t*)(p.ws + OFF_RKV); const bf16_t* A = (const bf16_t*)(p.ws + OFF_A);
    bf16_t* Y0 = (bf16_t*)(p.ws + OFF_Y3); bf16_t* Y1 = Y0 + (size_t)T * 512; bf16_t* Y2 = Y1 + (size_t)T * 512;
    const int c0 = lane * 8;
    float mur[8], muk[8], muv[8], kA[8], rk[8], lg[8], lb[8], nw1[8], nw2[8];
#pragma unroll
    for (int e = 0; e < 8; ++e) { const int c = c0 + e;
        mur[e] = p.in[I_MU][l * 1664 + c]; muk[e] = p.in[I_MU][l * 1664 + 512 + c]; muv[e] = p.in[I_MU][l * 1664 + 1024 + c];
        kA[e] = p.in[I_KA][l * 512 + c]; rk[e] = p.in[I_RK][l * 512 + c]; lg[e] = p.in[I_LNG][l * 512 + c]; lb[e] = p.in[I_LNB][l * 512 + c];
        nw1[e] = p.in[I_M2NW][l * 512 + c]; nw2[e] = p.in[I_GNW][l * 128 + (c & 127)]; }
    for (int row = gw; row < T; row += NGW) {
        const bool first = (row & (SEQ - 1)) == 0;
        float y[8], r[8], k[8], v[8], a[8];
        { const u32x4 yy = *(const u32x4*)(Y0 + (size_t)row * 512 + c0); const u32x4 aa = *(const u32x4*)(A + (size_t)row * 512 + c0);
          const u32x4 rr = *(const u32x4*)(RKV + (size_t)row * 1536 + c0), kk = *(const u32x4*)(RKV + (size_t)row * 1536 + 512 + c0), vv = *(const u32x4*)(RKV + (size_t)row * 1536 + 1024 + c0);
          u32x4 rp = (u32x4){0, 0, 0, 0}, kp = rp, vp = rp;
          if (!first) { rp = *(const u32x4*)(RKV + (size_t)(row - 1) * 1536 + c0); kp = *(const u32x4*)(RKV + (size_t)(row - 1) * 1536 + 512 + c0); vp = *(const u32x4*)(RKV + (size_t)(row - 1) * 1536 + 1024 + c0); }
#pragma unroll
          for (int q = 0; q < 4; ++q) {
              y[2 * q] = lo_bf(yy[q]); y[2 * q + 1] = hi_bf(yy[q]); a[2 * q] = lo_bf(aa[q]); a[2 * q + 1] = hi_bf(aa[q]);
              float x0 = lo_bf(rr[q]), x1 = hi_bf(rr[q]); r[2 * q] = x0 + mur[2 * q] * (lo_bf(rp[q]) - x0); r[2 * q + 1] = x1 + mur[2 * q + 1] * (hi_bf(rp[q]) - x1);
              x0 = lo_bf(kk[q]); x1 = hi_bf(kk[q]); k[2 * q] = x0 + muk[2 * q] * (lo_bf(kp[q]) - x0); k[2 * q + 1] = x1 + muk[2 * q + 1] * (hi_bf(kp[q]) - x1);
              x0 = lo_bf(vv[q]); x1 = hi_bf(vv[q]); v[2 * q] = x0 + muv[2 * q] * (lo_bf(vp[q]) - x0); v[2 * q + 1] = x1 + muv[2 * q + 1] * (hi_bf(vp[q]) - x1); } }
        float s = 0.f, bs = 0.f;
#pragma unroll
        for (int e = 0; e < 8; ++e) { s += y[e]; bs += r[e] * (k[e] * (1.f + (a[e] - 1.f) * kA[e])) * rk[e]; }
        s += __shfl_xor(s, 1); s += __shfl_xor(s, 2); s += __shfl_xor(s, 4);
        bs += __shfl_xor(bs, 1); bs += __shfl_xor(bs, 2); bs += __shfl_xor(bs, 4);
        const float mean = s * (1.f / 64.f); float s2 = 0.f;
#pragma unroll
        for (int e = 0; e < 8; ++e) { const float d = y[e] - mean; s2 += d * d; }
        s2 += __shfl_xor(s2, 1); s2 += __shfl_xor(s2, 2); s2 += __shfl_xor(s2, 4);
        const float rstd = rsqrtf(s2 * (1.f / 64.f) + 64e-5f);
        { float o[8];
#pragma unroll
          for (int e = 0; e < 8; ++e) o[e] = (y[e] - mean) * rstd * lg[e] + lb[e] + bs * v[e];
          u32x4 w; w.x = pk2(o[0], o[1]); w.y = pk2(o[2], o[3]); w.z = pk2(o[4], o[5]); w.w = pk2(o[6], o[7]);
          *(u32x4*)(Y0 + (size_t)row * 512 + c0) = w; }
        { const u32x4 yy = *(const u32x4*)(Y1 + (size_t)row * 512 + c0); float q2 = 0.f;
#pragma unroll
          for (int q = 0; q < 4; ++q) { y[2 * q] = lo_bf(yy[q]); y[2 * q + 1] = hi_bf(yy[q]); q2 += y[2 * q] * y[2 * q] + y[2 * q + 1] * y[2 * q + 1]; }
          q2 += __shfl_xor(q2, 1); q2 += __shfl_xor(q2, 2); q2 += __shfl_xor(q2, 4); q2 += __shfl_xor(q2, 8); q2 += __shfl_xor(q2, 16);
          const float rs = rsqrtf(q2 * (1.f / 256.f) + 1e-5f);
          u32x4 w; w.x = pk2(y[0] * rs * nw1[0], y[1] * rs * nw1[1]); w.y = pk2(y[2] * rs * nw1[2], y[3] * rs * nw1[3]); w.z = pk2(y[4] * rs * nw1[4], y[5] * rs * nw1[5]); w.w = pk2(y[6] * rs * nw1[6], y[7] * rs * nw1[7]);
          *(u32x4*)(Y1 + (size_t)row * 512 + c0) = w; }
        { const u32x4 yy = *(const u32x4*)(Y2 + (size_t)row * 512 + c0); float q2 = 0.f;
#pragma unroll
          for (int q = 0; q < 4; ++q) { y[2 * q] = lo_bf(yy[q]); y[2 * q + 1] = hi_bf(yy[q]); q2 += y[2 * q] * y[2 * q] + y[2 * q + 1] * y[2 * q + 1]; }
          q2 += __shfl_xor(q2, 1); q2 += __shfl_xor(q2, 2); q2 += __shfl_xor(q2, 4); q2 += __shfl_xor(q2, 8);
          const float rs = rsqrtf(q2 * (1.f / 128.f) + 1e-5f);
          u32x4 w; w.x = pk2(y[0] * rs * nw2[0], y[1] * rs * nw2[1]); w.y = pk2(y[2] * rs * nw2[2], y[3] * rs * nw2[3]); w.z = pk2(y[4] * rs * nw2[4], y[5] * rs * nw2[5]); w.w = pk2(y[6] * rs * nw2[6], y[7] * rs * nw2[7]);
          *(u32x4*)(Y2 + (size_t)row * 512 + c0) = w; }
    }
}

constexpr int NPHASE = 18;
#ifndef DIAG
#define DIAG 0
#endif
#ifndef DIAG_A
#define DIAG_A(ph, s) ((ph) >= 2 && (s) == 2)
#endif
#ifndef DIAG_B
#define DIAG_B(ph, s) ((ph) >= 2 && ((s) == 0 || (s) >= 4 && (s) <= 6))
#endif
#ifndef PHM
#define PHM 1023
#endif
__global__ __launch_bounds__(512, 2) void mega(Params p) {
    extern __shared__ __attribute__((aligned(16))) unsigned char shm[];
    LAS unsigned char* lds = (LAS unsigned char*)shm;
    cg::grid_group grid = cg::this_grid();
#if DIAG
    unsigned long long tA = 0, tB = 0;
#endif
    for (int ph = p.ph_lo; ph < p.ph_hi; ++ph) {
        const int TIDX = tid_opaque(), BIDX = bid_opaque();
#if DIAG
        const unsigned long long t_start = __builtin_amdgcn_s_memrealtime();
#endif
        if (ph == 0) { if (PHM & 1) { wprep(p, 0, lds, TIDX, BIDX); ada_phase(p, lds, TIDX, BIDX); } }
        else if (ph == 1) { if (PHM & 2) ln1_phase(p, 0, p.in[I_X], TIDX, BIDX); }
        else {
            const int l = (ph - 2) >> 3, s = (ph - 2) & 7;
            const float* xin = l == 0 ? p.in[I_X] : p.out;
            pg8::StaticOrder S;
            if (s == 0 && (PHM & 4)) { pg8::Gemm g{(const bf16_t*)(p.ws + OFF_H), (const bf16_t*)(p.ws + OFF_WT1), T, 4352, 1024, 1 << 30, 0};
                S.init(g.M, g.N, gridDim.x, BIDX); Epi<0> E{p.ws, nullptr, nullptr, nullptr}; pg8::gemm_phase(lds, g, S, E, TIDX); }
            else if (s == 1 && (PHM & 8)) { rwkv_prep_phase(p, l, lds, TIDX, BIDX, grid); }
            else if (s == 2 && (PHM & 16)) { scans_naive_phase(p, l, lds, TIDX, BIDX); }
            else if (s == 3 && (PHM & 32)) { post_phase(p, l, TIDX, BIDX); }
            else if (s == 4 && (PHM & 64)) { pg8::Gemm g{(const bf16_t*)(p.ws + OFF_H), (const bf16_t*)(p.ws + OFF_WT1) + (size_t)4352 * 1024, T, 4096, 1024, 1 << 30, 0};
                S.init(g.M, g.N, gridDim.x, BIDX); Epi<1> E{p.ws, nullptr, nullptr, nullptr}; pg8::gemm_phase(lds, g, S, E, TIDX); }
            else if (s == 5 && (PHM & 128)) { pg8::Gemm g{(const bf16_t*)(p.ws + OFF_Y3), (const bf16_t*)(p.ws + OFF_WT2), T, 3072, 512, 4, (size_t)T * 512 * 2};
                S.init(g.M, g.N, gridDim.x, BIDX); Epi<2> E{p.ws, nullptr, nullptr, nullptr}; pg8::gemm_phase(lds, g, S, E, TIDX); }
            else if (s == 6 && (PHM & 256)) { pg8::Gemm g{(const bf16_t*)(p.ws + OFF_GATES), (const bf16_t*)(p.ws + OFF_WT3), T, 1024, 3072, 1 << 30, 0};
                S.init(g.M, g.N, gridDim.x, BIDX); Epi<3> E{p.ws, xin, (const float*)(p.ws + OFF_MOD) + (size_t)l * 4 * 3072, p.out}; pg8::gemm_phase(lds, g, S, E, TIDX); }
            else if (s == 7 && (PHM & 512)) { lnpost_phase(p, l, TIDX, BIDX); if (l == 0) wprep(p, 1, lds, TIDX, BIDX); }
        }
        if (ph + 1 < p.ph_hi) grid.sync();
#if DIAG
        { const unsigned long long dt = __builtin_amdgcn_s_memrealtime() - t_start; const int s_ = (ph - 2) & 7;
          if (DIAG_A(ph, s_)) tA += dt; if (DIAG_B(ph, s_)) tB += dt; }
#endif
    }
#if DIAG
    grid.sync();
    if (blockIdx.x == 0) {
        const float vA = (float)tA * 10.f, vB = (float)tB * 10.f;
        for (int i = threadIdx.x; i < (1 << 20); i += 512) p.out[4096 + i] = vB;
        if (threadIdx.x == 0) p.out[0] = vA * 1000.f;
    }
#endif
}

extern "C" void kernel_launch(void* const* d_in, const int* in_sizes, int n_in, void* d_out, int out_size, void* d_ws, size_t ws_size, hipStream_t stream) {
    constexpr int LDS_BYTES = 131072;
    static int grid = 0;
    if (grid == 0) {
        if (n_in != 28 || out_size != T * DM || ws_size < WS_END) { fprintf(stderr, "kernel_launch: unexpected shapes / workspace (%zu < %zu)\n", ws_size, (size_t)WS_END); grid = -1; return; }
        int dev = 0, cus = 0, per_cu = 0;
        hipGetDevice(&dev); hipDeviceGetAttribute(&cus, hipDeviceAttributeMultiprocessorCount, dev);
        if (hipFuncSetAttribute((const void*)mega, hipFuncAttributeMaxDynamicSharedMemorySize, LDS_BYTES) != hipSuccess) { fprintf(stderr, "hipFuncSetAttribute failed\n"); grid = -1; return; }
        if (hipOccupancyMaxActiveBlocksPerMultiprocessor(&per_cu, (const void*)mega, 512, LDS_BYTES) != hipSuccess || per_cu < 1) per_cu = 1;
        (void)hipGetLastError();
        grid = cus * 1;
        if (grid != 256) { fprintf(stderr, "kernel_launch: built for 256 CUs\n"); grid = -1; return; }
    }
    if (grid < 0) return;
    Params p{};
    for (int i = 0; i < 28; ++i) p.in[i] = (const float*)d_in[i];
    p.out = (float*)d_out; p.ws = (unsigned char*)d_ws;
#if N_LAUNCH_MODE == 1
    p.ph_lo = 0; p.ph_hi = NPHASE;
    void* args[] = {&p};
    hipError_t e = hipLaunchCooperativeKernel((const void*)mega, dim3(grid), dim3(512), args, LDS_BYTES, stream);
    if (e != hipSuccess) fprintf(stderr, "cooperative launch failed: %s (grid %d)\n", hipGetErrorString(e), grid);
#else
    for (int ph = 0; ph < NPHASE; ++ph) { p.ph_lo = ph; p.ph_hi = ph + 1; hipLaunchKernelGGL(mega, dim3(grid), dim3(512), LDS_BYTES, stream, p); }
#endif
}
```

```cpp
#include <hip/hip_runtime.h>
#include <hip/hip_cooperative_groups.h>
#include <cstdio>
namespace cg = cooperative_groups;

#ifndef N_LAUNCH_MODE
#define N_LAUNCH_MODE 1
#endif

#define LAS __attribute__((address_space(3)))
typedef unsigned short bf16_t;
typedef short bf16x8 __attribute__((ext_vector_type(8)));
typedef float f32x4 __attribute__((ext_vector_type(4)));
typedef unsigned u32x4 __attribute__((ext_vector_type(4)));
typedef unsigned u32x2 __attribute__((ext_vector_type(2)));

constexpr int T = 32768, SEQ = 8192, DM = 1024, NB = 4;
constexpr int INW = 8344;
constexpr float ALPHA_DN = 1.4142135623730951f;

constexpr size_t SZ_WT1 = (size_t)8448 * 1024 * 2, SZ_WT2 = (size_t)3072 * 512 * 2, SZ_WT3 = (size_t)1024 * 3072 * 2, SZ_MOD = (size_t)2 * 4 * 3072 * 4;
constexpr size_t OFF_WT1 = 0, OFF_WT2 = OFF_WT1 + SZ_WT1, OFF_WT3 = OFF_WT2 + SZ_WT2, OFF_MOD = OFF_WT3 + SZ_WT3;
constexpr size_t OFF_H = OFF_MOD + SZ_MOD;
constexpr size_t OFF_Y3 = OFF_H + (size_t)T * 1024 * 2;
constexpr size_t OFF_RKV = OFF_Y3 + (size_t)3 * T * 512 * 2;
constexpr size_t OFF_XBC = OFF_RKV + (size_t)T * 1536 * 2;
constexpr size_t OFF_GQ = OFF_XBC + (size_t)T * 1024 * 2;
constexpr size_t OFF_GK = OFF_GQ + (size_t)T * 256 * 2;
constexpr size_t OFF_SMALL = OFF_GK + (size_t)T * 256 * 2;
constexpr size_t OFF_A = OFF_SMALL + (size_t)T * 160 * 4;
constexpr size_t OFF_DEC = OFF_A + (size_t)T * 512 * 2;
constexpr size_t WS_END = OFF_DEC + (size_t)T * 512 * 4;
constexpr size_t OFF_GATES = OFF_RKV;
static_assert(OFF_GK + (size_t)T * 256 * 2 - OFF_RKV == (size_t)T * 3072 * 2, "gates alias");

struct Params { const float* in[28]; float* out; unsigned char* ws; int ph_lo, ph_hi; };
enum { I_X = 0, I_C, I_ADAW, I_ADAB, I_WIN, I_MU, I_W0, I_WUP, I_A0, I_AUP, I_KK, I_KA, I_RK, I_LNG, I_LNB, I_CONVW, I_CONVB, I_DTB, I_ALOG, I_DSKIP,
       I_M2NW, I_GKUP, I_GKB, I_GNW, I_WBR, I_WOUT, I_PG, I_PB };

__device__ __forceinline__ float bf2f(bf16_t v) { return __uint_as_float(((unsigned)v) << 16); }
__device__ __forceinline__ bf16_t f2bf(float f) { unsigned u = __float_as_uint(f); u += 0x7FFFu + ((u >> 16) & 1u); return (bf16_t)(u >> 16); }
__device__ __forceinline__ unsigned pk2(float lo, float hi) { return (unsigned)f2bf(lo) | ((unsigned)f2bf(hi) << 16); }
__device__ __forceinline__ float lo_bf(unsigned w) { return __uint_as_float(w << 16); }
__device__ __forceinline__ float hi_bf(unsigned w) { return __uint_as_float(w & 0xFFFF0000u); }
__device__ __forceinline__ float sigmoidf_(float x) { return 1.0f / (1.0f + __expf(-x)); }
__device__ __forceinline__ float siluf_(float x) { return x / (1.0f + __expf(-x)); }
__device__ __forceinline__ float softplusf_(float x) { return x > 20.f ? x : log1pf(__expf(x)); }
__device__ __forceinline__ float wave_sum(float v) {
#pragma unroll
    for (int o = 1; o < 64; o <<= 1) v += __shfl_xor(v, o);
    return v;
}
__device__ __forceinline__ int tid_opaque() { int t = threadIdx.x; asm volatile("" : "+v"(t)); return t; }
__device__ __forceinline__ int bid_opaque() { int t = blockIdx.x; asm volatile("" : "+s"(t)); return t; }
#define WAVE_LDS_SYNC() do { asm volatile("s_waitcnt lgkmcnt(0)" ::: "memory"); __builtin_amdgcn_wave_barrier(); } while (0)

namespace pg8 {
constexpr int BM = 256, BK = 64, HALF = 128, HTB = HALF * BK * 2, STAGE_BYTES = 8 * HTB, NXCD = 8, WGM = 8;
__host__ __device__ __forceinline__ int lds_byte(int r, int c) { const int st = (r >> 4) * 2 + (c >> 5), rr = r & 15, cc = c & 31, ob = rr * 64 + cc * 2; return st * 1024 + (ob ^ (((ob >> 9) & 1) << 5)); }
__host__ __device__ __forceinline__ void stage_rc(int b, int& R, int& C) { const int st = b / 1024, sb = b % 1024, swz = sb ^ (((sb >> 9) & 1) << 5); R = (st >> 1) * 16 + swz / 64; C = (st & 1) * 32 + (swz % 64) / 2; }
__host__ __device__ __forceinline__ int perm32(int rho) { const int n = rho >> 4, i = rho & 15; return 8 * (i >> 2) + 4 * n + (i & 3); }
struct Unit { int pm, pn; };
struct Gemm { const bf16_t* A; const bf16_t* Bt; int M, N, K; int adiv; size_t astride; };
struct StaticOrder {
    int nM, nN, nwg, G, c;
    __device__ void init(int M, int N, int G_, int c_) { nM = M / BM; nN = N / BM; nwg = nM * nN; G = G_; c = c_; }
    __device__ bool next(int i, Unit& u) const {
        const long L = (long)i * G + c; if (L >= nwg) return false;
        int wgid = (int)L; { const int q = nwg / NXCD, r = nwg % NXCD, xcd = wgid % NXCD, off = wgid / NXCD; wgid = (xcd < r ? xcd * (q + 1) : r * (q + 1) + (xcd - r) * q) + off; }
        const int nig = WGM * nN, gid = wgid / nig, fm = gid * WGM, gsz = (nM - fm) < WGM ? (nM - fm) : WGM;
        u.pm = fm + ((wgid % nig) % gsz); u.pn = (wgid % nig) / gsz; return true;
    }
};
__device__ __forceinline__ unsigned cvt_pk_bf16(float lo, float hi) { unsigned r; asm volatile("v_cvt_pk_bf16_f32 %0, %1, %2" : "=v"(r) : "v"(lo), "v"(hi)); return r; }

template <class Epi>
__device__ __forceinline__ void gemm_phase(LAS unsigned char* lds, const Gemm g, const StaticOrder& S, const Epi& E, int TIDX) {
    const int tid = TIDX, wid = __builtin_amdgcn_readfirstlane(tid >> 6), lane = tid & 63, wr = wid >> 2, wc = wid & 3, fr = lane & 15, fq = lane >> 4;
    const int K = g.K, nt = K / BK;
    unsigned voffA[2], voffB[2];
#pragma unroll
    for (int i = 0; i < 2; ++i) { int R, C; stage_rc(tid * 16 + i * 8192, R, C); const int Rb = (R & ~31) + perm32(R & 31);
        voffA[i] = (unsigned)(R * K + C) * 2u; voffB[i] = (unsigned)(Rb * K + C) * 2u; }
    const size_t kstep = (size_t)(BK * 2);
    const size_t hstep = (size_t)HALF * K * 2;
    const size_t tstep = 2 * hstep;
    const unsigned ldsw = (unsigned)wid * 1024u;
    const int aoff = lds_byte(wr * 64 + fr, fq * 8), boff = lds_byte(wc * 32 + fr, fq * 8);
#define PG8_SA(b, h) (((b) * 2 + (h)) * HTB)
#define PG8_SB(b, h) ((4 + (b) * 2 + (h)) * HTB)
#define PG8_STAGE(bufoff, gbase, voff) do { _Pragma("unroll") for (int _i = 0; _i < 2; ++_i) \
        __builtin_amdgcn_global_load_lds((const unsigned*)((const char*)(gbase) + (voff)[_i]), (LAS unsigned*)(lds + (bufoff) + ldsw + _i * 8192), 16, 0, 0); } while (0)
#define PG8_LDA(dst, b, h) do { _Pragma("unroll") for (int m = 0; m < 4; ++m) _Pragma("unroll") for (int k = 0; k < 2; ++k) dst[m][k] = *(const LAS bf16x8*)(lds + PG8_SA(b, h) + aoff + m * 2048 + k * 1024); } while (0)
#define PG8_LDB(dst, b, h) do { _Pragma("unroll") for (int n = 0; n < 2; ++n) _Pragma("unroll") for (int k = 0; k < 2; ++k) dst[n][k] = *(const LAS bf16x8*)(lds + PG8_SB(b, h) + boff + n * 2048 + k * 1024); } while (0)
#define PG8_MMA(ai, bj, At, Bt) do { __builtin_amdgcn_s_setprio(1); _Pragma("unroll") for (int m = 0; m < 4; ++m) _Pragma("unroll") for (int n = 0; n < 2; ++n) _Pragma("unroll") for (int k = 0; k < 2; ++k) \
        acc[ai][bj][m][n] = __builtin_amdgcn_mfma_f32_16x16x32_bf16(Bt[n][k], At[m][k], acc[ai][bj][m][n], 0, 0, 0); __builtin_amdgcn_s_setprio(0); } while (0)
#define PG8_WAIT_V(n) asm volatile("s_waitcnt vmcnt(" #n ")" ::: "memory")
#define PG8_WAIT_L(n) asm volatile("s_waitcnt lgkmcnt(" #n ")" ::: "memory")
#define PG8_BAR __builtin_amdgcn_s_barrier()
#define PG8_SCHED __builtin_amdgcn_sched_barrier(0)
    Unit cur, nxt; int ui = 0;
    if (!S.next(0, cur)) return;
    f32x4 acc[2][2][4][2];
#pragma unroll
    for (int a = 0; a < 2; ++a)
#pragma unroll
        for (int b = 0; b < 2; ++b)
#pragma unroll
            for (int m = 0; m < 4; ++m)
#pragma unroll
                for (int n = 0; n < 2; ++n) acc[a][b][m][n] = (f32x4){0.f, 0.f, 0.f, 0.f};
    bf16x8 At[4][2], B0[2][2], B1[2][2];
    const char* cA = (const char*)g.A + (size_t)(cur.pn / g.adiv) * g.astride + (size_t)cur.pm * tstep; const char* cB = (const char*)g.Bt + (size_t)cur.pn * tstep;
    PG8_STAGE(PG8_SB(0, 0), cB, voffB); PG8_STAGE(PG8_SA(0, 0), cA, voffA); PG8_STAGE(PG8_SB(0, 1), cB + hstep, voffB); PG8_STAGE(PG8_SA(0, 1), cA + hstep, voffA);
    if (wr == 1) PG8_BAR;
    PG8_WAIT_V(4); PG8_BAR;
    PG8_STAGE(PG8_SB(1, 0), cB + kstep, voffB); PG8_STAGE(PG8_SA(1, 0), cA + kstep, voffA); PG8_STAGE(PG8_SB(1, 1), cB + hstep + kstep, voffB);
    PG8_WAIT_V(6); PG8_BAR;
    for (;;) {
        const bool has_next = S.next(ui + 1, nxt);
        const char* nA = has_next ? (const char*)g.A + (size_t)(nxt.pn / g.adiv) * g.astride + (size_t)nxt.pm * tstep : cA; const char* nB = has_next ? (const char*)g.Bt + (size_t)nxt.pn * tstep : cB;
        for (int t = 0; t < nt; t += 2) {
            const bool last = (t == nt - 2);
            const char* a1 = cA + (size_t)(t + 1) * kstep;
            const char* a2 = last ? nA : cA + (size_t)(t + 2) * kstep; const char* b2 = last ? nB : cB + (size_t)(t + 2) * kstep;
            const char* a3 = a2 + kstep; const char* b3 = b2 + kstep;
            PG8_LDB(B0, 0, 0); PG8_SCHED; PG8_LDA(At, 0, 0); PG8_STAGE(PG8_SA(1, 1), a1 + hstep, voffA);
            PG8_WAIT_L(8); PG8_BAR; PG8_WAIT_L(0); PG8_MMA(0, 0, At, B0); PG8_BAR; PG8_SCHED;
            PG8_LDB(B1, 0, 1); PG8_STAGE(PG8_SB(0, 0), b2, voffB);
            PG8_BAR; PG8_WAIT_L(0); PG8_MMA(0, 1, At, B1); PG8_BAR;
            PG8_LDA(At, 0, 1); PG8_STAGE(PG8_SA(0, 0), a2, voffA);
            PG8_BAR; PG8_WAIT_L(0); PG8_MMA(1, 0, At, B0); PG8_BAR; PG8_SCHED;
            PG8_STAGE(PG8_SB(0, 1), b2 + hstep, voffB);
            PG8_WAIT_V(6); PG8_BAR; PG8_MMA(1, 1, At, B1); PG8_BAR;
            PG8_LDB(B0, 1, 0); PG8_SCHED; PG8_LDA(At, 1, 0); PG8_STAGE(PG8_SA(0, 1), a2 + hstep, voffA);
            PG8_WAIT_L(8); PG8_BAR; PG8_WAIT_L(0); PG8_MMA(0, 0, At, B0); PG8_BAR; PG8_SCHED;
            PG8_LDB(B1, 1, 1); PG8_STAGE(PG8_SB(1, 0), b3, voffB);
            PG8_BAR; PG8_WAIT_L(0); PG8_MMA(0, 1, At, B1); PG8_BAR;
            PG8_LDA(At, 1, 1); PG8_STAGE(PG8_SA(1, 0), a3, voffA);
            PG8_BAR; PG8_WAIT_L(0); PG8_MMA(1, 0, At, B0); PG8_BAR; PG8_SCHED;
            PG8_STAGE(PG8_SB(1, 1), b3 + hstep, voffB);
            PG8_WAIT_V(6); PG8_BAR; PG8_MMA(1, 1, At, B1); PG8_BAR;
        }
        E(acc, cur, wr, wc, fr, fq);
        if (!has_next) break;
#pragma unroll
        for (int a = 0; a < 2; ++a)
#pragma unroll
            for (int b = 0; b < 2; ++b)
#pragma unroll
                for (int m = 0; m < 4; ++m)
#pragma unroll
                    for (int n = 0; n < 2; ++n) acc[a][b][m][n] = (f32x4){0.f, 0.f, 0.f, 0.f};
        cur = nxt; cA = nA; cB = nB; ++ui;
    }
    PG8_WAIT_V(0);
    if (wr == 0) PG8_BAR;
    PG8_BAR;
#undef PG8_SA
#undef PG8_SB
#undef PG8_STAGE
#undef PG8_LDA
#undef PG8_LDB
#undef PG8_MMA
#undef PG8_WAIT_V
#undef PG8_WAIT_L
#undef PG8_BAR
#undef PG8_SCHED
}
}

template <int MODE> struct Epi {
    unsigned char* ws; const float* xin; const float* gate; float* out;
    __device__ __forceinline__ void operator()(const f32x4 (&acc)[2][2][4][2], const pg8::Unit& u, int wr, int wc, int fr, int fq) const {
        const int pn = u.pn;
        bf16_t* base = nullptr; int ld = 0, c0 = 0;
        if (MODE == 0) {
            if (pn < 6) { base = (bf16_t*)(ws + OFF_RKV); ld = 1536; c0 = pn * 256; }
            else if (pn < 10) { base = (bf16_t*)(ws + OFF_XBC); ld = 1024; c0 = (pn - 6) * 256; }
            else if (pn < 12) { base = (bf16_t*)(ws + OFF_Y3) + (size_t)T * 512; ld = 512; c0 = (pn - 10) * 256; }
            else if (pn == 12) { base = (bf16_t*)(ws + OFF_GQ); ld = 256; c0 = 0; }
            else if (pn == 13) { base = (bf16_t*)(ws + OFF_GK); ld = 256; c0 = 0; }
            else if (pn < 16) { base = (bf16_t*)(ws + OFF_Y3) + (size_t)2 * T * 512; ld = 512; c0 = (pn - 14) * 256; }
        } else if (MODE == 1) {
            if (pn < 2) { base = (bf16_t*)(ws + OFF_Y3); ld = 512; c0 = pn * 256; }
            else if (pn < 4) { base = (bf16_t*)(ws + OFF_Y3) + (size_t)2 * T * 512; ld = 512; c0 = (pn - 2) * 256; }
            else { base = (bf16_t*)(ws + OFF_GATES); ld = 3072; c0 = (pn - 4) * 256; }
        } else if (MODE == 2) { base = (bf16_t*)(ws + OFF_GATES); ld = 3072; c0 = pn * 256; }
#pragma unroll
        for (int ai = 0; ai < 2; ++ai)
#pragma unroll
            for (int m = 0; m < 4; ++m) {
                const int row = u.pm * 256 + ai * 128 + wr * 64 + m * 16 + fr;
#pragma unroll
                for (int bj = 0; bj < 2; ++bj) {
                    const int cl = bj * 128 + wc * 32 + 8 * fq;
                    f32x4 v0 = acc[ai][bj][m][0], v1 = acc[ai][bj][m][1];
                    if (MODE == 0) {
                        if (pn < 16) {
                            u32x4 w; w.x = pg8::cvt_pk_bf16(v0[0], v0[1]); w.y = pg8::cvt_pk_bf16(v0[2], v0[3]); w.z = pg8::cvt_pk_bf16(v1[0], v1[1]); w.w = pg8::cvt_pk_bf16(v1[2], v1[3]);
                            *(u32x4*)(base + (size_t)row * ld + c0 + cl) = w;
                        } else if (cl < 160) {
                            float* d = (float*)(ws + OFF_SMALL) + (size_t)row * 160 + cl;
                            *(f32x4*)d = v0; *(f32x4*)(d + 4) = v1;
                        }
                    } else if (MODE == 1) {
                        bf16_t* d = base + (size_t)row * ld + c0 + cl;
                        if (pn < 4) {
                            const u32x4 o = *(const u32x4*)d;
                            u32x4 w;
                            w.x = pg8::cvt_pk_bf16(lo_bf(o.x) * siluf_(v0[0]), hi_bf(o.x) * siluf_(v0[1]));
                            w.y = pg8::cvt_pk_bf16(lo_bf(o.y) * siluf_(v0[2]), hi_bf(o.y) * siluf_(v0[3]));
                            w.z = pg8::cvt_pk_bf16(lo_bf(o.z) * siluf_(v1[0]), hi_bf(o.z) * siluf_(v1[1]));
                            w.w = pg8::cvt_pk_bf16(lo_bf(o.w) * siluf_(v1[2]), hi_bf(o.w) * siluf_(v1[3]));
                            *(u32x4*)d = w;
                        } else {
                            u32x4 w;
                            w.x = pg8::cvt_pk_bf16(sigmoidf_(v0[0]), sigmoidf_(v0[1])); w.y = pg8::cvt_pk_bf16(sigmoidf_(v0[2]), sigmoidf_(v0[3]));
                            w.z = pg8::cvt_pk_bf16(sigmoidf_(v1[0]), sigmoidf_(v1[1])); w.w = pg8::cvt_pk_bf16(sigmoidf_(v1[2]), sigmoidf_(v1[3]));
                            *(u32x4*)d = w;
                        }
                    } else if (MODE == 2) {
                        bf16_t* d = base + (size_t)row * ld + c0 + cl;
                        const u32x4 o = *(const u32x4*)d;
                        u32x4 w;
                        w.x = pg8::cvt_pk_bf16(lo_bf(o.x) * v0[0], hi_bf(o.x) * v0[1]); w.y = pg8::cvt_pk_bf16(lo_bf(o.y) * v0[2], hi_bf(o.y) * v0[3]);
                        w.z = pg8::cvt_pk_bf16(lo_bf(o.z) * v1[0], hi_bf(o.z) * v1[1]); w.w = pg8::cvt_pk_bf16(lo_bf(o.w) * v1[2], hi_bf(o.w) * v1[3]);
                        *(u32x4*)d = w;
                    } else {
                        const int col = pn * 256 + cl; const int b = row >> 13;
                        const f32x4 x0 = *(const f32x4*)(xin + (size_t)row * 1024 + col), x1 = *(const f32x4*)(xin + (size_t)row * 1024 + col + 4);
                        const f32x4 g0 = *(const f32x4*)(gate + b * 3072 + 2048 + col), g1 = *(const f32x4*)(gate + b * 3072 + 2048 + col + 4);
                        f32x4 r0, r1;
#pragma unroll
                        for (int j = 0; j < 4; ++j) { r0[j] = ALPHA_DN * x0[j] + (1.f + g0[j]) * v0[j]; r1[j] = ALPHA_DN * x1[j] + (1.f + g1[j]) * v1[j]; }
                        *(f32x4*)(out + (size_t)row * 1024 + col) = r0; *(f32x4*)(out + (size_t)row * 1024 + col + 4) = r1;
                    }
                }
            }
    }
};

__device__ __forceinline__ int wt1_src(int n) {
    if (n < 1536) return n;
    if (n < 2560) return 2176 + (n - 1536);
    if (n < 3072) return 3208 + (n - 2560);
    if (n < 3328) return 3720 + (n - 3072);
    if (n < 3584) return 3976 + (n - 3328);
    if (n < 4096) return 4232 + (n - 3584);
    if (n < 4352) { const int s = n - 4096; if (s < 128) return 1536 + s; if (s < 136) return 3200 + (s - 128); if (s < 152) return 4744 + (s - 136); return -1; }
    const int m = n - 4352;
    if (m < 512) return 1664 + m;
    if (m < 1024) return 4760 + (m - 512);
    return 5272 + (m - 1024);
}
template <bool MAP>
__device__ __forceinline__ void transpose_item(const float* W, int ldw, bf16_t* WT, int ldt, int row_off, int col_off, int nblk, LAS float* scr, int item, int lane) {
    const int kb = item / nblk, nb = item % nblk, k0 = 64 * kb, n0 = 32 * nb;
    int sc = n0 + (lane & 31); if (MAP) sc = wt1_src(sc);
#pragma unroll 8
    for (int i = 0; i < 32; ++i) { const int kk = 2 * i + (lane >> 5); scr[kk * 33 + (lane & 31)] = sc >= 0 ? W[(size_t)(k0 + kk) * ldw + sc] : 0.f; }
    WAVE_LDS_SYNC();
    const int c = lane & 7;
#pragma unroll
    for (int j = 0; j < 4; ++j) { const int n = (lane >> 3) + 8 * j; const LAS float* s = scr + (8 * c) * 33 + n;
        u32x4 o; o.x = pk2(s[0 * 33], s[1 * 33]); o.y = pk2(s[2 * 33], s[3 * 33]); o.z = pk2(s[4 * 33], s[5 * 33]); o.w = pk2(s[6 * 33], s[7 * 33]);
        *(u32x4*)(WT + (size_t)(row_off + n0 + n) * ldt + col_off + k0 + 8 * c) = o; }
    WAVE_LDS_SYNC();
}
__device__ void wprep(const Params& p, int l, LAS unsigned char* lds, int TIDX, int BIDX) {
    const int lane = TIDX & 63, wave = TIDX >> 6;
    LAS float* scr = (LAS float*)(lds + wave * 16384);
    const int gw = BIDX * 8 + wave, NGW = gridDim.x * 8;
    constexpr int I1 = (1024 / 64) * (8448 / 32), I2 = 3 * (512 / 64) * (1024 / 32), I3 = 3 * (1024 / 64) * (1024 / 32);
    bf16_t* WT1 = (bf16_t*)(p.ws + OFF_WT1); bf16_t* WT2 = (bf16_t*)(p.ws + OFF_WT2); bf16_t* WT3 = (bf16_t*)(p.ws + OFF_WT3);
    for (int it = gw; it < I1 + I2 + I3; it += NGW) {
        int r = it;
        if (r < I1) { transpose_item<true>(p.in[I_WIN] + (size_t)l * 1024 * INW, INW, WT1, 1024, 0, 0, 8448 / 32, scr, r, lane); continue; }
        r -= I1;
        if (r < I2) { const int b = r / (I2 / 3), rr = r % (I2 / 3); transpose_item<false>(p.in[I_WBR] + ((size_t)l * 3 + b) * 512 * 1024, 1024, WT2, 512, b * 1024, 0, 1024 / 32, scr, rr, lane); continue; }
        r -= I2;
        { const int j = r / (I3 / 3), rr = r % (I3 / 3); transpose_item<false>(p.in[I_WOUT] + (size_t)l * 1024 * 1024, 1024, WT3, 3072, 0, j * 1024, 1024 / 32, scr, rr, lane); }
    }
}
__device__ void ada_phase(const Params& p, LAS unsigned char* lds, int TIDX, int BIDX) {
    LAS float* red = (LAS float*)lds;
    const int tid = TIDX, kg = tid >> 5, cj = tid & 31;
    float* mod = (float*)(p.ws + OFF_MOD);
    for (int it = BIDX; it < 2 * 96; it += gridDim.x) {
        const int l = it / 96, col = (it % 96) * 32 + cj;
        const float* W = p.in[I_ADAW] + (size_t)l * 1024 * 3072;
        float a0 = 0.f, a1 = 0.f, a2 = 0.f, a3 = 0.f;
        for (int k = kg * 64; k < kg * 64 + 64; ++k) {
            const float w = W[(size_t)k * 3072 + col];
            a0 += siluf_(p.in[I_C][k]) * w; a1 += siluf_(p.in[I_C][1024 + k]) * w; a2 += siluf_(p.in[I_C][2048 + k]) * w; a3 += siluf_(p.in[I_C][3072 + k]) * w;
        }
        red[(kg * 32 + cj) * 4 + 0] = a0; red[(kg * 32 + cj) * 4 + 1] = a1; red[(kg * 32 + cj) * 4 + 2] = a2; red[(kg * 32 + cj) * 4 + 3] = a3;
        __syncthreads();
        if (tid < 128) { const int c2 = tid >> 2, b = tid & 3; float s = 0.f;
            for (int g = 0; g < 16; ++g) s += red[(g * 32 + c2) * 4 + b];
            const int cc = (it % 96) * 32 + c2;
            mod[((size_t)l * 4 + b) * 3072 + cc] = s + p.in[I_ADAB][(size_t)l * 3072 + cc]; }
        __syncthreads();
    }
}
__device__ __forceinline__ void ln_stats(const f32x4 (&v)[4], float& mean, float& rstd, float eps) {
    float s = 0.f;
#pragma unroll
    for (int j = 0; j < 4; ++j) s += (v[j][0] + v[j][1]) + (v[j][2] + v[j][3]);
    mean = wave_sum(s) * (1.f / 1024.f); float s2 = 0.f;
#pragma unroll
    for (int j = 0; j < 4; ++j) { const f32x4 d = v[j] - mean; s2 += (d[0] * d[0] + d[1] * d[1]) + (d[2] * d[2] + d[3] * d[3]); }
    rstd = rsqrtf(wave_sum(s2) * (1.f / 1024.f) + eps);
}
__device__ __forceinline__ void mod_row_to_h(const Params& p, const f32x4 (&v)[4], int row, int l, int lane) {
    float mean, rstd; ln_stats(v, mean, rstd, 1e-5f);
    const float* mod = (const float*)(p.ws + OFF_MOD) + ((size_t)l * 4 + (row >> 13)) * 3072;
    bf16_t* H = (bf16_t*)(p.ws + OFF_H) + (size_t)row * 1024;
#pragma unroll
    for (int j = 0; j < 4; ++j) { const int c = 256 * j + 4 * lane;
        const f32x4 sh = *(const f32x4*)(mod + c), sc = *(const f32x4*)(mod + 1024 + c);
        f32x4 h;
#pragma unroll
        for (int e = 0; e < 4; ++e) h[e] = (v[j][e] - mean) * rstd * (1.f + sc[e]) + sh[e];
        u32x2 o; o.x = pk2(h[0], h[1]); o.y = pk2(h[2], h[3]);
        *(u32x2*)(H + c) = o; }
}
__device__ void ln1_phase(const Params& p, int l, const float* xin, int TIDX, int BIDX) {
    const int lane = TIDX & 63, gw = BIDX * 8 + (TIDX >> 6), NGW = gridDim.x * 8;
    for (int row = gw; row < T; row += NGW) {
        f32x4 v[4];
#pragma unroll
        for (int j = 0; j < 4; ++j) v[j] = *(const f32x4*)(xin + (size_t)row * 1024 + 256 * j + 4 * lane);
        mod_row_to_h(p, v, row, l, lane);
    }
}
__device__ void lnpost_phase(const Params& p, int l, int TIDX, int BIDX) {
    const int lane = TIDX & 63, gw = BIDX * 8 + (TIDX >> 6), NGW = gridDim.x * 8;
    const float* pg = p.in[I_PG] + l * 1024; const float* pb = p.in[I_PB] + l * 1024;
    for (int row = gw; row < T; row += NGW) {
        f32x4 v[4];
#pragma unroll
        for (int j = 0; j < 4; ++j) v[j] = *(const f32x4*)(p.out + (size_t)row * 1024 + 256 * j + 4 * lane);
        float mean, rstd; ln_stats(v, mean, rstd, 1e-5f);
#pragma unroll
        for (int j = 0; j < 4; ++j) { const int c = 256 * j + 4 * lane; const f32x4 g = *(const f32x4*)(pg + c), b = *(const f32x4*)(pb + c);
#pragma unroll
            for (int e = 0; e < 4; ++e) v[j][e] = (v[j][e] - mean) * rstd * g[e] + b[e];
            *(f32x4*)(p.out + (size_t)row * 1024 + c) = v[j]; }
        if (l == 0) mod_row_to_h(p, v, row, 1, lane);
    }
}

__device__ __forceinline__ void conv_unpack(const u32x4 w, float (&x)[8]) {
#pragma unroll
    for (int q = 0; q < 4; ++q) { x[2 * q] = lo_bf(w[q]); x[2 * q + 1] = hi_bf(w[q]); }
}
__device__ void rwkv_prep_phase(const Params& p, int l, LAS unsigned char* lds, int TIDX, int BIDX, cg::grid_group& grid) {
    {
        bf16_t* XBC = (bf16_t*)(p.ws + OFF_XBC);
        const int cgp = TIDX & 127, qt = TIDX >> 7; const int q0 = BIDX * 128 + qt * 32; const int c8 = cgp * 8;
        float h1[8], h2[8], h3[8];
        if ((q0 & (SEQ - 1)) != 0) { conv_unpack(*(const u32x4*)(XBC + (size_t)(q0 - 1) * 1024 + c8), h1); conv_unpack(*(const u32x4*)(XBC + (size_t)(q0 - 2) * 1024 + c8), h2); conv_unpack(*(const u32x4*)(XBC + (size_t)(q0 - 3) * 1024 + c8), h3); }
        else {
#pragma unroll
            for (int e = 0; e < 8; ++e) h1[e] = h2[e] = h3[e] = 0.f; }
        grid.sync();
        float cw0[8], cw1[8], cw2[8], cw3[8], cb[8];
#pragma unroll
        for (int e = 0; e < 8; ++e) { cw0[e] = p.in[I_CONVW][((size_t)l * 4 + 0) * 1024 + c8 + e]; cw1[e] = p.in[I_CONVW][((size_t)l * 4 + 1) * 1024 + c8 + e];
            cw2[e] = p.in[I_CONVW][((size_t)l * 4 + 2) * 1024 + c8 + e]; cw3[e] = p.in[I_CONVW][((size_t)l * 4 + 3) * 1024 + c8 + e]; cb[e] = p.in[I_CONVB][l * 1024 + c8 + e]; }
#pragma unroll 4
        for (int i = 0; i < 32; ++i) {
            bf16_t* ptr = XBC + (size_t)(q0 + i) * 1024 + c8;
            float x0[8]; conv_unpack(*(const u32x4*)ptr, x0);
            float y[8];
#pragma unroll
            for (int e = 0; e < 8; ++e) { y[e] = siluf_(cw0[e] * h3[e] + cw1[e] * h2[e] + cw2[e] * h1[e] + cw3[e] * x0[e] + cb[e]); h3[e] = h2[e]; h2[e] = h1[e]; h1[e] = x0[e]; }
            u32x4 w; w.x = pk2(y[0], y[1]); w.y = pk2(y[2], y[3]); w.z = pk2(y[4], y[5]); w.w = pk2(y[6], y[7]);
            *(u32x4*)ptr = w;
        }
    }
    LAS float* s = (LAS float*)lds;
    const int c = TIDX;
    float wu[64], au[64];
#pragma unroll
    for (int j = 0; j < 64; ++j) { wu[j] = p.in[I_WUP][((size_t)l * 64 + j) * 512 + c]; au[j] = p.in[I_AUP][((size_t)l * 64 + j) * 512 + c]; }
    const float w0 = p.in[I_W0][l * 512 + c], a0 = p.in[I_A0][l * 512 + c];
    const float* SM = (const float*)(p.ws + OFF_SMALL);
    const float* mu = p.in[I_MU] + l * 1664 + 1536;
    bf16_t* A = (bf16_t*)(p.ws + OFF_A); float* DEC = (float*)(p.ws + OFF_DEC);
    const int tpb = T / gridDim.x;
    for (int t0 = BIDX * tpb; t0 < (BIDX + 1) * tpb; t0 += 4) {
        { const int tt = c >> 7, j = c & 127; const int row = t0 + tt;
          const float cur = SM[(size_t)row * 160 + j]; const float prev = (row & (SEQ - 1)) ? SM[(size_t)(row - 1) * 160 + j] : 0.f;
          const float v = cur + mu[j] * (prev - cur);
          s[tt * 128 + j] = j < 64 ? tanhf(v) : v; }
        __syncthreads();
#pragma unroll
        for (int tt = 0; tt < 4; ++tt) {
            float w = w0, a = a0;
#pragma unroll
            for (int j = 0; j < 64; ++j) { w += s[tt * 128 + j] * wu[j]; a += s[tt * 128 + 64 + j] * au[j]; }
            const size_t o = (size_t)(t0 + tt) * 512 + c;
            A[o] = f2bf(sigmoidf_(a)); DEC[o] = __expf(-0.6065306597126334f * sigmoidf_(w));
        }
        __syncthreads();
    }
}

typedef float f32x2 __attribute__((ext_vector_type(2)));
template <int CTRL> __device__ __forceinline__ float dpp_f(float x) { return __builtin_bit_cast(float, __builtin_amdgcn_update_dpp(0, __builtin_bit_cast(int, x), CTRL, 0xF, 0xF, true)); }
__device__ __forceinline__ float row16_sum(float x) { x += dpp_f<0xB1>(x); x += dpp_f<0x4E>(x); x += dpp_f<0x141>(x); x += dpp_f<0x140>(x); return x; }
constexpr int RW_TC = 32, RW_VEC_B = RW_TC * 5 * 64 * 4, RW_V_B = RW_TC * 16 * 4, RW_BUF_B = RW_VEC_B + 2 * RW_V_B;
__device__ void rwkv_scan_fast(const Params& p, int l, int unit, LAS unsigned char* lds, int TIDX) {
    const int bh = unit >> 2, rq = unit & 3, b = bh >> 3, h = bh & 7, wave = TIDX >> 6, lane = TIDX & 63;
    const size_t r0 = (size_t)b * SEQ;
    bf16_t* Y = (bf16_t*)(p.ws + OFF_Y3);
    if (wave >= 4) {
        const int lw = wave - 4, sl = lane >> 3, c8 = (lane & 7) * 8, ch0 = h * 64 + c8;
        const bf16_t* RKV = (const bf16_t*)(p.ws + OFF_RKV); const bf16_t* A = (const bf16_t*)(p.ws + OFF_A); const float* DEC = (const float*)(p.ws + OFF_DEC);
        float mu_r[8], mu_k[8], mu_v[8], k_k[8], k_a[8];
#pragma unroll
        for (int e = 0; e < 8; ++e) { mu_r[e] = p.in[I_MU][l * 1664 + ch0 + e]; mu_k[e] = p.in[I_MU][l * 1664 + 512 + ch0 + e]; mu_v[e] = p.in[I_MU][l * 1664 + 1024 + ch0 + e];
            k_k[e] = p.in[I_KK][l * 512 + ch0 + e]; k_a[e] = p.in[I_KA][l * 512 + ch0 + e]; }
        u32x4 nR, nK, nV, nRp, nKp, nVp, nA; f32x4 nD0, nD1;
        auto issue = [&](int cc) {
            const size_t row = r0 + (size_t)cc * RW_TC + lw * 8 + sl;
            nR = *(const u32x4*)(RKV + row * 1536 + ch0); nK = *(const u32x4*)(RKV + row * 1536 + 512 + ch0); nV = *(const u32x4*)(RKV + row * 1536 + 1024 + ch0);
            nA = *(const u32x4*)(A + row * 512 + ch0); nD0 = *(const f32x4*)(DEC + row * 512 + ch0); nD1 = *(const f32x4*)(DEC + row * 512 + ch0 + 4);
            const size_t prow = (row & (SEQ - 1)) != 0 ? row - 1 : row;
            nRp = *(const u32x4*)(RKV + prow * 1536 + ch0); nKp = *(const u32x4*)(RKV + prow * 1536 + 512 + ch0); nVp = *(const u32x4*)(RKV + prow * 1536 + 1024 + ch0);
        };
        issue(0);
        for (int c = -1; c < SEQ / RW_TC; ++c) {
            if (c >= 1) { LAS const float* yb = (LAS const float*)(lds + ((c - 1) & 1) * RW_BUF_B + RW_VEC_B + RW_V_B);
                const int idx = (lw * 64 + lane) * 2, s = idx >> 4, i = idx & 15;
                *(unsigned*)(Y + (r0 + (size_t)(c - 1) * RW_TC + s) * 512 + h * 64 + rq * 16 + i) = pk2(yb[idx], yb[idx + 1]); }
            if (c + 1 < SEQ / RW_TC) {
                const u32x4 cR = nR, cK = nK, cV = nV, cRp = nRp, cKp = nKp, cVp = nVp, cA = nA; const f32x4 cD0 = nD0, cD1 = nD1;
                if (c + 2 < SEQ / RW_TC) issue(c + 2);
                LAS float* vec = (LAS float*)(lds + ((c + 1) & 1) * RW_BUF_B); LAS float* vb = (LAS float*)(lds + ((c + 1) & 1) * RW_BUF_B + RW_VEC_B);
                const int s = lw * 8 + sl;
                float cr[8], ck[8], cv[8], pr[8], pk[8], pv[8], ca[8];
                conv_unpack(cR, cr); conv_unpack(cK, ck); conv_unpack(cV, cv); conv_unpack(cRp, pr); conv_unpack(cKp, pk); conv_unpack(cVp, pv); conv_unpack(cA, ca);
                if ((((c + 1) * RW_TC + s) & (SEQ - 1)) == 0) {
#pragma unroll
                    for (int e = 0; e < 8; ++e) pr[e] = pk[e] = pv[e] = 0.f; }
                float rr[8], kk[8], vv[8], kkj[8]; float n2 = 0.f;
#pragma unroll
                for (int e = 0; e < 8; ++e) { rr[e] = cr[e] + mu_r[e] * (pr[e] - cr[e]); kk[e] = ck[e] + mu_k[e] * (pk[e] - ck[e]); vv[e] = cv[e] + mu_v[e] * (pv[e] - cv[e]);
                    kkj[e] = kk[e] * k_k[e]; n2 += kkj[e] * kkj[e]; }
                n2 += dpp_f<0xB1>(n2); n2 += dpp_f<0x4E>(n2); n2 += dpp_f<0x141>(n2);
                const float inv = 1.f / fmaxf(sqrtf(n2), 1e-12f);
                f32x4 o0, o1;
                LAS float* d = vec + s * 320 + c8;
                *(LAS f32x4*)(d) = cD0; *(LAS f32x4*)(d + 4) = cD1;
#pragma unroll
                for (int e = 0; e < 4; ++e) { o0[e] = kkj[e] * inv; o1[e] = kkj[4 + e] * inv; }
                *(LAS f32x4*)(d + 64) = o0; *(LAS f32x4*)(d + 68) = o1;
#pragma unroll
                for (int e = 0; e < 4; ++e) { o0[e] *= ca[e]; o1[e] *= ca[4 + e]; }
                *(LAS f32x4*)(d + 128) = o0; *(LAS f32x4*)(d + 132) = o1;
#pragma unroll
                for (int e = 0; e < 4; ++e) { o0[e] = kk[e] * (1.f + (ca[e] - 1.f) * k_a[e]); o1[e] = kk[4 + e] * (1.f + (ca[4 + e] - 1.f) * k_a[4 + e]); }
                *(LAS f32x4*)(d + 192) = o0; *(LAS f32x4*)(d + 196) = o1;
#pragma unroll
                for (int e = 0; e < 4; ++e) { o0[e] = rr[e]; o1[e] = rr[4 + e]; }
                *(LAS f32x4*)(d + 256) = o0; *(LAS f32x4*)(d + 260) = o1;
                if ((c8 >> 4) == rq) {
#pragma unroll
                    for (int e = 0; e < 4; ++e) { o0[e] = vv[e]; o1[e] = vv[4 + e]; }
                    *(LAS f32x4*)(vb + s * 16 + (c8 & 15)) = o0; *(LAS f32x4*)(vb + s * 16 + (c8 & 15) + 4) = o1; }
            }
            __syncthreads();
        }
        { constexpr int c = SEQ / RW_TC; LAS const float* yb = (LAS const float*)(lds + ((c - 1) & 1) * RW_BUF_B + RW_VEC_B + RW_V_B);
          const int idx = (lw * 64 + lane) * 2, s = idx >> 4, i = idx & 15;
          *(unsigned*)(Y + (r0 + (size_t)(c - 1) * RW_TC + s) * 512 + h * 64 + rq * 16 + i) = pk2(yb[idx], yb[idx + 1]); }
    } else {
        const int rl = wave * 4 + (lane >> 4), cq = lane & 15;
        f32x2 S0 = (f32x2){0.f, 0.f}, S1 = (f32x2){0.f, 0.f};
        __syncthreads();
        for (int c = 0; c < SEQ / RW_TC; ++c) {
            LAS const unsigned char* buf = lds + (c & 1) * RW_BUF_B;
            LAS const float* vb = (LAS const float*)(buf + RW_VEC_B); LAS float* yb = (LAS float*)(buf + RW_VEC_B + RW_V_B);
            LAS const f32x4* q = (LAS const f32x4*)buf + cq;
            f32x4 w4 = q[0], k4 = q[16], b4 = q[32], t4 = q[48], r4 = q[64]; float v = vb[rl];
            float ykeep = 0.f;
#pragma unroll
            for (int s = 0; s < RW_TC; ++s) {
                f32x4 nw = w4, nk = k4, nb = b4, nt = t4, nr = r4; float nv = v;
                if (s + 1 < RW_TC) { LAS const f32x4* qn = q + (s + 1) * 80; nw = qn[0]; nk = qn[16]; nb = qn[32]; nt = qn[48]; nr = qn[64]; nv = vb[(s + 1) * 16 + rl]; }
                f32x2 sp = S0 * (f32x2){k4[0], k4[1]} + S1 * (f32x2){k4[2], k4[3]};
                const float sa = -row16_sum(sp[0] + sp[1]);
                S0 = S0 * (f32x2){w4[0], w4[1]} + (f32x2){b4[0], b4[1]} * sa + (f32x2){t4[0], t4[1]} * v;
                S1 = S1 * (f32x2){w4[2], w4[3]} + (f32x2){b4[2], b4[3]} * sa + (f32x2){t4[2], t4[3]} * v;
                f32x2 yp = S0 * (f32x2){r4[0], r4[1]} + S1 * (f32x2){r4[2], r4[3]};
                const float y = row16_sum(yp[0] + yp[1]);
                ykeep = ((s & 15) == cq) ? y : ykeep;
                if ((s & 15) == 15) yb[((s & ~15) + cq) * 16 + rl] = ykeep;
                w4 = nw; k4 = nk; b4 = nb; t4 = nt; r4 = nr; v = nv;
            }
            __syncthreads();
        }
    }
}

__device__ __forceinline__ int tm_shift(int t) { return ((t >> 3) & 3) * 16; }
template <int K, int AM, int BMODE>
__device__ __forceinline__ f32x4 mma_t(LAS const bf16_t* A, int lda, int arow0, LAS const bf16_t* B, int ldb, int brow0, f32x4 acc, int lane) {
    const int r = lane & 15, kg = lane >> 4;
#pragma unroll
    for (int k0 = 0; k0 < K; k0 += 32) {
        bf16x8 a, b;
        if (AM == 0) a = *(LAS const bf16x8*)(A + (arow0 + r) * lda + k0 + kg * 8);
        else if (AM == 2) a = *(LAS const bf16x8*)(A + (arow0 + r) * lda + tm_shift(arow0 + r) + k0 + kg * 8);
        else { LAS const bf16_t* q = A + (k0 + kg * 8) * lda + tm_shift(k0 + kg * 8) + arow0 + r;
#pragma unroll
            for (int j = 0; j < 8; ++j) a[j] = (short)q[j * lda]; }
        if (BMODE == 0) b = *(LAS const bf16x8*)(B + (brow0 + r) * ldb + k0 + kg * 8);
        else if (BMODE == 2) b = *(LAS const bf16x8*)(B + (brow0 + r) * ldb + tm_shift(brow0 + r) + k0 + kg * 8);
        else { LAS const bf16_t* q = B + (k0 + kg * 8) * ldb + tm_shift(k0 + kg * 8) + brow0 + r;
#pragma unroll
            for (int j = 0; j < 8; ++j) b[j] = (short)q[j * ldb]; }
        acc = __builtin_amdgcn_mfma_f32_16x16x32_bf16(a, b, acc, 0, 0, 0);
    }
    return acc;
}
__device__ void mamba2_chunk(const Params& p, int l, int bh, LAS unsigned char* lds, int TIDX) {
    const int b = bh >> 3, h = bh & 7, g = h >> 2, tid = TIDX, wave = tid >> 6, lane = tid & 63, r = lane & 15, kg = lane >> 4;
    LAS bf16_t* CB = (LAS bf16_t*)lds;
    LAS bf16_t* BB = (LAS bf16_t*)(lds + 17408);
    LAS bf16_t* AY = (LAS bf16_t*)(lds + 41984);
    LAS bf16_t* SB = (LAS bf16_t*)(lds + 67584);
    LAS bf16_t* XD = (LAS bf16_t*)(lds + 84992);
    LAS bf16_t* XE = (LAS bf16_t*)(lds + 101376);
    LAS bf16_t* XS = (LAS bf16_t*)(lds + 117760);
    LAS float* F = (LAS float*)(lds + 126976);
    const bf16_t* XBC = (const bf16_t*)(p.ws + OFF_XBC); const float* SM = (const float*)(p.ws + OFF_SMALL);
    bf16_t* Z = (bf16_t*)(p.ws + OFF_Y3) + (size_t)T * 512;
    const float dtb = p.in[I_DTB][l * 8 + h], ah = -__expf(p.in[I_ALOG][l * 8 + h]), dsk = p.in[I_DSKIP][l * 8 + h];
    const size_t rbase = (size_t)b * SEQ;
    f32x4 sacc[4];
#pragma unroll
    for (int i = 0; i < 4; ++i) sacc[i] = (f32x4){0.f, 0.f, 0.f, 0.f};
    for (int i = tid; i < 64 * 128; i += 512) SB[(i >> 7) * 136 + (i & 127)] = 0;
    u32x4 rc[2], rb[2], rx; float rdt = 0.f;
    auto prefetch = [&](int c) {
        const size_t row0 = rbase + (size_t)c * 64;
#pragma unroll
        for (int i = 0; i < 2; ++i) { const int item = tid + 512 * i, ll = item >> 4, ng = item & 15;
            rc[i] = *(const u32x4*)(XBC + (row0 + ll) * 1024 + 768 + g * 128 + ng * 8); rb[i] = *(const u32x4*)(XBC + (row0 + ll) * 1024 + 512 + g * 128 + ng * 8); }
        rx = *(const u32x4*)(XBC + (row0 + (tid >> 3)) * 1024 + h * 64 + (tid & 7) * 8);
        if (tid < 64) rdt = SM[(row0 + tid) * 160 + 128 + h];
    };
    prefetch(0);
    for (int c = 0; c < SEQ / 64; ++c) {
        const size_t row0 = rbase + (size_t)c * 64;
        if (tid < 64) { const float dt = softplusf_(rdt + dtb); float x = dt * ah;
#pragma unroll
            for (int o = 1; o < 64; o <<= 1) { const float y = __shfl_up(x, o); if (lane >= o) x += y; }
            F[tid] = x; F[64 + tid] = dt; }
        __syncthreads();
        const float acs_last = F[63];
#pragma unroll
        for (int i = 0; i < 2; ++i) { const int item = tid + 512 * i, ll = item >> 4, ng = item & 15;
            *(LAS u32x4*)(CB + ll * 136 + ng * 8) = rc[i]; *(LAS u32x4*)(BB + ll * 192 + tm_shift(ll) + ng * 8) = rb[i];
            const float ea = __expf(F[ll]); float cv[8]; conv_unpack(rc[i], cv);
            u32x4 w; w.x = pk2(cv[0] * ea, cv[1] * ea); w.y = pk2(cv[2] * ea, cv[3] * ea); w.z = pk2(cv[4] * ea, cv[5] * ea); w.w = pk2(cv[6] * ea, cv[7] * ea);
            *(LAS u32x4*)(AY + ll * 200 + 64 + ng * 8) = w; }
        { const int ll = tid >> 3, pg = tid & 7; float xv[8]; conv_unpack(rx, xv); const float dtl = F[64 + ll], ee = __expf(acs_last - F[ll]);
          float xd[8];
#pragma unroll
          for (int e = 0; e < 8; ++e) xd[e] = xv[e] * dtl;
          u32x4 w; w.x = pk2(xd[0], xd[1]); w.y = pk2(xd[2], xd[3]); w.z = pk2(xd[4], xd[5]); w.w = pk2(xd[6], xd[7]);
          *(LAS u32x4*)(XD + ll * 128 + tm_shift(ll) + pg * 8) = w;
          w.x = pk2(xd[0] * ee, xd[1] * ee); w.y = pk2(xd[2] * ee, xd[3] * ee); w.z = pk2(xd[4] * ee, xd[5] * ee); w.w = pk2(xd[6] * ee, xd[7] * ee);
          *(LAS u32x4*)(XE + ll * 128 + tm_shift(ll) + pg * 8) = w;
          *(LAS u32x4*)(XS + ll * 72 + pg * 8) = rx; }
        __syncthreads();
        if (c + 1 < SEQ / 64) prefetch(c + 1);
        bf16_t zpre[2][4];
#pragma unroll
        for (int q = 0; q < 2; ++q) { const int tt = wave + 8 * q, tl = tt >> 2, tp = tt & 3;
#pragma unroll
            for (int j = 0; j < 4; ++j) zpre[q][j] = Z[(row0 + tl * 16 + kg * 4 + j) * 512 + h * 64 + tp * 16 + r]; }
#pragma unroll
        for (int q = 0; q < 2; ++q) { const int tt = wave + 8 * q, tl = tt >> 2, ts = tt & 3;
            f32x4 acc = (f32x4){0.f, 0.f, 0.f, 0.f};
            if (ts <= tl) acc = mma_t<128, 0, 2>(CB, 136, tl * 16, BB, 192, ts * 16, acc, lane);
            const int sc = ts * 16 + r; const float as = F[sc];
#pragma unroll
            for (int j = 0; j < 4; ++j) { const int ll = tl * 16 + kg * 4 + j; const float v = (sc <= ll) ? acc[j] * __expf(F[ll] - as) : 0.f; AY[ll * 200 + sc] = f2bf(v); } }
        __syncthreads();
#pragma unroll
        for (int q = 0; q < 2; ++q) { const int tt = wave + 8 * q, tl = tt >> 2, tp = tt & 3;
            f32x4 acc = (f32x4){0.f, 0.f, 0.f, 0.f};
            acc = mma_t<64, 0, 1>(AY, 200, tl * 16, XD, 128, tp * 16, acc, lane);
            acc = mma_t<128, 0, 0>(AY + 64, 200, tl * 16, SB, 136, tp * 16, acc, lane);
            const int pp = tp * 16 + r;
#pragma unroll
            for (int j = 0; j < 4; ++j) { const int ll = tl * 16 + kg * 4 + j; bf16_t* zp = Z + (row0 + ll) * 512 + h * 64 + pp;
                const float y = acc[j] + dsk * bf2f(XS[ll * 72 + pp]); *zp = f2bf(y * siluf_(bf2f(zpre[q][j]))); } }
        const float dl = __expf(acs_last);
#pragma unroll
        for (int i = 0; i < 4; ++i) { const int id = wave * 4 + i, tp = id >> 3, tn = id & 7;
            sacc[i] = sacc[i] * dl; sacc[i] = mma_t<64, 1, 1>(XE, 128, tp * 16, BB, 192, tn * 16, sacc[i], lane); }
        __syncthreads();
#pragma unroll
        for (int i = 0; i < 4; ++i) { const int id = wave * 4 + i, tp = id >> 3, tn = id & 7;
#pragma unroll
            for (int j = 0; j < 4; ++j) SB[(tp * 16 + kg * 4 + j) * 136 + tn * 16 + r] = f2bf(sacc[i][j]); }
    }
}
__device__ void gla_chunk(const Params& p, int l, int unit, LAS unsigned char* lds, int TIDX) {
    const int bh = unit >> 1, eh = unit & 1, b = bh >> 2, h = bh & 3, tid = TIDX, wave = tid >> 6, lane = tid & 63, r = lane & 15, kg = lane >> 4;
    LAS bf16_t* KG = (LAS bf16_t*)lds;
    LAS bf16_t* AY = (LAS bf16_t*)(lds + 9216);
    LAS bf16_t* SB = (LAS bf16_t*)(lds + 26624);
    LAS bf16_t* VV = (LAS bf16_t*)(lds + 35840);
    LAS bf16_t* KD = (LAS bf16_t*)(lds + 52224);
    LAS float* G = (LAS float*)(lds + 68608);
    LAS float* UP = (LAS float*)(lds + 85248);
    LAS float* GD = (LAS float*)(lds + 89344);
    LAS float* SEG = (LAS float*)(lds + 93440);
    const bf16_t* GQ = (const bf16_t*)(p.ws + OFF_GQ); const bf16_t* GK = (const bf16_t*)(p.ws + OFF_GK); const float* SM = (const float*)(p.ws + OFF_SMALL);
    bf16_t* GV = (bf16_t*)(p.ws + OFF_Y3) + (size_t)2 * T * 512;
    const size_t rbase = (size_t)b * SEQ;
    const int ll = tid >> 3, dg = tid & 7;
    for (int i = tid; i < 16 * 64; i += 512) UP[i] = p.in[I_GKUP][((size_t)l * 16 + (i >> 6)) * 256 + h * 64 + (i & 63)];
    float gkb[8];
#pragma unroll
    for (int e = 0; e < 8; ++e) gkb[e] = p.in[I_GKB][l * 256 + h * 64 + dg * 8 + e];
    f32x4 sacc[2];
    sacc[0] = sacc[1] = (f32x4){0.f, 0.f, 0.f, 0.f};
    for (int i = tid; i < 64 * 64; i += 512) SB[(i >> 6) * 72 + (i & 63)] = 0;
    u32x4 rq, rk, rv; f32x4 rg = (f32x4){0.f, 0.f, 0.f, 0.f};
    auto prefetch = [&](int c) {
        const size_t row0 = rbase + (size_t)c * 64;
        rq = *(const u32x4*)(GQ + (row0 + ll) * 256 + h * 64 + dg * 8); rk = *(const u32x4*)(GK + (row0 + ll) * 256 + h * 64 + dg * 8);
        rv = *(const u32x4*)(GV + (row0 + ll) * 512 + h * 128 + eh * 64 + dg * 8);
        if (tid < 256) rg = *(const f32x4*)(SM + (row0 + (tid >> 2)) * 160 + 136 + (tid & 3) * 4);
    };
    prefetch(0);
    for (int c = 0; c < SEQ / 64; ++c) {
        const size_t row0 = rbase + (size_t)c * 64;
        if (tid < 256) *(LAS f32x4*)(GD + (tid >> 2) * 16 + (tid & 3) * 4) = rg;
        __syncthreads();
        { float gp[8];
#pragma unroll
          for (int e = 0; e < 8; ++e) gp[e] = gkb[e];
#pragma unroll
          for (int q = 0; q < 16; ++q) { const float gd = GD[ll * 16 + q];
#pragma unroll
              for (int e = 0; e < 8; ++e) gp[e] += gd * UP[q * 64 + dg * 8 + e]; }
#pragma unroll
          for (int e = 0; e < 8; ++e) G[ll * 65 + dg * 8 + e] = (fminf(gp[e], 0.f) - __logf(1.f + __expf(-fabsf(gp[e])))) * (1.f / 16.f); }
        __syncthreads();
        { const int d = tid & 63, sg = tid >> 6; float gv[8]; float a = 0.f;
#pragma unroll
          for (int q = 0; q < 8; ++q) { a += G[(sg * 8 + q) * 65 + d]; gv[q] = a; }
          SEG[sg * 64 + d] = a;
          __syncthreads();
          float off = 0.f;
#pragma unroll
          for (int q = 0; q < 7; ++q) off += (q < sg) ? SEG[q * 64 + d] : 0.f;
#pragma unroll
          for (int q = 0; q < 8; ++q) G[(sg * 8 + q) * 65 + d] = gv[q] + off; }
        __syncthreads();
        { float qv[8], kv[8]; conv_unpack(rq, qv); conv_unpack(rk, kv);
          float qg[8], ki[8], kd[8];
#pragma unroll
          for (int e = 0; e < 8; ++e) { const int d = dg * 8 + e; const float gl = G[ll * 65 + d], glast = G[63 * 65 + d];
              qg[e] = qv[e] * 0.125f * __expf(gl); ki[e] = kv[e] * __expf(-gl); kd[e] = kv[e] * __expf(glast - gl); }
          u32x4 w; w.x = pk2(qg[0], qg[1]); w.y = pk2(qg[2], qg[3]); w.z = pk2(qg[4], qg[5]); w.w = pk2(qg[6], qg[7]);
          *(LAS u32x4*)(AY + ll * 136 + 64 + dg * 8) = w;
          w.x = pk2(ki[0], ki[1]); w.y = pk2(ki[2], ki[3]); w.z = pk2(ki[4], ki[5]); w.w = pk2(ki[6], ki[7]);
          *(LAS u32x4*)(KG + ll * 72 + dg * 8) = w;
          w.x = pk2(kd[0], kd[1]); w.y = pk2(kd[2], kd[3]); w.z = pk2(kd[4], kd[5]); w.w = pk2(kd[6], kd[7]);
          *(LAS u32x4*)(KD + ll * 128 + tm_shift(ll) + dg * 8) = w;
          *(LAS u32x4*)(VV + ll * 128 + tm_shift(ll) + dg * 8) = rv; }
        __syncthreads();
        if (c + 1 < SEQ / 64) prefetch(c + 1);
#pragma unroll
        for (int q = 0; q < 2; ++q) { const int tt = wave + 8 * q, tl = tt >> 2, ts = tt & 3;
            f32x4 acc = (f32x4){0.f, 0.f, 0.f, 0.f};
            if (ts <= tl) acc = mma_t<64, 0, 0>(AY + 64, 136, tl * 16, KG, 72, ts * 16, acc, lane);
            const int sc = ts * 16 + r;
#pragma unroll
            for (int j = 0; j < 4; ++j) { const int l2 = tl * 16 + kg * 4 + j; AY[l2 * 136 + sc] = f2bf((sc <= l2) ? acc[j] : 0.f); } }
        __syncthreads();
#pragma unroll
        for (int q = 0; q < 2; ++q) { const int tt = wave + 8 * q, tl = tt >> 2, te = tt & 3;
            f32x4 acc = (f32x4){0.f, 0.f, 0.f, 0.f};
            acc = mma_t<64, 0, 1>(AY, 136, tl * 16, VV, 128, te * 16, acc, lane);
            acc = mma_t<64, 0, 0>(AY + 64, 136, tl * 16, SB, 72, te * 16, acc, lane);
#pragma unroll
            for (int j = 0; j < 4; ++j) GV[(row0 + tl * 16 + kg * 4 + j) * 512 + h * 128 + eh * 64 + te * 16 + r] = f2bf(acc[j]); }
#pragma unroll
        for (int i = 0; i < 2; ++i) { const int id = wave * 2 + i, te = id >> 2, td = id & 3;
            const float dl = __expf(G[63 * 65 + td * 16 + r]);
            sacc[i] = sacc[i] * dl; sacc[i] = mma_t<64, 1, 1>(VV, 128, te * 16, KD, 128, td * 16, sacc[i], lane); }
        __syncthreads();
#pragma unroll
        for (int i = 0; i < 2; ++i) { const int id = wave * 2 + i, te = id >> 2, td = id & 3;
#pragma unroll
            for (int j = 0; j < 4; ++j) SB[(te * 16 + kg * 4 + j) * 72 + td * 16 + r] = f2bf(sacc[i][j]); }
    }
}
__device__ void scans_naive_phase(const Params& p, int l, LAS unsigned char* lds, int TIDX, int BIDX) {
    const int wave = TIDX >> 6;
    LAS float* wl = (LAS float*)(lds + wave * 4096);
    if (BIDX < 128) { rwkv_scan_fast(p, l, BIDX, lds, TIDX); return; }
    const int u = BIDX - 128;
    if (u < 32) mamba2_chunk(p, l, u, lds, TIDX);
    else if (u < 64) gla_chunk(p, l, u - 32, lds, TIDX);
}
__device__ void post_phase(const Params& p, int l, int TIDX, int BIDX) {
    const int lane = TIDX & 63, gw = BIDX * 8 + (TIDX >> 6), NGW = gridDim.x * 8;
    const bf16_t* RKV = (const bf16_t*)(p.ws + OFF_RKV); const bf16_t* A = (const bf16_t*)(p.ws + OFF_A);
    bf16_t* Y0 = (bf16_t*)(p.ws + OFF_Y3); bf16_t* Y1 = Y0 + (size_t)T * 512; bf16_t* Y2 = Y1 + (size_t)T * 512;
    const int c0 = lane * 8;
    float mur[8], muk[8], muv[8], kA[8], rk[8], lg[8], lb[8], nw1[8], nw2[8];
#pragma unroll
    for (int e = 0; e < 8; ++e) { const int c = c0 + e;
        mur[e] = p.in[I_MU][l * 1664 + c]; muk[e] = p.in[I_MU][l * 1664 + 512 + c]; muv[e] = p.in[I_MU][l * 1664 + 1024 + c];
        kA[e] = p.in[I_KA][l * 512 + c]; rk[e] = p.in[I_RK][l * 512 + c]; lg[e] = p.in[I_LNG][l * 512 + c]; lb[e] = p.in[I_LNB][l * 512 + c];
        nw1[e] = p.in[I_M2NW][l * 512 + c]; nw2[e] = p.in[I_GNW][l * 128 + (c & 127)]; }
    for (int row = gw; row < T; row += NGW) {
        const bool first = (row & (SEQ - 1)) == 0;
        float y[8], r[8], k[8], v[8], a[8];
        { const u32x4 yy = *(const u32x4*)(Y0 + (size_t)row * 512 + c0); const u32x4 aa = *(const u32x4*)(A + (size_t)row * 512 + c0);
          const u32x4 rr = *(const u32x4*)(RKV + (size_t)row * 1536 + c0), kk = *(const u32x4*)(RKV + (size_t)row * 1536 + 512 + c0), vv = *(const u32x4*)(RKV + (size_t)row * 1536 + 1024 + c0);
          u32x4 rp = (u32x4){0, 0, 0, 0}, kp = rp, vp = rp;
          if (!first) { rp = *(const u32x4*)(RKV + (size_t)(row - 1) * 1536 + c0); kp = *(const u32x4*)(RKV + (size_t)(row - 1) * 1536 + 512 + c0); vp = *(const u32x4*)(RKV + (size_t)(row - 1) * 1536 + 1024 + c0); }
#pragma unroll
          for (int q = 0; q < 4; ++q) {
              y[2 * q] = lo_bf(yy[q]); y[2 * q + 1] = hi_bf(yy[q]); a[2 * q] = lo_bf(aa[q]); a[2 * q + 1] = hi_bf(aa[q]);
              float x0 = lo_bf(rr[q]), x1 = hi_bf(rr[q]); r[2 * q] = x0 + mur[2 * q] * (lo_bf(rp[q]) - x0); r[2 * q + 1] = x1 + mur[2 * q + 1] * (hi_bf(rp[q]) - x1);
              x0 = lo_bf(kk[q]); x1 = hi_bf(kk[q]); k[2 * q] = x0 + muk[2 * q] * (lo_bf(kp[q]) - x0); k[2 * q + 1] = x1 + muk[2 * q + 1] * (hi_bf(kp[q]) - x1);
              x0 = lo_bf(vv[q]); x1 = hi_bf(vv[q]); v[2 * q] = x0 + muv[2 * q] * (lo_bf(vp[q]) - x0); v[2 * q + 1] = x1 + muv[2 * q + 1] * (hi_bf(vp[q]) - x1); } }
        float s = 0.f, bs = 0.f;
#pragma unroll
        for (int e = 0; e < 8; ++e) { s += y[e]; bs += r[e] * (k[e] * (1.f + (a[e] - 1.f) * kA[e])) * rk[e]; }
        s += __shfl_xor(s, 1); s += __shfl_xor(s, 2); s += __shfl_xor(s, 4);
        bs += __shfl_xor(bs, 1); bs += __shfl_xor(bs, 2); bs += __shfl_xor(bs, 4);
        const float mean = s * (1.f / 64.f); float s2 = 0.f;
#pragma unroll
        for (int e = 0; e < 8; ++e) { const float d = y[e] - mean; s2 += d * d; }
        s2 += __shfl_xor(s2, 1); s2 += __shfl_xor(s2, 2); s2 += __shfl_xor(s2, 4);
        const float rstd = rsqrtf(s2 * (1.f / 64.f) + 64e-5f);
        { float o[8];
#pragma unroll
          for (int e = 0; e < 8; ++e) o[e] = (y[e] - mean) * rstd * lg[e] + lb[e] + bs * v[e];
          u32x4 w; w.x = pk2(o[0], o[1]); w.y = pk2(o[2], o[3]); w.z = pk2(o[4], o[5]); w.w = pk2(o[6], o[7]);
          *(u32x4*)(Y0 + (size_t)row * 512 + c0) = w; }
        { const u32x4 yy = *(const u32x4*)(Y1 + (size_t)row * 512 + c0); float q2 = 0.f;
#pragma unroll
          for (int q = 0; q < 4; ++q) { y[2 * q] = lo_bf(yy[q]); y[2 * q + 1] = hi_bf(yy[q]); q2 += y[2 * q] * y[2 * q] + y[2 * q + 1] * y[2 * q + 1]; }
          q2 += __shfl_xor(q2, 1); q2 += __shfl_xor(q2, 2); q2 += __shfl_xor(q2, 4); q2 += __shfl_xor(q2, 8); q2 += __shfl_xor(q2, 16);
          const float rs = rsqrtf(q2 * (1.f / 256.f) + 1e-5f);
          u32x4 w; w.x = pk2(y[0] * rs * nw1[0], y[1] * rs * nw1[1]); w.y = pk2(y[2] * rs * nw1[2], y[3] * rs * nw1[3]); w.z = pk2(y[4] * rs * nw1[4], y[5] * rs * nw1[5]); w.w = pk2(y[6] * rs * nw1[6], y[7] * rs * nw1[7]);
          *(u32x4*)(Y1 + (size_t)row * 512 + c0) = w; }
        { const u32x4 yy = *(const u32x4*)(Y2 + (size_t)row * 512 + c0); float q2 = 0.f;
#pragma unroll
          for (int q = 0; q < 4; ++q) { y[2 * q] = lo_bf(yy[q]); y[2 * q + 1] = hi_bf(yy[q]); q2 += y[2 * q] * y[2 * q] + y[2 * q + 1] * y[2 * q + 1]; }
          q2 += __shfl_xor(q2, 1); q2 += __shfl_xor(q2, 2); q2 += __shfl_xor(q2, 4); q2 += __shfl_xor(q2, 8);
          const float rs = rsqrtf(q2 * (1.f / 128.f) + 1e-5f);
          u32x4 w; w.x = pk2(y[0] * rs * nw2[0], y[1] * rs * nw2[1]); w.y = pk2(y[2] * rs * nw2[2], y[3] * rs * nw2[3]); w.z = pk2(y[4] * rs * nw2[4], y[5] * rs * nw2[5]); w.w = pk2(y[6] * rs * nw2[6], y[7] * rs * nw2[7]);
          *(u32x4*)(Y2 + (size_t)row * 512 + c0) = w; }
    }
}

constexpr int NPHASE = 18;
#ifndef DIAG
#define DIAG 0
#endif
#ifndef DIAG_A
#define DIAG_A(ph, s) ((ph) >= 2 && (s) == 2)
#endif
#ifndef DIAG_B
#define DIAG_B(ph, s) ((ph) >= 2 && ((s) == 0 || (s) >= 4 && (s) <= 6))
#endif
#ifndef PHM
#define PHM 1023
#endif
__global__ __launch_bounds__(512, 2) void mega(Params p) {
    extern __shared__ __attribute__((aligned(16))) unsigned char shm[];
    LAS unsigned char* lds = (LAS unsigned char*)shm;
    cg::grid_group grid = cg::this_grid();
#if DIAG
    unsigned long long tA = 0, tB = 0;
#endif
    for (int ph = p.ph_lo; ph < p.ph_hi; ++ph) {
        const int TIDX = tid_opaque(), BIDX = bid_opaque();
#if DIAG
        const unsigned long long t_start = __builtin_amdgcn_s_memrealtime();
#endif
        if (ph == 0) { if (PHM & 1) { wprep(p, 0, lds, TIDX, BIDX); ada_phase(p, lds, TIDX, BIDX); } }
        else if (ph == 1) { if (PHM & 2) ln1_phase(p, 0, p.in[I_X], TIDX, BIDX); }
        else {
            const int l = (ph - 2) >> 3, s = (ph - 2) & 7;
            const float* xin = l == 0 ? p.in[I_X] : p.out;
            pg8::StaticOrder S;
            if (s == 0 && (PHM & 4)) { pg8::Gemm g{(const bf16_t*)(p.ws + OFF_H), (const bf16_t*)(p.ws + OFF_WT1), T, 4352, 1024, 1 << 30, 0};
                S.init(g.M, g.N, gridDim.x, BIDX); Epi<0> E{p.ws, nullptr, nullptr, nullptr}; pg8::gemm_phase(lds, g, S, E, TIDX); }
            else if (s == 1 && (PHM & 8)) { rwkv_prep_phase(p, l, lds, TIDX, BIDX, grid); }
            else if (s == 2 && (PHM & 16)) { scans_naive_phase(p, l, lds, TIDX, BIDX); }
            else if (s == 3 && (PHM & 32)) { post_phase(p, l, TIDX, BIDX); }
            else if (s == 4 && (PHM & 64)) { pg8::Gemm g{(const bf16_t*)(p.ws + OFF_H), (const bf16_t*)(p.ws + OFF_WT1) + (size_t)4352 * 1024, T, 4096, 1024, 1 << 30, 0};
                S.init(g.M, g.N, gridDim.x, BIDX); Epi<1> E{p.ws, nullptr, nullptr, nullptr}; pg8::gemm_phase(lds, g, S, E, TIDX); }
            else if (s == 5 && (PHM & 128)) { pg8::Gemm g{(const bf16_t*)(p.ws + OFF_Y3), (const bf16_t*)(p.ws + OFF_WT2), T, 3072, 512, 4, (size_t)T * 512 * 2};
                S.init(g.M, g.N, gridDim.x, BIDX); Epi<2> E{p.ws, nullptr, nullptr, nullptr}; pg8::gemm_phase(lds, g, S, E, TIDX); }
            else if (s == 6 && (PHM & 256)) { pg8::Gemm g{(const bf16_t*)(p.ws + OFF_GATES), (const bf16_t*)(p.ws + OFF_WT3), T, 1024, 3072, 1 << 30, 0};
                S.init(g.M, g.N, gridDim.x, BIDX); Epi<3> E{p.ws, xin, (const float*)(p.ws + OFF_MOD) + (size_t)l * 4 * 3072, p.out}; pg8::gemm_phase(lds, g, S, E, TIDX); }
            else if (s == 7 && (PHM & 512)) { lnpost_phase(p, l, TIDX, BIDX); if (l == 0) wprep(p, 1, lds, TIDX, BIDX); }
        }
        if (ph + 1 < p.ph_hi) grid.sync();
#if DIAG
        { const unsigned long long dt = __builtin_amdgcn_s_memrealtime() - t_start; const int s_ = (ph - 2) & 7;
          if (DIAG_A(ph, s_)) tA += dt; if (DIAG_B(ph, s_)) tB += dt; }
#endif
    }
#if DIAG
    grid.sync();
    if (blockIdx.x == 0) {
        const float vA = (float)tA * 10.f, vB = (float)tB * 10.f;
        for (int i = threadIdx.x; i < (1 << 20); i += 512) p.out[4096 + i] = vB;
        if (threadIdx.x == 0) p.out[0] = vA * 1000.f;
    }
#endif
}

extern "C" void kernel_launch(void* const* d_in, const int* in_sizes, int n_in, void* d_out, int out_size, void* d_ws, size_t ws_size, hipStream_t stream) {
    constexpr int LDS_BYTES = 131072;
    static int grid = 0;
    if (grid == 0) {
        if (n_in != 28 || out_size != T * DM || ws_size < WS_END) { fprintf(stderr, "kernel_launch: unexpected shapes / workspace (%zu < %zu)\n", ws_size, (size_t)WS_END); grid = -1; return; }
        int dev = 0, cus = 0, per_cu = 0;
        hipGetDevice(&dev); hipDeviceGetAttribute(&cus, hipDeviceAttributeMultiprocessorCount, dev);
        if (hipFuncSetAttribute((const void*)mega, hipFuncAttributeMaxDynamicSharedMemorySize, LDS_BYTES) != hipSuccess) { fprintf(stderr, "hipFuncSetAttribute failed\n"); grid = -1; return; }
        if (hipOccupancyMaxActiveBlocksPerMultiprocessor(&per_cu, (const void*)mega, 512, LDS_BYTES) != hipSuccess || per_cu < 1) per_cu = 1;
        (void)hipGetLastError();
        grid = cus * 1;
        if (grid != 256) { fprintf(stderr, "kernel_launch: built for 256 CUs\n"); grid = -1; return; }
    }
    if (grid < 0) return;
    Params p{};
    for (int i = 0; i < 28; ++i) p.in[i] = (const float*)d_in[i];
    p.out = (float*)d_out; p.ws = (unsigned char*)d_ws;
#if N_LAUNCH_MODE == 1
    p.ph_lo = 0; p.ph_hi = NPHASE;
    void* args[] = {&p};
    hipError_t e = hipLaunchCooperativeKernel((const void*)mega, dim3(grid), dim3(512), args, LDS_BYTES, stream);
    if (e != hipSuccess) fprintf(stderr, "cooperative launch failed: %s (grid %d)\n", hipGetErrorString(e), grid);
#else
    for (int ph = 0; ph < NPHASE; ++ph) { p.ph_lo = ph; p.ph_hi = ph + 1; hipLaunchKernelGGL(mega, dim3(grid), dim3(512), LDS_BYTES, stream, p); }
#endif
}
```

```cpp
#include <hip/hip_runtime.h>
#include <hip/hip_cooperative_groups.h>
#include <cstdio>
namespace cg = cooperative_groups;

#ifndef N_LAUNCH_MODE
#define N_LAUNCH_MODE 1
#endif

#define LAS __attribute__((address_space(3)))
typedef unsigned short bf16_t;
typedef short bf16x8 __attribute__((ext_vector_type(8)));
typedef float f32x4 __attribute__((ext_vector_type(4)));
typedef unsigned u32x4 __attribute__((ext_vector_type(4)));
typedef unsigned u32x2 __attribute__((ext_vector_type(2)));

constexpr int T = 32768, SEQ = 8192, DM = 1024, NB = 4;
constexpr int INW = 8344;
constexpr float ALPHA_DN = 1.4142135623730951f;

constexpr size_t XCD_BAR_WORDS_B = 3456 * 4;
constexpr size_t SZ_WT1 = (size_t)8448 * 1024 * 2, SZ_WT2 = (size_t)3072 * 512 * 2, SZ_WT3 = (size_t)1024 * 3072 * 2, SZ_MOD = (size_t)2 * 4 * 3072 * 4;
constexpr size_t OFF_WT1 = 0, OFF_WT2 = OFF_WT1 + SZ_WT1, OFF_WT3 = OFF_WT2 + SZ_WT2, OFF_MOD = OFF_WT3 + SZ_WT3;
constexpr size_t OFF_H = OFF_MOD + SZ_MOD;
constexpr size_t OFF_Y3 = OFF_H + (size_t)T * 1024 * 2;
constexpr size_t OFF_RKV = OFF_Y3 + (size_t)3 * T * 512 * 2;
constexpr size_t OFF_XBC = OFF_RKV + (size_t)T * 1536 * 2;
constexpr size_t OFF_GQ = OFF_XBC + (size_t)T * 1024 * 2;
constexpr size_t OFF_GK = OFF_GQ + (size_t)T * 256 * 2;
constexpr size_t OFF_SMALL = OFF_GK + (size_t)T * 256 * 2;
constexpr size_t OFF_A = OFF_SMALL + (size_t)T * 160 * 4;
constexpr size_t OFF_DEC = OFF_A + (size_t)T * 512 * 2;
constexpr size_t WS_END = OFF_DEC + (size_t)T * 512 * 4;
constexpr size_t OFF_BAR = (WS_END + 255) & ~(size_t)255;
constexpr size_t WS_NEED = OFF_BAR + XCD_BAR_WORDS_B;
constexpr size_t OFF_GATES = OFF_RKV;
static_assert(OFF_GK + (size_t)T * 256 * 2 - OFF_RKV == (size_t)T * 3072 * 2, "gates alias");

struct Params { const float* in[28]; float* out; unsigned char* ws; int ph_lo, ph_hi; };
enum { I_X = 0, I_C, I_ADAW, I_ADAB, I_WIN, I_MU, I_W0, I_WUP, I_A0, I_AUP, I_KK, I_KA, I_RK, I_LNG, I_LNB, I_CONVW, I_CONVB, I_DTB, I_ALOG, I_DSKIP,
       I_M2NW, I_GKUP, I_GKB, I_GNW, I_WBR, I_WOUT, I_PG, I_PB };

__device__ __forceinline__ float bf2f(bf16_t v) { return __uint_as_float(((unsigned)v) << 16); }
__device__ __forceinline__ bf16_t f2bf(float f) { unsigned u = __float_as_uint(f); u += 0x7FFFu + ((u >> 16) & 1u); return (bf16_t)(u >> 16); }
__device__ __forceinline__ unsigned pk2(float lo, float hi) { return (unsigned)f2bf(lo) | ((unsigned)f2bf(hi) << 16); }
__device__ __forceinline__ float lo_bf(unsigned w) { return __uint_as_float(w << 16); }
__device__ __forceinline__ float hi_bf(unsigned w) { return __uint_as_float(w & 0xFFFF0000u); }
__device__ __forceinline__ float sigmoidf_(float x) { return 1.0f / (1.0f + __expf(-x)); }
__device__ __forceinline__ float siluf_(float x) { return x / (1.0f + __expf(-x)); }
__device__ __forceinline__ float softplusf_(float x) { return x > 20.f ? x : log1pf(__expf(x)); }
__device__ __forceinline__ float wave_sum(float v) {
#pragma unroll
    for (int o = 1; o < 64; o <<= 1) v += __shfl_xor(v, o);
    return v;
}
__device__ __forceinline__ int tid_opaque() { int t = threadIdx.x; asm volatile("" : "+v"(t)); return t; }
__device__ __forceinline__ int bid_opaque() { int t = blockIdx.x; asm volatile("" : "+s"(t)); return t; }
#define WAVE_LDS_SYNC() do { asm volatile("s_waitcnt lgkmcnt(0)" ::: "memory"); __builtin_amdgcn_wave_barrier(); } while (0)


#define XB_TMO      128
#define XB_XCNT(j)  (256  + 64 * (j))
#define XB_XSUB(j)  (1280 + 64 * (j))
#define XB_XGEN(j)  (2304 + 64 * (j))
#define XB_TOP      3328
#define XB_TOPGEN   3392
#define XCD_BAR_WORDS 3456
#define XB_SPIN_CAP (1u << 20)
__device__ __forceinline__ unsigned xb_ld(unsigned* p)              { return __hip_atomic_load(p, __ATOMIC_RELAXED, __HIP_MEMORY_SCOPE_AGENT); }
__device__ __forceinline__ unsigned xb_add(unsigned* p, unsigned v) { return __hip_atomic_fetch_add(p, v, __ATOMIC_RELAXED, __HIP_MEMORY_SCOPE_AGENT); }
__device__ __forceinline__ unsigned xb_xcc_id() { return (unsigned)__builtin_amdgcn_s_getreg((3 << 11) | 20) & 0xFu; }
#define XB_SPIN(cond, bar) do { unsigned _sp = 0; while (cond) { __builtin_amdgcn_s_sleep(1); \
    if ((++_sp & 255u) == 0u) { if (xb_ld(&(bar)[XB_TMO])) break; if (_sp > XB_SPIN_CAP) { atomicAdd(&(bar)[XB_TMO], 1u); break; } } } } while (0)
struct XcdBarrier { unsigned* bar; unsigned x; volatile LAS unsigned* st; };
__device__ __forceinline__ XcdBarrier xcd_barrier_post(unsigned* bar, volatile LAS unsigned* st) {
    XcdBarrier b; b.bar = bar; b.x = xb_xcc_id(); b.st = st;
    if (threadIdx.x == 0) (void)xb_add(&bar[XB_XCNT(b.x)], 1u);
    return b;
}
__device__ __forceinline__ void xcd_barrier_complete(unsigned* bar, unsigned x, unsigned& nloc, unsigned& nx) {
    const unsigned G = gridDim.x * gridDim.y * gridDim.z;
    unsigned sum, cnt, mine, sp = 0u;
    for (;;) {
        sum = 0u; cnt = 0u; mine = 0u;
#pragma unroll
        for (unsigned j = 0; j < 16; ++j) { const unsigned c = xb_ld(&bar[XB_XCNT(j)]); sum += c; cnt += (c > 0u) ? 1u : 0u; mine = (j == x) ? c : mine; }
        if (sum == G) break;
        __builtin_amdgcn_s_sleep(1);
        if ((++sp & 255u) == 0u) { if (xb_ld(&bar[XB_TMO])) break; if (sp > XB_SPIN_CAP) { atomicAdd(&bar[XB_TMO], 1u); break; } }
    }
    nloc = mine > 0u ? mine : 1u; nx = cnt > 0u ? cnt : 1u;
}
__device__ __forceinline__ void xcd_barrier(const XcdBarrier& b) {
    asm volatile("s_waitcnt vmcnt(0)" ::: "memory");
    __syncthreads();
    if (threadIdx.x == 0) {
        unsigned* bar = b.bar;
        __builtin_amdgcn_s_waitcnt(0);
        unsigned nloc = b.st[0], nx = b.st[1];
        if (nloc == 0u) { xcd_barrier_complete(bar, b.x, nloc, nx); b.st[0] = nloc; b.st[1] = nx; }
        const unsigned old = xb_add(&bar[XB_XSUB(b.x)], 1u);
        const unsigned gen = old / nloc;
        if (old + 1u == (gen + 1u) * nloc) {
            __builtin_amdgcn_fence(__ATOMIC_RELEASE, "agent");
            asm volatile("s_waitcnt vmcnt(0)" ::: "memory");
            const unsigned og = xb_add(&bar[XB_TOP], 1u);
            const unsigned tg = og / nx;
            if (og + 1u == (tg + 1u) * nx) xb_add(&bar[XB_TOPGEN], 1u);
            else XB_SPIN(xb_ld(&bar[XB_TOPGEN]) == tg, bar);
            __builtin_amdgcn_fence(__ATOMIC_ACQUIRE, "agent");
            xb_add(&bar[XB_XGEN(b.x)], 1u);
            asm volatile("s_waitcnt vmcnt(0)" ::: "memory");
        } else {
            XB_SPIN(xb_ld(&bar[XB_XGEN(b.x)]) == gen, bar);
            __builtin_amdgcn_fence(__ATOMIC_ACQUIRE, "agent");
            asm volatile("s_waitcnt vmcnt(0)" ::: "memory");
        }
    }
    __syncthreads();
}
namespace pg8 {
constexpr int BM = 256, BK = 64, HALF = 128, HTB = HALF * BK * 2, STAGE_BYTES = 8 * HTB, NXCD = 8, WGM = 8;
__host__ __device__ __forceinline__ int lds_byte(int r, int c) { const int st = (r >> 4) * 2 + (c >> 5), rr = r & 15, cc = c & 31, ob = rr * 64 + cc * 2; return st * 1024 + (ob ^ (((ob >> 9) & 1) << 5)); }
__host__ __device__ __forceinline__ void stage_rc(int b, int& R, int& C) { const int st = b / 1024, sb = b % 1024, swz = sb ^ (((sb >> 9) & 1) << 5); R = (st >> 1) * 16 + swz / 64; C = (st & 1) * 32 + (swz % 64) / 2; }
__host__ __device__ __forceinline__ int perm32(int rho) { const int n = rho >> 4, i = rho & 15; return 8 * (i >> 2) + 4 * n + (i & 3); }
struct Unit { int pm, pn; };
struct Gemm { const bf16_t* A; const bf16_t* Bt; int M, N, K; int adiv; size_t astride; };
struct StaticOrder {
    int nM, nN, nwg, G, c;
    __device__ void init(int M, int N, int G_, int c_) { nM = M / BM; nN = N / BM; nwg = nM * nN; G = G_; c = c_; }
    __device__ bool next(int i, Unit& u) const {
        const long L = (long)i * G + c; if (L >= nwg) return false;
        int wgid = (int)L; { const int q = nwg / NXCD, r = nwg % NXCD, xcd = wgid % NXCD, off = wgid / NXCD; wgid = (xcd < r ? xcd * (q + 1) : r * (q + 1) + (xcd - r) * q) + off; }
        const int nig = WGM * nN, gid = wgid / nig, fm = gid * WGM, gsz = (nM - fm) < WGM ? (nM - fm) : WGM;
        u.pm = fm + ((wgid % nig) % gsz); u.pn = (wgid % nig) / gsz; return true;
    }
};
__device__ __forceinline__ unsigned cvt_pk_bf16(float lo, float hi) { unsigned r; asm volatile("v_cvt_pk_bf16_f32 %0, %1, %2" : "=v"(r) : "v"(lo), "v"(hi)); return r; }

template <class Epi>
__device__ __forceinline__ void gemm_phase(LAS unsigned char* lds, const Gemm g, const StaticOrder& S, const Epi& E, int TIDX) {
    const int tid = TIDX, wid = __builtin_amdgcn_readfirstlane(tid >> 6), lane = tid & 63, wr = wid >> 2, wc = wid & 3, fr = lane & 15, fq = lane >> 4;
    const int K = g.K, nt = K / BK;
    unsigned voffA[2], voffB[2];
#pragma unroll
    for (int i = 0; i < 2; ++i) { int R, C; stage_rc(tid * 16 + i * 8192, R, C); const int Rb = (R & ~31) + perm32(R & 31);
        voffA[i] = (unsigned)(R * K + C) * 2u; voffB[i] = (unsigned)(Rb * K + C) * 2u; }
    const size_t kstep = (size_t)(BK * 2);
    const size_t hstep = (size_t)HALF * K * 2;
    const size_t tstep = 2 * hstep;
    const unsigned ldsw = (unsigned)wid * 1024u;
    const int aoff = lds_byte(wr * 64 + fr, fq * 8), boff = lds_byte(wc * 32 + fr, fq * 8);
#define PG8_SA(b, h) (((b) * 2 + (h)) * HTB)
#define PG8_SB(b, h) ((4 + (b) * 2 + (h)) * HTB)
#define PG8_STAGE(bufoff, gbase, voff) do { _Pragma("unroll") for (int _i = 0; _i < 2; ++_i) \
        __builtin_amdgcn_global_load_lds((const unsigned*)((const char*)(gbase) + (voff)[_i]), (LAS unsigned*)(lds + (bufoff) + ldsw + _i * 8192), 16, 0, 0); } while (0)
#define PG8_LDA(dst, b, h) do { _Pragma("unroll") for (int m = 0; m < 4; ++m) _Pragma("unroll") for (int k = 0; k < 2; ++k) dst[m][k] = *(const LAS bf16x8*)(lds + PG8_SA(b, h) + aoff + m * 2048 + k * 1024); } while (0)
#define PG8_LDB(dst, b, h) do { _Pragma("unroll") for (int n = 0; n < 2; ++n) _Pragma("unroll") for (int k = 0; k < 2; ++k) dst[n][k] = *(const LAS bf16x8*)(lds + PG8_SB(b, h) + boff + n * 2048 + k * 1024); } while (0)
#define PG8_MMA(ai, bj, At, Bt) do { __builtin_amdgcn_s_setprio(1); _Pragma("unroll") for (int m = 0; m < 4; ++m) _Pragma("unroll") for (int n = 0; n < 2; ++n) _Pragma("unroll") for (int k = 0; k < 2; ++k) \
        acc[ai][bj][m][n] = __builtin_amdgcn_mfma_f32_16x16x32_bf16(Bt[n][k], At[m][k], acc[ai][bj][m][n], 0, 0, 0); __builtin_amdgcn_s_setprio(0); } while (0)
#define PG8_WAIT_V(n) asm volatile("s_waitcnt vmcnt(" #n ")" ::: "memory")
#define PG8_WAIT_L(n) asm volatile("s_waitcnt lgkmcnt(" #n ")" ::: "memory")
#define PG8_BAR __builtin_amdgcn_s_barrier()
#define PG8_SCHED __builtin_amdgcn_sched_barrier(0)
    Unit cur, nxt; int ui = 0;
    if (!S.next(0, cur)) return;
    f32x4 acc[2][2][4][2];
#pragma unroll
    for (int a = 0; a < 2; ++a)
#pragma unroll
        for (int b = 0; b < 2; ++b)
#pragma unroll
            for (int m = 0; m < 4; ++m)
#pragma unroll
                for (int n = 0; n < 2; ++n) acc[a][b][m][n] = (f32x4){0.f, 0.f, 0.f, 0.f};
    bf16x8 At[4][2], B0[2][2], B1[2][2];
    const char* cA = (const char*)g.A + (size_t)(cur.pn / g.adiv) * g.astride + (size_t)cur.pm * tstep; const char* cB = (const char*)g.Bt + (size_t)cur.pn * tstep;
    PG8_STAGE(PG8_SB(0, 0), cB, voffB); PG8_STAGE(PG8_SA(0, 0), cA, voffA); PG8_STAGE(PG8_SB(0, 1), cB + hstep, voffB); PG8_STAGE(PG8_SA(0, 1), cA + hstep, voffA);
    if (wr == 1) PG8_BAR;
    PG8_WAIT_V(4); PG8_BAR;
    PG8_STAGE(PG8_SB(1, 0), cB + kstep, voffB); PG8_STAGE(PG8_SA(1, 0), cA + kstep, voffA); PG8_STAGE(PG8_SB(1, 1), cB + hstep + kstep, voffB);
    PG8_WAIT_V(6); PG8_BAR;
    for (;;) {
        const bool has_next = S.next(ui + 1, nxt);
        const char* nA = has_next ? (const char*)g.A + (size_t)(nxt.pn / g.adiv) * g.astride + (size_t)nxt.pm * tstep : cA; const char* nB = has_next ? (const char*)g.Bt + (size_t)nxt.pn * tstep : cB;
        for (int t = 0; t < nt; t += 2) {
            const bool last = (t == nt - 2);
            const char* a1 = cA + (size_t)(t + 1) * kstep;
            const char* a2 = last ? nA : cA + (size_t)(t + 2) * kstep; const char* b2 = last ? nB : cB + (size_t)(t + 2) * kstep;
            const char* a3 = a2 + kstep; const char* b3 = b2 + kstep;
            PG8_LDB(B0, 0, 0); PG8_SCHED; PG8_LDA(At, 0, 0); PG8_STAGE(PG8_SA(1, 1), a1 + hstep, voffA);
            PG8_WAIT_L(8); PG8_BAR; PG8_WAIT_L(0); PG8_MMA(0, 0, At, B0); PG8_BAR; PG8_SCHED;
            PG8_LDB(B1, 0, 1); PG8_STAGE(PG8_SB(0, 0), b2, voffB);
            PG8_BAR; PG8_WAIT_L(0); PG8_MMA(0, 1, At, B1); PG8_BAR;
            PG8_LDA(At, 0, 1); PG8_STAGE(PG8_SA(0, 0), a2, voffA);
            PG8_BAR; PG8_WAIT_L(0); PG8_MMA(1, 0, At, B0); PG8_BAR; PG8_SCHED;
            PG8_STAGE(PG8_SB(0, 1), b2 + hstep, voffB);
            PG8_WAIT_V(6); PG8_BAR; PG8_MMA(1, 1, At, B1); PG8_BAR;
            PG8_LDB(B0, 1, 0); PG8_SCHED; PG8_LDA(At, 1, 0); PG8_STAGE(PG8_SA(0, 1), a2 + hstep, voffA);
            PG8_WAIT_L(8); PG8_BAR; PG8_WAIT_L(0); PG8_MMA(0, 0, At, B0); PG8_BAR; PG8_SCHED;
            PG8_LDB(B1, 1, 1); PG8_STAGE(PG8_SB(1, 0), b3, voffB);
            PG8_BAR; PG8_WAIT_L(0); PG8_MMA(0, 1, At, B1); PG8_BAR;
            PG8_LDA(At, 1, 1); PG8_STAGE(PG8_SA(1, 0), a3, voffA);
            PG8_BAR; PG8_WAIT_L(0); PG8_MMA(1, 0, At, B0); PG8_BAR; PG8_SCHED;
            PG8_STAGE(PG8_SB(1, 1), b3 + hstep, voffB);
            PG8_WAIT_V(6); PG8_BAR; PG8_MMA(1, 1, At, B1); PG8_BAR;
        }
        E(acc, cur, wr, wc, fr, fq);
        if (!has_next) break;
#pragma unroll
        for (int a = 0; a < 2; ++a)
#pragma unroll
            for (int b = 0; b < 2; ++b)
#pragma unroll
                for (int m = 0; m < 4; ++m)
#pragma unroll
                    for (int n = 0; n < 2; ++n) acc[a][b][m][n] = (f32x4){0.f, 0.f, 0.f, 0.f};
        cur = nxt; cA = nA; cB = nB; ++ui;
    }
    PG8_WAIT_V(0);
    if (wr == 0) PG8_BAR;
    PG8_BAR;
#undef PG8_SA
#undef PG8_SB
#undef PG8_STAGE
#undef PG8_LDA
#undef PG8_LDB
#undef PG8_MMA
#undef PG8_WAIT_V
#undef PG8_WAIT_L
#undef PG8_BAR
#undef PG8_SCHED
}
}

template <int MODE> struct Epi {
    unsigned char* ws; const float* xin; const float* gate; float* out;
    __device__ __forceinline__ void operator()(const f32x4 (&acc)[2][2][4][2], const pg8::Unit& u, int wr, int wc, int fr, int fq) const {
        const int pn = u.pn;
        bf16_t* base = nullptr; int ld = 0, c0 = 0;
        if (MODE == 0) {
            if (pn < 6) { base = (bf16_t*)(ws + OFF_RKV); ld = 1536; c0 = pn * 256; }
            else if (pn < 10) { base = (bf16_t*)(ws + OFF_XBC); ld = 1024; c0 = (pn - 6) * 256; }
            else if (pn < 12) { base = (bf16_t*)(ws + OFF_Y3) + (size_t)T * 512; ld = 512; c0 = (pn - 10) * 256; }
            else if (pn == 12) { base = (bf16_t*)(ws + OFF_GQ); ld = 256; c0 = 0; }
            else if (pn == 13) { base = (bf16_t*)(ws + OFF_GK); ld = 256; c0 = 0; }
            else if (pn < 16) { base = (bf16_t*)(ws + OFF_Y3) + (size_t)2 * T * 512; ld = 512; c0 = (pn - 14) * 256; }
        } else if (MODE == 1) {
            if (pn < 2) { base = (bf16_t*)(ws + OFF_Y3); ld = 512; c0 = pn * 256; }
            else if (pn < 4) { base = (bf16_t*)(ws + OFF_Y3) + (size_t)2 * T * 512; ld = 512; c0 = (pn - 2) * 256; }
            else { base = (bf16_t*)(ws + OFF_GATES); ld = 3072; c0 = (pn - 4) * 256; }
        } else if (MODE == 2) { base = (bf16_t*)(ws + OFF_GATES); ld = 3072; c0 = pn * 256; }
#pragma unroll
        for (int ai = 0; ai < 2; ++ai)
#pragma unroll
            for (int m = 0; m < 4; ++m) {
                const int row = u.pm * 256 + ai * 128 + wr * 64 + m * 16 + fr;
#pragma unroll
                for (int bj = 0; bj < 2; ++bj) {
                    const int cl = bj * 128 + wc * 32 + 8 * fq;
                    f32x4 v0 = acc[ai][bj][m][0], v1 = acc[ai][bj][m][1];
                    if (MODE == 0) {
                        if (pn < 16) {
                            u32x4 w; w.x = pg8::cvt_pk_bf16(v0[0], v0[1]); w.y = pg8::cvt_pk_bf16(v0[2], v0[3]); w.z = pg8::cvt_pk_bf16(v1[0], v1[1]); w.w = pg8::cvt_pk_bf16(v1[2], v1[3]);
                            *(u32x4*)(base + (size_t)row * ld + c0 + cl) = w;
                        } else if (cl < 160) {
                            float* d = (float*)(ws + OFF_SMALL) + (size_t)row * 160 + cl;
                            *(f32x4*)d = v0; *(f32x4*)(d + 4) = v1;
                        }
                    } else if (MODE == 1) {
                        bf16_t* d = base + (size_t)row * ld + c0 + cl;
                        if (pn < 4) {
                            const u32x4 o = *(const u32x4*)d;
                            u32x4 w;
                            w.x = pg8::cvt_pk_bf16(lo_bf(o.x) * siluf_(v0[0]), hi_bf(o.x) * siluf_(v0[1]));
                            w.y = pg8::cvt_pk_bf16(lo_bf(o.y) * siluf_(v0[2]), hi_bf(o.y) * siluf_(v0[3]));
                            w.z = pg8::cvt_pk_bf16(lo_bf(o.z) * siluf_(v1[0]), hi_bf(o.z) * siluf_(v1[1]));
                            w.w = pg8::cvt_pk_bf16(lo_bf(o.w) * siluf_(v1[2]), hi_bf(o.w) * siluf_(v1[3]));
                            *(u32x4*)d = w;
                        } else {
                            u32x4 w;
                            w.x = pg8::cvt_pk_bf16(sigmoidf_(v0[0]), sigmoidf_(v0[1])); w.y = pg8::cvt_pk_bf16(sigmoidf_(v0[2]), sigmoidf_(v0[3]));
                            w.z = pg8::cvt_pk_bf16(sigmoidf_(v1[0]), sigmoidf_(v1[1])); w.w = pg8::cvt_pk_bf16(sigmoidf_(v1[2]), sigmoidf_(v1[3]));
                            *(u32x4*)d = w;
                        }
                    } else if (MODE == 2) {
                        bf16_t* d = base + (size_t)row * ld + c0 + cl;
                        const u32x4 o = *(const u32x4*)d;
                        u32x4 w;
                        w.x = pg8::cvt_pk_bf16(lo_bf(o.x) * v0[0], hi_bf(o.x) * v0[1]); w.y = pg8::cvt_pk_bf16(lo_bf(o.y) * v0[2], hi_bf(o.y) * v0[3]);
                        w.z = pg8::cvt_pk_bf16(lo_bf(o.z) * v1[0], hi_bf(o.z) * v1[1]); w.w = pg8::cvt_pk_bf16(lo_bf(o.w) * v1[2], hi_bf(o.w) * v1[3]);
                        *(u32x4*)d = w;
                    } else {
                        const int col = pn * 256 + cl; const int b = row >> 13;
                        const f32x4 x0 = *(const f32x4*)(xin + (size_t)row * 1024 + col), x1 = *(const f32x4*)(xin + (size_t)row * 1024 + col + 4);
                        const f32x4 g0 = *(const f32x4*)(gate + b * 3072 + 2048 + col), g1 = *(const f32x4*)(gate + b * 3072 + 2048 + col + 4);
                        f32x4 r0, r1;
#pragma unroll
                        for (int j = 0; j < 4; ++j) { r0[j] = ALPHA_DN * x0[j] + (1.f + g0[j]) * v0[j]; r1[j] = ALPHA_DN * x1[j] + (1.f + g1[j]) * v1[j]; }
                        *(f32x4*)(out + (size_t)row * 1024 + col) = r0; *(f32x4*)(out + (size_t)row * 1024 + col + 4) = r1;
                    }
                }
            }
    }
};

__device__ __forceinline__ int wt1_src(int n) {
    if (n < 1536) return n;
    if (n < 2560) return 2176 + (n - 1536);
    if (n < 3072) return 3208 + (n - 2560);
    if (n < 3328) return 3720 + (n - 3072);
    if (n < 3584) return 3976 + (n - 3328);
    if (n < 4096) return 4232 + (n - 3584);
    if (n < 4352) { const int s = n - 4096; if (s < 128) return 1536 + s; if (s < 136) return 3200 + (s - 128); if (s < 152) return 4744 + (s - 136); return -1; }
    const int m = n - 4352;
    if (m < 512) return 1664 + m;
    if (m < 1024) return 4760 + (m - 512);
    return 5272 + (m - 1024);
}
template <bool MAP>
__device__ __forceinline__ void transpose_item(const float* W, int ldw, bf16_t* WT, int ldt, int row_off, int col_off, int nblk, LAS float* scr, int item, int lane) {
    const int kb = item / nblk, nb = item % nblk, k0 = 64 * kb, n0 = 32 * nb;
    int sc = n0 + (lane & 31); if (MAP) sc = wt1_src(sc);
#pragma unroll 8
    for (int i = 0; i < 32; ++i) { const int kk = 2 * i + (lane >> 5); scr[kk * 33 + (lane & 31)] = sc >= 0 ? W[(size_t)(k0 + kk) * ldw + sc] : 0.f; }
    WAVE_LDS_SYNC();
    const int c = lane & 7;
#pragma unroll
    for (int j = 0; j < 4; ++j) { const int n = (lane >> 3) + 8 * j; const LAS float* s = scr + (8 * c) * 33 + n;
        u32x4 o; o.x = pk2(s[0 * 33], s[1 * 33]); o.y = pk2(s[2 * 33], s[3 * 33]); o.z = pk2(s[4 * 33], s[5 * 33]); o.w = pk2(s[6 * 33], s[7 * 33]);
        *(u32x4*)(WT + (size_t)(row_off + n0 + n) * ldt + col_off + k0 + 8 * c) = o; }
    WAVE_LDS_SYNC();
}
__device__ void wprep(const Params& p, int l, LAS unsigned char* lds, int TIDX, int BIDX) {
    const int lane = TIDX & 63, wave = TIDX >> 6;
    LAS float* scr = (LAS float*)(lds + wave * 16384);
    const int gw = BIDX * 8 + wave, NGW = gridDim.x * 8;
    constexpr int I1 = (1024 / 64) * (8448 / 32), I2 = 3 * (512 / 64) * (1024 / 32), I3 = 3 * (1024 / 64) * (1024 / 32);
    bf16_t* WT1 = (bf16_t*)(p.ws + OFF_WT1); bf16_t* WT2 = (bf16_t*)(p.ws + OFF_WT2); bf16_t* WT3 = (bf16_t*)(p.ws + OFF_WT3);
    for (int it = gw; it < I1 + I2 + I3; it += NGW) {
        int r = it;
        if (r < I1) { transpose_item<true>(p.in[I_WIN] + (size_t)l * 1024 * INW, INW, WT1, 1024, 0, 0, 8448 / 32, scr, r, lane); continue; }
        r -= I1;
        if (r < I2) { const int b = r / (I2 / 3), rr = r % (I2 / 3); transpose_item<false>(p.in[I_WBR] + ((size_t)l * 3 + b) * 512 * 1024, 1024, WT2, 512, b * 1024, 0, 1024 / 32, scr, rr, lane); continue; }
        r -= I2;
        { const int j = r / (I3 / 3), rr = r % (I3 / 3); transpose_item<false>(p.in[I_WOUT] + (size_t)l * 1024 * 1024, 1024, WT3, 3072, 0, j * 1024, 1024 / 32, scr, rr, lane); }
    }
}
__device__ void ada_phase(const Params& p, LAS unsigned char* lds, int TIDX, int BIDX) {
    LAS float* red = (LAS float*)lds;
    const int tid = TIDX, kg = tid >> 5, cj = tid & 31;
    float* mod = (float*)(p.ws + OFF_MOD);
    for (int it = BIDX; it < 2 * 96; it += gridDim.x) {
        const int l = it / 96, col = (it % 96) * 32 + cj;
        const float* W = p.in[I_ADAW] + (size_t)l * 1024 * 3072;
        float a0 = 0.f, a1 = 0.f, a2 = 0.f, a3 = 0.f;
        for (int k = kg * 64; k < kg * 64 + 64; ++k) {
            const float w = W[(size_t)k * 3072 + col];
            a0 += siluf_(p.in[I_C][k]) * w; a1 += siluf_(p.in[I_C][1024 + k]) * w; a2 += siluf_(p.in[I_C][2048 + k]) * w; a3 += siluf_(p.in[I_C][3072 + k]) * w;
        }
        red[(kg * 32 + cj) * 4 + 0] = a0; red[(kg * 32 + cj) * 4 + 1] = a1; red[(kg * 32 + cj) * 4 + 2] = a2; red[(kg * 32 + cj) * 4 + 3] = a3;
        __syncthreads();
        if (tid < 128) { const int c2 = tid >> 2, b = tid & 3; float s = 0.f;
            for (int g = 0; g < 16; ++g) s += red[(g * 32 + c2) * 4 + b];
            const int cc = (it % 96) * 32 + c2;
            mod[((size_t)l * 4 + b) * 3072 + cc] = s + p.in[I_ADAB][(size_t)l * 3072 + cc]; }
        __syncthreads();
    }
}
__device__ __forceinline__ void ln_stats(const f32x4 (&v)[4], float& mean, float& rstd, float eps) {
    float s = 0.f;
#pragma unroll
    for (int j = 0; j < 4; ++j) s += (v[j][0] + v[j][1]) + (v[j][2] + v[j][3]);
    mean = wave_sum(s) * (1.f / 1024.f); float s2 = 0.f;
#pragma unroll
    for (int j = 0; j < 4; ++j) { const f32x4 d = v[j] - mean; s2 += (d[0] * d[0] + d[1] * d[1]) + (d[2] * d[2] + d[3] * d[3]); }
    rstd = rsqrtf(wave_sum(s2) * (1.f / 1024.f) + eps);
}
__device__ __forceinline__ void mod_row_to_h(const Params& p, const f32x4 (&v)[4], int row, int l, int lane) {
    float mean, rstd; ln_stats(v, mean, rstd, 1e-5f);
    const float* mod = (const float*)(p.ws + OFF_MOD) + ((size_t)l * 4 + (row >> 13)) * 3072;
    bf16_t* H = (bf16_t*)(p.ws + OFF_H) + (size_t)row * 1024;
#pragma unroll
    for (int j = 0; j < 4; ++j) { const int c = 256 * j + 4 * lane;
        const f32x4 sh = *(const f32x4*)(mod + c), sc = *(const f32x4*)(mod + 1024 + c);
        f32x4 h;
#pragma unroll
        for (int e = 0; e < 4; ++e) h[e] = (v[j][e] - mean) * rstd * (1.f + sc[e]) + sh[e];
        u32x2 o; o.x = pk2(h[0], h[1]); o.y = pk2(h[2], h[3]);
        *(u32x2*)(H + c) = o; }
}
__device__ void ln1_phase(const Params& p, int l, const float* xin, int TIDX, int BIDX) {
    const int lane = TIDX & 63, gw = BIDX * 8 + (TIDX >> 6), NGW = gridDim.x * 8;
    for (int row = gw; row < T; row += NGW) {
        f32x4 v[4];
#pragma unroll
        for (int j = 0; j < 4; ++j) v[j] = *(const f32x4*)(xin + (size_t)row * 1024 + 256 * j + 4 * lane);
        mod_row_to_h(p, v, row, l, lane);
    }
}
__device__ void lnpost_phase(const Params& p, int l, int TIDX, int BIDX) {
    const int lane = TIDX & 63, gw = BIDX * 8 + (TIDX >> 6), NGW = gridDim.x * 8;
    const float* pg = p.in[I_PG] + l * 1024; const float* pb = p.in[I_PB] + l * 1024;
    for (int row = gw; row < T; row += NGW) {
        f32x4 v[4];
#pragma unroll
        for (int j = 0; j < 4; ++j) v[j] = *(const f32x4*)(p.out + (size_t)row * 1024 + 256 * j + 4 * lane);
        float mean, rstd; ln_stats(v, mean, rstd, 1e-5f);
#pragma unroll
        for (int j = 0; j < 4; ++j) { const int c = 256 * j + 4 * lane; const f32x4 g = *(const f32x4*)(pg + c), b = *(const f32x4*)(pb + c);
#pragma unroll
            for (int e = 0; e < 4; ++e) v[j][e] = (v[j][e] - mean) * rstd * g[e] + b[e];
            *(f32x4*)(p.out + (size_t)row * 1024 + c) = v[j]; }
        if (l == 0) mod_row_to_h(p, v, row, 1, lane);
    }
}

__device__ __forceinline__ void conv_unpack(const u32x4 w, float (&x)[8]) {
#pragma unroll
    for (int q = 0; q < 4; ++q) { x[2 * q] = lo_bf(w[q]); x[2 * q + 1] = hi_bf(w[q]); }
}
__device__ void rwkv_prep_phase(const Params& p, int l, LAS unsigned char* lds, int TIDX, int BIDX, const XcdBarrier& xb) {
    {
        bf16_t* XBC = (bf16_t*)(p.ws + OFF_XBC);
        const int cgp = TIDX & 127, qt = TIDX >> 7; const int q0 = BIDX * 128 + qt * 32; const int c8 = cgp * 8;
        float h1[8], h2[8], h3[8];
        if ((q0 & (SEQ - 1)) != 0) { conv_unpack(*(const u32x4*)(XBC + (size_t)(q0 - 1) * 1024 + c8), h1); conv_unpack(*(const u32x4*)(XBC + (size_t)(q0 - 2) * 1024 + c8), h2); conv_unpack(*(const u32x4*)(XBC + (size_t)(q0 - 3) * 1024 + c8), h3); }
        else {
#pragma unroll
            for (int e = 0; e < 8; ++e) h1[e] = h2[e] = h3[e] = 0.f; }
        xcd_barrier(xb);
        float cw0[8], cw1[8], cw2[8], cw3[8], cb[8];
#pragma unroll
        for (int e = 0; e < 8; ++e) { cw0[e] = p.in[I_CONVW][((size_t)l * 4 + 0) * 1024 + c8 + e]; cw1[e] = p.in[I_CONVW][((size_t)l * 4 + 1) * 1024 + c8 + e];
            cw2[e] = p.in[I_CONVW][((size_t)l * 4 + 2) * 1024 + c8 + e]; cw3[e] = p.in[I_CONVW][((size_t)l * 4 + 3) * 1024 + c8 + e]; cb[e] = p.in[I_CONVB][l * 1024 + c8 + e]; }
#pragma unroll 4
        for (int i = 0; i < 32; ++i) {
            bf16_t* ptr = XBC + (size_t)(q0 + i) * 1024 + c8;
            float x0[8]; conv_unpack(*(const u32x4*)ptr, x0);
            float y[8];
#pragma unroll
            for (int e = 0; e < 8; ++e) { y[e] = siluf_(cw0[e] * h3[e] + cw1[e] * h2[e] + cw2[e] * h1[e] + cw3[e] * x0[e] + cb[e]); h3[e] = h2[e]; h2[e] = h1[e]; h1[e] = x0[e]; }
            u32x4 w; w.x = pk2(y[0], y[1]); w.y = pk2(y[2], y[3]); w.z = pk2(y[4], y[5]); w.w = pk2(y[6], y[7]);
            *(u32x4*)ptr = w;
        }
    }
    LAS float* s = (LAS float*)lds;
    const int c = TIDX;
    float wu[64], au[64];
#pragma unroll
    for (int j = 0; j < 64; ++j) { wu[j] = p.in[I_WUP][((size_t)l * 64 + j) * 512 + c]; au[j] = p.in[I_AUP][((size_t)l * 64 + j) * 512 + c]; }
    const float w0 = p.in[I_W0][l * 512 + c], a0 = p.in[I_A0][l * 512 + c];
    const float* SM = (const float*)(p.ws + OFF_SMALL);
    const float* mu = p.in[I_MU] + l * 1664 + 1536;
    bf16_t* A = (bf16_t*)(p.ws + OFF_A); float* DEC = (float*)(p.ws + OFF_DEC);
    const int tpb = T / gridDim.x;
    for (int t0 = BIDX * tpb; t0 < (BIDX + 1) * tpb; t0 += 4) {
        { const int tt = c >> 7, j = c & 127; const int row = t0 + tt;
          const float cur = SM[(size_t)row * 160 + j]; const float prev = (row & (SEQ - 1)) ? SM[(size_t)(row - 1) * 160 + j] : 0.f;
          const float v = cur + mu[j] * (prev - cur);
          s[tt * 128 + j] = j < 64 ? tanhf(v) : v; }
        __syncthreads();
#pragma unroll
        for (int tt = 0; tt < 4; ++tt) {
            float w = w0, a = a0;
#pragma unroll
            for (int j = 0; j < 64; ++j) { w += s[tt * 128 + j] * wu[j]; a += s[tt * 128 + 64 + j] * au[j]; }
            const size_t o = (size_t)(t0 + tt) * 512 + c;
            A[o] = f2bf(sigmoidf_(a)); DEC[o] = __expf(-0.6065306597126334f * sigmoidf_(w));
        }
        __syncthreads();
    }
}

typedef float f32x2 __attribute__((ext_vector_type(2)));
template <int CTRL> __device__ __forceinline__ float dpp_f(float x) { return __builtin_bit_cast(float, __builtin_amdgcn_update_dpp(0, __builtin_bit_cast(int, x), CTRL, 0xF, 0xF, true)); }
__device__ __forceinline__ float row16_sum(float x) { x += dpp_f<0xB1>(x); x += dpp_f<0x4E>(x); x += dpp_f<0x141>(x); x += dpp_f<0x140>(x); return x; }
constexpr int RW_TC = 32, RW_VEC_B = RW_TC * 5 * 64 * 4, RW_V_B = RW_TC * 16 * 4, RW_BUF_B = RW_VEC_B + 2 * RW_V_B;
__device__ void rwkv_scan_fast(const Params& p, int l, int unit, LAS unsigned char* lds, int TIDX) {
    const int bh = unit >> 2, rq = unit & 3, b = bh >> 3, h = bh & 7, wave = TIDX >> 6, lane = TIDX & 63;
    const size_t r0 = (size_t)b * SEQ;
    bf16_t* Y = (bf16_t*)(p.ws + OFF_Y3);
    if (wave >= 4) {
        const int lw = wave - 4, sl = lane >> 3, c8 = (lane & 7) * 8, ch0 = h * 64 + c8;
        const bf16_t* RKV = (const bf16_t*)(p.ws + OFF_RKV); const bf16_t* A = (const bf16_t*)(p.ws + OFF_A); const float* DEC = (const float*)(p.ws + OFF_DEC);
        float mu_r[8], mu_k[8], mu_v[8], k_k[8], k_a[8];
#pragma unroll
        for (int e = 0; e < 8; ++e) { mu_r[e] = p.in[I_MU][l * 1664 + ch0 + e]; mu_k[e] = p.in[I_MU][l * 1664 + 512 + ch0 + e]; mu_v[e] = p.in[I_MU][l * 1664 + 1024 + ch0 + e];
            k_k[e] = p.in[I_KK][l * 512 + ch0 + e]; k_a[e] = p.in[I_KA][l * 512 + ch0 + e]; }
        u32x4 nR, nK, nV, nRp, nKp, nVp, nA; f32x4 nD0, nD1;
        auto issue = [&](int cc) {
            const size_t row = r0 + (size_t)cc * RW_TC + lw * 8 + sl;
            nR = *(const u32x4*)(RKV + row * 1536 + ch0); nK = *(const u32x4*)(RKV + row * 1536 + 512 + ch0); nV = *(const u32x4*)(RKV + row * 1536 + 1024 + ch0);
            nA = *(const u32x4*)(A + row * 512 + ch0); nD0 = *(const f32x4*)(DEC + row * 512 + ch0); nD1 = *(const f32x4*)(DEC + row * 512 + ch0 + 4);
            const size_t prow = (row & (SEQ - 1)) != 0 ? row - 1 : row;
            nRp = *(const u32x4*)(RKV + prow * 1536 + ch0); nKp = *(const u32x4*)(RKV + prow * 1536 + 512 + ch0); nVp = *(const u32x4*)(RKV + prow * 1536 + 1024 + ch0);
        };
        issue(0);
        for (int c = -1; c < SEQ / RW_TC; ++c) {
            if (c >= 1) { LAS const float* yb = (LAS const float*)(lds + ((c - 1) & 1) * RW_BUF_B + RW_VEC_B + RW_V_B);
                const int idx = (lw * 64 + lane) * 2, s = idx >> 4, i = idx & 15;
                *(unsigned*)(Y + (r0 + (size_t)(c - 1) * RW_TC + s) * 512 + h * 64 + rq * 16 + i) = pk2(yb[idx], yb[idx + 1]); }
            if (c + 1 < SEQ / RW_TC) {
                const u32x4 cR = nR, cK = nK, cV = nV, cRp = nRp, cKp = nKp, cVp = nVp, cA = nA; const f32x4 cD0 = nD0, cD1 = nD1;
                if (c + 2 < SEQ / RW_TC) issue(c + 2);
                LAS float* vec = (LAS float*)(lds + ((c + 1) & 1) * RW_BUF_B); LAS float* vb = (LAS float*)(lds + ((c + 1) & 1) * RW_BUF_B + RW_VEC_B);
                const int s = lw * 8 + sl;
                float cr[8], ck[8], cv[8], pr[8], pk[8], pv[8], ca[8];
                conv_unpack(cR, cr); conv_unpack(cK, ck); conv_unpack(cV, cv); conv_unpack(cRp, pr); conv_unpack(cKp, pk); conv_unpack(cVp, pv); conv_unpack(cA, ca);
                if ((((c + 1) * RW_TC + s) & (SEQ - 1)) == 0) {
#pragma unroll
                    for (int e = 0; e < 8; ++e) pr[e] = pk[e] = pv[e] = 0.f; }
                float rr[8], kk[8], vv[8], kkj[8]; float n2 = 0.f;
#pragma unroll
                for (int e = 0; e < 8; ++e) { rr[e] = cr[e] + mu_r[e] * (pr[e] - cr[e]); kk[e] = ck[e] + mu_k[e] * (pk[e] - ck[e]); vv[e] = cv[e] + mu_v[e] * (pv[e] - cv[e]);
                    kkj[e] = kk[e] * k_k[e]; n2 += kkj[e] * kkj[e]; }
                n2 += dpp_f<0xB1>(n2); n2 += dpp_f<0x4E>(n2); n2 += dpp_f<0x141>(n2);
                const float inv = 1.f / fmaxf(sqrtf(n2), 1e-12f);
                f32x4 o0, o1;
                LAS float* d = vec + s * 320 + c8;
                *(LAS f32x4*)(d) = cD0; *(LAS f32x4*)(d + 4) = cD1;
#pragma unroll
                for (int e = 0; e < 4; ++e) { o0[e] = kkj[e] * inv; o1[e] = kkj[4 + e] * inv; }
                *(LAS f32x4*)(d + 64) = o0; *(LAS f32x4*)(d + 68) = o1;
#pragma unroll
                for (int e = 0; e < 4; ++e) { o0[e] *= ca[e]; o1[e] *= ca[4 + e]; }
                *(LAS f32x4*)(d + 128) = o0; *(LAS f32x4*)(d + 132) = o1;
#pragma unroll
                for (int e = 0; e < 4; ++e) { o0[e] = kk[e] * (1.f + (ca[e] - 1.f) * k_a[e]); o1[e] = kk[4 + e] * (1.f + (ca[4 + e] - 1.f) * k_a[4 + e]); }
                *(LAS f32x4*)(d + 192) = o0; *(LAS f32x4*)(d + 196) = o1;
#pragma unroll
                for (int e = 0; e < 4; ++e) { o0[e] = rr[e]; o1[e] = rr[4 + e]; }
                *(LAS f32x4*)(d + 256) = o0; *(LAS f32x4*)(d + 260) = o1;
                if ((c8 >> 4) == rq) {
#pragma unroll
                    for (int e = 0; e < 4; ++e) { o0[e] = vv[e]; o1[e] = vv[4 + e]; }
                    *(LAS f32x4*)(vb + s * 16 + (c8 & 15)) = o0; *(LAS f32x4*)(vb + s * 16 + (c8 & 15) + 4) = o1; }
            }
            __syncthreads();
        }
        { constexpr int c = SEQ / RW_TC; LAS const float* yb = (LAS const float*)(lds + ((c - 1) & 1) * RW_BUF_B + RW_VEC_B + RW_V_B);
          const int idx = (lw * 64 + lane) * 2, s = idx >> 4, i = idx & 15;
          *(unsigned*)(Y + (r0 + (size_t)(c - 1) * RW_TC + s) * 512 + h * 64 + rq * 16 + i) = pk2(yb[idx], yb[idx + 1]); }
    } else {
        const int rl = wave * 4 + (lane >> 4), cq = lane & 15;
        f32x2 S0 = (f32x2){0.f, 0.f}, S1 = (f32x2){0.f, 0.f};
        __syncthreads();
        for (int c = 0; c < SEQ / RW_TC; ++c) {
            LAS const unsigned char* buf = lds + (c & 1) * RW_BUF_B;
            LAS const float* vb = (LAS const float*)(buf + RW_VEC_B); LAS float* yb = (LAS float*)(buf + RW_VEC_B + RW_V_B);
            LAS const f32x4* q = (LAS const f32x4*)buf + cq;
            f32x4 w4 = q[0], k4 = q[16], b4 = q[32], t4 = q[48], r4 = q[64]; float v = vb[rl];
            float ykeep = 0.f;
#pragma unroll
            for (int s = 0; s < RW_TC; ++s) {
                f32x4 nw = w4, nk = k4, nb = b4, nt = t4, nr = r4; float nv = v;
                if (s + 1 < RW_TC) { LAS const f32x4* qn = q + (s + 1) * 80; nw = qn[0]; nk = qn[16]; nb = qn[32]; nt = qn[48]; nr = qn[64]; nv = vb[(s + 1) * 16 + rl]; }
                f32x2 sp = S0 * (f32x2){k4[0], k4[1]} + S1 * (f32x2){k4[2], k4[3]};
                const float sa = -row16_sum(sp[0] + sp[1]);
                S0 = S0 * (f32x2){w4[0], w4[1]} + (f32x2){b4[0], b4[1]} * sa + (f32x2){t4[0], t4[1]} * v;
                S1 = S1 * (f32x2){w4[2], w4[3]} + (f32x2){b4[2], b4[3]} * sa + (f32x2){t4[2], t4[3]} * v;
                f32x2 yp = S0 * (f32x2){r4[0], r4[1]} + S1 * (f32x2){r4[2], r4[3]};
                const float y = row16_sum(yp[0] + yp[1]);
                ykeep = ((s & 15) == cq) ? y : ykeep;
                if ((s & 15) == 15) yb[((s & ~15) + cq) * 16 + rl] = ykeep;
                w4 = nw; k4 = nk; b4 = nb; t4 = nt; r4 = nr; v = nv;
            }
            __syncthreads();
        }
    }
}

__device__ __forceinline__ int tm_shift(int t) { return ((t >> 3) & 3) * 16; }
template <int K, int AM, int BMODE>
__device__ __forceinline__ f32x4 mma_t(LAS const bf16_t* A, int lda, int arow0, LAS const bf16_t* B, int ldb, int brow0, f32x4 acc, int lane) {
    const int r = lane & 15, kg = lane >> 4;
#pragma unroll
    for (int k0 = 0; k0 < K; k0 += 32) {
        bf16x8 a, b;
        if (AM == 0) a = *(LAS const bf16x8*)(A + (arow0 + r) * lda + k0 + kg * 8);
        else if (AM == 2) a = *(LAS const bf16x8*)(A + (arow0 + r) * lda + tm_shift(arow0 + r) + k0 + kg * 8);
        else { LAS const bf16_t* q = A + (k0 + kg * 8) * lda + tm_shift(k0 + kg * 8) + arow0 + r;
#pragma unroll
            for (int j = 0; j < 8; ++j) a[j] = (short)q[j * lda]; }
        if (BMODE == 0) b = *(LAS const bf16x8*)(B + (brow0 + r) * ldb + k0 + kg * 8);
        else if (BMODE == 2) b = *(LAS const bf16x8*)(B + (brow0 + r) * ldb + tm_shift(brow0 + r) + k0 + kg * 8);
        else { LAS const bf16_t* q = B + (k0 + kg * 8) * ldb + tm_shift(k0 + kg * 8) + brow0 + r;
#pragma unroll
            for (int j = 0; j < 8; ++j) b[j] = (short)q[j * ldb]; }
        acc = __builtin_amdgcn_mfma_f32_16x16x32_bf16(a, b, acc, 0, 0, 0);
    }
    return acc;
}
__device__ void mamba2_chunk(const Params& p, int l, int bh, LAS unsigned char* lds, int TIDX) {
    const int b = bh >> 3, h = bh & 7, g = h >> 2, tid = TIDX, wave = tid >> 6, lane = tid & 63, r = lane & 15, kg = lane >> 4;
    LAS bf16_t* CB = (LAS bf16_t*)lds;
    LAS bf16_t* BB = (LAS bf16_t*)(lds + 17408);
    LAS bf16_t* AY = (LAS bf16_t*)(lds + 41984);
    LAS bf16_t* SB = (LAS bf16_t*)(lds + 67584);
    LAS bf16_t* XD = (LAS bf16_t*)(lds + 84992);
    LAS bf16_t* XE = (LAS bf16_t*)(lds + 101376);
    LAS bf16_t* XS = (LAS bf16_t*)(lds + 117760);
    LAS float* F = (LAS float*)(lds + 126976);
    const bf16_t* XBC = (const bf16_t*)(p.ws + OFF_XBC); const float* SM = (const float*)(p.ws + OFF_SMALL);
    bf16_t* Z = (bf16_t*)(p.ws + OFF_Y3) + (size_t)T * 512;
    const float dtb = p.in[I_DTB][l * 8 + h], ah = -__expf(p.in[I_ALOG][l * 8 + h]), dsk = p.in[I_DSKIP][l * 8 + h];
    const size_t rbase = (size_t)b * SEQ;
    f32x4 sacc[4];
#pragma unroll
    for (int i = 0; i < 4; ++i) sacc[i] = (f32x4){0.f, 0.f, 0.f, 0.f};
    for (int i = tid; i < 64 * 128; i += 512) SB[(i >> 7) * 136 + (i & 127)] = 0;
    u32x4 rc[2], rb[2], rx; float rdt = 0.f;
    auto prefetch = [&](int c) {
        const size_t row0 = rbase + (size_t)c * 64;
#pragma unroll
        for (int i = 0; i < 2; ++i) { const int item = tid + 512 * i, ll = item >> 4, ng = item & 15;
            rc[i] = *(const u32x4*)(XBC + (row0 + ll) * 1024 + 768 + g * 128 + ng * 8); rb[i] = *(const u32x4*)(XBC + (row0 + ll) * 1024 + 512 + g * 128 + ng * 8); }
        rx = *(const u32x4*)(XBC + (row0 + (tid >> 3)) * 1024 + h * 64 + (tid & 7) * 8);
        if (tid < 64) rdt = SM[(row0 + tid) * 160 + 128 + h];
    };
    prefetch(0);
    for (int c = 0; c < SEQ / 64; ++c) {
        const size_t row0 = rbase + (size_t)c * 64;
        if (tid < 64) { const float dt = softplusf_(rdt + dtb); float x = dt * ah;
#pragma unroll
            for (int o = 1; o < 64; o <<= 1) { const float y = __shfl_up(x, o); if (lane >= o) x += y; }
            F[tid] = x; F[64 + tid] = dt; }
        __syncthreads();
        const float acs_last = F[63];
#pragma unroll
        for (int i = 0; i < 2; ++i) { const int item = tid + 512 * i, ll = item >> 4, ng = item & 15;
            *(LAS u32x4*)(CB + ll * 136 + ng * 8) = rc[i]; *(LAS u32x4*)(BB + ll * 192 + tm_shift(ll) + ng * 8) = rb[i];
            const float ea = __expf(F[ll]); float cv[8]; conv_unpack(rc[i], cv);
            u32x4 w; w.x = pk2(cv[0] * ea, cv[1] * ea); w.y = pk2(cv[2] * ea, cv[3] * ea); w.z = pk2(cv[4] * ea, cv[5] * ea); w.w = pk2(cv[6] * ea, cv[7] * ea);
            *(LAS u32x4*)(AY + ll * 200 + 64 + ng * 8) = w; }
        { const int ll = tid >> 3, pg = tid & 7; float xv[8]; conv_unpack(rx, xv); const float dtl = F[64 + ll], ee = __expf(acs_last - F[ll]);
          float xd[8];
#pragma unroll
          for (int e = 0; e < 8; ++e) xd[e] = xv[e] * dtl;
          u32x4 w; w.x = pk2(xd[0], xd[1]); w.y = pk2(xd[2], xd[3]); w.z = pk2(xd[4], xd[5]); w.w = pk2(xd[6], xd[7]);
          *(LAS u32x4*)(XD + ll * 128 + tm_shift(ll) + pg * 8) = w;
          w.x = pk2(xd[0] * ee, xd[1] * ee); w.y = pk2(xd[2] * ee, xd[3] * ee); w.z = pk2(xd[4] * ee, xd[5] * ee); w.w = pk2(xd[6] * ee, xd[7] * ee);
          *(LAS u32x4*)(XE + ll * 128 + tm_shift(ll) + pg * 8) = w;
          *(LAS u32x4*)(XS + ll * 72 + pg * 8) = rx; }
        __syncthreads();
        if (c + 1 < SEQ / 64) prefetch(c + 1);
        bf16_t zpre[2][4];
#pragma unroll
        for (int q = 0; q < 2; ++q) { const int tt = wave + 8 * q, tl = tt >> 2, tp = tt & 3;
#pragma unroll
            for (int j = 0; j < 4; ++j) zpre[q][j] = Z[(row0 + tl * 16 + kg * 4 + j) * 512 + h * 64 + tp * 16 + r]; }
#pragma unroll
        for (int q = 0; q < 2; ++q) { const int tt = wave + 8 * q, tl = tt >> 2, ts = tt & 3;
            f32x4 acc = (f32x4){0.f, 0.f, 0.f, 0.f};
            if (ts <= tl) acc = mma_t<128, 0, 2>(CB, 136, tl * 16, BB, 192, ts * 16, acc, lane);
            const int sc = ts * 16 + r; const float as = F[sc];
#pragma unroll
            for (int j = 0; j < 4; ++j) { const int ll = tl * 16 + kg * 4 + j; const float v = (sc <= ll) ? acc[j] * __expf(F[ll] - as) : 0.f; AY[ll * 200 + sc] = f2bf(v); } }
        __syncthreads();
#pragma unroll
        for (int q = 0; q < 2; ++q) { const int tt = wave + 8 * q, tl = tt >> 2, tp = tt & 3;
            f32x4 acc = (f32x4){0.f, 0.f, 0.f, 0.f};
            acc = mma_t<64, 0, 1>(AY, 200, tl * 16, XD, 128, tp * 16, acc, lane);
            acc = mma_t<128, 0, 0>(AY + 64, 200, tl * 16, SB, 136, tp * 16, acc, lane);
            const int pp = tp * 16 + r;
#pragma unroll
            for (int j = 0; j < 4; ++j) { const int ll = tl * 16 + kg * 4 + j; bf16_t* zp = Z + (row0 + ll) * 512 + h * 64 + pp;
                const float y = acc[j] + dsk * bf2f(XS[ll * 72 + pp]); *zp = f2bf(y * siluf_(bf2f(zpre[q][j]))); } }
        const float dl = __expf(acs_last);
#pragma unroll
        for (int i = 0; i < 4; ++i) { const int id = wave * 4 + i, tp = id >> 3, tn = id & 7;
            sacc[i] = sacc[i] * dl; sacc[i] = mma_t<64, 1, 1>(XE, 128, tp * 16, BB, 192, tn * 16, sacc[i], lane); }
        __syncthreads();
#pragma unroll
        for (int i = 0; i < 4; ++i) { const int id = wave * 4 + i, tp = id >> 3, tn = id & 7;
#pragma unroll
            for (int j = 0; j < 4; ++j) SB[(tp * 16 + kg * 4 + j) * 136 + tn * 16 + r] = f2bf(sacc[i][j]); }
    }
}
__device__ void gla_chunk(const Params& p, int l, int unit, LAS unsigned char* lds, int TIDX) {
    const int bh = unit >> 1, eh = unit & 1, b = bh >> 2, h = bh & 3, tid = TIDX, wave = tid >> 6, lane = tid & 63, r = lane & 15, kg = lane >> 4;
    LAS bf16_t* KG = (LAS bf16_t*)lds;
    LAS bf16_t* AY = (LAS bf16_t*)(lds + 9216);
    LAS bf16_t* SB = (LAS bf16_t*)(lds + 26624);
    LAS bf16_t* VV = (LAS bf16_t*)(lds + 35840);
    LAS bf16_t* KD = (LAS bf16_t*)(lds + 52224);
    LAS float* G = (LAS float*)(lds + 68608);
    LAS float* UP = (LAS float*)(lds + 85248);
    LAS float* GD = (LAS float*)(lds + 89344);
    LAS float* SEG = (LAS float*)(lds + 93440);
    const bf16_t* GQ = (const bf16_t*)(p.ws + OFF_GQ); const bf16_t* GK = (const bf16_t*)(p.ws + OFF_GK); const float* SM = (const float*)(p.ws + OFF_SMALL);
    bf16_t* GV = (bf16_t*)(p.ws + OFF_Y3) + (size_t)2 * T * 512;
    const size_t rbase = (size_t)b * SEQ;
    const int ll = tid >> 3, dg = tid & 7;
    for (int i = tid; i < 16 * 64; i += 512) UP[i] = p.in[I_GKUP][((size_t)l * 16 + (i >> 6)) * 256 + h * 64 + (i & 63)];
    float gkb[8];
#pragma unroll
    for (int e = 0; e < 8; ++e) gkb[e] = p.in[I_GKB][l * 256 + h * 64 + dg * 8 + e];
    f32x4 sacc[2];
    sacc[0] = sacc[1] = (f32x4){0.f, 0.f, 0.f, 0.f};
    for (int i = tid; i < 64 * 64; i += 512) SB[(i >> 6) * 72 + (i & 63)] = 0;
    u32x4 rq, rk, rv; f32x4 rg = (f32x4){0.f, 0.f, 0.f, 0.f};
    auto prefetch = [&](int c) {
        const size_t row0 = rbase + (size_t)c * 64;
        rq = *(const u32x4*)(GQ + (row0 + ll) * 256 + h * 64 + dg * 8); rk = *(const u32x4*)(GK + (row0 + ll) * 256 + h * 64 + dg * 8);
        rv = *(const u32x4*)(GV + (row0 + ll) * 512 + h * 128 + eh * 64 + dg * 8);
        if (tid < 256) rg = *(const f32x4*)(SM + (row0 + (tid >> 2)) * 160 + 136 + (tid & 3) * 4);
    };
    prefetch(0);
    for (int c = 0; c < SEQ / 64; ++c) {
        const size_t row0 = rbase + (size_t)c * 64;
        if (tid < 256) *(LAS f32x4*)(GD + (tid >> 2) * 16 + (tid & 3) * 4) = rg;
        __syncthreads();
        { float gp[8];
#pragma unroll
          for (int e = 0; e < 8; ++e) gp[e] = gkb[e];
#pragma unroll
          for (int q = 0; q < 16; ++q) { const float gd = GD[ll * 16 + q];
#pragma unroll
              for (int e = 0; e < 8; ++e) gp[e] += gd * UP[q * 64 + dg * 8 + e]; }
#pragma unroll
          for (int e = 0; e < 8; ++e) G[ll * 65 + dg * 8 + e] = (fminf(gp[e], 0.f) - __logf(1.f + __expf(-fabsf(gp[e])))) * (1.f / 16.f); }
        __syncthreads();
        { const int d = tid & 63, sg = tid >> 6; float gv[8]; float a = 0.f;
#pragma unroll
          for (int q = 0; q < 8; ++q) { a += G[(sg * 8 + q) * 65 + d]; gv[q] = a; }
          SEG[sg * 64 + d] = a;
          __syncthreads();
          float off = 0.f;
#pragma unroll
          for (int q = 0; q < 7; ++q) off += (q < sg) ? SEG[q * 64 + d] : 0.f;
#pragma unroll
          for (int q = 0; q < 8; ++q) G[(sg * 8 + q) * 65 + d] = gv[q] + off; }
        __syncthreads();
        { float qv[8], kv[8]; conv_unpack(rq, qv); conv_unpack(rk, kv);
          float qg[8], ki[8], kd[8];
#pragma unroll
          for (int e = 0; e < 8; ++e) { const int d = dg * 8 + e; const float gl = G[ll * 65 + d], glast = G[63 * 65 + d];
              qg[e] = qv[e] * 0.125f * __expf(gl); ki[e] = kv[e] * __expf(-gl); kd[e] = kv[e] * __expf(glast - gl); }
          u32x4 w; w.x = pk2(qg[0], qg[1]); w.y = pk2(qg[2], qg[3]); w.z = pk2(qg[4], qg[5]); w.w = pk2(qg[6], qg[7]);
          *(LAS u32x4*)(AY + ll * 136 + 64 + dg * 8) = w;
          w.x = pk2(ki[0], ki[1]); w.y = pk2(ki[2], ki[3]); w.z = pk2(ki[4], ki[5]); w.w = pk2(ki[6], ki[7]);
          *(LAS u32x4*)(KG + ll * 72 + dg * 8) = w;
          w.x = pk2(kd[0], kd[1]); w.y = pk2(kd[2], kd[3]); w.z = pk2(kd[4], kd[5]); w.w = pk2(kd[6], kd[7]);
          *(LAS u32x4*)(KD + ll * 128 + tm_shift(ll) + dg * 8) = w;
          *(LAS u32x4*)(VV + ll * 128 + tm_shift(ll) + dg * 8) = rv; }
        __syncthreads();
        if (c + 1 < SEQ / 64) prefetch(c + 1);
#pragma unroll
        for (int q = 0; q < 2; ++q) { const int tt = wave + 8 * q, tl = tt >> 2, ts = tt & 3;
            f32x4 acc = (f32x4){0.f, 0.f, 0.f, 0.f};
            if (ts <= tl) acc = mma_t<64, 0, 0>(AY + 64, 136, tl * 16, KG, 72, ts * 16, acc, lane);
            const int sc = ts * 16 + r;
#pragma unroll
            for (int j = 0; j < 4; ++j) { const int l2 = tl * 16 + kg * 4 + j; AY[l2 * 136 + sc] = f2bf((sc <= l2) ? acc[j] : 0.f); } }
        __syncthreads();
#pragma unroll
        for (int q = 0; q < 2; ++q) { const int tt = wave + 8 * q, tl = tt >> 2, te = tt & 3;
            f32x4 acc = (f32x4){0.f, 0.f, 0.f, 0.f};
            acc = mma_t<64, 0, 1>(AY, 136, tl * 16, VV, 128, te * 16, acc, lane);
            acc = mma_t<64, 0, 0>(AY + 64, 136, tl * 16, SB, 72, te * 16, acc, lane);
#pragma unroll
            for (int j = 0; j < 4; ++j) GV[(row0 + tl * 16 + kg * 4 + j) * 512 + h * 128 + eh * 64 + te * 16 + r] = f2bf(acc[j]); }
#pragma unroll
        for (int i = 0; i < 2; ++i) { const int id = wave * 2 + i, te = id >> 2, td = id & 3;
            const float dl = __expf(G[63 * 65 + td * 16 + r]);
            sacc[i] = sacc[i] * dl; sacc[i] = mma_t<64, 1, 1>(VV, 128, te * 16, KD, 128, td * 16, sacc[i], lane); }
        __syncthreads();
#pragma unroll
        for (int i = 0; i < 2; ++i) { const int id = wave * 2 + i, te = id >> 2, td = id & 3;
#pragma unroll
            for (int j = 0; j < 4; ++j) SB[(te * 16 + kg * 4 + j) * 72 + td * 16 + r] = f2bf(sacc[i][j]); }
    }
}
__device__ void scans_naive_phase(const Params& p, int l, LAS unsigned char* lds, int TIDX, int BIDX) {
    const int wave = TIDX >> 6;
    LAS float* wl = (LAS float*)(lds + wave * 4096);
    if (BIDX < 128) { rwkv_scan_fast(p, l, BIDX, lds, TIDX); return; }
    const int u = BIDX - 128;
    if (u < 32) mamba2_chunk(p, l, u, lds, TIDX);
    else if (u < 64) gla_chunk(p, l, u - 32, lds, TIDX);
}
__device__ void post_phase(const Params& p, int l, int TIDX, int BIDX) {
    const int lane = TIDX & 63, gw = BIDX * 8 + (TIDX >> 6), NGW = gridDim.x * 8;
    const bf16_t* RKV = (const bf16_t*)(p.ws + OFF_RKV); const bf16_t* A = (const bf16_t*)(p.ws + OFF_A);
    bf16_t* Y0 = (bf16_t*)(p.ws + OFF_Y3); bf16_t* Y1 = Y0 + (size_t)T * 512; bf16_t* Y2 = Y1 + (size_t)T * 512;
    const int c0 = lane * 8;
    float mur[8], muk[8], muv[8], kA[8], rk[8], lg[8], lb[8], nw1[8], nw2[8];
#pragma unroll
    for (int e = 0; e < 8; ++e) { const int c = c0 + e;
        mur[e] = p.in[I_MU][l * 1664 + c]; muk[e] = p.in[I_MU][l * 1664 + 512 + c]; muv[e] = p.in[I_MU][l * 1664 + 1024 + c];
        kA[e] = p.in[I_KA][l * 512 + c]; rk[e] = p.in[I_RK][l * 512 + c]; lg[e] = p.in[I_LNG][l * 512 + c]; lb[e] = p.in[I_LNB][l * 512 + c];
        nw1[e] = p.in[I_M2NW][l * 512 + c]; nw2[e] = p.in[I_GNW][l * 128 + (c & 127)]; }
    for (int row = gw; row < T; row += NGW) {
        const bool first = (row & (SEQ - 1)) == 0;
        float y[8], r[8], k[8], v[8], a[8];
        { const u32x4 yy = *(const u32x4*)(Y0 + (size_t)row * 512 + c0); const u32x4 aa = *(const u32x4*)(A + (size_t)row * 512 + c0);
          const u32x4 rr = *(const u32x4*)(RKV + (size_t)row * 1536 + c0), kk = *(const u32x4*)(RKV + (size_t)row * 1536 + 512 + c0), vv = *(const u32x4*)(RKV + (size_t)row * 1536 + 1024 + c0);
          u32x4 rp = (u32x4){0, 0, 0, 0}, kp = rp, vp = rp;
          if (!first) { rp = *(const u32x4*)(RKV + (size_t)(row - 1) * 1536 + c0); kp = *(const u32x4*)(RKV + (size_t)(row - 1) * 1536 + 512 + c0); vp = *(const u32x4*)(RKV + (size_t)(row - 1) * 1536 + 1024 + c0); }
#pragma unroll
          for (int q = 0; q < 4; ++q) {
              y[2 * q] = lo_bf(yy[q]); y[2 * q + 1] = hi_bf(yy[q]); a[2 * q] = lo_bf(aa[q]); a[2 * q + 1] = hi_bf(aa[q]);
              float x0 = lo_bf(rr[q]), x1 = hi_bf(rr[q]); r[2 * q] = x0 + mur[2 * q] * (lo_bf(rp[q]) - x0); r[2 * q + 1] = x1 + mur[2 * q + 1] * (hi_bf(rp[q]) - x1);
              x0 = lo_bf(kk[q]); x1 = hi_bf(kk[q]); k[2 * q] = x0 + muk[2 * q] * (lo_bf(kp[q]) - x0); k[2 * q + 1] = x1 + muk[2 * q + 1] * (hi_bf(kp[q]) - x1);
              x0 = lo_bf(vv[q]); x1 = hi_bf(vv[q]); v[2 * q] = x0 + muv[2 * q] * (lo_bf(vp[q]) - x0); v[2 * q + 1] = x1 + muv[2 * q + 1] * (hi_bf(vp[q]) - x1); } }
        float s = 0.f, bs = 0.f;
#pragma unroll
        for (int e = 0; e < 8; ++e) { s += y[e]; bs += r[e] * (k[e] * (1.f + (a[e] - 1.f) * kA[e])) * rk[e]; }
        s += __shfl_xor(s, 1); s += __shfl_xor(s, 2); s += __shfl_xor(s, 4);
        bs += __shfl_xor(bs, 1); bs += __shfl_xor(bs, 2); bs += __shfl_xor(bs, 4);
        const float mean = s * (1.f / 64.f); float s2 = 0.f;
#pragma unroll
        for (int e = 0; e < 8; ++e) { const float d = y[e] - mean; s2 += d * d; }
        s2 += __shfl_xor(s2, 1); s2 += __shfl_xor(s2, 2); s2 += __shfl_xor(s2, 4);
        const float rstd = rsqrtf(s2 * (1.f / 64.f) + 64e-5f);
        { float o[8];
#pragma unroll
          for (int e = 0; e < 8; ++e) o[e] = (y[e] - mean) * rstd * lg[e] + lb[e] + bs * v[e];
          u32x4 w; w.x = pk2(o[0], o[1]); w.y = pk2(o[2], o[3]); w.z = pk2(o[4], o[5]); w.w = pk2(o[6], o[7]);
          *(u32x4*)(Y0 + (size_t)row * 512 + c0) = w; }
        { const u32x4 yy = *(const u32x4*)(Y1 + (size_t)row * 512 + c0); float q2 = 0.f;
#pragma unroll
          for (int q = 0; q < 4; ++q) { y[2 * q] = lo_bf(yy[q]); y[2 * q + 1] = hi_bf(yy[q]); q2 += y[2 * q] * y[2 * q] + y[2 * q + 1] * y[2 * q + 1]; }
          q2 += __shfl_xor(q2, 1); q2 += __shfl_xor(q2, 2); q2 += __shfl_xor(q2, 4); q2 += __shfl_xor(q2, 8); q2 += __shfl_xor(q2, 16);
          const float rs = rsqrtf(q2 * (1.f / 256.f) + 1e-5f);
          u32x4 w; w.x = pk2(y[0] * rs * nw1[0], y[1] * rs * nw1[1]); w.y = pk2(y[2] * rs * nw1[2], y[3] * rs * nw1[3]); w.z = pk2(y[4] * rs * nw1[4], y[5] * rs * nw1[5]); w.w = pk2(y[6] * rs * nw1[6], y[7] * rs * nw1[7]);
          *(u32x4*)(Y1 + (size_t)row * 512 + c0) = w; }
        { const u32x4 yy = *(const u32x4*)(Y2 + (size_t)row * 512 + c0); float q2 = 0.f;
#pragma unroll
          for (int q = 0; q < 4; ++q) { y[2 * q] = lo_bf(yy[q]); y[2 * q + 1] = hi_bf(yy[q]); q2 += y[2 * q] * y[2 * q] + y[2 * q + 1] * y[2 * q + 1]; }
          q2 += __shfl_xor(q2, 1); q2 += __shfl_xor(q2, 2); q2 += __shfl_xor(q2, 4); q2 += __shfl_xor(q2, 8);
          const float rs = rsqrtf(q2 * (1.f / 128.f) + 1e-5f);
          u32x4 w; w.x = pk2(y[0] * rs * nw2[0], y[1] * rs * nw2[1]); w.y = pk2(y[2] * rs * nw2[2], y[3] * rs * nw2[3]); w.z = pk2(y[4] * rs * nw2[4], y[5] * rs * nw2[5]); w.w = pk2(y[6] * rs * nw2[6], y[7] * rs * nw2[7]);
          *(u32x4*)(Y2 + (size_t)row * 512 + c0) = w; }
    }
}

constexpr int NPHASE = 18;
#ifndef DIAG
#define DIAG 0
#endif
#ifndef DIAG_A
#define DIAG_A(ph, s) ((ph) >= 2 && (s) == 2)
#endif
#ifndef DIAG_B
#define DIAG_B(ph, s) ((ph) >= 2 && ((s) == 0 || (s) >= 4 && (s) <= 6))
#endif
#ifndef PHM
#define PHM 1023
#endif
__global__ __launch_bounds__(512, 2) void mega(Params p) {
    extern __shared__ __attribute__((aligned(16))) unsigned char shm[];
    LAS unsigned char* lds = (LAS unsigned char*)shm;
    cg::grid_group grid = cg::this_grid();
    volatile LAS unsigned* xst = (volatile LAS unsigned*)(lds + 131072);
    if (threadIdx.x < 2) xst[threadIdx.x] = 0u;
    __syncthreads();
    const XcdBarrier xb = xcd_barrier_post((unsigned*)(p.ws + OFF_BAR), xst);
#if DIAG
    unsigned long long tA = 0, tB = 0;
#endif
    for (int ph = p.ph_lo; ph < p.ph_hi; ++ph) {
        const int TIDX = tid_opaque(), BIDX = bid_opaque();
#if DIAG
        const unsigned long long t_start = __builtin_amdgcn_s_memrealtime();
#endif
        if (ph == 0) { if (PHM & 1) { wprep(p, 0, lds, TIDX, BIDX); ada_phase(p, lds, TIDX, BIDX); } }
        else if (ph == 1) { if (PHM & 2) ln1_phase(p, 0, p.in[I_X], TIDX, BIDX); }
        else {
            const int l = (ph - 2) >> 3, s = (ph - 2) & 7;
            const float* xin = l == 0 ? p.in[I_X] : p.out;
            pg8::StaticOrder S;
            if (s == 0 && (PHM & 4)) { pg8::Gemm g{(const bf16_t*)(p.ws + OFF_H), (const bf16_t*)(p.ws + OFF_WT1), T, 4352, 1024, 1 << 30, 0};
                S.init(g.M, g.N, gridDim.x, BIDX); Epi<0> E{p.ws, nullptr, nullptr, nullptr}; pg8::gemm_phase(lds, g, S, E, TIDX); }
            else if (s == 1 && (PHM & 8)) { rwkv_prep_phase(p, l, lds, TIDX, BIDX, xb); }
            else if (s == 2 && (PHM & 16)) { scans_naive_phase(p, l, lds, TIDX, BIDX); }
            else if (s == 3 && (PHM & 32)) { post_phase(p, l, TIDX, BIDX); }
            else if (s == 4 && (PHM & 64)) { pg8::Gemm g{(const bf16_t*)(p.ws + OFF_H), (const bf16_t*)(p.ws + OFF_WT1) + (size_t)4352 * 1024, T, 4096, 1024, 1 << 30, 0};
                S.init(g.M, g.N, gridDim.x, BIDX); Epi<1> E{p.ws, nullptr, nullptr, nullptr}; pg8::gemm_phase(lds, g, S, E, TIDX); }
            else if (s == 5 && (PHM & 128)) { pg8::Gemm g{(const bf16_t*)(p.ws + OFF_Y3), (const bf16_t*)(p.ws + OFF_WT2), T, 3072, 512, 4, (size_t)T * 512 * 2};
                S.init(g.M, g.N, gridDim.x, BIDX); Epi<2> E{p.ws, nullptr, nullptr, nullptr}; pg8::gemm_phase(lds, g, S, E, TIDX); }
            else if (s == 6 && (PHM & 256)) { pg8::Gemm g{(const bf16_t*)(p.ws + OFF_GATES), (const bf16_t*)(p.ws + OFF_WT3), T, 1024, 3072, 1 << 30, 0};
                S.init(g.M, g.N, gridDim.x, BIDX); Epi<3> E{p.ws, xin, (const float*)(p.ws + OFF_MOD) + (size_t)l * 4 * 3072, p.out}; pg8::gemm_phase(lds, g, S, E, TIDX); }
            else if (s == 7 && (PHM & 512)) { lnpost_phase(p, l, TIDX, BIDX); if (l == 0) wprep(p, 1, lds, TIDX, BIDX); }
        }
        if (ph + 1 < p.ph_hi) { if (ph == p.ph_lo) grid.sync(); else xcd_barrier(xb); }
#if DIAG
        { const unsigned long long dt = __builtin_amdgcn_s_memrealtime() - t_start; const int s_ = (ph - 2) & 7;
          if (DIAG_A(ph, s_)) tA += dt; if (DIAG_B(ph, s_)) tB += dt; }
#endif
    }
#if DIAG
    grid.sync();
    if (blockIdx.x == 0) {
        const float vA = (float)tA * 10.f, vB = (float)tB * 10.f;
        for (int i = threadIdx.x; i < (1 << 20); i += 512) p.out[4096 + i] = vB;
        if (threadIdx.x == 0) p.out[0] = vA * 1000.f;
    }
#endif
}

extern "C" void kernel_launch(void* const* d_in, const int* in_sizes, int n_in, void* d_out, int out_size, void* d_ws, size_t ws_size, hipStream_t stream) {
    constexpr int LDS_BYTES = 131072 + 16;
    static int grid = 0;
    if (grid == 0) {
        if (n_in != 28 || out_size != T * DM || ws_size < WS_NEED) { fprintf(stderr, "kernel_launch: unexpected shapes / workspace (%zu < %zu)\n", ws_size, (size_t)WS_NEED); grid = -1; return; }
        int dev = 0, cus = 0, per_cu = 0;
        hipGetDevice(&dev); hipDeviceGetAttribute(&cus, hipDeviceAttributeMultiprocessorCount, dev);
        if (hipFuncSetAttribute((const void*)mega, hipFuncAttributeMaxDynamicSharedMemorySize, LDS_BYTES) != hipSuccess) { fprintf(stderr, "hipFuncSetAttribute failed\n"); grid = -1; return; }
        if (hipOccupancyMaxActiveBlocksPerMultiprocessor(&per_cu, (const void*)mega, 512, LDS_BYTES) != hipSuccess || per_cu < 1) per_cu = 1;
        (void)hipGetLastError();
        grid = cus * 1;
        if (grid != 256) { fprintf(stderr, "kernel_launch: built for 256 CUs\n"); grid = -1; return; }
    }
    if (grid < 0) return;
    if (hipMemsetAsync((char*)d_ws + OFF_BAR, 0, XCD_BAR_WORDS_B, stream) != hipSuccess) { fprintf(stderr, "kernel_launch: memset of barrier words failed\n"); return; }
    Params p{};
    for (int i = 0; i < 28; ++i) p.in[i] = (const float*)d_in[i];
    p.out = (float*)d_out; p.ws = (unsigned char*)d_ws;
#if N_LAUNCH_MODE == 1
    p.ph_lo = 0; p.ph_hi = NPHASE;
    void* args[] = {&p};
    hipError_t e = hipLaunchCooperativeKernel((const void*)mega, dim3(grid), dim3(512), args, LDS_BYTES, stream);
    if (e != hipSuccess) fprintf(stderr, "cooperative launch failed: %s (grid %d)\n", hipGetErrorString(e), grid);
#else
    for (int ph = 0; ph < NPHASE; ++ph) { p.ph_lo = ph; p.ph_hi = ph + 1; hipLaunchKernelGGL(mega, dim3(grid), dim3(512), LDS_BYTES, stream, p); }
#endif
}
```

```cpp
#include <hip/hip_runtime.h>
#include <hip/hip_cooperative_groups.h>
#include <cstdio>
namespace cg = cooperative_groups;

#ifndef N_LAUNCH_MODE
#define N_LAUNCH_MODE 1
#endif

#define LAS __attribute__((address_space(3)))
typedef unsigned short bf16_t;
typedef short bf16x8 __attribute__((ext_vector_type(8)));
typedef float f32x4 __attribute__((ext_vector_type(4)));
typedef unsigned u32x4 __attribute__((ext_vector_type(4)));
typedef unsigned u32x2 __attribute__((ext_vector_type(2)));

constexpr int T = 32768, SEQ = 8192, DM = 1024, NB = 4;
constexpr int INW = 8344;
constexpr float ALPHA_DN = 1.4142135623730951f;

constexpr size_t XCD_BAR_WORDS_B = 3456 * 4;
constexpr size_t SZ_WT1 = (size_t)8448 * 1024 * 2, SZ_WT2 = (size_t)3072 * 512 * 2, SZ_WT3 = (size_t)1024 * 3072 * 2, SZ_MOD = (size_t)2 * 4 * 3072 * 4;
constexpr size_t OFF_WT1 = 0, OFF_WT2 = OFF_WT1 + SZ_WT1, OFF_WT3 = OFF_WT2 + SZ_WT2, OFF_MOD = OFF_WT3 + SZ_WT3;
constexpr size_t OFF_H = OFF_MOD + SZ_MOD;
constexpr size_t OFF_Y3 = OFF_H + (size_t)T * 1024 * 2;
constexpr size_t OFF_RKV = OFF_Y3 + (size_t)3 * T * 512 * 2;
constexpr size_t OFF_XBC = OFF_RKV + (size_t)T * 1536 * 2;
constexpr size_t OFF_GQ = OFF_XBC + (size_t)T * 1024 * 2;
constexpr size_t OFF_GK = OFF_GQ + (size_t)T * 256 * 2;
constexpr size_t OFF_SMALL = OFF_GK + (size_t)T * 256 * 2;
constexpr size_t OFF_A = OFF_SMALL + (size_t)T * 160 * 4;
constexpr size_t OFF_DEC = OFF_A + (size_t)T * 512 * 2;
constexpr size_t WS_END = OFF_DEC + (size_t)T * 512 * 4;
constexpr size_t OFF_BAR = (WS_END + 255) & ~(size_t)255;
constexpr size_t WS_NEED = OFF_BAR + XCD_BAR_WORDS_B;
constexpr size_t OFF_GATES = OFF_RKV;
static_assert(OFF_GK + (size_t)T * 256 * 2 - OFF_RKV == (size_t)T * 3072 * 2, "gates alias");

struct Params { const float* in[28]; float* out; unsigned char* ws; int ph_lo, ph_hi; };
enum { I_X = 0, I_C, I_ADAW, I_ADAB, I_WIN, I_MU, I_W0, I_WUP, I_A0, I_AUP, I_KK, I_KA, I_RK, I_LNG, I_LNB, I_CONVW, I_CONVB, I_DTB, I_ALOG, I_DSKIP,
       I_M2NW, I_GKUP, I_GKB, I_GNW, I_WBR, I_WOUT, I_PG, I_PB };

__device__ __forceinline__ float bf2f(bf16_t v) { return __uint_as_float(((unsigned)v) << 16); }
__device__ __forceinline__ bf16_t f2bf(float f) { unsigned u = __float_as_uint(f); u += 0x7FFFu + ((u >> 16) & 1u); return (bf16_t)(u >> 16); }
__device__ __forceinline__ unsigned pk2(float lo, float hi) { return (unsigned)f2bf(lo) | ((unsigned)f2bf(hi) << 16); }
__device__ __forceinline__ float lo_bf(unsigned w) { return __uint_as_float(w << 16); }
__device__ __forceinline__ float hi_bf(unsigned w) { return __uint_as_float(w & 0xFFFF0000u); }
__device__ __forceinline__ float sigmoidf_(float x) { return 1.0f / (1.0f + __expf(-x)); }
__device__ __forceinline__ float siluf_(float x) { return x / (1.0f + __expf(-x)); }
__device__ __forceinline__ float softplusf_(float x) { return x > 20.f ? x : log1pf(__expf(x)); }
__device__ __forceinline__ float wave_sum(float v) {
#pragma unroll
    for (int o = 1; o < 64; o <<= 1) v += __shfl_xor(v, o);
    return v;
}
__device__ __forceinline__ int tid_opaque() { int t = threadIdx.x; asm volatile("" : "+v"(t)); return t; }
__device__ __forceinline__ int bid_opaque() { int t = blockIdx.x; asm volatile("" : "+s"(t)); return t; }
#define WAVE_LDS_SYNC() do { asm volatile("s_waitcnt lgkmcnt(0)" ::: "memory"); __builtin_amdgcn_wave_barrier(); } while (0)


#define XB_TMO      128
#define XB_XCNT(j)  (256  + 64 * (j))
#define XB_XSUB(j)  (1280 + 64 * (j))
#define XB_XGEN(j)  (2304 + 64 * (j))
#define XB_TOP      3328
#define XB_TOPGEN   3392
#define XCD_BAR_WORDS 3456
#define XB_SPIN_CAP (1u << 20)
__device__ __forceinline__ unsigned xb_ld(unsigned* p)              { return __hip_atomic_load(p, __ATOMIC_RELAXED, __HIP_MEMORY_SCOPE_AGENT); }
__device__ __forceinline__ unsigned xb_add(unsigned* p, unsigned v) { return __hip_atomic_fetch_add(p, v, __ATOMIC_RELAXED, __HIP_MEMORY_SCOPE_AGENT); }
__device__ __forceinline__ unsigned xb_xcc_id() { return (unsigned)__builtin_amdgcn_s_getreg((3 << 11) | 20) & 0xFu; }
#define XB_SPIN(cond, bar) do { unsigned _sp = 0; while (cond) { __builtin_amdgcn_s_sleep(1); \
    if ((++_sp & 255u) == 0u) { if (xb_ld(&(bar)[XB_TMO])) break; if (_sp > XB_SPIN_CAP) { atomicAdd(&(bar)[XB_TMO], 1u); break; } } } } while (0)
struct XcdBarrier { unsigned* bar; unsigned x; volatile LAS unsigned* st; };
__device__ __forceinline__ XcdBarrier xcd_barrier_post(unsigned* bar, volatile LAS unsigned* st) {
    XcdBarrier b; b.bar = bar; b.x = xb_xcc_id(); b.st = st;
    if (threadIdx.x == 0) (void)xb_add(&bar[XB_XCNT(b.x)], 1u);
    return b;
}
__device__ __forceinline__ void xcd_barrier_complete(unsigned* bar, unsigned x, unsigned& nloc, unsigned& nx) {
    const unsigned G = gridDim.x * gridDim.y * gridDim.z;
    unsigned sum, cnt, mine, sp = 0u;
    for (;;) {
        sum = 0u; cnt = 0u; mine = 0u;
#pragma unroll
        for (unsigned j = 0; j < 16; ++j) { const unsigned c = xb_ld(&bar[XB_XCNT(j)]); sum += c; cnt += (c > 0u) ? 1u : 0u; mine = (j == x) ? c : mine; }
        if (sum == G) break;
        __builtin_amdgcn_s_sleep(1);
        if ((++sp & 255u) == 0u) { if (xb_ld(&bar[XB_TMO])) break; if (sp > XB_SPIN_CAP) { atomicAdd(&bar[XB_TMO], 1u); break; } }
    }
    nloc = mine > 0u ? mine : 1u; nx = cnt > 0u ? cnt : 1u;
}
__device__ __forceinline__ void xcd_barrier(const XcdBarrier& b) {
    asm volatile("s_waitcnt vmcnt(0)" ::: "memory");
    __syncthreads();
    if (threadIdx.x == 0) {
        unsigned* bar = b.bar;
        __builtin_amdgcn_s_waitcnt(0);
        unsigned nloc = b.st[0], nx = b.st[1];
        if (nloc == 0u) { xcd_barrier_complete(bar, b.x, nloc, nx); b.st[0] = nloc; b.st[1] = nx; }
        const unsigned old = xb_add(&bar[XB_XSUB(b.x)], 1u);
        const unsigned gen = old / nloc;
        if (old + 1u == (gen + 1u) * nloc) {
            __builtin_amdgcn_fence(__ATOMIC_RELEASE, "agent");
            asm volatile("s_waitcnt vmcnt(0)" ::: "memory");
            const unsigned og = xb_add(&bar[XB_TOP], 1u);
            const unsigned tg = og / nx;
            if (og + 1u == (tg + 1u) * nx) xb_add(&bar[XB_TOPGEN], 1u);
            else XB_SPIN(xb_ld(&bar[XB_TOPGEN]) == tg, bar);
            __builtin_amdgcn_fence(__ATOMIC_ACQUIRE, "agent");
            xb_add(&bar[XB_XGEN(b.x)], 1u);
            asm volatile("s_waitcnt vmcnt(0)" ::: "memory");
        } else {
            XB_SPIN(xb_ld(&bar[XB_XGEN(b.x)]) == gen, bar);
            __builtin_amdgcn_fence(__ATOMIC_ACQUIRE, "agent");
            asm volatile("s_waitcnt vmcnt(0)" ::: "memory");
        }
    }
    __syncthreads();
}
namespace pg8 {
constexpr int BM = 256, BK = 64, HALF = 128, HTB = HALF * BK * 2, STAGE_BYTES = 8 * HTB, NXCD = 8, WGM = 8;
__host__ __device__ __forceinline__ int lds_byte(int r, int c) { const int st = (r >> 4) * 2 + (c >> 5), rr = r & 15, cc = c & 31, ob = rr * 64 + cc * 2; return st * 1024 + (ob ^ (((ob >> 9) & 1) << 5)); }
__host__ __device__ __forceinline__ void stage_rc(int b, int& R, int& C) { const int st = b / 1024, sb = b % 1024, swz = sb ^ (((sb >> 9) & 1) << 5); R = (st >> 1) * 16 + swz / 64; C = (st & 1) * 32 + (swz % 64) / 2; }
__host__ __device__ __forceinline__ int perm32(int rho) { const int n = rho >> 4, i = rho & 15; return 8 * (i >> 2) + 4 * n + (i & 3); }
struct Unit { int pm, pn; };
struct Gemm { const bf16_t* A; const bf16_t* Bt; int M, N, K; int adiv; size_t astride; };
struct StaticOrder {
    int nM, nN, nwg, G, c, rep;
    __device__ void init(int M, int N, int G_, int c_, int rep_ = 1) { nM = M / BM; nN = N / BM; nwg = nM * nN; G = G_; c = c_; rep = rep_; }
    __device__ bool next(int i0, Unit& u) const {
        const int i = rep == 3 ? i0 / 3 : i0;
        const long L = (long)i * G + c; if (L >= nwg) return false;
        int wgid = (int)L; { const int q = nwg / NXCD, r = nwg % NXCD, xcd = wgid % NXCD, off = wgid / NXCD; wgid = (xcd < r ? xcd * (q + 1) : r * (q + 1) + (xcd - r) * q) + off; }
        const int nig = WGM * nN, gid = wgid / nig, fm = gid * WGM, gsz = (nM - fm) < WGM ? (nM - fm) : WGM;
        u.pm = fm + ((wgid % nig) % gsz); u.pn = (wgid % nig) / gsz; if (rep == 3) u.pn += nN * (i0 - 3 * i); return true;
    }
};
__device__ __forceinline__ unsigned cvt_pk_bf16(float lo, float hi) { unsigned r; asm volatile("v_cvt_pk_bf16_f32 %0, %1, %2" : "=v"(r) : "v"(lo), "v"(hi)); return r; }

template <class Epi>
__device__ __forceinline__ void gemm_phase(LAS unsigned char* lds, const Gemm g, const StaticOrder& S, const Epi& E, int TIDX) {
    const int tid = TIDX, wid = __builtin_amdgcn_readfirstlane(tid >> 6), lane = tid & 63, wr = wid >> 2, wc = wid & 3, fr = lane & 15, fq = lane >> 4;
    const int K = g.K, nt = K / BK;
    unsigned voffA[2], voffB[2];
#pragma unroll
    for (int i = 0; i < 2; ++i) { int R, C; stage_rc(tid * 16 + i * 8192, R, C); const int Rb = (R & ~31) + perm32(R & 31);
        voffA[i] = (unsigned)(R * K + C) * 2u; voffB[i] = (unsigned)(Rb * K + C) * 2u; }
    const size_t kstep = (size_t)(BK * 2);
    const size_t hstep = (size_t)HALF * K * 2;
    const size_t tstep = 2 * hstep;
    const unsigned ldsw = (unsigned)wid * 1024u;
    const int aoff = lds_byte(wr * 64 + fr, fq * 8), boff = lds_byte(wc * 32 + fr, fq * 8);
#define PG8_SA(b, h) (((b) * 2 + (h)) * HTB)
#define PG8_SB(b, h) ((4 + (b) * 2 + (h)) * HTB)
#define PG8_STAGE(bufoff, gbase, voff) do { _Pragma("unroll") for (int _i = 0; _i < 2; ++_i) \
        __builtin_amdgcn_global_load_lds((const unsigned*)((const char*)(gbase) + (voff)[_i]), (LAS unsigned*)(lds + (bufoff) + ldsw + _i * 8192), 16, 0, 0); } while (0)
#define PG8_LDA(dst, b, h) do { _Pragma("unroll") for (int m = 0; m < 4; ++m) _Pragma("unroll") for (int k = 0; k < 2; ++k) dst[m][k] = *(const LAS bf16x8*)(lds + PG8_SA(b, h) + aoff + m * 2048 + k * 1024); } while (0)
#define PG8_LDB(dst, b, h) do { _Pragma("unroll") for (int n = 0; n < 2; ++n) _Pragma("unroll") for (int k = 0; k < 2; ++k) dst[n][k] = *(const LAS bf16x8*)(lds + PG8_SB(b, h) + boff + n * 2048 + k * 1024); } while (0)
#define PG8_MMA(ai, bj, At, Bt) do { __builtin_amdgcn_s_setprio(1); _Pragma("unroll") for (int m = 0; m < 4; ++m) _Pragma("unroll") for (int n = 0; n < 2; ++n) _Pragma("unroll") for (int k = 0; k < 2; ++k) \
        acc[ai][bj][m][n] = __builtin_amdgcn_mfma_f32_16x16x32_bf16(Bt[n][k], At[m][k], acc[ai][bj][m][n], 0, 0, 0); __builtin_amdgcn_s_setprio(0); } while (0)
#define PG8_WAIT_V(n) asm volatile("s_waitcnt vmcnt(" #n ")" ::: "memory")
#define PG8_WAIT_L(n) asm volatile("s_waitcnt lgkmcnt(" #n ")" ::: "memory")
#define PG8_BAR __builtin_amdgcn_s_barrier()
#define PG8_SCHED __builtin_amdgcn_sched_barrier(0)
    Unit cur, nxt; int ui = 0;
    if (!S.next(0, cur)) return;
    f32x4 acc[2][2][4][2];
#pragma unroll
    for (int a = 0; a < 2; ++a)
#pragma unroll
        for (int b = 0; b < 2; ++b)
#pragma unroll
            for (int m = 0; m < 4; ++m)
#pragma unroll
                for (int n = 0; n < 2; ++n) acc[a][b][m][n] = (f32x4){0.f, 0.f, 0.f, 0.f};
    bf16x8 At[4][2], B0[2][2], B1[2][2];
    const char* cA = (const char*)g.A + (size_t)(cur.pn / g.adiv) * g.astride + (size_t)cur.pm * tstep; const char* cB = (const char*)g.Bt + (size_t)cur.pn * tstep;
    PG8_STAGE(PG8_SB(0, 0), cB, voffB); PG8_STAGE(PG8_SA(0, 0), cA, voffA); PG8_STAGE(PG8_SB(0, 1), cB + hstep, voffB); PG8_STAGE(PG8_SA(0, 1), cA + hstep, voffA);
    if (wr == 1) PG8_BAR;
    PG8_WAIT_V(4); PG8_BAR;
    PG8_STAGE(PG8_SB(1, 0), cB + kstep, voffB); PG8_STAGE(PG8_SA(1, 0), cA + kstep, voffA); PG8_STAGE(PG8_SB(1, 1), cB + hstep + kstep, voffB);
    PG8_WAIT_V(6); PG8_BAR;
    for (;;) {
        const bool has_next = S.next(ui + 1, nxt);
        const char* nA = has_next ? (const char*)g.A + (size_t)(nxt.pn / g.adiv) * g.astride + (size_t)nxt.pm * tstep : cA; const char* nB = has_next ? (const char*)g.Bt + (size_t)nxt.pn * tstep : cB;
        for (int t = 0; t < nt; t += 2) {
            const bool last = (t == nt - 2);
            const char* a1 = cA + (size_t)(t + 1) * kstep;
            const char* a2 = last ? nA : cA + (size_t)(t + 2) * kstep; const char* b2 = last ? nB : cB + (size_t)(t + 2) * kstep;
            const char* a3 = a2 + kstep; const char* b3 = b2 + kstep;
            PG8_LDB(B0, 0, 0); PG8_SCHED; PG8_LDA(At, 0, 0); PG8_STAGE(PG8_SA(1, 1), a1 + hstep, voffA);
            PG8_WAIT_L(8); PG8_BAR; PG8_WAIT_L(0); PG8_MMA(0, 0, At, B0); PG8_BAR; PG8_SCHED;
            PG8_LDB(B1, 0, 1); PG8_STAGE(PG8_SB(0, 0), b2, voffB);
            PG8_BAR; PG8_WAIT_L(0); PG8_MMA(0, 1, At, B1); PG8_BAR;
            PG8_LDA(At, 0, 1); PG8_STAGE(PG8_SA(0, 0), a2, voffA);
            PG8_BAR; PG8_WAIT_L(0); PG8_MMA(1, 0, At, B0); PG8_BAR; PG8_SCHED;
            PG8_STAGE(PG8_SB(0, 1), b2 + hstep, voffB);
            PG8_WAIT_V(6); PG8_BAR; PG8_MMA(1, 1, At, B1); PG8_BAR;
            PG8_LDB(B0, 1, 0); PG8_SCHED; PG8_LDA(At, 1, 0); PG8_STAGE(PG8_SA(0, 1), a2 + hstep, voffA);
            PG8_WAIT_L(8); PG8_BAR; PG8_WAIT_L(0); PG8_MMA(0, 0, At, B0); PG8_BAR; PG8_SCHED;
            PG8_LDB(B1, 1, 1); PG8_STAGE(PG8_SB(1, 0), b3, voffB);
            PG8_BAR; PG8_WAIT_L(0); PG8_MMA(0, 1, At, B1); PG8_BAR;
            PG8_LDA(At, 1, 1); PG8_STAGE(PG8_SA(1, 0), a3, voffA);
            PG8_BAR; PG8_WAIT_L(0); PG8_MMA(1, 0, At, B0); PG8_BAR; PG8_SCHED;
            PG8_STAGE(PG8_SB(1, 1), b3 + hstep, voffB);
            PG8_WAIT_V(6); PG8_BAR; PG8_MMA(1, 1, At, B1); PG8_BAR;
        }
        E(acc, cur, wr, wc, fr, fq);
        if (!has_next) break;
#pragma unroll
        for (int a = 0; a < 2; ++a)
#pragma unroll
            for (int b = 0; b < 2; ++b)
#pragma unroll
                for (int m = 0; m < 4; ++m)
#pragma unroll
                    for (int n = 0; n < 2; ++n) acc[a][b][m][n] = (f32x4){0.f, 0.f, 0.f, 0.f};
        cur = nxt; cA = nA; cB = nB; ++ui;
    }
    PG8_WAIT_V(0);
    if (wr == 0) PG8_BAR;
    PG8_BAR;
#undef PG8_SA
#undef PG8_SB
#undef PG8_STAGE
#undef PG8_LDA
#undef PG8_LDB
#undef PG8_MMA
#undef PG8_WAIT_V
#undef PG8_WAIT_L
#undef PG8_BAR
#undef PG8_SCHED
}
}

template <int MODE> struct Epi {
    unsigned char* ws; const float* xin; const float* gate; float* out;
    __device__ __forceinline__ void operator()(const f32x4 (&acc)[2][2][4][2], const pg8::Unit& u, int wr, int wc, int fr, int fq) const {
        const int pn = u.pn;
        bf16_t* base = nullptr; int ld = 0, c0 = 0;
        if (MODE == 0) {
            if (pn < 6) { base = (bf16_t*)(ws + OFF_RKV); ld = 1536; c0 = pn * 256; }
            else if (pn < 10) { base = (bf16_t*)(ws + OFF_XBC); ld = 1024; c0 = (pn - 6) * 256; }
            else if (pn < 12) { base = (bf16_t*)(ws + OFF_Y3) + (size_t)T * 512; ld = 512; c0 = (pn - 10) * 256; }
            else if (pn == 12) { base = (bf16_t*)(ws + OFF_GQ); ld = 256; c0 = 0; }
            else if (pn == 13) { base = (bf16_t*)(ws + OFF_GK); ld = 256; c0 = 0; }
            else if (pn < 16) { base = (bf16_t*)(ws + OFF_Y3) + (size_t)2 * T * 512; ld = 512; c0 = (pn - 14) * 256; }
        } else if (MODE == 1) {
            if (pn < 2) { base = (bf16_t*)(ws + OFF_Y3); ld = 512; c0 = pn * 256; }
            else if (pn < 4) { base = (bf16_t*)(ws + OFF_Y3) + (size_t)2 * T * 512; ld = 512; c0 = (pn - 2) * 256; }
            else { base = (bf16_t*)(ws + OFF_GATES); ld = 3072; c0 = (pn - 4) * 256; }
        } else if (MODE == 2) { base = (bf16_t*)(ws + OFF_H); ld = 1024; c0 = (pn & 3) * 256; }
#pragma unroll
        for (int ai = 0; ai < 2; ++ai)
#pragma unroll
            for (int m = 0; m < 4; ++m) {
                const int row = u.pm * 256 + ai * 128 + wr * 64 + m * 16 + fr;
#pragma unroll
                for (int bj = 0; bj < 2; ++bj) {
                    const int cl = bj * 128 + wc * 32 + 8 * fq;
                    f32x4 v0 = acc[ai][bj][m][0], v1 = acc[ai][bj][m][1];
                    if (MODE == 0) {
                        if (pn < 16) {
                            u32x4 w; w.x = pg8::cvt_pk_bf16(v0[0], v0[1]); w.y = pg8::cvt_pk_bf16(v0[2], v0[3]); w.z = pg8::cvt_pk_bf16(v1[0], v1[1]); w.w = pg8::cvt_pk_bf16(v1[2], v1[3]);
                            *(u32x4*)(base + (size_t)row * ld + c0 + cl) = w;
                        } else if (cl < 160) {
                            float* d = (float*)(ws + OFF_SMALL) + (size_t)row * 160 + cl;
                            *(f32x4*)d = v0; *(f32x4*)(d + 4) = v1;
                        }
                    } else if (MODE == 1) {
                        bf16_t* d = base + (size_t)row * ld + c0 + cl;
                        if (pn < 4) {
                            const u32x4 o = *(const u32x4*)d;
                            u32x4 w;
                            w.x = pg8::cvt_pk_bf16(lo_bf(o.x) * siluf_(v0[0]), hi_bf(o.x) * siluf_(v0[1]));
                            w.y = pg8::cvt_pk_bf16(lo_bf(o.y) * siluf_(v0[2]), hi_bf(o.y) * siluf_(v0[3]));
                            w.z = pg8::cvt_pk_bf16(lo_bf(o.z) * siluf_(v1[0]), hi_bf(o.z) * siluf_(v1[1]));
                            w.w = pg8::cvt_pk_bf16(lo_bf(o.w) * siluf_(v1[2]), hi_bf(o.w) * siluf_(v1[3]));
                            *(u32x4*)d = w;
                        } else {
                            u32x4 w;
                            w.x = pg8::cvt_pk_bf16(sigmoidf_(v0[0]), sigmoidf_(v0[1])); w.y = pg8::cvt_pk_bf16(sigmoidf_(v0[2]), sigmoidf_(v0[3]));
                            w.z = pg8::cvt_pk_bf16(sigmoidf_(v1[0]), sigmoidf_(v1[1])); w.w = pg8::cvt_pk_bf16(sigmoidf_(v1[2]), sigmoidf_(v1[3]));
                            *(u32x4*)d = w;
                        }
                    } else if (MODE == 2) {
                        bf16_t* d = base + (size_t)row * ld + c0 + cl;
                        const u32x4 o = *(const u32x4*)((const bf16_t*)(ws + OFF_GATES) + (size_t)row * 3072 + pn * 256 + cl);
                        f32x4 m0 = (f32x4){0.f, 0.f, 0.f, 0.f}, m1 = m0;
                        if (pn >= 4) { const u32x4 pm_ = *(const u32x4*)d; m0 = (f32x4){lo_bf(pm_.x), hi_bf(pm_.x), lo_bf(pm_.y), hi_bf(pm_.y)}; m1 = (f32x4){lo_bf(pm_.z), hi_bf(pm_.z), lo_bf(pm_.w), hi_bf(pm_.w)}; }
                        u32x4 w;
                        w.x = pg8::cvt_pk_bf16(m0[0] + lo_bf(o.x) * v0[0], m0[1] + hi_bf(o.x) * v0[1]); w.y = pg8::cvt_pk_bf16(m0[2] + lo_bf(o.y) * v0[2], m0[3] + hi_bf(o.y) * v0[3]);
                        w.z = pg8::cvt_pk_bf16(m1[0] + lo_bf(o.z) * v1[0], m1[1] + hi_bf(o.z) * v1[1]); w.w = pg8::cvt_pk_bf16(m1[2] + lo_bf(o.w) * v1[2], m1[3] + hi_bf(o.w) * v1[3]);
                        *(u32x4*)d = w;
                    } else {
                        const int col = pn * 256 + cl; const int b = row >> 13;
                        const f32x4 x0 = *(const f32x4*)(xin + (size_t)row * 1024 + col), x1 = *(const f32x4*)(xin + (size_t)row * 1024 + col + 4);
                        const f32x4 g0 = *(const f32x4*)(gate + b * 3072 + 2048 + col), g1 = *(const f32x4*)(gate + b * 3072 + 2048 + col + 4);
                        f32x4 r0, r1;
#pragma unroll
                        for (int j = 0; j < 4; ++j) { r0[j] = ALPHA_DN * x0[j] + (1.f + g0[j]) * v0[j]; r1[j] = ALPHA_DN * x1[j] + (1.f + g1[j]) * v1[j]; }
                        *(f32x4*)(out + (size_t)row * 1024 + col) = r0; *(f32x4*)(out + (size_t)row * 1024 + col + 4) = r1;
                    }
                }
            }
    }
};

__device__ __forceinline__ int wt1_src(int n) {
    if (n < 1536) return n;
    if (n < 2560) return 2176 + (n - 1536);
    if (n < 3072) return 3208 + (n - 2560);
    if (n < 3328) return 3720 + (n - 3072);
    if (n < 3584) return 3976 + (n - 3328);
    if (n < 4096) return 4232 + (n - 3584);
    if (n < 4352) { const int s = n - 4096; if (s < 128) return 1536 + s; if (s < 136) return 3200 + (s - 128); if (s < 152) return 4744 + (s - 136); return -1; }
    const int m = n - 4352;
    if (m < 512) return 1664 + m;
    if (m < 1024) return 4760 + (m - 512);
    return 5272 + (m - 1024);
}
template <bool MAP>
__device__ __forceinline__ void transpose_item(const float* W, int ldw, bf16_t* WT, int ldt, int row_off, int col_off, int nblk, LAS float* scr, int item, int lane) {
    const int kb = item / nblk, nb = item % nblk, k0 = 64 * kb, n0 = 32 * nb;
    int sc = n0 + (lane & 31); if (MAP) sc = wt1_src(sc);
#pragma unroll 8
    for (int i = 0; i < 32; ++i) { const int kk = 2 * i + (lane >> 5); scr[kk * 33 + (lane & 31)] = sc >= 0 ? W[(size_t)(k0 + kk) * ldw + sc] : 0.f; }
    WAVE_LDS_SYNC();
    const int c = lane & 7;
#pragma unroll
    for (int j = 0; j < 4; ++j) { const int n = (lane >> 3) + 8 * j; const LAS float* s = scr + (8 * c) * 33 + n;
        u32x4 o; o.x = pk2(s[0 * 33], s[1 * 33]); o.y = pk2(s[2 * 33], s[3 * 33]); o.z = pk2(s[4 * 33], s[5 * 33]); o.w = pk2(s[6 * 33], s[7 * 33]);
        *(u32x4*)(WT + (size_t)(row_off + n0 + n) * ldt + col_off + k0 + 8 * c) = o; }
    WAVE_LDS_SYNC();
}
__device__ void wprep(const Params& p, int l, LAS unsigned char* lds, int TIDX, int BIDX) {
    const int lane = TIDX & 63, wave = TIDX >> 6;
    LAS float* scr = (LAS float*)(lds + wave * 16384);
    const int gw = BIDX * 8 + wave, NGW = gridDim.x * 8;
    constexpr int I1 = (1024 / 64) * (8448 / 32), I2 = 3 * (512 / 64) * (1024 / 32), I3 = (1024 / 64) * (1024 / 32);
    bf16_t* WT1 = (bf16_t*)(p.ws + OFF_WT1); bf16_t* WT2 = (bf16_t*)(p.ws + OFF_WT2); bf16_t* WT3 = (bf16_t*)(p.ws + OFF_WT3);
    for (int it = gw; it < I1 + I2 + I3; it += NGW) {
        int r = it;
        if (r < I1) { transpose_item<true>(p.in[I_WIN] + (size_t)l * 1024 * INW, INW, WT1, 1024, 0, 0, 8448 / 32, scr, r, lane); continue; }
        r -= I1;
        if (r < I2) { const int b = r / (I2 / 3), rr = r % (I2 / 3); transpose_item<false>(p.in[I_WBR] + ((size_t)l * 3 + b) * 512 * 1024, 1024, WT2, 512, b * 1024, 0, 1024 / 32, scr, rr, lane); continue; }
        r -= I2;
        transpose_item<false>(p.in[I_WOUT] + (size_t)l * 1024 * 1024, 1024, WT3, 1024, 0, 0, 1024 / 32, scr, r, lane);
    }
}
__device__ void ada_phase(const Params& p, LAS unsigned char* lds, int TIDX, int BIDX) {
    LAS float* red = (LAS float*)lds;
    const int tid = TIDX, kg = tid >> 5, cj = tid & 31;
    float* mod = (float*)(p.ws + OFF_MOD);
    for (int it = BIDX; it < 2 * 96; it += gridDim.x) {
        const int l = it / 96, col = (it % 96) * 32 + cj;
        const float* W = p.in[I_ADAW] + (size_t)l * 1024 * 3072;
        float a0 = 0.f, a1 = 0.f, a2 = 0.f, a3 = 0.f;
        for (int k = kg * 64; k < kg * 64 + 64; ++k) {
            const float w = W[(size_t)k * 3072 + col];
            a0 += siluf_(p.in[I_C][k]) * w; a1 += siluf_(p.in[I_C][1024 + k]) * w; a2 += siluf_(p.in[I_C][2048 + k]) * w; a3 += siluf_(p.in[I_C][3072 + k]) * w;
        }
        red[(kg * 32 + cj) * 4 + 0] = a0; red[(kg * 32 + cj) * 4 + 1] = a1; red[(kg * 32 + cj) * 4 + 2] = a2; red[(kg * 32 + cj) * 4 + 3] = a3;
        __syncthreads();
        if (tid < 128) { const int c2 = tid >> 2, b = tid & 3; float s = 0.f;
            for (int g = 0; g < 16; ++g) s += red[(g * 32 + c2) * 4 + b];
            const int cc = (it % 96) * 32 + c2;
            mod[((size_t)l * 4 + b) * 3072 + cc] = s + p.in[I_ADAB][(size_t)l * 3072 + cc]; }
        __syncthreads();
    }
}
__device__ __forceinline__ void ln_stats(const f32x4 (&v)[4], float& mean, float& rstd, float eps) {
    float s = 0.f;
#pragma unroll
    for (int j = 0; j < 4; ++j) s += (v[j][0] + v[j][1]) + (v[j][2] + v[j][3]);
    mean = wave_sum(s) * (1.f / 1024.f); float s2 = 0.f;
#pragma unroll
    for (int j = 0; j < 4; ++j) { const f32x4 d = v[j] - mean; s2 += (d[0] * d[0] + d[1] * d[1]) + (d[2] * d[2] + d[3] * d[3]); }
    rstd = rsqrtf(wave_sum(s2) * (1.f / 1024.f) + eps);
}
__device__ __forceinline__ void mod_row_to_h(const Params& p, const f32x4 (&v)[4], int row, int l, int lane) {
    float mean, rstd; ln_stats(v, mean, rstd, 1e-5f);
    const float* mod = (const float*)(p.ws + OFF_MOD) + ((size_t)l * 4 + (row >> 13)) * 3072;
    bf16_t* H = (bf16_t*)(p.ws + OFF_H) + (size_t)row * 1024;
#pragma unroll
    for (int j = 0; j < 4; ++j) { const int c = 256 * j + 4 * lane;
        const f32x4 sh = *(const f32x4*)(mod + c), sc = *(const f32x4*)(mod + 1024 + c);
        f32x4 h;
#pragma unroll
        for (int e = 0; e < 4; ++e) h[e] = (v[j][e] - mean) * rstd * (1.f + sc[e]) + sh[e];
        u32x2 o; o.x = pk2(h[0], h[1]); o.y = pk2(h[2], h[3]);
        *(u32x2*)(H + c) = o; }
}
__device__ void ln1_phase(const Params& p, int l, const float* xin, int TIDX, int BIDX) {
    const int lane = TIDX & 63, gw = BIDX * 8 + (TIDX >> 6), NGW = gridDim.x * 8;
    for (int row = gw; row < T; row += NGW) {
        f32x4 v[4];
#pragma unroll
        for (int j = 0; j < 4; ++j) v[j] = *(const f32x4*)(xin + (size_t)row * 1024 + 256 * j + 4 * lane);
        mod_row_to_h(p, v, row, l, lane);
    }
}
__device__ void lnpost_phase(const Params& p, int l, int TIDX, int BIDX) {
    const int lane = TIDX & 63, gw = BIDX * 8 + (TIDX >> 6), NGW = gridDim.x * 8;
    const float* pg = p.in[I_PG] + l * 1024; const float* pb = p.in[I_PB] + l * 1024;
    for (int row = gw; row < T; row += NGW) {
        f32x4 v[4];
#pragma unroll
        for (int j = 0; j < 4; ++j) v[j] = *(const f32x4*)(p.out + (size_t)row * 1024 + 256 * j + 4 * lane);
        float mean, rstd; ln_stats(v, mean, rstd, 1e-5f);
#pragma unroll
        for (int j = 0; j < 4; ++j) { const int c = 256 * j + 4 * lane; const f32x4 g = *(const f32x4*)(pg + c), b = *(const f32x4*)(pb + c);
#pragma unroll
            for (int e = 0; e < 4; ++e) v[j][e] = (v[j][e] - mean) * rstd * g[e] + b[e];
            *(f32x4*)(p.out + (size_t)row * 1024 + c) = v[j]; }
        if (l == 0) mod_row_to_h(p, v, row, 1, lane);
    }
}

__device__ __forceinline__ void conv_unpack(const u32x4 w, float (&x)[8]) {
#pragma unroll
    for (int q = 0; q < 4; ++q) { x[2 * q] = lo_bf(w[q]); x[2 * q + 1] = hi_bf(w[q]); }
}
__device__ void rwkv_prep_phase(const Params& p, int l, LAS unsigned char* lds, int TIDX, int BIDX, const XcdBarrier& xb) {
    {
        bf16_t* XBC = (bf16_t*)(p.ws + OFF_XBC);
        const int cgp = TIDX & 127, qt = TIDX >> 7; const int q0 = BIDX * 128 + qt * 32; const int c8 = cgp * 8;
        float h1[8], h2[8], h3[8];
        if ((q0 & (SEQ - 1)) != 0) { conv_unpack(*(const u32x4*)(XBC + (size_t)(q0 - 1) * 1024 + c8), h1); conv_unpack(*(const u32x4*)(XBC + (size_t)(q0 - 2) * 1024 + c8), h2); conv_unpack(*(const u32x4*)(XBC + (size_t)(q0 - 3) * 1024 + c8), h3); }
        else {
#pragma unroll
            for (int e = 0; e < 8; ++e) h1[e] = h2[e] = h3[e] = 0.f; }
        xcd_barrier(xb);
        float cw0[8], cw1[8], cw2[8], cw3[8], cb[8];
#pragma unroll
        for (int e = 0; e < 8; ++e) { cw0[e] = p.in[I_CONVW][((size_t)l * 4 + 0) * 1024 + c8 + e]; cw1[e] = p.in[I_CONVW][((size_t)l * 4 + 1) * 1024 + c8 + e];
            cw2[e] = p.in[I_CONVW][((size_t)l * 4 + 2) * 1024 + c8 + e]; cw3[e] = p.in[I_CONVW][((size_t)l * 4 + 3) * 1024 + c8 + e]; cb[e] = p.in[I_CONVB][l * 1024 + c8 + e]; }
#pragma unroll 4
        for (int i = 0; i < 32; ++i) {
            bf16_t* ptr = XBC + (size_t)(q0 + i) * 1024 + c8;
            float x0[8]; conv_unpack(*(const u32x4*)ptr, x0);
            float y[8];
#pragma unroll
            for (int e = 0; e < 8; ++e) { y[e] = siluf_(cw0[e] * h3[e] + cw1[e] * h2[e] + cw2[e] * h1[e] + cw3[e] * x0[e] + cb[e]); h3[e] = h2[e]; h2[e] = h1[e]; h1[e] = x0[e]; }
            u32x4 w; w.x = pk2(y[0], y[1]); w.y = pk2(y[2], y[3]); w.z = pk2(y[4], y[5]); w.w = pk2(y[6], y[7]);
            *(u32x4*)ptr = w;
        }
    }
    LAS float* s = (LAS float*)lds;
    const int c = TIDX;
    float wu[64], au[64];
#pragma unroll
    for (int j = 0; j < 64; ++j) { wu[j] = p.in[I_WUP][((size_t)l * 64 + j) * 512 + c]; au[j] = p.in[I_AUP][((size_t)l * 64 + j) * 512 + c]; }
    const float w0 = p.in[I_W0][l * 512 + c], a0 = p.in[I_A0][l * 512 + c];
    const float* SM = (const float*)(p.ws + OFF_SMALL);
    const float* mu = p.in[I_MU] + l * 1664 + 1536;
    bf16_t* A = (bf16_t*)(p.ws + OFF_A); float* DEC = (float*)(p.ws + OFF_DEC);
    const int tpb = T / gridDim.x;
    for (int t0 = BIDX * tpb; t0 < (BIDX + 1) * tpb; t0 += 4) {
        { const int tt = c >> 7, j = c & 127; const int row = t0 + tt;
          const float cur = SM[(size_t)row * 160 + j]; const float prev = (row & (SEQ - 1)) ? SM[(size_t)(row - 1) * 160 + j] : 0.f;
          const float v = cur + mu[j] * (prev - cur);
          s[tt * 128 + j] = j < 64 ? tanhf(v) : v; }
        __syncthreads();
#pragma unroll
        for (int tt = 0; tt < 4; ++tt) {
            float w = w0, a = a0;
#pragma unroll
            for (int j = 0; j < 64; ++j) { w += s[tt * 128 + j] * wu[j]; a += s[tt * 128 + 64 + j] * au[j]; }
            const size_t o = (size_t)(t0 + tt) * 512 + c;
            A[o] = f2bf(sigmoidf_(a)); DEC[o] = __expf(-0.6065306597126334f * sigmoidf_(w));
        }
        __syncthreads();
    }
}

typedef float f32x2 __attribute__((ext_vector_type(2)));
template <int CTRL> __device__ __forceinline__ float dpp_f(float x) { return __builtin_bit_cast(float, __builtin_amdgcn_update_dpp(0, __builtin_bit_cast(int, x), CTRL, 0xF, 0xF, true)); }
__device__ __forceinline__ float row16_sum(float x) { x += dpp_f<0xB1>(x); x += dpp_f<0x4E>(x); x += dpp_f<0x141>(x); x += dpp_f<0x140>(x); return x; }
constexpr int RW_TC = 32, RW_VEC_B = RW_TC * 5 * 64 * 4, RW_V_B = RW_TC * 16 * 4, RW_BUF_B = RW_VEC_B + 2 * RW_V_B;
__device__ void rwkv_scan_fast(const Params& p, int l, int unit, LAS unsigned char* lds, int TIDX) {
    const int bh = unit >> 2, rq = unit & 3, b = bh >> 3, h = bh & 7, wave = TIDX >> 6, lane = TIDX & 63;
    const size_t r0 = (size_t)b * SEQ;
    bf16_t* Y = (bf16_t*)(p.ws + OFF_Y3);
    if (wave >= 4) {
        const int lw = wave - 4, sl = lane >> 3, c8 = (lane & 7) * 8, ch0 = h * 64 + c8;
        const bf16_t* RKV = (const bf16_t*)(p.ws + OFF_RKV); const bf16_t* A = (const bf16_t*)(p.ws + OFF_A); const float* DEC = (const float*)(p.ws + OFF_DEC);
        float mu_r[8], mu_k[8], mu_v[8], k_k[8], k_a[8];
#pragma unroll
        for (int e = 0; e < 8; ++e) { mu_r[e] = p.in[I_MU][l * 1664 + ch0 + e]; mu_k[e] = p.in[I_MU][l * 1664 + 512 + ch0 + e]; mu_v[e] = p.in[I_MU][l * 1664 + 1024 + ch0 + e];
            k_k[e] = p.in[I_KK][l * 512 + ch0 + e]; k_a[e] = p.in[I_KA][l * 512 + ch0 + e]; }
        u32x4 nR, nK, nV, nRp, nKp, nVp, nA; f32x4 nD0, nD1;
        auto issue = [&](int cc) {
            const size_t row = r0 + (size_t)cc * RW_TC + lw * 8 + sl;
            nR = *(const u32x4*)(RKV + row * 1536 + ch0); nK = *(const u32x4*)(RKV + row * 1536 + 512 + ch0); nV = *(const u32x4*)(RKV + row * 1536 + 1024 + ch0);
            nA = *(const u32x4*)(A + row * 512 + ch0); nD0 = *(const f32x4*)(DEC + row * 512 + ch0); nD1 = *(const f32x4*)(DEC + row * 512 + ch0 + 4);
            const size_t prow = (row & (SEQ - 1)) != 0 ? row - 1 : row;
            nRp = *(const u32x4*)(RKV + prow * 1536 + ch0); nKp = *(const u32x4*)(RKV + prow * 1536 + 512 + ch0); nVp = *(const u32x4*)(RKV + prow * 1536 + 1024 + ch0);
        };
        issue(0);
        for (int c = -1; c < SEQ / RW_TC; ++c) {
            if (c >= 1) { LAS const float* yb = (LAS const float*)(lds + ((c - 1) & 1) * RW_BUF_B + RW_VEC_B + RW_V_B);
                const int idx = (lw * 64 + lane) * 2, s = idx >> 4, i = idx & 15;
                *(unsigned*)(Y + (r0 + (size_t)(c - 1) * RW_TC + s) * 512 + h * 64 + rq * 16 + i) = pk2(yb[idx], yb[idx + 1]); }
            if (c + 1 < SEQ / RW_TC) {
                const u32x4 cR = nR, cK = nK, cV = nV, cRp = nRp, cKp = nKp, cVp = nVp, cA = nA; const f32x4 cD0 = nD0, cD1 = nD1;
                if (c + 2 < SEQ / RW_TC) issue(c + 2);
                LAS float* vec = (LAS float*)(lds + ((c + 1) & 1) * RW_BUF_B); LAS float* vb = (LAS float*)(lds + ((c + 1) & 1) * RW_BUF_B + RW_VEC_B);
                const int s = lw * 8 + sl;
                float cr[8], ck[8], cv[8], pr[8], pk[8], pv[8], ca[8];
                conv_unpack(cR, cr); conv_unpack(cK, ck); conv_unpack(cV, cv); conv_unpack(cRp, pr); conv_unpack(cKp, pk); conv_unpack(cVp, pv); conv_unpack(cA, ca);
                if ((((c + 1) * RW_TC + s) & (SEQ - 1)) == 0) {
#pragma unroll
                    for (int e = 0; e < 8; ++e) pr[e] = pk[e] = pv[e] = 0.f; }
                float rr[8], kk[8], vv[8], kkj[8]; float n2 = 0.f;
#pragma unroll
                for (int e = 0; e < 8; ++e) { rr[e] = cr[e] + mu_r[e] * (pr[e] - cr[e]); kk[e] = ck[e] + mu_k[e] * (pk[e] - ck[e]); vv[e] = cv[e] + mu_v[e] * (pv[e] - cv[e]);
                    kkj[e] = kk[e] * k_k[e]; n2 += kkj[e] * kkj[e]; }
                n2 += dpp_f<0xB1>(n2); n2 += dpp_f<0x4E>(n2); n2 += dpp_f<0x141>(n2);
                const float inv = 1.f / fmaxf(sqrtf(n2), 1e-12f);
                f32x4 o0, o1;
                LAS float* d = vec + s * 320 + c8;
                *(LAS f32x4*)(d) = cD0; *(LAS f32x4*)(d + 4) = cD1;
#pragma unroll
                for (int e = 0; e < 4; ++e) { o0[e] = kkj[e] * inv; o1[e] = kkj[4 + e] * inv; }
                *(LAS f32x4*)(d + 64) = o0; *(LAS f32x4*)(d + 68) = o1;
#pragma unroll
                for (int e = 0; e < 4; ++e) { o0[e] *= ca[e]; o1[e] *= ca[4 + e]; }
                *(LAS f32x4*)(d + 128) = o0; *(LAS f32x4*)(d + 132) = o1;
#pragma unroll
                for (int e = 0; e < 4; ++e) { o0[e] = kk[e] * (1.f + (ca[e] - 1.f) * k_a[e]); o1[e] = kk[4 + e] * (1.f + (ca[4 + e] - 1.f) * k_a[4 + e]); }
                *(LAS f32x4*)(d + 192) = o0; *(LAS f32x4*)(d + 196) = o1;
#pragma unroll
                for (int e = 0; e < 4; ++e) { o0[e] = rr[e]; o1[e] = rr[4 + e]; }
                *(LAS f32x4*)(d + 256) = o0; *(LAS f32x4*)(d + 260) = o1;
                if ((c8 >> 4) == rq) {
#pragma unroll
                    for (int e = 0; e < 4; ++e) { o0[e] = vv[e]; o1[e] = vv[4 + e]; }
                    *(LAS f32x4*)(vb + s * 16 + (c8 & 15)) = o0; *(LAS f32x4*)(vb + s * 16 + (c8 & 15) + 4) = o1; }
            }
            __syncthreads();
        }
        { constexpr int c = SEQ / RW_TC; LAS const float* yb = (LAS const float*)(lds + ((c - 1) & 1) * RW_BUF_B + RW_VEC_B + RW_V_B);
          const int idx = (lw * 64 + lane) * 2, s = idx >> 4, i = idx & 15;
          *(unsigned*)(Y + (r0 + (size_t)(c - 1) * RW_TC + s) * 512 + h * 64 + rq * 16 + i) = pk2(yb[idx], yb[idx + 1]); }
    } else {
        const int rl = wave * 4 + (lane >> 4), cq = lane & 15;
        f32x2 S0 = (f32x2){0.f, 0.f}, S1 = (f32x2){0.f, 0.f};
        __syncthreads();
        for (int c = 0; c < SEQ / RW_TC; ++c) {
            LAS const unsigned char* buf = lds + (c & 1) * RW_BUF_B;
            LAS const float* vb = (LAS const float*)(buf + RW_VEC_B); LAS float* yb = (LAS float*)(buf + RW_VEC_B + RW_V_B);
            LAS const f32x4* q = (LAS const f32x4*)buf + cq;
            f32x4 w4 = q[0], k4 = q[16], b4 = q[32], t4 = q[48], r4 = q[64]; float v = vb[rl];
            float ykeep = 0.f;
#pragma unroll
            for (int s = 0; s < RW_TC; ++s) {
                f32x4 nw = w4, nk = k4, nb = b4, nt = t4, nr = r4; float nv = v;
                if (s + 1 < RW_TC) { LAS const f32x4* qn = q + (s + 1) * 80; nw = qn[0]; nk = qn[16]; nb = qn[32]; nt = qn[48]; nr = qn[64]; nv = vb[(s + 1) * 16 + rl]; }
                f32x2 sp = S0 * (f32x2){k4[0], k4[1]} + S1 * (f32x2){k4[2], k4[3]};
                const float sa = -row16_sum(sp[0] + sp[1]);
                S0 = S0 * (f32x2){w4[0], w4[1]} + (f32x2){b4[0], b4[1]} * sa + (f32x2){t4[0], t4[1]} * v;
                S1 = S1 * (f32x2){w4[2], w4[3]} + (f32x2){b4[2], b4[3]} * sa + (f32x2){t4[2], t4[3]} * v;
                f32x2 yp = S0 * (f32x2){r4[0], r4[1]} + S1 * (f32x2){r4[2], r4[3]};
                const float y = row16_sum(yp[0] + yp[1]);
                ykeep = ((s & 15) == cq) ? y : ykeep;
                if ((s & 15) == 15) yb[((s & ~15) + cq) * 16 + rl] = ykeep;
                w4 = nw; k4 = nk; b4 = nb; t4 = nt; r4 = nr; v = nv;
            }
            __syncthreads();
        }
    }
}

__device__ __forceinline__ int tm_shift(int t) { return ((t >> 3) & 3) * 16; }
template <int K, int AM, int BMODE>
__device__ __forceinline__ f32x4 mma_t(LAS const bf16_t* A, int lda, int arow0, LAS const bf16_t* B, int ldb, int brow0, f32x4 acc, int lane) {
    const int r = lane & 15, kg = lane >> 4;
#pragma unroll
    for (int k0 = 0; k0 < K; k0 += 32) {
        bf16x8 a, b;
        if (AM == 0) a = *(LAS const bf16x8*)(A + (arow0 + r) * lda + k0 + kg * 8);
        else if (AM == 2) a = *(LAS const bf16x8*)(A + (arow0 + r) * lda + tm_shift(arow0 + r) + k0 + kg * 8);
        else { LAS const bf16_t* q = A + (k0 + kg * 8) * lda + tm_shift(k0 + kg * 8) + arow0 + r;
#pragma unroll
            for (int j = 0; j < 8; ++j) a[j] = (short)q[j * lda]; }
        if (BMODE == 0) b = *(LAS const bf16x8*)(B + (brow0 + r) * ldb + k0 + kg * 8);
        else if (BMODE == 2) b = *(LAS const bf16x8*)(B + (brow0 + r) * ldb + tm_shift(brow0 + r) + k0 + kg * 8);
        else { LAS const bf16_t* q = B + (k0 + kg * 8) * ldb + tm_shift(k0 + kg * 8) + brow0 + r;
#pragma unroll
            for (int j = 0; j < 8; ++j) b[j] = (short)q[j * ldb]; }
        acc = __builtin_amdgcn_mfma_f32_16x16x32_bf16(a, b, acc, 0, 0, 0);
    }
    return acc;
}
__device__ void mamba2_chunk(const Params& p, int l, int bh, LAS unsigned char* lds, int TIDX) {
    const int b = bh >> 3, h = bh & 7, g = h >> 2, tid = TIDX, wave = tid >> 6, lane = tid & 63, r = lane & 15, kg = lane >> 4;
    LAS bf16_t* CB = (LAS bf16_t*)lds;
    LAS bf16_t* BB = (LAS bf16_t*)(lds + 17408);
    LAS bf16_t* AY = (LAS bf16_t*)(lds + 41984);
    LAS bf16_t* SB = (LAS bf16_t*)(lds + 67584);
    LAS bf16_t* XD = (LAS bf16_t*)(lds + 84992);
    LAS bf16_t* XE = (LAS bf16_t*)(lds + 101376);
    LAS bf16_t* XS = (LAS bf16_t*)(lds + 117760);
    LAS float* F = (LAS float*)(lds + 126976);
    const bf16_t* XBC = (const bf16_t*)(p.ws + OFF_XBC); const float* SM = (const float*)(p.ws + OFF_SMALL);
    bf16_t* Z = (bf16_t*)(p.ws + OFF_Y3) + (size_t)T * 512;
    const float dtb = p.in[I_DTB][l * 8 + h], ah = -__expf(p.in[I_ALOG][l * 8 + h]), dsk = p.in[I_DSKIP][l * 8 + h];
    const size_t rbase = (size_t)b * SEQ;
    f32x4 sacc[4];
#pragma unroll
    for (int i = 0; i < 4; ++i) sacc[i] = (f32x4){0.f, 0.f, 0.f, 0.f};
    for (int i = tid; i < 64 * 128; i += 512) SB[(i >> 7) * 136 + (i & 127)] = 0;
    u32x4 rc[2], rb[2], rx; float rdt = 0.f;
    auto prefetch = [&](int c) {
        const size_t row0 = rbase + (size_t)c * 64;
#pragma unroll
        for (int i = 0; i < 2; ++i) { const int item = tid + 512 * i, ll = item >> 4, ng = item & 15;
            rc[i] = *(const u32x4*)(XBC + (row0 + ll) * 1024 + 768 + g * 128 + ng * 8); rb[i] = *(const u32x4*)(XBC + (row0 + ll) * 1024 + 512 + g * 128 + ng * 8); }
        rx = *(const u32x4*)(XBC + (row0 + (tid >> 3)) * 1024 + h * 64 + (tid & 7) * 8);
        if (tid < 64) rdt = SM[(row0 + tid) * 160 + 128 + h];
    };
    prefetch(0);
    for (int c = 0; c < SEQ / 64; ++c) {
        const size_t row0 = rbase + (size_t)c * 64;
        if (tid < 64) { const float dt = softplusf_(rdt + dtb); float x = dt * ah;
#pragma unroll
            for (int o = 1; o < 64; o <<= 1) { const float y = __shfl_up(x, o); if (lane >= o) x += y; }
            F[tid] = x; F[64 + tid] = dt; }
        __syncthreads();
        const float acs_last = F[63];
#pragma unroll
        for (int i = 0; i < 2; ++i) { const int item = tid + 512 * i, ll = item >> 4, ng = item & 15;
            *(LAS u32x4*)(CB + ll * 136 + ng * 8) = rc[i]; *(LAS u32x4*)(BB + ll * 192 + tm_shift(ll) + ng * 8) = rb[i];
            const float ea = __expf(F[ll]); float cv[8]; conv_unpack(rc[i], cv);
            u32x4 w; w.x = pk2(cv[0] * ea, cv[1] * ea); w.y = pk2(cv[2] * ea, cv[3] * ea); w.z = pk2(cv[4] * ea, cv[5] * ea); w.w = pk2(cv[6] * ea, cv[7] * ea);
            *(LAS u32x4*)(AY + ll * 200 + 64 + ng * 8) = w; }
        { const int ll = tid >> 3, pg = tid & 7; float xv[8]; conv_unpack(rx, xv); const float dtl = F[64 + ll], ee = __expf(acs_last - F[ll]);
          float xd[8];
#pragma unroll
          for (int e = 0; e < 8; ++e) xd[e] = xv[e] * dtl;
          u32x4 w; w.x = pk2(xd[0], xd[1]); w.y = pk2(xd[2], xd[3]); w.z = pk2(xd[4], xd[5]); w.w = pk2(xd[6], xd[7]);
          *(LAS u32x4*)(XD + ll * 128 + tm_shift(ll) + pg * 8) = w;
          w.x = pk2(xd[0] * ee, xd[1] * ee); w.y = pk2(xd[2] * ee, xd[3] * ee); w.z = pk2(xd[4] * ee, xd[5] * ee); w.w = pk2(xd[6] * ee, xd[7] * ee);
          *(LAS u32x4*)(XE + ll * 128 + tm_shift(ll) + pg * 8) = w;
          *(LAS u32x4*)(XS + ll * 72 + pg * 8) = rx; }
        __syncthreads();
        if (c + 1 < SEQ / 64) prefetch(c + 1);
        bf16_t zpre[2][4];
#pragma unroll
        for (int q = 0; q < 2; ++q) { const int tt = wave + 8 * q, tl = tt >> 2, tp = tt & 3;
#pragma unroll
            for (int j = 0; j < 4; ++j) zpre[q][j] = Z[(row0 + tl * 16 + kg * 4 + j) * 512 + h * 64 + tp * 16 + r]; }
#pragma unroll
        for (int q = 0; q < 2; ++q) { const int tt = wave + 8 * q, tl = tt >> 2, ts = tt & 3;
            f32x4 acc = (f32x4){0.f, 0.f, 0.f, 0.f};
            if (ts <= tl) acc = mma_t<128, 0, 2>(CB, 136, tl * 16, BB, 192, ts * 16, acc, lane);
            const int sc = ts * 16 + r; const float as = F[sc];
#pragma unroll
            for (int j = 0; j < 4; ++j) { const int ll = tl * 16 + kg * 4 + j; const float v = (sc <= ll) ? acc[j] * __expf(F[ll] - as) : 0.f; AY[ll * 200 + sc] = f2bf(v); } }
        __syncthreads();
#pragma unroll
        for (int q = 0; q < 2; ++q) { const int tt = wave + 8 * q, tl = tt >> 2, tp = tt & 3;
            f32x4 acc = (f32x4){0.f, 0.f, 0.f, 0.f};
            acc = mma_t<64, 0, 1>(AY, 200, tl * 16, XD, 128, tp * 16, acc, lane);
            acc = mma_t<128, 0, 0>(AY + 64, 200, tl * 16, SB, 136, tp * 16, acc, lane);
            const int pp = tp * 16 + r;
#pragma unroll
            for (int j = 0; j < 4; ++j) { const int ll = tl * 16 + kg * 4 + j; bf16_t* zp = Z + (row0 + ll) * 512 + h * 64 + pp;
                const float y = acc[j] + dsk * bf2f(XS[ll * 72 + pp]); *zp = f2bf(y * siluf_(bf2f(zpre[q][j]))); } }
        const float dl = __expf(acs_last);
#pragma unroll
        for (int i = 0; i < 4; ++i) { const int id = wave * 4 + i, tp = id >> 3, tn = id & 7;
            sacc[i] = sacc[i] * dl; sacc[i] = mma_t<64, 1, 1>(XE, 128, tp * 16, BB, 192, tn * 16, sacc[i], lane); }
        __syncthreads();
#pragma unroll
        for (int i = 0; i < 4; ++i) { const int id = wave * 4 + i, tp = id >> 3, tn = id & 7;
#pragma unroll
            for (int j = 0; j < 4; ++j) SB[(tp * 16 + kg * 4 + j) * 136 + tn * 16 + r] = f2bf(sacc[i][j]); }
    }
}
__device__ void gla_chunk(const Params& p, int l, int unit, LAS unsigned char* lds, int TIDX) {
    const int bh = unit >> 1, eh = unit & 1, b = bh >> 2, h = bh & 3, tid = TIDX, wave = tid >> 6, lane = tid & 63, r = lane & 15, kg = lane >> 4;
    LAS bf16_t* KG = (LAS bf16_t*)lds;
    LAS bf16_t* AY = (LAS bf16_t*)(lds + 9216);
    LAS bf16_t* SB = (LAS bf16_t*)(lds + 26624);
    LAS bf16_t* VV = (LAS bf16_t*)(lds + 35840);
    LAS bf16_t* KD = (LAS bf16_t*)(lds + 52224);
    LAS float* G = (LAS float*)(lds + 68608);
    LAS float* UP = (LAS float*)(lds + 85248);
    LAS float* GD = (LAS float*)(lds + 89344);
    LAS float* SEG = (LAS float*)(lds + 93440);
    const bf16_t* GQ = (const bf16_t*)(p.ws + OFF_GQ); const bf16_t* GK = (const bf16_t*)(p.ws + OFF_GK); const float* SM = (const float*)(p.ws + OFF_SMALL);
    bf16_t* GV = (bf16_t*)(p.ws + OFF_Y3) + (size_t)2 * T * 512;
    const size_t rbase = (size_t)b * SEQ;
    const int ll = tid >> 3, dg = tid & 7;
    for (int i = tid; i < 16 * 64; i += 512) UP[i] = p.in[I_GKUP][((size_t)l * 16 + (i >> 6)) * 256 + h * 64 + (i & 63)];
    float gkb[8];
#pragma unroll
    for (int e = 0; e < 8; ++e) gkb[e] = p.in[I_GKB][l * 256 + h * 64 + dg * 8 + e];
    f32x4 sacc[2];
    sacc[0] = sacc[1] = (f32x4){0.f, 0.f, 0.f, 0.f};
    for (int i = tid; i < 64 * 64; i += 512) SB[(i >> 6) * 72 + (i & 63)] = 0;
    u32x4 rq, rk, rv; f32x4 rg = (f32x4){0.f, 0.f, 0.f, 0.f};
    auto prefetch = [&](int c) {
        const size_t row0 = rbase + (size_t)c * 64;
        rq = *(const u32x4*)(GQ + (row0 + ll) * 256 + h * 64 + dg * 8); rk = *(const u32x4*)(GK + (row0 + ll) * 256 + h * 64 + dg * 8);
        rv = *(const u32x4*)(GV + (row0 + ll) * 512 + h * 128 + eh * 64 + dg * 8);
        if (tid < 256) rg = *(const f32x4*)(SM + (row0 + (tid >> 2)) * 160 + 136 + (tid & 3) * 4);
    };
    prefetch(0);
    for (int c = 0; c < SEQ / 64; ++c) {
        const size_t row0 = rbase + (size_t)c * 64;
        if (tid < 256) *(LAS f32x4*)(GD + (tid >> 2) * 16 + (tid & 3) * 4) = rg;
        __syncthreads();
        { float gp[8];
#pragma unroll
          for (int e = 0; e < 8; ++e) gp[e] = gkb[e];
#pragma unroll
          for (int q = 0; q < 16; ++q) { const float gd = GD[ll * 16 + q];
#pragma unroll
              for (int e = 0; e < 8; ++e) gp[e] += gd * UP[q * 64 + dg * 8 + e]; }
#pragma unroll
          for (int e = 0; e < 8; ++e) G[ll * 65 + dg * 8 + e] = (fminf(gp[e], 0.f) - __logf(1.f + __expf(-fabsf(gp[e])))) * (1.f / 16.f); }
        __syncthreads();
        { const int d = tid & 63, sg = tid >> 6; float gv[8]; float a = 0.f;
#pragma unroll
          for (int q = 0; q < 8; ++q) { a += G[(sg * 8 + q) * 65 + d]; gv[q] = a; }
          SEG[sg * 64 + d] = a;
          __syncthreads();
          float off = 0.f;
#pragma unroll
          for (int q = 0; q < 7; ++q) off += (q < sg) ? SEG[q * 64 + d] : 0.f;
#pragma unroll
          for (int q = 0; q < 8; ++q) G[(sg * 8 + q) * 65 + d] = gv[q] + off; }
        __syncthreads();
        { float qv[8], kv[8]; conv_unpack(rq, qv); conv_unpack(rk, kv);
          float qg[8], ki[8], kd[8];
#pragma unroll
          for (int e = 0; e < 8; ++e) { const int d = dg * 8 + e; const float gl = G[ll * 65 + d], glast = G[63 * 65 + d];
              qg[e] = qv[e] * 0.125f * __expf(gl); ki[e] = kv[e] * __expf(-gl); kd[e] = kv[e] * __expf(glast - gl); }
          u32x4 w; w.x = pk2(qg[0], qg[1]); w.y = pk2(qg[2], qg[3]); w.z = pk2(qg[4], qg[5]); w.w = pk2(qg[6], qg[7]);
          *(LAS u32x4*)(AY + ll * 136 + 64 + dg * 8) = w;
          w.x = pk2(ki[0], ki[1]); w.y = pk2(ki[2], ki[3]); w.z = pk2(ki[4], ki[5]); w.w = pk2(ki[6], ki[7]);
          *(LAS u32x4*)(KG + ll * 72 + dg * 8) = w;
          w.x = pk2(kd[0], kd[1]); w.y = pk2(kd[2], kd[3]); w.z = pk2(kd[4], kd[5]); w.w = pk2(kd[6], kd[7]);
          *(LAS u32x4*)(KD + ll * 128 + tm_shift(ll) + dg * 8) = w;
          *(LAS u32x4*)(VV + ll * 128 + tm_shift(ll) + dg * 8) = rv; }
        __syncthreads();
        if (c + 1 < SEQ / 64) prefetch(c + 1);
#pragma unroll
        for (int q = 0; q < 2; ++q) { const int tt = wave + 8 * q, tl = tt >> 2, ts = tt & 3;
            f32x4 acc = (f32x4){0.f, 0.f, 0.f, 0.f};
            if (ts <= tl) acc = mma_t<64, 0, 0>(AY + 64, 136, tl * 16, KG, 72, ts * 16, acc, lane);
            const int sc = ts * 16 + r;
#pragma unroll
            for (int j = 0; j < 4; ++j) { const int l2 = tl * 16 + kg * 4 + j; AY[l2 * 136 + sc] = f2bf((sc <= l2) ? acc[j] : 0.f); } }
        __syncthreads();
#pragma unroll
        for (int q = 0; q < 2; ++q) { const int tt = wave + 8 * q, tl = tt >> 2, te = tt & 3;
            f32x4 acc = (f32x4){0.f, 0.f, 0.f, 0.f};
            acc = mma_t<64, 0, 1>(AY, 136, tl * 16, VV, 128, te * 16, acc, lane);
            acc = mma_t<64, 0, 0>(AY + 64, 136, tl * 16, SB, 72, te * 16, acc, lane);
#pragma unroll
            for (int j = 0; j < 4; ++j) GV[(row0 + tl * 16 + kg * 4 + j) * 512 + h * 128 + eh * 64 + te * 16 + r] = f2bf(acc[j]); }
#pragma unroll
        for (int i = 0; i < 2; ++i) { const int id = wave * 2 + i, te = id >> 2, td = id & 3;
            const float dl = __expf(G[63 * 65 + td * 16 + r]);
            sacc[i] = sacc[i] * dl; sacc[i] = mma_t<64, 1, 1>(VV, 128, te * 16, KD, 128, td * 16, sacc[i], lane); }
        __syncthreads();
#pragma unroll
        for (int i = 0; i < 2; ++i) { const int id = wave * 2 + i, te = id >> 2, td = id & 3;
#pragma unroll
            for (int j = 0; j < 4; ++j) SB[(te * 16 + kg * 4 + j) * 72 + td * 16 + r] = f2bf(sacc[i][j]); }
    }
}
__device__ void scans_naive_phase(const Params& p, int l, LAS unsigned char* lds, int TIDX, int BIDX) {
    const int wave = TIDX >> 6;
    LAS float* wl = (LAS float*)(lds + wave * 4096);
    if (BIDX < 128) { rwkv_scan_fast(p, l, BIDX, lds, TIDX); return; }
    const int u = BIDX - 128;
    if (u < 32) mamba2_chunk(p, l, u, lds, TIDX);
    else if (u < 64) gla_chunk(p, l, u - 32, lds, TIDX);
}
__device__ void post_phase(const Params& p, int l, int TIDX, int BIDX) {
    const int lane = TIDX & 63, gw = BIDX * 8 + (TIDX >> 6), NGW = gridDim.x * 8;
    const bf16_t* RKV = (const bf16_t*)(p.ws + OFF_RKV); const bf16_t* A = (const bf16_t*)(p.ws + OFF_A);
    bf16_t* Y0 = (bf16_t*)(p.ws + OFF_Y3); bf16_t* Y1 = Y0 + (size_t)T * 512; bf16_t* Y2 = Y1 + (size_t)T * 512;
    const int c0 = lane * 8;
    float mur[8], muk[8], muv[8], kA[8], rk[8], lg[8], lb[8], nw1[8], nw2[8];
#pragma unroll
    for (int e = 0; e < 8; ++e) { const int c = c0 + e;
        mur[e] = p.in[I_MU][l * 1664 + c]; muk[e] = p.in[I_MU][l * 1664 + 512 + c]; muv[e] = p.in[I_MU][l * 1664 + 1024 + c];
        kA[e] = p.in[I_KA][l * 512 + c]; rk[e] = p.in[I_RK][l * 512 + c]; lg[e] = p.in[I_LNG][l * 512 + c]; lb[e] = p.in[I_LNB][l * 512 + c];
        nw1[e] = p.in[I_M2NW][l * 512 + c]; nw2[e] = p.in[I_GNW][l * 128 + (c & 127)]; }
    for (int row = gw; row < T; row += NGW) {
        const bool first = (row & (SEQ - 1)) == 0;
        float y[8], r[8], k[8], v[8], a[8];
        { const u32x4 yy = *(const u32x4*)(Y0 + (size_t)row * 512 + c0); const u32x4 aa = *(const u32x4*)(A + (size_t)row * 512 + c0);
          const u32x4 rr = *(const u32x4*)(RKV + (size_t)row * 1536 + c0), kk = *(const u32x4*)(RKV + (size_t)row * 1536 + 512 + c0), vv = *(const u32x4*)(RKV + (size_t)row * 1536 + 1024 + c0);
          u32x4 rp = (u32x4){0, 0, 0, 0}, kp = rp, vp = rp;
          if (!first) { rp = *(const u32x4*)(RKV + (size_t)(row - 1) * 1536 + c0); kp = *(const u32x4*)(RKV + (size_t)(row - 1) * 1536 + 512 + c0); vp = *(const u32x4*)(RKV + (size_t)(row - 1) * 1536 + 1024 + c0); }
#pragma unroll
          for (int q = 0; q < 4; ++q) {
              y[2 * q] = lo_bf(yy[q]); y[2 * q + 1] = hi_bf(yy[q]); a[2 * q] = lo_bf(aa[q]); a[2 * q + 1] = hi_bf(aa[q]);
              float x0 = lo_bf(rr[q]), x1 = hi_bf(rr[q]); r[2 * q] = x0 + mur[2 * q] * (lo_bf(rp[q]) - x0); r[2 * q + 1] = x1 + mur[2 * q + 1] * (hi_bf(rp[q]) - x1);
              x0 = lo_bf(kk[q]); x1 = hi_bf(kk[q]); k[2 * q] = x0 + muk[2 * q] * (lo_bf(kp[q]) - x0); k[2 * q + 1] = x1 + muk[2 * q + 1] * (hi_bf(kp[q]) - x1);
              x0 = lo_bf(vv[q]); x1 = hi_bf(vv[q]); v[2 * q] = x0 + muv[2 * q] * (lo_bf(vp[q]) - x0); v[2 * q + 1] = x1 + muv[2 * q + 1] * (hi_bf(vp[q]) - x1); } }
        float s = 0.f, bs = 0.f;
#pragma unroll
        for (int e = 0; e < 8; ++e) { s += y[e]; bs += r[e] * (k[e] * (1.f + (a[e] - 1.f) * kA[e])) * rk[e]; }
        s += __shfl_xor(s, 1); s += __shfl_xor(s, 2); s += __shfl_xor(s, 4);
        bs += __shfl_xor(bs, 1); bs += __shfl_xor(bs, 2); bs += __shfl_xor(bs, 4);
        const float mean = s * (1.f / 64.f); float s2 = 0.f;
#pragma unroll
        for (int e = 0; e < 8; ++e) { const float d = y[e] - mean; s2 += d * d; }
        s2 += __shfl_xor(s2, 1); s2 += __shfl_xor(s2, 2); s2 += __shfl_xor(s2, 4);
        const float rstd = rsqrtf(s2 * (1.f / 64.f) + 64e-5f);
        { float o[8];
#pragma unroll
          for (int e = 0; e < 8; ++e) o[e] = (y[e] - mean) * rstd * lg[e] + lb[e] + bs * v[e];
          u32x4 w; w.x = pk2(o[0], o[1]); w.y = pk2(o[2], o[3]); w.z = pk2(o[4], o[5]); w.w = pk2(o[6], o[7]);
          *(u32x4*)(Y0 + (size_t)row * 512 + c0) = w; }
        { const u32x4 yy = *(const u32x4*)(Y1 + (size_t)row * 512 + c0); float q2 = 0.f;
#pragma unroll
          for (int q = 0; q < 4; ++q) { y[2 * q] = lo_bf(yy[q]); y[2 * q + 1] = hi_bf(yy[q]); q2 += y[2 * q] * y[2 * q] + y[2 * q + 1] * y[2 * q + 1]; }
          q2 += __shfl_xor(q2, 1); q2 += __shfl_xor(q2, 2); q2 += __shfl_xor(q2, 4); q2 += __shfl_xor(q2, 8); q2 += __shfl_xor(q2, 16);
          const float rs = rsqrtf(q2 * (1.f / 256.f) + 1e-5f);
          u32x4 w; w.x = pk2(y[0] * rs * nw1[0], y[1] * rs * nw1[1]); w.y = pk2(y[2] * rs * nw1[2], y[3] * rs * nw1[3]); w.z = pk2(y[4] * rs * nw1[4], y[5] * rs * nw1[5]); w.w = pk2(y[6] * rs * nw1[6], y[7] * rs * nw1[7]);
          *(u32x4*)(Y1 + (size_t)row * 512 + c0) = w; }
        { const u32x4 yy = *(const u32x4*)(Y2 + (size_t)row * 512 + c0); float q2 = 0.f;
#pragma unroll
          for (int q = 0; q < 4; ++q) { y[2 * q] = lo_bf(yy[q]); y[2 * q + 1] = hi_bf(yy[q]); q2 += y[2 * q] * y[2 * q] + y[2 * q + 1] * y[2 * q + 1]; }
          q2 += __shfl_xor(q2, 1); q2 += __shfl_xor(q2, 2); q2 += __shfl_xor(q2, 4); q2 += __shfl_xor(q2, 8);
          const float rs = rsqrtf(q2 * (1.f / 128.f) + 1e-5f);
          u32x4 w; w.x = pk2(y[0] * rs * nw2[0], y[1] * rs * nw2[1]); w.y = pk2(y[2] * rs * nw2[2], y[3] * rs * nw2[3]); w.z = pk2(y[4] * rs * nw2[4], y[5] * rs * nw2[5]); w.w = pk2(y[6] * rs * nw2[6], y[7] * rs * nw2[7]);
          *(u32x4*)(Y2 + (size_t)row * 512 + c0) = w; }
    }
}

constexpr int NPHASE = 18;
#ifndef DIAG
#define DIAG 0
#endif
#ifndef DIAG_A
#define DIAG_A(ph, s) ((ph) >= 2 && (s) == 2)
#endif
#ifndef DIAG_B
#define DIAG_B(ph, s) ((ph) >= 2 && ((s) == 0 || (s) >= 4 && (s) <= 6))
#endif
#ifndef PHM
#define PHM 1023
#endif
__global__ __launch_bounds__(512, 2) void mega(Params p) {
    extern __shared__ __attribute__((aligned(16))) unsigned char shm[];
    LAS unsigned char* lds = (LAS unsigned char*)shm;
    cg::grid_group grid = cg::this_grid();
    volatile LAS unsigned* xst = (volatile LAS unsigned*)(lds + 131072);
    if (threadIdx.x < 2) xst[threadIdx.x] = 0u;
    __syncthreads();
    const XcdBarrier xb = xcd_barrier_post((unsigned*)(p.ws + OFF_BAR), xst);
#if DIAG
    unsigned long long tA = 0, tB = 0;
#endif
    for (int ph = p.ph_lo; ph < p.ph_hi; ++ph) {
        const int TIDX = tid_opaque(), BIDX = bid_opaque();
#if DIAG
        const unsigned long long t_start = __builtin_amdgcn_s_memrealtime();
#endif
        if (ph == 0) { if (PHM & 1) { wprep(p, 0, lds, TIDX, BIDX); ada_phase(p, lds, TIDX, BIDX); } }
        else if (ph == 1) { if (PHM & 2) ln1_phase(p, 0, p.in[I_X], TIDX, BIDX); }
        else {
            const int l = (ph - 2) >> 3, s = (ph - 2) & 7;
            const float* xin = l == 0 ? p.in[I_X] : p.out;
            pg8::StaticOrder S;
            if (s == 0 && (PHM & 4)) { pg8::Gemm g{(const bf16_t*)(p.ws + OFF_H), (const bf16_t*)(p.ws + OFF_WT1), T, 4352, 1024, 1 << 30, 0};
                S.init(g.M, g.N, gridDim.x, BIDX); Epi<0> E{p.ws, nullptr, nullptr, nullptr}; pg8::gemm_phase(lds, g, S, E, TIDX); }
            else if (s == 1 && (PHM & 8)) { rwkv_prep_phase(p, l, lds, TIDX, BIDX, xb); }
            else if (s == 2 && (PHM & 16)) { scans_naive_phase(p, l, lds, TIDX, BIDX); }
            else if (s == 3 && (PHM & 32)) { post_phase(p, l, TIDX, BIDX); }
            else if (s == 4 && (PHM & 64)) { pg8::Gemm g{(const bf16_t*)(p.ws + OFF_H), (const bf16_t*)(p.ws + OFF_WT1) + (size_t)4352 * 1024, T, 4096, 1024, 1 << 30, 0};
                S.init(g.M, g.N, gridDim.x, BIDX); Epi<1> E{p.ws, nullptr, nullptr, nullptr}; pg8::gemm_phase(lds, g, S, E, TIDX); }
            else if (s == 5 && (PHM & 128)) { pg8::Gemm g{(const bf16_t*)(p.ws + OFF_Y3), (const bf16_t*)(p.ws + OFF_WT2), T, 1024, 512, 4, (size_t)T * 512 * 2};
                S.init(g.M, g.N, gridDim.x, BIDX, 3); Epi<2> E{p.ws, nullptr, nullptr, nullptr}; pg8::gemm_phase(lds, g, S, E, TIDX); }
            else if (s == 6 && (PHM & 256)) { pg8::Gemm g{(const bf16_t*)(p.ws + OFF_H), (const bf16_t*)(p.ws + OFF_WT3), T, 1024, 1024, 1 << 30, 0};
                S.init(g.M, g.N, gridDim.x, BIDX); Epi<3> E{p.ws, xin, (const float*)(p.ws + OFF_MOD) + (size_t)l * 4 * 3072, p.out}; pg8::gemm_phase(lds, g, S, E, TIDX); }
            else if (s == 7 && (PHM & 512)) { lnpost_phase(p, l, TIDX, BIDX); if (l == 0) wprep(p, 1, lds, TIDX, BIDX); }
        }
        if (ph + 1 < p.ph_hi) { if (ph == p.ph_lo) grid.sync(); else xcd_barrier(xb); }
#if DIAG
        { const unsigned long long dt = __builtin_amdgcn_s_memrealtime() - t_start; const int s_ = (ph - 2) & 7;
          if (DIAG_A(ph, s_)) tA += dt; if (DIAG_B(ph, s_)) tB += dt; }
#endif
    }
#if DIAG
    grid.sync();
    if (blockIdx.x == 0) {
        const float vA = (float)tA * 10.f, vB = (float)tB * 10.f;
        for (int i = threadIdx.x; i < (1 << 20); i += 512) p.out[4096 + i] = vB;
        if (threadIdx.x == 0) p.out[0] = vA * 1000.f;
    }
#endif
}

extern "C" void kernel_launch(void* const* d_in, const int* in_sizes, int n_in, void* d_out, int out_size, void* d_ws, size_t ws_size, hipStream_t stream) {
    constexpr int LDS_BYTES = 131072 + 16;
    static int grid = 0;
    if (grid == 0) {
        if (n_in != 28 || out_size != T * DM || ws_size < WS_NEED) { fprintf(stderr, "kernel_launch: unexpected shapes / workspace (%zu < %zu)\n", ws_size, (size_t)WS_NEED); grid = -1; return; }
        int dev = 0, cus = 0, per_cu = 0;
        hipGetDevice(&dev); hipDeviceGetAttribute(&cus, hipDeviceAttributeMultiprocessorCount, dev);
        if (hipFuncSetAttribute((const void*)mega, hipFuncAttributeMaxDynamicSharedMemorySize, LDS_BYTES) != hipSuccess) { fprintf(stderr, "hipFuncSetAttribute failed\n"); grid = -1; return; }
        if (hipOccupancyMaxActiveBlocksPerMultiprocessor(&per_cu, (const void*)mega, 512, LDS_BYTES) != hipSuccess || per_cu < 1) per_cu = 1;
        (void)hipGetLastError();
        grid = cus * 1;
        if (grid != 256) { fprintf(stderr, "kernel_launch: built for 256 CUs\n"); grid = -1; return; }
    }
    if (grid < 0) return;
    if (hipMemsetAsync((char*)d_ws + OFF_BAR, 0, XCD_BAR_WORDS_B, stream) != hipSuccess) { fprintf(stderr, "kernel_launch: memset of barrier words failed\n"); return; }
    Params p{};
    for (int i = 0; i < 28; ++i) p.in[i] = (const float*)d_in[i];
    p.out = (float*)d_out; p.ws = (unsigned char*)d_ws;
#if N_LAUNCH_MODE == 1
    p.ph_lo = 0; p.ph_hi = NPHASE;
    void* args[] = {&p};
    hipError_t e = hipLaunchCooperativeKernel((const void*)mega, dim3(grid), dim3(512), args, LDS_BYTES, stream);
    if (e != hipSuccess) fprintf(stderr, "cooperative launch failed: %s (grid %d)\n", hipGetErrorString(e), grid);
#else
    for (int ph = 0; ph < NPHASE; ++ph) { p.ph_lo = ph; p.ph_hi = ph + 1; hipLaunchKernelGGL(mega, dim3(grid), dim3(512), LDS_BYTES, stream, p); }
#endif
}
```

```cpp
#include <hip/hip_runtime.h>
#include <hip/hip_cooperative_groups.h>
#include <cstdio>
namespace cg = cooperative_groups;

#ifndef N_LAUNCH_MODE
#define N_LAUNCH_MODE 1
#endif

#define LAS __attribute__((address_space(3)))
typedef unsigned short bf16_t;
typedef short bf16x8 __attribute__((ext_vector_type(8)));
typedef float f32x4 __attribute__((ext_vector_type(4)));
typedef unsigned u32x4 __attribute__((ext_vector_type(4)));
typedef unsigned u32x2 __attribute__((ext_vector_type(2)));

constexpr int T = 32768, SEQ = 8192, DM = 1024, NB = 4;
constexpr int INW = 8344;
constexpr float ALPHA_DN = 1.4142135623730951f;

constexpr size_t XCD_BAR_WORDS_B = 3456 * 4;
constexpr size_t SZ_WT1 = (size_t)8448 * 1024 * 2, SZ_WT2 = (size_t)3072 * 512 * 2, SZ_WT3 = (size_t)1024 * 3072 * 2, SZ_MOD = (size_t)2 * 4 * 3072 * 4;
constexpr size_t OFF_WT1 = 0, OFF_WT2 = OFF_WT1 + SZ_WT1, OFF_WT3 = OFF_WT2 + SZ_WT2, OFF_MOD = OFF_WT3 + SZ_WT3;
constexpr size_t OFF_H = OFF_MOD + SZ_MOD;
constexpr size_t OFF_Y3 = OFF_H + (size_t)T * 1024 * 2;
constexpr size_t OFF_RKV = OFF_Y3 + (size_t)3 * T * 512 * 2;
constexpr size_t OFF_XBC = OFF_RKV + (size_t)T * 1536 * 2;
constexpr size_t OFF_GQ = OFF_XBC + (size_t)T * 1024 * 2;
constexpr size_t OFF_GK = OFF_GQ + (size_t)T * 256 * 2;
constexpr size_t OFF_SMALL = OFF_GK + (size_t)T * 256 * 2;
constexpr size_t OFF_A = OFF_SMALL + (size_t)T * 160 * 4;
constexpr size_t OFF_DEC = OFF_A + (size_t)T * 512 * 2;
constexpr size_t WS_END = OFF_DEC + (size_t)T * 512 * 4;
constexpr size_t OFF_BAR = (WS_END + 255) & ~(size_t)255;
constexpr size_t WS_NEED = OFF_BAR + XCD_BAR_WORDS_B;
constexpr size_t OFF_GATES = OFF_RKV;
static_assert(OFF_GK + (size_t)T * 256 * 2 - OFF_RKV == (size_t)T * 3072 * 2, "gates alias");

struct Params { const float* in[28]; float* out; unsigned char* ws; int ph_lo, ph_hi; };
enum { I_X = 0, I_C, I_ADAW, I_ADAB, I_WIN, I_MU, I_W0, I_WUP, I_A0, I_AUP, I_KK, I_KA, I_RK, I_LNG, I_LNB, I_CONVW, I_CONVB, I_DTB, I_ALOG, I_DSKIP,
       I_M2NW, I_GKUP, I_GKB, I_GNW, I_WBR, I_WOUT, I_PG, I_PB };

__device__ __forceinline__ float bf2f(bf16_t v) { return __uint_as_float(((unsigned)v) << 16); }
__device__ __forceinline__ bf16_t f2bf(float f) { unsigned u = __float_as_uint(f); u += 0x7FFFu + ((u >> 16) & 1u); return (bf16_t)(u >> 16); }
__device__ __forceinline__ unsigned pk2(float lo, float hi) { return (unsigned)f2bf(lo) | ((unsigned)f2bf(hi) << 16); }
__device__ __forceinline__ float lo_bf(unsigned w) { return __uint_as_float(w << 16); }
__device__ __forceinline__ float hi_bf(unsigned w) { return __uint_as_float(w & 0xFFFF0000u); }
__device__ __forceinline__ float sigmoidf_(float x) { return 1.0f / (1.0f + __expf(-x)); }
__device__ __forceinline__ float siluf_(float x) { return x / (1.0f + __expf(-x)); }
__device__ __forceinline__ float softplusf_(float x) { return x > 20.f ? x : log1pf(__expf(x)); }
__device__ __forceinline__ float wave_sum(float v) {
#pragma unroll
    for (int o = 1; o < 64; o <<= 1) v += __shfl_xor(v, o);
    return v;
}
__device__ __forceinline__ int tid_opaque() { int t = threadIdx.x; asm volatile("" : "+v"(t)); return t; }
__device__ __forceinline__ int bid_opaque() { int t = blockIdx.x; asm volatile("" : "+s"(t)); return t; }
#define WAVE_LDS_SYNC() do { asm volatile("s_waitcnt lgkmcnt(0)" ::: "memory"); __builtin_amdgcn_wave_barrier(); } while (0)


#define XB_TMO      128
#define XB_XCNT(j)  (256  + 64 * (j))
#define XB_XSUB(j)  (1280 + 64 * (j))
#define XB_XGEN(j)  (2304 + 64 * (j))
#define XB_TOP      3328
#define XB_TOPGEN   3392
#define XCD_BAR_WORDS 3456
#define XB_SPIN_CAP (1u << 20)
__device__ __forceinline__ unsigned xb_ld(unsigned* p)              { return __hip_atomic_load(p, __ATOMIC_RELAXED, __HIP_MEMORY_SCOPE_AGENT); }
__device__ __forceinline__ unsigned xb_add(unsigned* p, unsigned v) { return __hip_atomic_fetch_add(p, v, __ATOMIC_RELAXED, __HIP_MEMORY_SCOPE_AGENT); }
__device__ __forceinline__ unsigned xb_xcc_id() { return (unsigned)__builtin_amdgcn_s_getreg((3 << 11) | 20) & 0xFu; }
#define XB_SPIN(cond, bar) do { unsigned _sp = 0; while (cond) { __builtin_amdgcn_s_sleep(1); \
    if ((++_sp & 255u) == 0u) { if (xb_ld(&(bar)[XB_TMO])) break; if (_sp > XB_SPIN_CAP) { atomicAdd(&(bar)[XB_TMO], 1u); break; } } } } while (0)
struct XcdBarrier { unsigned* bar; unsigned x; volatile LAS unsigned* st; };
__device__ __forceinline__ XcdBarrier xcd_barrier_post(unsigned* bar, volatile LAS unsigned* st) {
    XcdBarrier b; b.bar = bar; b.x = xb_xcc_id(); b.st = st;
    if (threadIdx.x == 0) (void)xb_add(&bar[XB_XCNT(b.x)], 1u);
    return b;
}
__device__ __forceinline__ void xcd_barrier_complete(unsigned* bar, unsigned x, unsigned& nloc, unsigned& nx) {
    const unsigned G = gridDim.x * gridDim.y * gridDim.z;
    unsigned sum, cnt, mine, sp = 0u;
    for (;;) {
        sum = 0u; cnt = 0u; mine = 0u;
#pragma unroll
        for (unsigned j = 0; j < 16; ++j) { const unsigned c = xb_ld(&bar[XB_XCNT(j)]); sum += c; cnt += (c > 0u) ? 1u : 0u; mine = (j == x) ? c : mine; }
        if (sum == G) break;
        __builtin_amdgcn_s_sleep(1);
        if ((++sp & 255u) == 0u) { if (xb_ld(&bar[XB_TMO])) break; if (sp > XB_SPIN_CAP) { atomicAdd(&bar[XB_TMO], 1u); break; } }
    }
    nloc = mine > 0u ? mine : 1u; nx = cnt > 0u ? cnt : 1u;
}
__device__ __forceinline__ void xcd_barrier(const XcdBarrier& b) {
    asm volatile("s_waitcnt vmcnt(0)" ::: "memory");
    __syncthreads();
    if (threadIdx.x == 0) {
        unsigned* bar = b.bar;
        __builtin_amdgcn_s_waitcnt(0);
        unsigned nloc = b.st[0], nx = b.st[1];
        if (nloc == 0u) { xcd_barrier_complete(bar, b.x, nloc, nx); b.st[0] = nloc; b.st[1] = nx; }
        const unsigned old = xb_add(&bar[XB_XSUB(b.x)], 1u);
        const unsigned gen = old / nloc;
        if (old + 1u == (gen + 1u) * nloc) {
            __builtin_amdgcn_fence(__ATOMIC_RELEASE, "agent");
            asm volatile("s_waitcnt vmcnt(0)" ::: "memory");
            const unsigned og = xb_add(&bar[XB_TOP], 1u);
            const unsigned tg = og / nx;
            if (og + 1u == (tg + 1u) * nx) xb_add(&bar[XB_TOPGEN], 1u);
            else XB_SPIN(xb_ld(&bar[XB_TOPGEN]) == tg, bar);
            __builtin_amdgcn_fence(__ATOMIC_ACQUIRE, "agent");
            xb_add(&bar[XB_XGEN(b.x)], 1u);
            asm volatile("s_waitcnt vmcnt(0)" ::: "memory");
        } else {
            XB_SPIN(xb_ld(&bar[XB_XGEN(b.x)]) == gen, bar);
            __builtin_amdgcn_fence(__ATOMIC_ACQUIRE, "agent");
            asm volatile("s_waitcnt vmcnt(0)" ::: "memory");
        }
    }
    __syncthreads();
}
namespace pg8 {
constexpr int BM = 256, BK = 64, HALF = 128, HTB = HALF * BK * 2, STAGE_BYTES = 8 * HTB, NXCD = 8, WGM = 8;
__host__ __device__ __forceinline__ int lds_byte(int r, int c) { const int st = (r >> 4) * 2 + (c >> 5), rr = r & 15, cc = c & 31, ob = rr * 64 + cc * 2; return st * 1024 + (ob ^ (((ob >> 9) & 1) << 5)); }
__host__ __device__ __forceinline__ void stage_rc(int b, int& R, int& C) { const int st = b / 1024, sb = b % 1024, swz = sb ^ (((sb >> 9) & 1) << 5); R = (st >> 1) * 16 + swz / 64; C = (st & 1) * 32 + (swz % 64) / 2; }
__host__ __device__ __forceinline__ int perm32(int rho) { const int n = rho >> 4, i = rho & 15; return 8 * (i >> 2) + 4 * n + (i & 3); }
struct Unit { int pm, pn; };
struct Gemm { const bf16_t* A; const bf16_t* Bt; int M, N, K; int adiv; size_t astride; };
struct StaticOrder {
    int nM, nN, nwg, G, c, rep;
    __device__ void init(int M, int N, int G_, int c_, int rep_ = 1) { nM = M / BM; nN = N / BM; nwg = nM * nN; G = G_; c = c_; rep = rep_; }
    __device__ bool next(int i0, Unit& u) const {
        const int i = rep == 3 ? i0 / 3 : i0;
        const long L = (long)i * G + c; if (L >= nwg) return false;
        int wgid = (int)L; { const int q = nwg / NXCD, r = nwg % NXCD, xcd = wgid % NXCD, off = wgid / NXCD; wgid = (xcd < r ? xcd * (q + 1) : r * (q + 1) + (xcd - r) * q) + off; }
        const int nig = WGM * nN, gid = wgid / nig, fm = gid * WGM, gsz = (nM - fm) < WGM ? (nM - fm) : WGM;
        u.pm = fm + ((wgid % nig) % gsz); u.pn = (wgid % nig) / gsz; if (rep == 3) u.pn += nN * (i0 - 3 * i); return true;
    }
};
__device__ __forceinline__ unsigned cvt_pk_bf16(float lo, float hi) { unsigned r; asm volatile("v_cvt_pk_bf16_f32 %0, %1, %2" : "=v"(r) : "v"(lo), "v"(hi)); return r; }

template <class Epi>
__device__ __forceinline__ void gemm_phase(LAS unsigned char* lds, const Gemm g, const StaticOrder& S, const Epi& E, int TIDX) {
    const int tid = TIDX, wid = __builtin_amdgcn_readfirstlane(tid >> 6), lane = tid & 63, wr = wid >> 2, wc = wid & 3, fr = lane & 15, fq = lane >> 4;
    const int K = g.K, nt = K / BK;
    unsigned voffA[2], voffB[2];
#pragma unroll
    for (int i = 0; i < 2; ++i) { int R, C; stage_rc(tid * 16 + i * 8192, R, C); const int Rb = (R & ~31) + perm32(R & 31);
        voffA[i] = (unsigned)(R * K + C) * 2u; voffB[i] = (unsigned)(Rb * K + C) * 2u; }
    const size_t kstep = (size_t)(BK * 2);
    const size_t hstep = (size_t)HALF * K * 2;
    const size_t tstep = 2 * hstep;
    const unsigned ldsw = (unsigned)wid * 1024u;
    const int aoff = lds_byte(wr * 64 + fr, fq * 8), boff = lds_byte(wc * 32 + fr, fq * 8);
#define PG8_SA(b, h) (((b) * 2 + (h)) * HTB)
#define PG8_SB(b, h) ((4 + (b) * 2 + (h)) * HTB)
#define PG8_STAGE(bufoff, gbase, voff) do { _Pragma("unroll") for (int _i = 0; _i < 2; ++_i) \
        __builtin_amdgcn_global_load_lds((const unsigned*)((const char*)(gbase) + (voff)[_i]), (LAS unsigned*)(lds + (bufoff) + ldsw + _i * 8192), 16, 0, 0); } while (0)
#define PG8_LDA(dst, b, h) do { _Pragma("unroll") for (int m = 0; m < 4; ++m) _Pragma("unroll") for (int k = 0; k < 2; ++k) dst[m][k] = *(const LAS bf16x8*)(lds + PG8_SA(b, h) + aoff + m * 2048 + k * 1024); } while (0)
#define PG8_LDB(dst, b, h) do { _Pragma("unroll") for (int n = 0; n < 2; ++n) _Pragma("unroll") for (int k = 0; k < 2; ++k) dst[n][k] = *(const LAS bf16x8*)(lds + PG8_SB(b, h) + boff + n * 2048 + k * 1024); } while (0)
#define PG8_MMA(ai, bj, At, Bt) do { __builtin_amdgcn_s_setprio(1); _Pragma("unroll") for (int m = 0; m < 4; ++m) _Pragma("unroll") for (int n = 0; n < 2; ++n) _Pragma("unroll") for (int k = 0; k < 2; ++k) \
        acc[ai][bj][m][n] = __builtin_amdgcn_mfma_f32_16x16x32_bf16(Bt[n][k], At[m][k], acc[ai][bj][m][n], 0, 0, 0); __builtin_amdgcn_s_setprio(0); } while (0)
#define PG8_WAIT_V(n) asm volatile("s_waitcnt vmcnt(" #n ")" ::: "memory")
#define PG8_WAIT_L(n) asm volatile("s_waitcnt lgkmcnt(" #n ")" ::: "memory")
#define PG8_BAR __builtin_amdgcn_s_barrier()
#define PG8_SCHED __builtin_amdgcn_sched_barrier(0)
    Unit cur, nxt; int ui = 0;
    if (!S.next(0, cur)) return;
    f32x4 acc[2][2][4][2];
#pragma unroll
    for (int a = 0; a < 2; ++a)
#pragma unroll
        for (int b = 0; b < 2; ++b)
#pragma unroll
            for (int m = 0; m < 4; ++m)
#pragma unroll
                for (int n = 0; n < 2; ++n) acc[a][b][m][n] = (f32x4){0.f, 0.f, 0.f, 0.f};
    bf16x8 At[4][2], B0[2][2], B1[2][2];
    const char* cA = (const char*)g.A + (size_t)(cur.pn / g.adiv) * g.astride + (size_t)cur.pm * tstep; const char* cB = (const char*)g.Bt + (size_t)cur.pn * tstep;
    PG8_STAGE(PG8_SB(0, 0), cB, voffB); PG8_STAGE(PG8_SA(0, 0), cA, voffA); PG8_STAGE(PG8_SB(0, 1), cB + hstep, voffB); PG8_STAGE(PG8_SA(0, 1), cA + hstep, voffA);
    if (wr == 1) PG8_BAR;
    PG8_WAIT_V(4); PG8_BAR;
    PG8_STAGE(PG8_SB(1, 0), cB + kstep, voffB); PG8_STAGE(PG8_SA(1, 0), cA + kstep, voffA); PG8_STAGE(PG8_SB(1, 1), cB + hstep + kstep, voffB);
    PG8_WAIT_V(6); PG8_BAR;
    for (;;) {
        const bool has_next = S.next(ui + 1, nxt);
        const char* nA = has_next ? (const char*)g.A + (size_t)(nxt.pn / g.adiv) * g.astride + (size_t)nxt.pm * tstep : cA; const char* nB = has_next ? (const char*)g.Bt + (size_t)nxt.pn * tstep : cB;
        for (int t = 0; t < nt; t += 2) {
            const bool last = (t == nt - 2);
            const char* a1 = cA + (size_t)(t + 1) * kstep;
            const char* a2 = last ? nA : cA + (size_t)(t + 2) * kstep; const char* b2 = last ? nB : cB + (size_t)(t + 2) * kstep;
            const char* a3 = a2 + kstep; const char* b3 = b2 + kstep;
            PG8_LDB(B0, 0, 0); PG8_SCHED; PG8_LDA(At, 0, 0); PG8_STAGE(PG8_SA(1, 1), a1 + hstep, voffA);
            PG8_WAIT_L(8); PG8_BAR; PG8_WAIT_L(0); PG8_MMA(0, 0, At, B0); PG8_BAR; PG8_SCHED;
            PG8_LDB(B1, 0, 1); PG8_STAGE(PG8_SB(0, 0), b2, voffB);
            PG8_BAR; PG8_WAIT_L(0); PG8_MMA(0, 1, At, B1); PG8_BAR;
            PG8_LDA(At, 0, 1); PG8_STAGE(PG8_SA(0, 0), a2, voffA);
            PG8_BAR; PG8_WAIT_L(0); PG8_MMA(1, 0, At, B0); PG8_BAR; PG8_SCHED;
            PG8_STAGE(PG8_SB(0, 1), b2 + hstep, voffB);
            PG8_WAIT_V(6); PG8_BAR; PG8_MMA(1, 1, At, B1); PG8_BAR;
            PG8_LDB(B0, 1, 0); PG8_SCHED; PG8_LDA(At, 1, 0); PG8_STAGE(PG8_SA(0, 1), a2 + hstep, voffA);
            PG8_WAIT_L(8); PG8_BAR; PG8_WAIT_L(0); PG8_MMA(0, 0, At, B0); PG8_BAR; PG8_SCHED;
            PG8_LDB(B1, 1, 1); PG8_STAGE(PG8_SB(1, 0), b3, voffB);
            PG8_BAR; PG8_WAIT_L(0); PG8_MMA(0, 1, At, B1); PG8_BAR;
            PG8_LDA(At, 1, 1); PG8_STAGE(PG8_SA(1, 0), a3, voffA);
            PG8_BAR; PG8_WAIT_L(0); PG8_MMA(1, 0, At, B0); PG8_BAR; PG8_SCHED;
            PG8_STAGE(PG8_SB(1, 1), b3 + hstep, voffB);
            PG8_WAIT_V(6); PG8_BAR; PG8_MMA(1, 1, At, B1); PG8_BAR;
        }
        E(acc, cur, wr, wc, fr, fq);
        if (!has_next) break;
#pragma unroll
        for (int a = 0; a < 2; ++a)
#pragma unroll
            for (int b = 0; b < 2; ++b)
#pragma unroll
                for (int m = 0; m < 4; ++m)
#pragma unroll
                    for (int n = 0; n < 2; ++n) acc[a][b][m][n] = (f32x4){0.f, 0.f, 0.f, 0.f};
        cur = nxt; cA = nA; cB = nB; ++ui;
    }
    PG8_WAIT_V(0);
    if (wr == 0) PG8_BAR;
    PG8_BAR;
#undef PG8_SA
#undef PG8_SB
#undef PG8_STAGE
#undef PG8_LDA
#undef PG8_LDB
#undef PG8_MMA
#undef PG8_WAIT_V
#undef PG8_WAIT_L
#undef PG8_BAR
#undef PG8_SCHED
}
}

template <int MODE> struct Epi {
    unsigned char* ws; const float* xin; const float* gate; float* out; int dry;
    __device__ __forceinline__ void operator()(const f32x4 (&acc)[2][2][4][2], const pg8::Unit& u, int wr, int wc, int fr, int fq) const {
        const int pn = u.pn;
        bf16_t* base = nullptr; int ld = 0, c0 = 0;
        if (MODE == 0) {
            if (pn < 6) { base = (bf16_t*)(ws + OFF_RKV); ld = 1536; c0 = pn * 256; }
            else if (pn < 10) { base = (bf16_t*)(ws + OFF_XBC); ld = 1024; c0 = (pn - 6) * 256; }
            else if (pn < 12) { base = (bf16_t*)(ws + OFF_Y3) + (size_t)T * 512; ld = 512; c0 = (pn - 10) * 256; }
            else if (pn == 12) { base = (bf16_t*)(ws + OFF_GQ); ld = 256; c0 = 0; }
            else if (pn == 13) { base = (bf16_t*)(ws + OFF_GK); ld = 256; c0 = 0; }
            else if (pn < 16) { base = (bf16_t*)(ws + OFF_Y3) + (size_t)2 * T * 512; ld = 512; c0 = (pn - 14) * 256; }
        } else if (MODE == 1) {
            if (pn < 2) { base = (bf16_t*)(ws + OFF_Y3); ld = 512; c0 = pn * 256; }
            else if (pn < 4) { base = (bf16_t*)(ws + OFF_Y3) + (size_t)2 * T * 512; ld = 512; c0 = (pn - 2) * 256; }
            else { base = (bf16_t*)(ws + OFF_GATES); ld = 3072; c0 = (pn - 4) * 256; }
        } else if (MODE == 2) { base = (bf16_t*)(ws + OFF_H); ld = 1024; c0 = (pn & 3) * 256; }
        if (MODE == 0 || (MODE == 1 && pn >= 4)) {
#pragma unroll
            for (int ai = 0; ai < 2; ++ai)
#pragma unroll
                for (int m = 0; m < 4; ++m) {
                    const int row = u.pm * 256 + ai * 128 + wr * 64 + m * 16 + fr;
#pragma unroll
                    for (int bj = 0; bj < 2; ++bj) {
                        const int cl = bj * 128 + wc * 32 + 8 * fq;
                        f32x4 v0 = acc[ai][bj][m][0], v1 = acc[ai][bj][m][1];
                        if (MODE == 0) {
                            if (pn < 16) {
                                u32x4 w; w.x = pg8::cvt_pk_bf16(v0[0], v0[1]); w.y = pg8::cvt_pk_bf16(v0[2], v0[3]); w.z = pg8::cvt_pk_bf16(v1[0], v1[1]); w.w = pg8::cvt_pk_bf16(v1[2], v1[3]);
                                *(u32x4*)(base + (size_t)row * ld + c0 + cl) = w;
                            } else if (cl < 160) {
                                float* d = (float*)(ws + OFF_SMALL) + (size_t)row * 160 + cl;
                                *(f32x4*)d = v0; *(f32x4*)(d + 4) = v1;
                            }
                        } else {
                            u32x4 w;
                            w.x = pg8::cvt_pk_bf16(sigmoidf_(v0[0]), sigmoidf_(v0[1])); w.y = pg8::cvt_pk_bf16(sigmoidf_(v0[2]), sigmoidf_(v0[3]));
                            w.z = pg8::cvt_pk_bf16(sigmoidf_(v1[0]), sigmoidf_(v1[1])); w.w = pg8::cvt_pk_bf16(sigmoidf_(v1[2]), sigmoidf_(v1[3]));
                            *(u32x4*)(base + (size_t)row * ld + c0 + cl) = w;
                        }
                    }
                }
        } else {
            f32x4 gm[2][2];
            if (MODE == 3) {
#pragma unroll
                for (int bj = 0; bj < 2; ++bj) { const int col = pn * 256 + bj * 128 + wc * 32 + 8 * fq; const int bb = (u.pm * 256) >> 13;
                    gm[bj][0] = *(const f32x4*)(gate + bb * 3072 + 2048 + col); gm[bj][1] = *(const f32x4*)(gate + bb * 3072 + 2048 + col + 4); }
            }
#pragma unroll
            for (int ai = 0; ai < 2; ++ai)
#pragma unroll
                for (int mp = 0; mp < 2; ++mp) {
                    u32x4 la[4], lb[4]; f32x4 fa[4], fb[4];
#pragma unroll
                    for (int q = 0; q < 4; ++q) { const int m = mp * 2 + (q >> 1), bj = q & 1;
                        const int row = u.pm * 256 + ai * 128 + wr * 64 + m * 16 + fr, cl = bj * 128 + wc * 32 + 8 * fq;
                        if (MODE == 1) la[q] = *(const u32x4*)(base + (size_t)row * ld + c0 + cl);
                        if (MODE == 2) { la[q] = *(const u32x4*)((const bf16_t*)(ws + OFF_GATES) + (size_t)row * 3072 + pn * 256 + cl);
                            lb[q] = (u32x4){0u, 0u, 0u, 0u}; if (pn >= 4) lb[q] = *(const u32x4*)(base + (size_t)row * ld + c0 + cl); }
                        if (MODE == 3) { const int col = pn * 256 + cl; fa[q] = *(const f32x4*)(xin + (size_t)row * 1024 + col); fb[q] = *(const f32x4*)(xin + (size_t)row * 1024 + col + 4); } }
#pragma unroll
                    for (int q = 0; q < 4; ++q) { const int m = mp * 2 + (q >> 1), bj = q & 1;
                        const int row = u.pm * 256 + ai * 128 + wr * 64 + m * 16 + fr, cl = bj * 128 + wc * 32 + 8 * fq;
                        const f32x4 v0 = acc[ai][bj][m][0], v1 = acc[ai][bj][m][1];
                        if (MODE == 1) { const u32x4 o = la[q]; u32x4 w;
                            w.x = pg8::cvt_pk_bf16(lo_bf(o.x) * siluf_(v0[0]), hi_bf(o.x) * siluf_(v0[1])); w.y = pg8::cvt_pk_bf16(lo_bf(o.y) * siluf_(v0[2]), hi_bf(o.y) * siluf_(v0[3]));
                            w.z = pg8::cvt_pk_bf16(lo_bf(o.z) * siluf_(v1[0]), hi_bf(o.z) * siluf_(v1[1])); w.w = pg8::cvt_pk_bf16(lo_bf(o.w) * siluf_(v1[2]), hi_bf(o.w) * siluf_(v1[3]));
                            *(u32x4*)(base + (size_t)row * ld + c0 + cl) = dry ? o : w; }
                        if (MODE == 2) { const u32x4 o = la[q], pm_ = lb[q]; u32x4 w;
                            w.x = pg8::cvt_pk_bf16(lo_bf(pm_.x) + lo_bf(o.x) * v0[0], hi_bf(pm_.x) + hi_bf(o.x) * v0[1]); w.y = pg8::cvt_pk_bf16(lo_bf(pm_.y) + lo_bf(o.y) * v0[2], hi_bf(pm_.y) + hi_bf(o.y) * v0[3]);
                            w.z = pg8::cvt_pk_bf16(lo_bf(pm_.z) + lo_bf(o.z) * v1[0], hi_bf(pm_.z) + hi_bf(o.z) * v1[1]); w.w = pg8::cvt_pk_bf16(lo_bf(pm_.w) + lo_bf(o.w) * v1[2], hi_bf(pm_.w) + hi_bf(o.w) * v1[3]);
                            *(u32x4*)(base + (size_t)row * ld + c0 + cl) = (dry && pn >= 4) ? pm_ : w; }
                        if (MODE == 3) { const int col = pn * 256 + cl; f32x4 r0, r1;
#pragma unroll
                            for (int j = 0; j < 4; ++j) { r0[j] = ALPHA_DN * fa[q][j] + (1.f + gm[bj][0][j]) * v0[j]; r1[j] = ALPHA_DN * fb[q][j] + (1.f + gm[bj][1][j]) * v1[j]; }
                            if (dry && xin == out) { r0 = fa[q]; r1 = fb[q]; }
                            *(f32x4*)(out + (size_t)row * 1024 + col) = r0; *(f32x4*)(out + (size_t)row * 1024 + col + 4) = r1; }
                    }
                }
        }
    }
};

__device__ __forceinline__ int wt1_src(int n) {
    if (n < 1536) return n;
    if (n < 2560) return 2176 + (n - 1536);
    if (n < 3072) return 3208 + (n - 2560);
    if (n < 3328) return 3720 + (n - 3072);
    if (n < 3584) return 3976 + (n - 3328);
    if (n < 4096) return 4232 + (n - 3584);
    if (n < 4352) { const int s = n - 4096; if (s < 128) return 1536 + s; if (s < 136) return 3200 + (s - 128); if (s < 152) return 4744 + (s - 136); return -1; }
    const int m = n - 4352;
    if (m < 512) return 1664 + m;
    if (m < 1024) return 4760 + (m - 512);
    return 5272 + (m - 1024);
}
template <bool MAP>
__device__ __forceinline__ void transpose_item(const float* W, int ldw, bf16_t* WT, int ldt, int row_off, int col_off, int nblk, LAS float* scr, int item, int lane) {
    const int kb = item / nblk, nb = item % nblk, k0 = 64 * kb, n0 = 32 * nb;
    int sc = n0 + (lane & 31); if (MAP) sc = wt1_src(sc);
#pragma unroll 8
    for (int i = 0; i < 32; ++i) { const int kk = 2 * i + (lane >> 5); scr[kk * 33 + (lane & 31)] = sc >= 0 ? W[(size_t)(k0 + kk) * ldw + sc] : 0.f; }
    WAVE_LDS_SYNC();
    const int c = lane & 7;
#pragma unroll
    for (int j = 0; j < 4; ++j) { const int n = (lane >> 3) + 8 * j; const LAS float* s = scr + (8 * c) * 33 + n;
        u32x4 o; o.x = pk2(s[0 * 33], s[1 * 33]); o.y = pk2(s[2 * 33], s[3 * 33]); o.z = pk2(s[4 * 33], s[5 * 33]); o.w = pk2(s[6 * 33], s[7 * 33]);
        *(u32x4*)(WT + (size_t)(row_off + n0 + n) * ldt + col_off + k0 + 8 * c) = o; }
    WAVE_LDS_SYNC();
}
__device__ void wprep(const Params& p, int l, LAS unsigned char* lds, int TIDX, int BIDX) {
    const int lane = TIDX & 63, wave = TIDX >> 6;
    LAS float* scr = (LAS float*)(lds + wave * 16384);
    const int gw = BIDX * 8 + wave, NGW = gridDim.x * 8;
    constexpr int I1 = (1024 / 64) * (8448 / 32), I2 = 3 * (512 / 64) * (1024 / 32), I3 = (1024 / 64) * (1024 / 32);
    bf16_t* WT1 = (bf16_t*)(p.ws + OFF_WT1); bf16_t* WT2 = (bf16_t*)(p.ws + OFF_WT2); bf16_t* WT3 = (bf16_t*)(p.ws + OFF_WT3);
    for (int it = gw; it < I1 + I2 + I3; it += NGW) {
        int r = it;
        if (r < I1) { transpose_item<true>(p.in[I_WIN] + (size_t)l * 1024 * INW, INW, WT1, 1024, 0, 0, 8448 / 32, scr, r, lane); continue; }
        r -= I1;
        if (r < I2) { const int b = r / (I2 / 3), rr = r % (I2 / 3); transpose_item<false>(p.in[I_WBR] + ((size_t)l * 3 + b) * 512 * 1024, 1024, WT2, 512, b * 1024, 0, 1024 / 32, scr, rr, lane); continue; }
        r -= I2;
        transpose_item<false>(p.in[I_WOUT] + (size_t)l * 1024 * 1024, 1024, WT3, 1024, 0, 0, 1024 / 32, scr, r, lane);
    }
}
__device__ void ada_phase(const Params& p, LAS unsigned char* lds, int TIDX, int BIDX) {
    LAS float* red = (LAS float*)lds;
    const int tid = TIDX, kg = tid >> 5, cj = tid & 31;
    float* mod = (float*)(p.ws + OFF_MOD);
    for (int it = BIDX; it < 2 * 96; it += gridDim.x) {
        const int l = it / 96, col = (it % 96) * 32 + cj;
        const float* W = p.in[I_ADAW] + (size_t)l * 1024 * 3072;
        float a0 = 0.f, a1 = 0.f, a2 = 0.f, a3 = 0.f;
        for (int k = kg * 64; k < kg * 64 + 64; ++k) {
            const float w = W[(size_t)k * 3072 + col];
            a0 += siluf_(p.in[I_C][k]) * w; a1 += siluf_(p.in[I_C][1024 + k]) * w; a2 += siluf_(p.in[I_C][2048 + k]) * w; a3 += siluf_(p.in[I_C][3072 + k]) * w;
        }
        red[(kg * 32 + cj) * 4 + 0] = a0; red[(kg * 32 + cj) * 4 + 1] = a1; red[(kg * 32 + cj) * 4 + 2] = a2; red[(kg * 32 + cj) * 4 + 3] = a3;
        __syncthreads();
        if (tid < 128) { const int c2 = tid >> 2, b = tid & 3; float s = 0.f;
            for (int g = 0; g < 16; ++g) s += red[(g * 32 + c2) * 4 + b];
            const int cc = (it % 96) * 32 + c2;
            mod[((size_t)l * 4 + b) * 3072 + cc] = s + p.in[I_ADAB][(size_t)l * 3072 + cc]; }
        __syncthreads();
    }
}
__device__ __forceinline__ void ln_stats(const f32x4 (&v)[4], float& mean, float& rstd, float eps) {
    float s = 0.f;
#pragma unroll
    for (int j = 0; j < 4; ++j) s += (v[j][0] + v[j][1]) + (v[j][2] + v[j][3]);
    mean = wave_sum(s) * (1.f / 1024.f); float s2 = 0.f;
#pragma unroll
    for (int j = 0; j < 4; ++j) { const f32x4 d = v[j] - mean; s2 += (d[0] * d[0] + d[1] * d[1]) + (d[2] * d[2] + d[3] * d[3]); }
    rstd = rsqrtf(wave_sum(s2) * (1.f / 1024.f) + eps);
}
__device__ __forceinline__ void mod_row_to_h(const Params& p, const f32x4 (&v)[4], int row, int l, int lane) {
    float mean, rstd; ln_stats(v, mean, rstd, 1e-5f);
    const float* mod = (const float*)(p.ws + OFF_MOD) + ((size_t)l * 4 + (row >> 13)) * 3072;
    bf16_t* H = (bf16_t*)(p.ws + OFF_H) + (size_t)row * 1024;
#pragma unroll
    for (int j = 0; j < 4; ++j) { const int c = 256 * j + 4 * lane;
        const f32x4 sh = *(const f32x4*)(mod + c), sc = *(const f32x4*)(mod + 1024 + c);
        f32x4 h;
#pragma unroll
        for (int e = 0; e < 4; ++e) h[e] = (v[j][e] - mean) * rstd * (1.f + sc[e]) + sh[e];
        u32x2 o; o.x = pk2(h[0], h[1]); o.y = pk2(h[2], h[3]);
        *(u32x2*)(H + c) = o; }
}
__device__ void ln1_phase(const Params& p, int l, const float* xin, int TIDX, int BIDX) {
    const int lane = TIDX & 63, gw = BIDX * 8 + (TIDX >> 6), NGW = gridDim.x * 8;
    for (int row = gw; row < T; row += NGW) {
        f32x4 v[4];
#pragma unroll
        for (int j = 0; j < 4; ++j) v[j] = *(const f32x4*)(xin + (size_t)row * 1024 + 256 * j + 4 * lane);
        mod_row_to_h(p, v, row, l, lane);
    }
}
__device__ void lnpost_phase(const Params& p, int l, int TIDX, int BIDX, int dry) {
    const int lane = TIDX & 63, gw = BIDX * 8 + (TIDX >> 6), NGW = gridDim.x * 8;
    const float* pg = p.in[I_PG] + l * 1024; const float* pb = p.in[I_PB] + l * 1024;
    for (int row = gw; row < T; row += NGW) {
        f32x4 v[4];
#pragma unroll
        for (int j = 0; j < 4; ++j) v[j] = *(const f32x4*)(p.out + (size_t)row * 1024 + 256 * j + 4 * lane);
        float mean, rstd; ln_stats(v, mean, rstd, 1e-5f);
#pragma unroll
        for (int j = 0; j < 4; ++j) { const int c = 256 * j + 4 * lane; const f32x4 g = *(const f32x4*)(pg + c), b = *(const f32x4*)(pb + c);
            const f32x4 orig = v[j];
#pragma unroll
            for (int e = 0; e < 4; ++e) v[j][e] = (v[j][e] - mean) * rstd * g[e] + b[e];
            *(f32x4*)(p.out + (size_t)row * 1024 + c) = dry ? orig : v[j]; }
        if (l == 0) mod_row_to_h(p, v, row, 1, lane);
    }
}

__device__ __forceinline__ void conv_unpack(const u32x4 w, float (&x)[8]) {
#pragma unroll
    for (int q = 0; q < 4; ++q) { x[2 * q] = lo_bf(w[q]); x[2 * q + 1] = hi_bf(w[q]); }
}
__device__ void rwkv_prep_phase(const Params& p, int l, LAS unsigned char* lds, int TIDX, int BIDX, const XcdBarrier& xb, int dry) {
    {
        bf16_t* XBC = (bf16_t*)(p.ws + OFF_XBC);
        const int cgp = TIDX & 127, qt = TIDX >> 7; const int q0 = BIDX * 128 + qt * 32; const int c8 = cgp * 8;
        float h1[8], h2[8], h3[8];
        if ((q0 & (SEQ - 1)) != 0) { conv_unpack(*(const u32x4*)(XBC + (size_t)(q0 - 1) * 1024 + c8), h1); conv_unpack(*(const u32x4*)(XBC + (size_t)(q0 - 2) * 1024 + c8), h2); conv_unpack(*(const u32x4*)(XBC + (size_t)(q0 - 3) * 1024 + c8), h3); }
        else {
#pragma unroll
            for (int e = 0; e < 8; ++e) h1[e] = h2[e] = h3[e] = 0.f; }
        xcd_barrier(xb);
        float cw0[8], cw1[8], cw2[8], cw3[8], cb[8];
#pragma unroll
        for (int e = 0; e < 8; ++e) { cw0[e] = p.in[I_CONVW][((size_t)l * 4 + 0) * 1024 + c8 + e]; cw1[e] = p.in[I_CONVW][((size_t)l * 4 + 1) * 1024 + c8 + e];
            cw2[e] = p.in[I_CONVW][((size_t)l * 4 + 2) * 1024 + c8 + e]; cw3[e] = p.in[I_CONVW][((size_t)l * 4 + 3) * 1024 + c8 + e]; cb[e] = p.in[I_CONVB][l * 1024 + c8 + e]; }
#pragma unroll 4
        for (int i = 0; i < 32; ++i) {
            bf16_t* ptr = XBC + (size_t)(q0 + i) * 1024 + c8;
            const u32x4 raw_ = *(const u32x4*)ptr; float x0[8]; conv_unpack(raw_, x0);
            float y[8];
#pragma unroll
            for (int e = 0; e < 8; ++e) { y[e] = siluf_(cw0[e] * h3[e] + cw1[e] * h2[e] + cw2[e] * h1[e] + cw3[e] * x0[e] + cb[e]); h3[e] = h2[e]; h2[e] = h1[e]; h1[e] = x0[e]; }
            u32x4 w; w.x = pk2(y[0], y[1]); w.y = pk2(y[2], y[3]); w.z = pk2(y[4], y[5]); w.w = pk2(y[6], y[7]);
            *(u32x4*)ptr = dry ? raw_ : w;
        }
    }
    LAS float* s = (LAS float*)lds;
    const int c = TIDX;
    float wu[64], au[64];
#pragma unroll
    for (int j = 0; j < 64; ++j) { wu[j] = p.in[I_WUP][((size_t)l * 64 + j) * 512 + c]; au[j] = p.in[I_AUP][((size_t)l * 64 + j) * 512 + c]; }
    const float w0 = p.in[I_W0][l * 512 + c], a0 = p.in[I_A0][l * 512 + c];
    const float* SM = (const float*)(p.ws + OFF_SMALL);
    const float* mu = p.in[I_MU] + l * 1664 + 1536;
    bf16_t* A = (bf16_t*)(p.ws + OFF_A); float* DEC = (float*)(p.ws + OFF_DEC);
    const int tpb = T / gridDim.x;
    for (int t0 = BIDX * tpb; t0 < (BIDX + 1) * tpb; t0 += 4) {
        { const int tt = c >> 7, j = c & 127; const int row = t0 + tt;
          const float cur = SM[(size_t)row * 160 + j]; const float prev = (row & (SEQ - 1)) ? SM[(size_t)(row - 1) * 160 + j] : 0.f;
          const float v = cur + mu[j] * (prev - cur);
          s[tt * 128 + j] = j < 64 ? tanhf(v) : v; }
        __syncthreads();
#pragma unroll
        for (int tt = 0; tt < 4; ++tt) {
            float w = w0, a = a0;
#pragma unroll
            for (int j = 0; j < 64; ++j) { w += s[tt * 128 + j] * wu[j]; a += s[tt * 128 + 64 + j] * au[j]; }
            const size_t o = (size_t)(t0 + tt) * 512 + c;
            A[o] = f2bf(sigmoidf_(a)); DEC[o] = __expf(-0.6065306597126334f * sigmoidf_(w));
        }
        __syncthreads();
    }
}

typedef float f32x2 __attribute__((ext_vector_type(2)));
template <int CTRL> __device__ __forceinline__ float dpp_f(float x) { return __builtin_bit_cast(float, __builtin_amdgcn_update_dpp(0, __builtin_bit_cast(int, x), CTRL, 0xF, 0xF, true)); }
__device__ __forceinline__ float row16_sum(float x) { x += dpp_f<0xB1>(x); x += dpp_f<0x4E>(x); x += dpp_f<0x141>(x); x += dpp_f<0x140>(x); return x; }
constexpr int RW_TC = 32, RW_VEC_B = RW_TC * 5 * 64 * 4, RW_V_B = RW_TC * 16 * 4, RW_BUF_B = RW_VEC_B + 2 * RW_V_B;
__device__ void rwkv_scan_fast(const Params& p, int l, int unit, LAS unsigned char* lds, int TIDX) {
    const int bh = unit >> 2, rq = unit & 3, b = bh >> 3, h = bh & 7, wave = TIDX >> 6, lane = TIDX & 63;
    const size_t r0 = (size_t)b * SEQ;
    bf16_t* Y = (bf16_t*)(p.ws + OFF_Y3);
    if (wave >= 4) {
        const int lw = wave - 4, sl = lane >> 3, c8 = (lane & 7) * 8, ch0 = h * 64 + c8;
        const bf16_t* RKV = (const bf16_t*)(p.ws + OFF_RKV); const bf16_t* A = (const bf16_t*)(p.ws + OFF_A); const float* DEC = (const float*)(p.ws + OFF_DEC);
        float mu_r[8], mu_k[8], mu_v[8], k_k[8], k_a[8];
#pragma unroll
        for (int e = 0; e < 8; ++e) { mu_r[e] = p.in[I_MU][l * 1664 + ch0 + e]; mu_k[e] = p.in[I_MU][l * 1664 + 512 + ch0 + e]; mu_v[e] = p.in[I_MU][l * 1664 + 1024 + ch0 + e];
            k_k[e] = p.in[I_KK][l * 512 + ch0 + e]; k_a[e] = p.in[I_KA][l * 512 + ch0 + e]; }
        u32x4 nR, nK, nV, nRp, nKp, nVp, nA; f32x4 nD0, nD1;
        auto issue = [&](int cc) {
            const size_t row = r0 + (size_t)cc * RW_TC + lw * 8 + sl;
            nR = *(const u32x4*)(RKV + row * 1536 + ch0); nK = *(const u32x4*)(RKV + row * 1536 + 512 + ch0); nV = *(const u32x4*)(RKV + row * 1536 + 1024 + ch0);
            nA = *(const u32x4*)(A + row * 512 + ch0); nD0 = *(const f32x4*)(DEC + row * 512 + ch0); nD1 = *(const f32x4*)(DEC + row * 512 + ch0 + 4);
            const size_t prow = (row & (SEQ - 1)) != 0 ? row - 1 : row;
            nRp = *(const u32x4*)(RKV + prow * 1536 + ch0); nKp = *(const u32x4*)(RKV + prow * 1536 + 512 + ch0); nVp = *(const u32x4*)(RKV + prow * 1536 + 1024 + ch0);
        };
        issue(0);
        for (int c = -1; c < SEQ / RW_TC; ++c) {
            if (c >= 1) { LAS const float* yb = (LAS const float*)(lds + ((c - 1) & 1) * RW_BUF_B + RW_VEC_B + RW_V_B);
                const int idx = (lw * 64 + lane) * 2, s = idx >> 4, i = idx & 15;
                *(unsigned*)(Y + (r0 + (size_t)(c - 1) * RW_TC + s) * 512 + h * 64 + rq * 16 + i) = pk2(yb[idx], yb[idx + 1]); }
            if (c + 1 < SEQ / RW_TC) {
                const u32x4 cR = nR, cK = nK, cV = nV, cRp = nRp, cKp = nKp, cVp = nVp, cA = nA; const f32x4 cD0 = nD0, cD1 = nD1;
                if (c + 2 < SEQ / RW_TC) issue(c + 2);
                LAS float* vec = (LAS float*)(lds + ((c + 1) & 1) * RW_BUF_B); LAS float* vb = (LAS float*)(lds + ((c + 1) & 1) * RW_BUF_B + RW_VEC_B);
                const int s = lw * 8 + sl;
                float cr[8], ck[8], cv[8], pr[8], pk[8], pv[8], ca[8];
                conv_unpack(cR, cr); conv_unpack(cK, ck); conv_unpack(cV, cv); conv_unpack(cRp, pr); conv_unpack(cKp, pk); conv_unpack(cVp, pv); conv_unpack(cA, ca);
                if ((((c + 1) * RW_TC + s) & (SEQ - 1)) == 0) {
#pragma unroll
                    for (int e = 0; e < 8; ++e) pr[e] = pk[e] = pv[e] = 0.f; }
                float rr[8], kk[8], vv[8], kkj[8]; float n2 = 0.f;
#pragma unroll
                for (int e = 0; e < 8; ++e) { rr[e] = cr[e] + mu_r[e] * (pr[e] - cr[e]); kk[e] = ck[e] + mu_k[e] * (pk[e] - ck[e]); vv[e] = cv[e] + mu_v[e] * (pv[e] - cv[e]);
                    kkj[e] = kk[e] * k_k[e]; n2 += kkj[e] * kkj[e]; }
                n2 += dpp_f<0xB1>(n2); n2 += dpp_f<0x4E>(n2); n2 += dpp_f<0x141>(n2);
                const float inv = 1.f / fmaxf(sqrtf(n2), 1e-12f);
                f32x4 o0, o1;
                LAS float* d = vec + s * 320 + c8;
                *(LAS f32x4*)(d) = cD0; *(LAS f32x4*)(d + 4) = cD1;
#pragma unroll
                for (int e = 0; e < 4; ++e) { o0[e] = kkj[e] * inv; o1[e] = kkj[4 + e] * inv; }
                *(LAS f32x4*)(d + 64) = o0; *(LAS f32x4*)(d + 68) = o1;
#pragma unroll
                for (int e = 0; e < 4; ++e) { o0[e] *= ca[e]; o1[e] *= ca[4 + e]; }
                *(LAS f32x4*)(d + 128) = o0; *(LAS f32x4*)(d + 132) = o1;
#pragma unroll
                for (int e = 0; e < 4; ++e) { o0[e] = kk[e] * (1.f + (ca[e] - 1.f) * k_a[e]); o1[e] = kk[4 + e] * (1.f + (ca[4 + e] - 1.f) * k_a[4 + e]); }
                *(LAS f32x4*)(d + 192) = o0; *(LAS f32x4*)(d + 196) = o1;
#pragma unroll
                for (int e = 0; e < 4; ++e) { o0[e] = rr[e]; o1[e] = rr[4 + e]; }
                *(LAS f32x4*)(d + 256) = o0; *(LAS f32x4*)(d + 260) = o1;
                if ((c8 >> 4) == rq) {
#pragma unroll
                    for (int e = 0; e < 4; ++e) { o0[e] = vv[e]; o1[e] = vv[4 + e]; }
                    *(LAS f32x4*)(vb + s * 16 + (c8 & 15)) = o0; *(LAS f32x4*)(vb + s * 16 + (c8 & 15) + 4) = o1; }
            }
            __syncthreads();
        }
        { constexpr int c = SEQ / RW_TC; LAS const float* yb = (LAS const float*)(lds + ((c - 1) & 1) * RW_BUF_B + RW_VEC_B + RW_V_B);
          const int idx = (lw * 64 + lane) * 2, s = idx >> 4, i = idx & 15;
          *(unsigned*)(Y + (r0 + (size_t)(c - 1) * RW_TC + s) * 512 + h * 64 + rq * 16 + i) = pk2(yb[idx], yb[idx + 1]); }
    } else {
        const int rl = wave * 4 + (lane >> 4), cq = lane & 15;
        f32x2 S0 = (f32x2){0.f, 0.f}, S1 = (f32x2){0.f, 0.f};
        __syncthreads();
        for (int c = 0; c < SEQ / RW_TC; ++c) {
            LAS const unsigned char* buf = lds + (c & 1) * RW_BUF_B;
            LAS const float* vb = (LAS const float*)(buf + RW_VEC_B); LAS float* yb = (LAS float*)(buf + RW_VEC_B + RW_V_B);
            LAS const f32x4* q = (LAS const f32x4*)buf + cq;
            f32x4 w4 = q[0], k4 = q[16], b4 = q[32], t4 = q[48], r4 = q[64]; float v = vb[rl];
            float ykeep = 0.f;
#pragma unroll
            for (int s = 0; s < RW_TC; ++s) {
                f32x4 nw = w4, nk = k4, nb = b4, nt = t4, nr = r4; float nv = v;
                if (s + 1 < RW_TC) { LAS const f32x4* qn = q + (s + 1) * 80; nw = qn[0]; nk = qn[16]; nb = qn[32]; nt = qn[48]; nr = qn[64]; nv = vb[(s + 1) * 16 + rl]; }
                f32x2 sp = S0 * (f32x2){k4[0], k4[1]} + S1 * (f32x2){k4[2], k4[3]};
                const float sa = -row16_sum(sp[0] + sp[1]);
                S0 = S0 * (f32x2){w4[0], w4[1]} + (f32x2){b4[0], b4[1]} * sa + (f32x2){t4[0], t4[1]} * v;
                S1 = S1 * (f32x2){w4[2], w4[3]} + (f32x2){b4[2], b4[3]} * sa + (f32x2){t4[2], t4[3]} * v;
                f32x2 yp = S0 * (f32x2){r4[0], r4[1]} + S1 * (f32x2){r4[2], r4[3]};
                const float y = row16_sum(yp[0] + yp[1]);
                ykeep = ((s & 15) == cq) ? y : ykeep;
                if ((s & 15) == 15) yb[((s & ~15) + cq) * 16 + rl] = ykeep;
                w4 = nw; k4 = nk; b4 = nb; t4 = nt; r4 = nr; v = nv;
            }
            __syncthreads();
        }
    }
}

__device__ __forceinline__ int tm_shift(int t) { return ((t >> 3) & 3) * 16; }
template <int K, int AM, int BMODE>
__device__ __forceinline__ f32x4 mma_t(LAS const bf16_t* A, int lda, int arow0, LAS const bf16_t* B, int ldb, int brow0, f32x4 acc, int lane) {
    const int r = lane & 15, kg = lane >> 4;
#pragma unroll
    for (int k0 = 0; k0 < K; k0 += 32) {
        bf16x8 a, b;
        if (AM == 0) a = *(LAS const bf16x8*)(A + (arow0 + r) * lda + k0 + kg * 8);
        else if (AM == 2) a = *(LAS const bf16x8*)(A + (arow0 + r) * lda + tm_shift(arow0 + r) + k0 + kg * 8);
        else { LAS const bf16_t* q = A + (k0 + kg * 8) * lda + tm_shift(k0 + kg * 8) + arow0 + r;
#pragma unroll
            for (int j = 0; j < 8; ++j) a[j] = (short)q[j * lda]; }
        if (BMODE == 0) b = *(LAS const bf16x8*)(B + (brow0 + r) * ldb + k0 + kg * 8);
        else if (BMODE == 2) b = *(LAS const bf16x8*)(B + (brow0 + r) * ldb + tm_shift(brow0 + r) + k0 + kg * 8);
        else { LAS const bf16_t* q = B + (k0 + kg * 8) * ldb + tm_shift(k0 + kg * 8) + brow0 + r;
#pragma unroll
            for (int j = 0; j < 8; ++j) b[j] = (short)q[j * ldb]; }
        acc = __builtin_amdgcn_mfma_f32_16x16x32_bf16(a, b, acc, 0, 0, 0);
    }
    return acc;
}
__device__ void mamba2_chunk(const Params& p, int l, int bh, LAS unsigned char* lds, int TIDX) {
    const int b = bh >> 3, h = bh & 7, g = h >> 2, tid = TIDX, wave = tid >> 6, lane = tid & 63, r = lane & 15, kg = lane >> 4;
    LAS bf16_t* CB = (LAS bf16_t*)lds;
    LAS bf16_t* BB = (LAS bf16_t*)(lds + 17408);
    LAS bf16_t* AY = (LAS bf16_t*)(lds + 41984);
    LAS bf16_t* SB = (LAS bf16_t*)(lds + 67584);
    LAS bf16_t* XD = (LAS bf16_t*)(lds + 84992);
    LAS bf16_t* XE = (LAS bf16_t*)(lds + 101376);
    LAS bf16_t* XS = (LAS bf16_t*)(lds + 117760);
    LAS float* F = (LAS float*)(lds + 126976);
    const bf16_t* XBC = (const bf16_t*)(p.ws + OFF_XBC); const float* SM = (const float*)(p.ws + OFF_SMALL);
    bf16_t* Z = (bf16_t*)(p.ws + OFF_Y3) + (size_t)T * 512;
    const float dtb = p.in[I_DTB][l * 8 + h], ah = -__expf(p.in[I_ALOG][l * 8 + h]), dsk = p.in[I_DSKIP][l * 8 + h];
    const size_t rbase = (size_t)b * SEQ;
    f32x4 sacc[4];
#pragma unroll
    for (int i = 0; i < 4; ++i) sacc[i] = (f32x4){0.f, 0.f, 0.f, 0.f};
    for (int i = tid; i < 64 * 128; i += 512) SB[(i >> 7) * 136 + (i & 127)] = 0;
    u32x4 rc[2], rb[2], rx; float rdt = 0.f;
    auto prefetch = [&](int c) {
        const size_t row0 = rbase + (size_t)c * 64;
#pragma unroll
        for (int i = 0; i < 2; ++i) { const int item = tid + 512 * i, ll = item >> 4, ng = item & 15;
            rc[i] = *(const u32x4*)(XBC + (row0 + ll) * 1024 + 768 + g * 128 + ng * 8); rb[i] = *(const u32x4*)(XBC + (row0 + ll) * 1024 + 512 + g * 128 + ng * 8); }
        rx = *(const u32x4*)(XBC + (row0 + (tid >> 3)) * 1024 + h * 64 + (tid & 7) * 8);
        if (tid < 64) rdt = SM[(row0 + tid) * 160 + 128 + h];
    };
    prefetch(0);
    for (int c = 0; c < SEQ / 64; ++c) {
        const size_t row0 = rbase + (size_t)c * 64;
        if (tid < 64) { const float dt = softplusf_(rdt + dtb); float x = dt * ah;
#pragma unroll
            for (int o = 1; o < 64; o <<= 1) { const float y = __shfl_up(x, o); if (lane >= o) x += y; }
            F[tid] = x; F[64 + tid] = dt; }
        __syncthreads();
        const float acs_last = F[63];
#pragma unroll
        for (int i = 0; i < 2; ++i) { const int item = tid + 512 * i, ll = item >> 4, ng = item & 15;
            *(LAS u32x4*)(CB + ll * 136 + ng * 8) = rc[i]; *(LAS u32x4*)(BB + ll * 192 + tm_shift(ll) + ng * 8) = rb[i];
            const float ea = __expf(F[ll]); float cv[8]; conv_unpack(rc[i], cv);
            u32x4 w; w.x = pk2(cv[0] * ea, cv[1] * ea); w.y = pk2(cv[2] * ea, cv[3] * ea); w.z = pk2(cv[4] * ea, cv[5] * ea); w.w = pk2(cv[6] * ea, cv[7] * ea);
            *(LAS u32x4*)(AY + ll * 200 + 64 + ng * 8) = w; }
        { const int ll = tid >> 3, pg = tid & 7; float xv[8]; conv_unpack(rx, xv); const float dtl = F[64 + ll], ee = __expf(acs_last - F[ll]);
          float xd[8];
#pragma unroll
          for (int e = 0; e < 8; ++e) xd[e] = xv[e] * dtl;
          u32x4 w; w.x = pk2(xd[0], xd[1]); w.y = pk2(xd[2], xd[3]); w.z = pk2(xd[4], xd[5]); w.w = pk2(xd[6], xd[7]);
          *(LAS u32x4*)(XD + ll * 128 + tm_shift(ll) + pg * 8) = w;
          w.x = pk2(xd[0] * ee, xd[1] * ee); w.y = pk2(xd[2] * ee, xd[3] * ee); w.z = pk2(xd[4] * ee, xd[5] * ee); w.w = pk2(xd[6] * ee, xd[7] * ee);
          *(LAS u32x4*)(XE + ll * 128 + tm_shift(ll) + pg * 8) = w;
          *(LAS u32x4*)(XS + ll * 72 + pg * 8) = rx; }
        __syncthreads();
        if (c + 1 < SEQ / 64) prefetch(c + 1);
        bf16_t zpre[2][4];
#pragma unroll
        for (int q = 0; q < 2; ++q) { const int tt = wave + 8 * q, tl = tt >> 2, tp = tt & 3;
#pragma unroll
            for (int j = 0; j < 4; ++j) zpre[q][j] = Z[(row0 + tl * 16 + kg * 4 + j) * 512 + h * 64 + tp * 16 + r]; }
#pragma unroll
        for (int q = 0; q < 2; ++q) { const int tt = wave + 8 * q, tl = tt >> 2, ts = tt & 3;
            f32x4 acc = (f32x4){0.f, 0.f, 0.f, 0.f};
            if (ts <= tl) acc = mma_t<128, 0, 2>(CB, 136, tl * 16, BB, 192, ts * 16, acc, lane);
            const int sc = ts * 16 + r; const float as = F[sc];
#pragma unroll
            for (int j = 0; j < 4; ++j) { const int ll = tl * 16 + kg * 4 + j; const float v = (sc <= ll) ? acc[j] * __expf(F[ll] - as) : 0.f; AY[ll * 200 + sc] = f2bf(v); } }
        __syncthreads();
#pragma unroll
        for (int q = 0; q < 2; ++q) { const int tt = wave + 8 * q, tl = tt >> 2, tp = tt & 3;
            f32x4 acc = (f32x4){0.f, 0.f, 0.f, 0.f};
            acc = mma_t<64, 0, 1>(AY, 200, tl * 16, XD, 128, tp * 16, acc, lane);
            acc = mma_t<128, 0, 0>(AY + 64, 200, tl * 16, SB, 136, tp * 16, acc, lane);
            const int pp = tp * 16 + r;
#pragma unroll
            for (int j = 0; j < 4; ++j) { const int ll = tl * 16 + kg * 4 + j; bf16_t* zp = Z + (row0 + ll) * 512 + h * 64 + pp;
                const float y = acc[j] + dsk * bf2f(XS[ll * 72 + pp]); *zp = f2bf(y * siluf_(bf2f(zpre[q][j]))); } }
        const float dl = __expf(acs_last);
#pragma unroll
        for (int i = 0; i < 4; ++i) { const int id = wave * 4 + i, tp = id >> 3, tn = id & 7;
            sacc[i] = sacc[i] * dl; sacc[i] = mma_t<64, 1, 1>(XE, 128, tp * 16, BB, 192, tn * 16, sacc[i], lane); }
        __syncthreads();
#pragma unroll
        for (int i = 0; i < 4; ++i) { const int id = wave * 4 + i, tp = id >> 3, tn = id & 7;
#pragma unroll
            for (int j = 0; j < 4; ++j) SB[(tp * 16 + kg * 4 + j) * 136 + tn * 16 + r] = f2bf(sacc[i][j]); }
    }
}
__device__ void gla_chunk(const Params& p, int l, int unit, LAS unsigned char* lds, int TIDX) {
    const int bh = unit >> 1, eh = unit & 1, b = bh >> 2, h = bh & 3, tid = TIDX, wave = tid >> 6, lane = tid & 63, r = lane & 15, kg = lane >> 4;
    LAS bf16_t* KG = (LAS bf16_t*)lds;
    LAS bf16_t* AY = (LAS bf16_t*)(lds + 9216);
    LAS bf16_t* SB = (LAS bf16_t*)(lds + 26624);
    LAS bf16_t* VV = (LAS bf16_t*)(lds + 35840);
    LAS bf16_t* KD = (LAS bf16_t*)(lds + 52224);
    LAS float* G = (LAS float*)(lds + 68608);
    LAS float* UP = (LAS float*)(lds + 85248);
    LAS float* GD = (LAS float*)(lds + 89344);
    LAS float* SEG = (LAS float*)(lds + 93440);
    const bf16_t* GQ = (const bf16_t*)(p.ws + OFF_GQ); const bf16_t* GK = (const bf16_t*)(p.ws + OFF_GK); const float* SM = (const float*)(p.ws + OFF_SMALL);
    bf16_t* GV = (bf16_t*)(p.ws + OFF_Y3) + (size_t)2 * T * 512;
    const size_t rbase = (size_t)b * SEQ;
    const int ll = tid >> 3, dg = tid & 7;
    for (int i = tid; i < 16 * 64; i += 512) UP[i] = p.in[I_GKUP][((size_t)l * 16 + (i >> 6)) * 256 + h * 64 + (i & 63)];
    float gkb[8];
#pragma unroll
    for (int e = 0; e < 8; ++e) gkb[e] = p.in[I_GKB][l * 256 + h * 64 + dg * 8 + e];
    f32x4 sacc[2];
    sacc[0] = sacc[1] = (f32x4){0.f, 0.f, 0.f, 0.f};
    for (int i = tid; i < 64 * 64; i += 512) SB[(i >> 6) * 72 + (i & 63)] = 0;
    u32x4 rq, rk, rv; f32x4 rg = (f32x4){0.f, 0.f, 0.f, 0.f};
    auto prefetch = [&](int c) {
        const size_t row0 = rbase + (size_t)c * 64;
        rq = *(const u32x4*)(GQ + (row0 + ll) * 256 + h * 64 + dg * 8); rk = *(const u32x4*)(GK + (row0 + ll) * 256 + h * 64 + dg * 8);
        rv = *(const u32x4*)(GV + (row0 + ll) * 512 + h * 128 + eh * 64 + dg * 8);
        if (tid < 256) rg = *(const f32x4*)(SM + (row0 + (tid >> 2)) * 160 + 136 + (tid & 3) * 4);
    };
    prefetch(0);
    for (int c = 0; c < SEQ / 64; ++c) {
        const size_t row0 = rbase + (size_t)c * 64;
        if (tid < 256) *(LAS f32x4*)(GD + (tid >> 2) * 16 + (tid & 3) * 4) = rg;
        __syncthreads();
        { float gp[8];
#pragma unroll
          for (int e = 0; e < 8; ++e) gp[e] = gkb[e];
#pragma unroll
          for (int q = 0; q < 16; ++q) { const float gd = GD[ll * 16 + q];
#pragma unroll
              for (int e = 0; e < 8; ++e) gp[e] += gd * UP[q * 64 + dg * 8 + e]; }
#pragma unroll
          for (int e = 0; e < 8; ++e) G[ll * 65 + dg * 8 + e] = (fminf(gp[e], 0.f) - __logf(1.f + __expf(-fabsf(gp[e])))) * (1.f / 16.f); }
        __syncthreads();
        { const int d = tid & 63, sg = tid >> 6; float gv[8]; float a = 0.f;
#pragma unroll
          for (int q = 0; q < 8; ++q) { a += G[(sg * 8 + q) * 65 + d]; gv[q] = a; }
          SEG[sg * 64 + d] = a;
          __syncthreads();
          float off = 0.f;
#pragma unroll
          for (int q = 0; q < 7; ++q) off += (q < sg) ? SEG[q * 64 + d] : 0.f;
#pragma unroll
          for (int q = 0; q < 8; ++q) G[(sg * 8 + q) * 65 + d] = gv[q] + off; }
        __syncthreads();
        { float qv[8], kv[8]; conv_unpack(rq, qv); conv_unpack(rk, kv);
          float qg[8], ki[8], kd[8];
#pragma unroll
          for (int e = 0; e < 8; ++e) { const int d = dg * 8 + e; const float gl = G[ll * 65 + d], glast = G[63 * 65 + d];
              qg[e] = qv[e] * 0.125f * __expf(gl); ki[e] = kv[e] * __expf(-gl); kd[e] = kv[e] * __expf(glast - gl); }
          u32x4 w; w.x = pk2(qg[0], qg[1]); w.y = pk2(qg[2], qg[3]); w.z = pk2(qg[4], qg[5]); w.w = pk2(qg[6], qg[7]);
          *(LAS u32x4*)(AY + ll * 136 + 64 + dg * 8) = w;
          w.x = pk2(ki[0], ki[1]); w.y = pk2(ki[2], ki[3]); w.z = pk2(ki[4], ki[5]); w.w = pk2(ki[6], ki[7]);
          *(LAS u32x4*)(KG + ll * 72 + dg * 8) = w;
          w.x = pk2(kd[0], kd[1]); w.y = pk2(kd[2], kd[3]); w.z = pk2(kd[4], kd[5]); w.w = pk2(kd[6], kd[7]);
          *(LAS u32x4*)(KD + ll * 128 + tm_shift(ll) + dg * 8) = w;
          *(LAS u32x4*)(VV + ll * 128 + tm_shift(ll) + dg * 8) = rv; }
        __syncthreads();
        if (c + 1 < SEQ / 64) prefetch(c + 1);
#pragma unroll
        for (int q = 0; q < 2; ++q) { const int tt = wave + 8 * q, tl = tt >> 2, ts = tt & 3;
            f32x4 acc = (f32x4){0.f, 0.f, 0.f, 0.f};
            if (ts <= tl) acc = mma_t<64, 0, 0>(AY + 64, 136, tl * 16, KG, 72, ts * 16, acc, lane);
            const int sc = ts * 16 + r;
#pragma unroll
            for (int j = 0; j < 4; ++j) { const int l2 = tl * 16 + kg * 4 + j; AY[l2 * 136 + sc] = f2bf((sc <= l2) ? acc[j] : 0.f); } }
        __syncthreads();
#pragma unroll
        for (int q = 0; q < 2; ++q) { const int tt = wave + 8 * q, tl = tt >> 2, te = tt & 3;
            f32x4 acc = (f32x4){0.f, 0.f, 0.f, 0.f};
            acc = mma_t<64, 0, 1>(AY, 136, tl * 16, VV, 128, te * 16, acc, lane);
            acc = mma_t<64, 0, 0>(AY + 64, 136, tl * 16, SB, 72, te * 16, acc, lane);
#pragma unroll
            for (int j = 0; j < 4; ++j) GV[(row0 + tl * 16 + kg * 4 + j) * 512 + h * 128 + eh * 64 + te * 16 + r] = f2bf(acc[j]); }
#pragma unroll
        for (int i = 0; i < 2; ++i) { const int id = wave * 2 + i, te = id >> 2, td = id & 3;
            const float dl = __expf(G[63 * 65 + td * 16 + r]);
            sacc[i] = sacc[i] * dl; sacc[i] = mma_t<64, 1, 1>(VV, 128, te * 16, KD, 128, td * 16, sacc[i], lane); }
        __syncthreads();
#pragma unroll
        for (int i = 0; i < 2; ++i) { const int id = wave * 2 + i, te = id >> 2, td = id & 3;
#pragma unroll
            for (int j = 0; j < 4; ++j) SB[(te * 16 + kg * 4 + j) * 72 + td * 16 + r] = f2bf(sacc[i][j]); }
    }
}
__device__ void scans_naive_phase(const Params& p, int l, LAS unsigned char* lds, int TIDX, int BIDX) {
    const int wave = TIDX >> 6;
    LAS float* wl = (LAS float*)(lds + wave * 4096);
    if (BIDX < 128) { rwkv_scan_fast(p, l, BIDX, lds, TIDX); return; }
    const int u = BIDX - 128;
    if (u < 32) mamba2_chunk(p, l, u, lds, TIDX);
    else if (u < 64) gla_chunk(p, l, u - 32, lds, TIDX);
}
__device__ void post_phase(const Params& p, int l, int TIDX, int BIDX, int dry) {
    const int lane = TIDX & 63, gw = BIDX * 8 + (TIDX >> 6), NGW = gridDim.x * 8;
    const bf16_t* RKV = (const bf16_t*)(p.ws + OFF_RKV); const bf16_t* A = (const bf16_t*)(p.ws + OFF_A);
    bf16_t* Y0 = (bf16_t*)(p.ws + OFF_Y3); bf16_t* Y1 = Y0 + (size_t)T * 512; bf16_t* Y2 = Y1 + (size_t)T * 512;
    const int c0 = lane * 8;
    float mur[8], muk[8], muv[8], kA[8], rk[8], lg[8], lb[8], nw1[8], nw2[8];
#pragma unroll
    for (int e = 0; e < 8; ++e) { const int c = c0 + e;
        mur[e] = p.in[I_MU][l * 1664 + c]; muk[e] = p.in[I_MU][l * 1664 + 512 + c]; muv[e] = p.in[I_MU][l * 1664 + 1024 + c];
        kA[e] = p.in[I_KA][l * 512 + c]; rk[e] = p.in[I_RK][l * 512 + c]; lg[e] = p.in[I_LNG][l * 512 + c]; lb[e] = p.in[I_LNB][l * 512 + c];
        nw1[e] = p.in[I_M2NW][l * 512 + c]; nw2[e] = p.in[I_GNW][l * 128 + (c & 127)]; }
    for (int row = gw; row < T; row += NGW) {
        const bool first = (row & (SEQ - 1)) == 0;
        float y[8], r[8], k[8], v[8], a[8];
        u32x4 ysave;
        { const u32x4 yy = *(const u32x4*)(Y0 + (size_t)row * 512 + c0); ysave = yy; const u32x4 aa = *(const u32x4*)(A + (size_t)row * 512 + c0);
          const u32x4 rr = *(const u32x4*)(RKV + (size_t)row * 1536 + c0), kk = *(const u32x4*)(RKV + (size_t)row * 1536 + 512 + c0), vv = *(const u32x4*)(RKV + (size_t)row * 1536 + 1024 + c0);
          u32x4 rp = (u32x4){0, 0, 0, 0}, kp = rp, vp = rp;
          if (!first) { rp = *(const u32x4*)(RKV + (size_t)(row - 1) * 1536 + c0); kp = *(const u32x4*)(RKV + (size_t)(row - 1) * 1536 + 512 + c0); vp = *(const u32x4*)(RKV + (size_t)(row - 1) * 1536 + 1024 + c0); }
#pragma unroll
          for (int q = 0; q < 4; ++q) {
              y[2 * q] = lo_bf(yy[q]); y[2 * q + 1] = hi_bf(yy[q]); a[2 * q] = lo_bf(aa[q]); a[2 * q + 1] = hi_bf(aa[q]);
              float x0 = lo_bf(rr[q]), x1 = hi_bf(rr[q]); r[2 * q] = x0 + mur[2 * q] * (lo_bf(rp[q]) - x0); r[2 * q + 1] = x1 + mur[2 * q + 1] * (hi_bf(rp[q]) - x1);
              x0 = lo_bf(kk[q]); x1 = hi_bf(kk[q]); k[2 * q] = x0 + muk[2 * q] * (lo_bf(kp[q]) - x0); k[2 * q + 1] = x1 + muk[2 * q + 1] * (hi_bf(kp[q]) - x1);
              x0 = lo_bf(vv[q]); x1 = hi_bf(vv[q]); v[2 * q] = x0 + muv[2 * q] * (lo_bf(vp[q]) - x0); v[2 * q + 1] = x1 + muv[2 * q + 1] * (hi_bf(vp[q]) - x1); } }
        float s = 0.f, bs = 0.f;
#pragma unroll
        for (int e = 0; e < 8; ++e) { s += y[e]; bs += r[e] * (k[e] * (1.f + (a[e] - 1.f) * kA[e])) * rk[e]; }
        s += __shfl_xor(s, 1); s += __shfl_xor(s, 2); s += __shfl_xor(s, 4);
        bs += __shfl_xor(bs, 1); bs += __shfl_xor(bs, 2); bs += __shfl_xor(bs, 4);
        const float mean = s * (1.f / 64.f); float s2 = 0.f;
#pragma unroll
        for (int e = 0; e < 8; ++e) { const float d = y[e] - mean; s2 += d * d; }
        s2 += __shfl_xor(s2, 1); s2 += __shfl_xor(s2, 2); s2 += __shfl_xor(s2, 4);
        const float rstd = rsqrtf(s2 * (1.f / 64.f) + 64e-5f);
        { float o[8];
#pragma unroll
          for (int e = 0; e < 8; ++e) o[e] = (y[e] - mean) * rstd * lg[e] + lb[e] + bs * v[e];
          u32x4 w; w.x = pk2(o[0], o[1]); w.y = pk2(o[2], o[3]); w.z = pk2(o[4], o[5]); w.w = pk2(o[6], o[7]);
          *(u32x4*)(Y0 + (size_t)row * 512 + c0) = dry ? ysave : w; }
        { const u32x4 yy = *(const u32x4*)(Y1 + (size_t)row * 512 + c0); float q2 = 0.f;
#pragma unroll
          for (int q = 0; q < 4; ++q) { y[2 * q] = lo_bf(yy[q]); y[2 * q + 1] = hi_bf(yy[q]); q2 += y[2 * q] * y[2 * q] + y[2 * q + 1] * y[2 * q + 1]; }
          q2 += __shfl_xor(q2, 1); q2 += __shfl_xor(q2, 2); q2 += __shfl_xor(q2, 4); q2 += __shfl_xor(q2, 8); q2 += __shfl_xor(q2, 16);
          const float rs = rsqrtf(q2 * (1.f / 256.f) + 1e-5f);
          u32x4 w; w.x = pk2(y[0] * rs * nw1[0], y[1] * rs * nw1[1]); w.y = pk2(y[2] * rs * nw1[2], y[3] * rs * nw1[3]); w.z = pk2(y[4] * rs * nw1[4], y[5] * rs * nw1[5]); w.w = pk2(y[6] * rs * nw1[6], y[7] * rs * nw1[7]);
          *(u32x4*)(Y1 + (size_t)row * 512 + c0) = dry ? yy : w; }
        { const u32x4 yy = *(const u32x4*)(Y2 + (size_t)row * 512 + c0); float q2 = 0.f;
#pragma unroll
          for (int q = 0; q < 4; ++q) { y[2 * q] = lo_bf(yy[q]); y[2 * q + 1] = hi_bf(yy[q]); q2 += y[2 * q] * y[2 * q] + y[2 * q + 1] * y[2 * q + 1]; }
          q2 += __shfl_xor(q2, 1); q2 += __shfl_xor(q2, 2); q2 += __shfl_xor(q2, 4); q2 += __shfl_xor(q2, 8);
          const float rs = rsqrtf(q2 * (1.f / 128.f) + 1e-5f);
          u32x4 w; w.x = pk2(y[0] * rs * nw2[0], y[1] * rs * nw2[1]); w.y = pk2(y[2] * rs * nw2[2], y[3] * rs * nw2[3]); w.z = pk2(y[4] * rs * nw2[4], y[5] * rs * nw2[5]); w.w = pk2(y[6] * rs * nw2[6], y[7] * rs * nw2[7]);
          *(u32x4*)(Y2 + (size_t)row * 512 + c0) = dry ? yy : w; }
    }
}

constexpr int NPHASE = 18;
#ifndef EXP_S
#define EXP_S -1
#endif
#ifndef DIAG
#define DIAG 0
#endif
#ifndef DIAG_A
#define DIAG_A(ph, s) ((ph) >= 2 && (s) == 2)
#endif
#ifndef DIAG_B
#define DIAG_B(ph, s) ((ph) >= 2 && ((s) == 0 || (s) >= 4 && (s) <= 6))
#endif
#ifndef PHM
#define PHM 1023
#endif
__global__ __launch_bounds__(512, 2) void mega(Params p) {
    extern __shared__ __attribute__((aligned(16))) unsigned char shm[];
    LAS unsigned char* lds = (LAS unsigned char*)shm;
    cg::grid_group grid = cg::this_grid();
    volatile LAS unsigned* xst = (volatile LAS unsigned*)(lds + 131072);
    if (threadIdx.x < 2) xst[threadIdx.x] = 0u;
    __syncthreads();
    const XcdBarrier xb = xcd_barrier_post((unsigned*)(p.ws + OFF_BAR), xst);
#if DIAG
    unsigned long long tA = 0, tB = 0;
#endif
    for (int ph = p.ph_lo; ph < p.ph_hi; ++ph) {
        const int TIDX = tid_opaque(), BIDX = bid_opaque();
#if DIAG
        const unsigned long long t_start = __builtin_amdgcn_s_memrealtime();
#endif
        if (ph == 0) { if (PHM & 1) { wprep(p, 0, lds, TIDX, BIDX); ada_phase(p, lds, TIDX, BIDX); } }
        else if (ph == 1) { if (PHM & 2) ln1_phase(p, 0, p.in[I_X], TIDX, BIDX); }
        else {
            const int l = (ph - 2) >> 3, s = (ph - 2) & 7;
            const float* xin = l == 0 ? p.in[I_X] : p.out;
            pg8::StaticOrder S;
            if (s == 0 && (PHM & 4)) { pg8::Gemm g{(const bf16_t*)(p.ws + OFF_H), (const bf16_t*)(p.ws + OFF_WT1), T, 4352, 1024, 1 << 30, 0};
                S.init(g.M, g.N, gridDim.x, BIDX); Epi<0> E{p.ws, nullptr, nullptr, nullptr, 0}; pg8::gemm_phase(lds, g, S, E, TIDX); }
            else if (s == 1 && (PHM & 8)) { if (EXP_S == 1) { rwkv_prep_phase(p, l, lds, TIDX, BIDX, xb, 1); xcd_barrier(xb); } rwkv_prep_phase(p, l, lds, TIDX, BIDX, xb, 0); }
            else if (s == 2 && (PHM & 16)) { scans_naive_phase(p, l, lds, TIDX, BIDX); }
            else if (s == 3 && (PHM & 32)) { if (EXP_S == 3) { post_phase(p, l, TIDX, BIDX, 1); xcd_barrier(xb); } post_phase(p, l, TIDX, BIDX, 0); }
            else if (s == 4 && (PHM & 64)) { pg8::Gemm g{(const bf16_t*)(p.ws + OFF_H), (const bf16_t*)(p.ws + OFF_WT1) + (size_t)4352 * 1024, T, 4096, 1024, 1 << 30, 0};
                S.init(g.M, g.N, gridDim.x, BIDX); Epi<1> E{p.ws, nullptr, nullptr, nullptr, 0}; if (EXP_S == s) { E.dry = 1; pg8::gemm_phase(lds, g, S, E, TIDX); xcd_barrier(xb); E.dry = 0; } pg8::gemm_phase(lds, g, S, E, TIDX); }
            else if (s == 5 && (PHM & 128)) { pg8::Gemm g{(const bf16_t*)(p.ws + OFF_Y3), (const bf16_t*)(p.ws + OFF_WT2), T, 1024, 512, 4, (size_t)T * 512 * 2};
                S.init(g.M, g.N, gridDim.x, BIDX, 3); Epi<2> E{p.ws, nullptr, nullptr, nullptr, 0}; if (EXP_S == s) { E.dry = 1; pg8::gemm_phase(lds, g, S, E, TIDX); xcd_barrier(xb); E.dry = 0; } pg8::gemm_phase(lds, g, S, E, TIDX); }
            else if (s == 6 && (PHM & 256)) { pg8::Gemm g{(const bf16_t*)(p.ws + OFF_H), (const bf16_t*)(p.ws + OFF_WT3), T, 1024, 1024, 1 << 30, 0};
                S.init(g.M, g.N, gridDim.x, BIDX); Epi<3> E{p.ws, xin, (const float*)(p.ws + OFF_MOD) + (size_t)l * 4 * 3072, p.out, 0}; if (EXP_S == s) { E.dry = 1; pg8::gemm_phase(lds, g, S, E, TIDX); xcd_barrier(xb); E.dry = 0; } pg8::gemm_phase(lds, g, S, E, TIDX); }
            else if (s == 7 && (PHM & 512)) { if (EXP_S == 7) { lnpost_phase(p, l, TIDX, BIDX, 1); if (l == 0) wprep(p, 1, lds, TIDX, BIDX); xcd_barrier(xb); } lnpost_phase(p, l, TIDX, BIDX, 0); if (l == 0) wprep(p, 1, lds, TIDX, BIDX); }
        }
        if (ph + 1 < p.ph_hi) { if (ph == p.ph_lo) grid.sync(); else xcd_barrier(xb); }
#if DIAG
        { const unsigned long long dt = __builtin_amdgcn_s_memrealtime() - t_start; const int s_ = (ph - 2) & 7;
          if (DIAG_A(ph, s_)) tA += dt; if (DIAG_B(ph, s_)) tB += dt; }
#endif
    }
#if DIAG
    grid.sync();
    if (blockIdx.x == 0) {
        const float vA = (float)tA * 10.f, vB = (float)tB * 10.f;
        for (int i = threadIdx.x; i < (1 << 20); i += 512) p.out[4096 + i] = vB;
        if (threadIdx.x == 0) p.out[0] = vA * 1000.f;
    }
#endif
}

extern "C" void kernel_launch(void* const* d_in, const int* in_sizes, int n_in, void* d_out, int out_size, void* d_ws, size_t ws_size, hipStream_t stream) {
    constexpr int LDS_BYTES = 131072 + 16;
    static int grid = 0;
    if (grid == 0) {
        if (n_in != 28 || out_size != T * DM || ws_size < WS_NEED) { fprintf(stderr, "kernel_launch: unexpected shapes / workspace (%zu < %zu)\n", ws_size, (size_t)WS_NEED); grid = -1; return; }
        int dev = 0, cus = 0, per_cu = 0;
        hipGetDevice(&dev); hipDeviceGetAttribute(&cus, hipDeviceAttributeMultiprocessorCount, dev);
        if (hipFuncSetAttribute((const void*)mega, hipFuncAttributeMaxDynamicSharedMemorySize, LDS_BYTES) != hipSuccess) { fprintf(stderr, "hipFuncSetAttribute failed\n"); grid = -1; return; }
        if (hipOccupancyMaxActiveBlocksPerMultiprocessor(&per_cu, (const void*)mega, 512, LDS_BYTES) != hipSuccess || per_cu < 1) per_cu = 1;
        (void)hipGetLastError();
        grid = cus * 1;
        if (grid != 256) { fprintf(stderr, "kernel_launch: built for 256 CUs\n"); grid = -1; return; }
    }
    if (grid < 0) return;
    if (hipMemsetAsync((char*)d_ws + OFF_BAR, 0, XCD_BAR_WORDS_B, stream) != hipSuccess) { fprintf(stderr, "kernel_launch: memset of barrier words failed\n"); return; }
    Params p{};
    for (int i = 0; i < 28; ++i) p.in[i] = (const float*)d_in[i];
    p.out = (float*)d_out; p.ws = (unsigned char*)d_ws;
#if N_LAUNCH_MODE == 1
    p.ph_lo = 0; p.ph_hi = NPHASE;
    void* args[] = {&p};
    hipError_t e = hipLaunchCooperativeKernel((const void*)mega, dim3(grid), dim3(512), args, LDS_BYTES, stream);
    if (e != hipSuccess) fprintf(stderr, "cooperative launch failed: %s (grid %d)\n", hipGetErrorString(e), grid);
#else
    for (int ph = 0; ph < NPHASE; ++ph) { p.ph_lo = ph; p.ph_hi = ph + 1; hipLaunchKernelGGL(mega, dim3(grid), dim3(512), LDS_BYTES, stream, p); }
#endif
}
```

```cpp
#include <hip/hip_runtime.h>
#include <hip/hip_cooperative_groups.h>
#include <cstdio>
namespace cg = cooperative_groups;

#ifndef N_LAUNCH_MODE
#define N_LAUNCH_MODE 1
#endif

#define LAS __attribute__((address_space(3)))
typedef unsigned short bf16_t;
typedef short bf16x8 __attribute__((ext_vector_type(8)));
typedef float f32x4 __attribute__((ext_vector_type(4)));
typedef unsigned u32x4 __attribute__((ext_vector_type(4)));
typedef unsigned u32x2 __attribute__((ext_vector_type(2)));

constexpr int T = 32768, SEQ = 8192, DM = 1024, NB = 4;
constexpr int INW = 8344;
constexpr float ALPHA_DN = 1.4142135623730951f;

constexpr size_t XCD_BAR_WORDS_B = 3456 * 4;
constexpr size_t SZ_WT1 = (size_t)8448 * 1024 * 2, SZ_WT2 = (size_t)3072 * 512 * 2, SZ_WT3 = (size_t)1024 * 3072 * 2, SZ_MOD = (size_t)2 * 4 * 3072 * 4;
constexpr size_t OFF_WT1 = 0, OFF_WT2 = OFF_WT1 + SZ_WT1, OFF_WT3 = OFF_WT2 + SZ_WT2, OFF_MOD = OFF_WT3 + SZ_WT3;
constexpr size_t OFF_H = OFF_MOD + SZ_MOD;
constexpr size_t OFF_Y3 = OFF_H + (size_t)T * 1024 * 2;
constexpr size_t OFF_RKV = OFF_Y3 + (size_t)3 * T * 512 * 2;
constexpr size_t OFF_XBC = OFF_RKV + (size_t)T * 1536 * 2;
constexpr size_t OFF_GQ = OFF_XBC + (size_t)T * 1024 * 2;
constexpr size_t OFF_GK = OFF_GQ + (size_t)T * 256 * 2;
constexpr size_t OFF_SMALL = OFF_GK + (size_t)T * 256 * 2;
constexpr size_t OFF_A = OFF_SMALL + (size_t)T * 160 * 4;
constexpr size_t OFF_DEC = OFF_A + (size_t)T * 512 * 2;
constexpr size_t WS_END = OFF_DEC + (size_t)T * 512 * 4;
constexpr size_t OFF_BAR = (WS_END + 255) & ~(size_t)255;
constexpr size_t WS_NEED = OFF_BAR + XCD_BAR_WORDS_B;
constexpr size_t OFF_GATES = OFF_RKV;
static_assert(OFF_GK + (size_t)T * 256 * 2 - OFF_RKV == (size_t)T * 3072 * 2, "gates alias");

struct Params { const float* in[28]; float* out; unsigned char* ws; int ph_lo, ph_hi; };
enum { I_X = 0, I_C, I_ADAW, I_ADAB, I_WIN, I_MU, I_W0, I_WUP, I_A0, I_AUP, I_KK, I_KA, I_RK, I_LNG, I_LNB, I_CONVW, I_CONVB, I_DTB, I_ALOG, I_DSKIP,
       I_M2NW, I_GKUP, I_GKB, I_GNW, I_WBR, I_WOUT, I_PG, I_PB };

__device__ __forceinline__ float bf2f(bf16_t v) { return __uint_as_float(((unsigned)v) << 16); }
__device__ __forceinline__ bf16_t f2bf(float f) { unsigned u = __float_as_uint(f); u += 0x7FFFu + ((u >> 16) & 1u); return (bf16_t)(u >> 16); }
__device__ __forceinline__ unsigned pk2(float lo, float hi) { return (unsigned)f2bf(lo) | ((unsigned)f2bf(hi) << 16); }
__device__ __forceinline__ float lo_bf(unsigned w) { return __uint_as_float(w << 16); }
__device__ __forceinline__ float hi_bf(unsigned w) { return __uint_as_float(w & 0xFFFF0000u); }
__device__ __forceinline__ float sigmoidf_(float x) { return __builtin_amdgcn_rcpf(1.0f + __expf(-x)); }
__device__ __forceinline__ float siluf_(float x) { return x / (1.0f + __expf(-x)); }
__device__ __forceinline__ float softplusf_(float x) { return x > 20.f ? x : log1pf(__expf(x)); }
__device__ __forceinline__ float wave_sum(float v) {
#pragma unroll
    for (int o = 1; o < 64; o <<= 1) v += __shfl_xor(v, o);
    return v;
}
__device__ __forceinline__ int tid_opaque() { int t = threadIdx.x; asm volatile("" : "+v"(t)); return t; }
__device__ __forceinline__ int bid_opaque() { int t = blockIdx.x; asm volatile("" : "+s"(t)); return t; }
#define WAVE_LDS_SYNC() do { asm volatile("s_waitcnt lgkmcnt(0)" ::: "memory"); __builtin_amdgcn_wave_barrier(); } while (0)


#define XB_TMO      128
#define XB_XCNT(j)  (256  + 64 * (j))
#define XB_XSUB(j)  (1280 + 64 * (j))
#define XB_XGEN(j)  (2304 + 64 * (j))
#define XB_TOP      3328
#define XB_TOPGEN   3392
#define XCD_BAR_WORDS 3456
#define XB_SPIN_CAP (1u << 20)
__device__ __forceinline__ unsigned xb_ld(unsigned* p)              { return __hip_atomic_load(p, __ATOMIC_RELAXED, __HIP_MEMORY_SCOPE_AGENT); }
__device__ __forceinline__ unsigned xb_add(unsigned* p, unsigned v) { return __hip_atomic_fetch_add(p, v, __ATOMIC_RELAXED, __HIP_MEMORY_SCOPE_AGENT); }
__device__ __forceinline__ unsigned xb_xcc_id() { return (unsigned)__builtin_amdgcn_s_getreg((3 << 11) | 20) & 0xFu; }
#define XB_SPIN(cond, bar) do { unsigned _sp = 0; while (cond) { __builtin_amdgcn_s_sleep(1); \
    if ((++_sp & 255u) == 0u) { if (xb_ld(&(bar)[XB_TMO])) break; if (_sp > XB_SPIN_CAP) { atomicAdd(&(bar)[XB_TMO], 1u); break; } } } } while (0)
struct XcdBarrier { unsigned* bar; unsigned x; volatile LAS unsigned* st; };
__device__ __forceinline__ XcdBarrier xcd_barrier_post(unsigned* bar, volatile LAS unsigned* st) {
    XcdBarrier b; b.bar = bar; b.x = xb_xcc_id(); b.st = st;
    if (threadIdx.x == 0) (void)xb_add(&bar[XB_XCNT(b.x)], 1u);
    return b;
}
__device__ __forceinline__ void xcd_barrier_complete(unsigned* bar, unsigned x, unsigned& nloc, unsigned& nx) {
    const unsigned G = gridDim.x * gridDim.y * gridDim.z;
    unsigned sum, cnt, mine, sp = 0u;
    for (;;) {
        sum = 0u; cnt = 0u; mine = 0u;
#pragma unroll
        for (unsigned j = 0; j < 16; ++j) { const unsigned c = xb_ld(&bar[XB_XCNT(j)]); sum += c; cnt += (c > 0u) ? 1u : 0u; mine = (j == x) ? c : mine; }
        if (sum == G) break;
        __builtin_amdgcn_s_sleep(1);
        if ((++sp & 255u) == 0u) { if (xb_ld(&bar[XB_TMO])) break; if (sp > XB_SPIN_CAP) { atomicAdd(&bar[XB_TMO], 1u); break; } }
    }
    nloc = mine > 0u ? mine : 1u; nx = cnt > 0u ? cnt : 1u;
}
__device__ __forceinline__ void xcd_barrier(const XcdBarrier& b) {
    asm volatile("s_waitcnt vmcnt(0)" ::: "memory");
    __syncthreads();
    if (threadIdx.x == 0) {
        unsigned* bar = b.bar;
        __builtin_amdgcn_s_waitcnt(0);
        unsigned nloc = b.st[0], nx = b.st[1];
        if (nloc == 0u) { xcd_barrier_complete(bar, b.x, nloc, nx); b.st[0] = nloc; b.st[1] = nx; }
        const unsigned old = xb_add(&bar[XB_XSUB(b.x)], 1u);
        const unsigned gen = old / nloc;
        if (old + 1u == (gen + 1u) * nloc) {
            __builtin_amdgcn_fence(__ATOMIC_RELEASE, "agent");
            asm volatile("s_waitcnt vmcnt(0)" ::: "memory");
            const unsigned og = xb_add(&bar[XB_TOP], 1u);
            const unsigned tg = og / nx;
            if (og + 1u == (tg + 1u) * nx) xb_add(&bar[XB_TOPGEN], 1u);
            else XB_SPIN(xb_ld(&bar[XB_TOPGEN]) == tg, bar);
            __builtin_amdgcn_fence(__ATOMIC_ACQUIRE, "agent");
            xb_add(&bar[XB_XGEN(b.x)], 1u);
            asm volatile("s_waitcnt vmcnt(0)" ::: "memory");
        } else {
            XB_SPIN(xb_ld(&bar[XB_XGEN(b.x)]) == gen, bar);
            __builtin_amdgcn_fence(__ATOMIC_ACQUIRE, "agent");
            asm volatile("s_waitcnt vmcnt(0)" ::: "memory");
        }
    }
    __syncthreads();
}
namespace pg8 {
constexpr int BM = 256, BK = 64, HALF = 128, HTB = HALF * BK * 2, STAGE_BYTES = 8 * HTB, NXCD = 8, WGM = 8;
__host__ __device__ __forceinline__ int lds_byte(int r, int c) { const int st = (r >> 4) * 2 + (c >> 5), rr = r & 15, cc = c & 31, ob = rr * 64 + cc * 2; return st * 1024 + (ob ^ (((ob >> 9) & 1) << 5)); }
__host__ __device__ __forceinline__ void stage_rc(int b, int& R, int& C) { const int st = b / 1024, sb = b % 1024, swz = sb ^ (((sb >> 9) & 1) << 5); R = (st >> 1) * 16 + swz / 64; C = (st & 1) * 32 + (swz % 64) / 2; }
__host__ __device__ __forceinline__ int perm32(int rho) { const int n = rho >> 4, i = rho & 15; return 8 * (i >> 2) + 4 * n + (i & 3); }
struct Unit { int pm, pn; };
struct Gemm { const bf16_t* A; const bf16_t* Bt; int M, N, K; int adiv; size_t astride; };
struct StaticOrder {
    int nM, nN, nwg, G, c, rep;
    __device__ void init(int M, int N, int G_, int c_, int rep_ = 1) { nM = M / BM; nN = N / BM; nwg = nM * nN; G = G_; c = c_; rep = rep_; }
    __device__ bool next(int i0, Unit& u) const {
        const int i = rep == 3 ? i0 / 3 : i0;
        const long L = (long)i * G + c; if (L >= nwg) return false;
        int wgid = (int)L; { const int q = nwg / NXCD, r = nwg % NXCD, xcd = wgid % NXCD, off = wgid / NXCD; wgid = (xcd < r ? xcd * (q + 1) : r * (q + 1) + (xcd - r) * q) + off; }
        const int nig = WGM * nN, gid = wgid / nig, fm = gid * WGM, gsz = (nM - fm) < WGM ? (nM - fm) : WGM;
        u.pm = fm + ((wgid % nig) % gsz); u.pn = (wgid % nig) / gsz; if (rep == 3) u.pn += nN * (i0 - 3 * i); return true;
    }
};
__device__ __forceinline__ unsigned cvt_pk_bf16_t(float lo, float hi) { unsigned r; asm volatile("s_nop 1\n\tv_cvt_pk_bf16_f32 %0, %1, %2" : "=v"(r) : "v"(lo), "v"(hi)); return r; }
__device__ __forceinline__ unsigned cvt_pk_bf16(float lo, float hi) { unsigned r; asm volatile("v_cvt_pk_bf16_f32 %0, %1, %2" : "=v"(r) : "v"(lo), "v"(hi)); return r; }

template <class Epi>
__device__ __forceinline__ void gemm_phase(LAS unsigned char* lds, const Gemm g, const StaticOrder& S, const Epi& E, int TIDX) {
    const int tid = TIDX, wid = __builtin_amdgcn_readfirstlane(tid >> 6), lane = tid & 63, wr = wid >> 2, wc = wid & 3, fr = lane & 15, fq = lane >> 4;
    const int K = g.K, nt = K / BK;
    unsigned voffA[2], voffB[2];
#pragma unroll
    for (int i = 0; i < 2; ++i) { int R, C; stage_rc(tid * 16 + i * 8192, R, C); const int Rb = (R & ~31) + perm32(R & 31);
        voffA[i] = (unsigned)(R * K + C) * 2u; voffB[i] = (unsigned)(Rb * K + C) * 2u; }
    const size_t kstep = (size_t)(BK * 2);
    const size_t hstep = (size_t)HALF * K * 2;
    const size_t tstep = 2 * hstep;
    const unsigned ldsw = (unsigned)wid * 1024u;
    const int aoff = lds_byte(wr * 64 + fr, fq * 8), boff = lds_byte(wc * 32 + fr, fq * 8);
#define PG8_SA(b, h) (((b) * 2 + (h)) * HTB)
#define PG8_SB(b, h) ((4 + (b) * 2 + (h)) * HTB)
#define PG8_STAGE(bufoff, gbase, voff) do { _Pragma("unroll") for (int _i = 0; _i < 2; ++_i) \
        __builtin_amdgcn_global_load_lds((const unsigned*)((const char*)(gbase) + (voff)[_i]), (LAS unsigned*)(lds + (bufoff) + ldsw + _i * 8192), 16, 0, 0); } while (0)
#define PG8_LDA(dst, b, h) do { _Pragma("unroll") for (int m = 0; m < 4; ++m) _Pragma("unroll") for (int k = 0; k < 2; ++k) dst[m][k] = *(const LAS bf16x8*)(lds + PG8_SA(b, h) + aoff + m * 2048 + k * 1024); } while (0)
#define PG8_LDB(dst, b, h) do { _Pragma("unroll") for (int n = 0; n < 2; ++n) _Pragma("unroll") for (int k = 0; k < 2; ++k) dst[n][k] = *(const LAS bf16x8*)(lds + PG8_SB(b, h) + boff + n * 2048 + k * 1024); } while (0)
#define PG8_MMA(ai, bj, At, Bt) do { __builtin_amdgcn_s_setprio(1); _Pragma("unroll") for (int m = 0; m < 4; ++m) _Pragma("unroll") for (int n = 0; n < 2; ++n) _Pragma("unroll") for (int k = 0; k < 2; ++k) \
        acc[ai][bj][m][n] = __builtin_amdgcn_mfma_f32_16x16x32_bf16(Bt[n][k], At[m][k], acc[ai][bj][m][n], 0, 0, 0); __builtin_amdgcn_s_setprio(0); } while (0)
#define PG8_WAIT_V(n) asm volatile("s_waitcnt vmcnt(" #n ")" ::: "memory")
#define PG8_WAIT_L(n) asm volatile("s_waitcnt lgkmcnt(" #n ")" ::: "memory")
#define PG8_BAR __builtin_amdgcn_s_barrier()
#define PG8_SCHED __builtin_amdgcn_sched_barrier(0)
    Unit cur, nxt; int ui = 0;
    if (!S.next(0, cur)) return;
    f32x4 acc[2][2][4][2];
#pragma unroll
    for (int a = 0; a < 2; ++a)
#pragma unroll
        for (int b = 0; b < 2; ++b)
#pragma unroll
            for (int m = 0; m < 4; ++m)
#pragma unroll
                for (int n = 0; n < 2; ++n) acc[a][b][m][n] = (f32x4){0.f, 0.f, 0.f, 0.f};
    bf16x8 At[4][2], B0[2][2], B1[2][2];
    const char* cA = (const char*)g.A + (size_t)(cur.pn / g.adiv) * g.astride + (size_t)cur.pm * tstep; const char* cB = (const char*)g.Bt + (size_t)cur.pn * tstep;
    PG8_STAGE(PG8_SB(0, 0), cB, voffB); PG8_STAGE(PG8_SA(0, 0), cA, voffA); PG8_STAGE(PG8_SB(0, 1), cB + hstep, voffB); PG8_STAGE(PG8_SA(0, 1), cA + hstep, voffA);
    if (wr == 1) PG8_BAR;
    PG8_WAIT_V(4); PG8_BAR;
    PG8_STAGE(PG8_SB(1, 0), cB + kstep, voffB); PG8_STAGE(PG8_SA(1, 0), cA + kstep, voffA); PG8_STAGE(PG8_SB(1, 1), cB + hstep + kstep, voffB);
    PG8_WAIT_V(6); PG8_BAR;
    for (;;) {
        const bool has_next = S.next(ui + 1, nxt);
        const char* nA = has_next ? (const char*)g.A + (size_t)(nxt.pn / g.adiv) * g.astride + (size_t)nxt.pm * tstep : cA; const char* nB = has_next ? (const char*)g.Bt + (size_t)nxt.pn * tstep : cB;
        for (int t = 0; t < nt; t += 2) {
            const bool last = (t == nt - 2);
            const char* a1 = cA + (size_t)(t + 1) * kstep;
            const char* a2 = last ? nA : cA + (size_t)(t + 2) * kstep; const char* b2 = last ? nB : cB + (size_t)(t + 2) * kstep;
            const char* a3 = a2 + kstep; const char* b3 = b2 + kstep;
            PG8_LDB(B0, 0, 0); PG8_SCHED; PG8_LDA(At, 0, 0); PG8_STAGE(PG8_SA(1, 1), a1 + hstep, voffA);
            PG8_WAIT_L(8); PG8_BAR; PG8_WAIT_L(0); PG8_MMA(0, 0, At, B0); PG8_BAR; PG8_SCHED;
            PG8_LDB(B1, 0, 1); PG8_STAGE(PG8_SB(0, 0), b2, voffB);
            PG8_BAR; PG8_WAIT_L(0); PG8_MMA(0, 1, At, B1); PG8_BAR;
            PG8_LDA(At, 0, 1); PG8_STAGE(PG8_SA(0, 0), a2, voffA);
            PG8_BAR; PG8_WAIT_L(0); PG8_MMA(1, 0, At, B0); PG8_BAR; PG8_SCHED;
            PG8_STAGE(PG8_SB(0, 1), b2 + hstep, voffB);
            PG8_WAIT_V(6); PG8_BAR; PG8_MMA(1, 1, At, B1); PG8_BAR;
            PG8_LDB(B0, 1, 0); PG8_SCHED; PG8_LDA(At, 1, 0); PG8_STAGE(PG8_SA(0, 1), a2 + hstep, voffA);
            PG8_WAIT_L(8); PG8_BAR; PG8_WAIT_L(0); PG8_MMA(0, 0, At, B0); PG8_BAR; PG8_SCHED;
            PG8_LDB(B1, 1, 1); PG8_STAGE(PG8_SB(1, 0), b3, voffB);
            PG8_BAR; PG8_WAIT_L(0); PG8_MMA(0, 1, At, B1); PG8_BAR;
            PG8_LDA(At, 1, 1); PG8_STAGE(PG8_SA(1, 0), a3, voffA);
            PG8_BAR; PG8_WAIT_L(0); PG8_MMA(1, 0, At, B0); PG8_BAR; PG8_SCHED;
            PG8_STAGE(PG8_SB(1, 1), b3 + hstep, voffB);
            PG8_WAIT_V(6); PG8_BAR; PG8_MMA(1, 1, At, B1); PG8_BAR;
        }
        E(acc, cur, wr, wc, fr, fq);
        if (!has_next) break;
#pragma unroll
        for (int a = 0; a < 2; ++a)
#pragma unroll
            for (int b = 0; b < 2; ++b)
#pragma unroll
                for (int m = 0; m < 4; ++m)
#pragma unroll
                    for (int n = 0; n < 2; ++n) acc[a][b][m][n] = (f32x4){0.f, 0.f, 0.f, 0.f};
        cur = nxt; cA = nA; cB = nB; ++ui;
    }
    PG8_WAIT_V(0);
    if (wr == 0) PG8_BAR;
    PG8_BAR;
#undef PG8_SA
#undef PG8_SB
#undef PG8_STAGE
#undef PG8_LDA
#undef PG8_LDB
#undef PG8_MMA
#undef PG8_WAIT_V
#undef PG8_WAIT_L
#undef PG8_BAR
#undef PG8_SCHED
}
}

template <int MODE> struct Epi {
    unsigned char* ws; const float* xin; const float* gate; float* out; int dry;
    __device__ __forceinline__ void operator()(const f32x4 (&acc)[2][2][4][2], const pg8::Unit& u, int wr, int wc, int fr, int fq) const {
        const int pn = u.pn;
        bf16_t* base = nullptr; int ld = 0, c0 = 0;
        if (MODE == 0) {
            if (pn < 6) { base = (bf16_t*)(ws + OFF_RKV); ld = 1536; c0 = pn * 256; }
            else if (pn < 10) { base = (bf16_t*)(ws + OFF_XBC); ld = 1024; c0 = (pn - 6) * 256; }
            else if (pn < 12) { base = (bf16_t*)(ws + OFF_Y3) + (size_t)T * 512; ld = 512; c0 = (pn - 10) * 256; }
            else if (pn == 12) { base = (bf16_t*)(ws + OFF_GQ); ld = 256; c0 = 0; }
            else if (pn == 13) { base = (bf16_t*)(ws + OFF_GK); ld = 256; c0 = 0; }
            else if (pn < 16) { base = (bf16_t*)(ws + OFF_Y3) + (size_t)2 * T * 512; ld = 512; c0 = (pn - 14) * 256; }
        } else if (MODE == 1) {
            if (pn < 2) { base = (bf16_t*)(ws + OFF_Y3); ld = 512; c0 = pn * 256; }
            else if (pn < 4) { base = (bf16_t*)(ws + OFF_Y3) + (size_t)2 * T * 512; ld = 512; c0 = (pn - 2) * 256; }
            else { base = (bf16_t*)(ws + OFF_GATES); ld = 3072; c0 = (pn - 4) * 256; }
        } else if (MODE == 2) { base = (bf16_t*)(ws + OFF_H); ld = 1024; c0 = (pn & 3) * 256; }
        if (MODE == 0 || (MODE == 1 && pn >= 4)) {
#pragma unroll
            for (int ai = 0; ai < 2; ++ai)
#pragma unroll
                for (int m = 0; m < 4; ++m) {
                    const int row = u.pm * 256 + ai * 128 + wr * 64 + m * 16 + fr;
#pragma unroll
                    for (int bj = 0; bj < 2; ++bj) {
                        const int cl = bj * 128 + wc * 32 + 8 * fq;
                        f32x4 v0 = acc[ai][bj][m][0], v1 = acc[ai][bj][m][1];
                        if (MODE == 0) {
                            if (pn < 16) {
                                u32x4 w; w.x = pg8::cvt_pk_bf16(v0[0], v0[1]); w.y = pg8::cvt_pk_bf16(v0[2], v0[3]); w.z = pg8::cvt_pk_bf16(v1[0], v1[1]); w.w = pg8::cvt_pk_bf16(v1[2], v1[3]);
                                *(u32x4*)(base + (size_t)row * ld + c0 + cl) = w;
                            } else if (cl < 160) {
                                float* d = (float*)(ws + OFF_SMALL) + (size_t)row * 160 + cl;
                                *(f32x4*)d = v0; *(f32x4*)(d + 4) = v1;
                            }
                        } else {
                            u32x4 w;
                            w.x = pg8::cvt_pk_bf16_t(sigmoidf_(v0[0]), sigmoidf_(v0[1])); w.y = pg8::cvt_pk_bf16_t(sigmoidf_(v0[2]), sigmoidf_(v0[3]));
                            w.z = pg8::cvt_pk_bf16_t(sigmoidf_(v1[0]), sigmoidf_(v1[1])); w.w = pg8::cvt_pk_bf16_t(sigmoidf_(v1[2]), sigmoidf_(v1[3]));
                            *(u32x4*)(base + (size_t)row * ld + c0 + cl) = w;
                        }
                    }
                }
        } else {
            f32x4 gm[2][2];
            if (MODE == 3) {
#pragma unroll
                for (int bj = 0; bj < 2; ++bj) { const int col = pn * 256 + bj * 128 + wc * 32 + 8 * fq; const int bb = (u.pm * 256) >> 13;
                    gm[bj][0] = *(const f32x4*)(gate + bb * 3072 + 2048 + col); gm[bj][1] = *(const f32x4*)(gate + bb * 3072 + 2048 + col + 4); }
            }
#pragma unroll
            for (int ai = 0; ai < 2; ++ai)
#pragma unroll
                for (int mp = 0; mp < 2; ++mp) {
                    u32x4 la[4], lb[4]; f32x4 fa[4], fb[4];
#pragma unroll
                    for (int q = 0; q < 4; ++q) { const int m = mp * 2 + (q >> 1), bj = q & 1;
                        const int row = u.pm * 256 + ai * 128 + wr * 64 + m * 16 + fr, cl = bj * 128 + wc * 32 + 8 * fq;
                        if (MODE == 1) la[q] = *(const u32x4*)(base + (size_t)row * ld + c0 + cl);
                        if (MODE == 2) { la[q] = *(const u32x4*)((const bf16_t*)(ws + OFF_GATES) + (size_t)row * 3072 + pn * 256 + cl);
                            lb[q] = (u32x4){0u, 0u, 0u, 0u}; if (pn >= 4) lb[q] = *(const u32x4*)(base + (size_t)row * ld + c0 + cl); }
                        if (MODE == 3) { const int col = pn * 256 + cl; fa[q] = *(const f32x4*)(xin + (size_t)row * 1024 + col); fb[q] = *(const f32x4*)(xin + (size_t)row * 1024 + col + 4); } }
#pragma unroll
                    for (int q = 0; q < 4; ++q) { const int m = mp * 2 + (q >> 1), bj = q & 1;
                        const int row = u.pm * 256 + ai * 128 + wr * 64 + m * 16 + fr, cl = bj * 128 + wc * 32 + 8 * fq;
                        const f32x4 v0 = acc[ai][bj][m][0], v1 = acc[ai][bj][m][1];
                        if (MODE == 1) { const u32x4 o = la[q]; u32x4 w;
                            w.x = pg8::cvt_pk_bf16(lo_bf(o.x) * siluf_(v0[0]), hi_bf(o.x) * siluf_(v0[1])); w.y = pg8::cvt_pk_bf16(lo_bf(o.y) * siluf_(v0[2]), hi_bf(o.y) * siluf_(v0[3]));
                            w.z = pg8::cvt_pk_bf16(lo_bf(o.z) * siluf_(v1[0]), hi_bf(o.z) * siluf_(v1[1])); w.w = pg8::cvt_pk_bf16(lo_bf(o.w) * siluf_(v1[2]), hi_bf(o.w) * siluf_(v1[3]));
                            *(u32x4*)(base + (size_t)row * ld + c0 + cl) = dry ? o : w; }
                        if (MODE == 2) { const u32x4 o = la[q], pm_ = lb[q]; u32x4 w;
                            w.x = pg8::cvt_pk_bf16(lo_bf(pm_.x) + lo_bf(o.x) * v0[0], hi_bf(pm_.x) + hi_bf(o.x) * v0[1]); w.y = pg8::cvt_pk_bf16(lo_bf(pm_.y) + lo_bf(o.y) * v0[2], hi_bf(pm_.y) + hi_bf(o.y) * v0[3]);
                            w.z = pg8::cvt_pk_bf16(lo_bf(pm_.z) + lo_bf(o.z) * v1[0], hi_bf(pm_.z) + hi_bf(o.z) * v1[1]); w.w = pg8::cvt_pk_bf16(lo_bf(pm_.w) + lo_bf(o.w) * v1[2], hi_bf(pm_.w) + hi_bf(o.w) * v1[3]);
                            *(u32x4*)(base + (size_t)row * ld + c0 + cl) = (dry && pn >= 4) ? pm_ : w; }
                        if (MODE == 3) { const int col = pn * 256 + cl; f32x4 r0, r1;
#pragma unroll
                            for (int j = 0; j < 4; ++j) { r0[j] = ALPHA_DN * fa[q][j] + (1.f + gm[bj][0][j]) * v0[j]; r1[j] = ALPHA_DN * fb[q][j] + (1.f + gm[bj][1][j]) * v1[j]; }
                            if (dry && xin == out) { r0 = fa[q]; r1 = fb[q]; }
                            *(f32x4*)(out + (size_t)row * 1024 + col) = r0; *(f32x4*)(out + (size_t)row * 1024 + col + 4) = r1; }
                    }
                }
        }
    }
};

__device__ __forceinline__ int wt1_src(int n) {
    if (n < 1536) return n;
    if (n < 2560) return 2176 + (n - 1536);
    if (n < 3072) return 3208 + (n - 2560);
    if (n < 3328) return 3720 + (n - 3072);
    if (n < 3584) return 3976 + (n - 3328);
    if (n < 4096) return 4232 + (n - 3584);
    if (n < 4352) { const int s = n - 4096; if (s < 128) return 1536 + s; if (s < 136) return 3200 + (s - 128); if (s < 152) return 4744 + (s - 136); return -1; }
    const int m = n - 4352;
    if (m < 512) return 1664 + m;
    if (m < 1024) return 4760 + (m - 512);
    return 5272 + (m - 1024);
}
template <bool MAP>
__device__ __forceinline__ void transpose_item(const float* W, int ldw, bf16_t* WT, int ldt, int row_off, int col_off, int nblk, LAS float* scr, int item, int lane) {
    const int kb = item / nblk, nb = item % nblk, k0 = 64 * kb, n0 = 32 * nb;
    int sc = n0 + (lane & 31); if (MAP) sc = wt1_src(sc);
#pragma unroll 8
    for (int i = 0; i < 32; ++i) { const int kk = 2 * i + (lane >> 5); scr[kk * 33 + (lane & 31)] = sc >= 0 ? W[(size_t)(k0 + kk) * ldw + sc] : 0.f; }
    WAVE_LDS_SYNC();
    const int c = lane & 7;
#pragma unroll
    for (int j = 0; j < 4; ++j) { const int n = (lane >> 3) + 8 * j; const LAS float* s = scr + (8 * c) * 33 + n;
        u32x4 o; o.x = pk2(s[0 * 33], s[1 * 33]); o.y = pk2(s[2 * 33], s[3 * 33]); o.z = pk2(s[4 * 33], s[5 * 33]); o.w = pk2(s[6 * 33], s[7 * 33]);
        *(u32x4*)(WT + (size_t)(row_off + n0 + n) * ldt + col_off + k0 + 8 * c) = o; }
    WAVE_LDS_SYNC();
}
__device__ void wprep(const Params& p, int l, LAS unsigned char* lds, int TIDX, int BIDX) {
    const int lane = TIDX & 63, wave = TIDX >> 6;
    LAS float* scr = (LAS float*)(lds + wave * 16384);
    const int gw = BIDX * 8 + wave, NGW = gridDim.x * 8;
    constexpr int I1 = (1024 / 64) * (8448 / 32), I2 = 3 * (512 / 64) * (1024 / 32), I3 = (1024 / 64) * (1024 / 32);
    bf16_t* WT1 = (bf16_t*)(p.ws + OFF_WT1); bf16_t* WT2 = (bf16_t*)(p.ws + OFF_WT2); bf16_t* WT3 = (bf16_t*)(p.ws + OFF_WT3);
    for (int it = gw; it < I1 + I2 + I3; it += NGW) {
        int r = it;
        if (r < I1) { transpose_item<true>(p.in[I_WIN] + (size_t)l * 1024 * INW, INW, WT1, 1024, 0, 0, 8448 / 32, scr, r, lane); continue; }
        r -= I1;
        if (r < I2) { const int b = r / (I2 / 3), rr = r % (I2 / 3); transpose_item<false>(p.in[I_WBR] + ((size_t)l * 3 + b) * 512 * 1024, 1024, WT2, 512, b * 1024, 0, 1024 / 32, scr, rr, lane); continue; }
        r -= I2;
        transpose_item<false>(p.in[I_WOUT] + (size_t)l * 1024 * 1024, 1024, WT3, 1024, 0, 0, 1024 / 32, scr, r, lane);
    }
}
__device__ void ada_phase(const Params& p, LAS unsigned char* lds, int TIDX, int BIDX) {
    LAS float* red = (LAS float*)lds;
    const int tid = TIDX, kg = tid >> 5, cj = tid & 31;
    float* mod = (float*)(p.ws + OFF_MOD);
    for (int it = BIDX; it < 2 * 96; it += gridDim.x) {
        const int l = it / 96, col = (it % 96) * 32 + cj;
        const float* W = p.in[I_ADAW] + (size_t)l * 1024 * 3072;
        float a0 = 0.f, a1 = 0.f, a2 = 0.f, a3 = 0.f;
        for (int k = kg * 64; k < kg * 64 + 64; ++k) {
            const float w = W[(size_t)k * 3072 + col];
            a0 += siluf_(p.in[I_C][k]) * w; a1 += siluf_(p.in[I_C][1024 + k]) * w; a2 += siluf_(p.in[I_C][2048 + k]) * w; a3 += siluf_(p.in[I_C][3072 + k]) * w;
        }
        red[(kg * 32 + cj) * 4 + 0] = a0; red[(kg * 32 + cj) * 4 + 1] = a1; red[(kg * 32 + cj) * 4 + 2] = a2; red[(kg * 32 + cj) * 4 + 3] = a3;
        __syncthreads();
        if (tid < 128) { const int c2 = tid >> 2, b = tid & 3; float s = 0.f;
            for (int g = 0; g < 16; ++g) s += red[(g * 32 + c2) * 4 + b];
            const int cc = (it % 96) * 32 + c2;
            mod[((size_t)l * 4 + b) * 3072 + cc] = s + p.in[I_ADAB][(size_t)l * 3072 + cc]; }
        __syncthreads();
    }
}
__device__ __forceinline__ void ln_stats(const f32x4 (&v)[4], float& mean, float& rstd, float eps) {
    float s = 0.f;
#pragma unroll
    for (int j = 0; j < 4; ++j) s += (v[j][0] + v[j][1]) + (v[j][2] + v[j][3]);
    mean = wave_sum(s) * (1.f / 1024.f); float s2 = 0.f;
#pragma unroll
    for (int j = 0; j < 4; ++j) { const f32x4 d = v[j] - mean; s2 += (d[0] * d[0] + d[1] * d[1]) + (d[2] * d[2] + d[3] * d[3]); }
    rstd = rsqrtf(wave_sum(s2) * (1.f / 1024.f) + eps);
}
__device__ __forceinline__ void mod_row_to_h(const Params& p, const f32x4 (&v)[4], int row, int l, int lane) {
    float mean, rstd; ln_stats(v, mean, rstd, 1e-5f);
    const float* mod = (const float*)(p.ws + OFF_MOD) + ((size_t)l * 4 + (row >> 13)) * 3072;
    bf16_t* H = (bf16_t*)(p.ws + OFF_H) + (size_t)row * 1024;
#pragma unroll
    for (int j = 0; j < 4; ++j) { const int c = 256 * j + 4 * lane;
        const f32x4 sh = *(const f32x4*)(mod + c), sc = *(const f32x4*)(mod + 1024 + c);
        f32x4 h;
#pragma unroll
        for (int e = 0; e < 4; ++e) h[e] = (v[j][e] - mean) * rstd * (1.f + sc[e]) + sh[e];
        u32x2 o; o.x = pk2(h[0], h[1]); o.y = pk2(h[2], h[3]);
        *(u32x2*)(H + c) = o; }
}
__device__ void ln1_phase(const Params& p, int l, const float* xin, int TIDX, int BIDX) {
    const int lane = TIDX & 63, gw = BIDX * 8 + (TIDX >> 6), NGW = gridDim.x * 8;
    for (int row = gw; row < T; row += NGW) {
        f32x4 v[4];
#pragma unroll
        for (int j = 0; j < 4; ++j) v[j] = *(const f32x4*)(xin + (size_t)row * 1024 + 256 * j + 4 * lane);
        mod_row_to_h(p, v, row, l, lane);
    }
}
__device__ void lnpost_phase(const Params& p, int l, int TIDX, int BIDX, int dry) {
    const int lane = TIDX & 63, gw = BIDX * 8 + (TIDX >> 6), NGW = gridDim.x * 8;
    const float* pg = p.in[I_PG] + l * 1024; const float* pb = p.in[I_PB] + l * 1024;
    for (int row = gw; row < T; row += NGW) {
        f32x4 v[4];
#pragma unroll
        for (int j = 0; j < 4; ++j) v[j] = *(const f32x4*)(p.out + (size_t)row * 1024 + 256 * j + 4 * lane);
        float mean, rstd; ln_stats(v, mean, rstd, 1e-5f);
#pragma unroll
        for (int j = 0; j < 4; ++j) { const int c = 256 * j + 4 * lane; const f32x4 g = *(const f32x4*)(pg + c), b = *(const f32x4*)(pb + c);
            const f32x4 orig = v[j];
#pragma unroll
            for (int e = 0; e < 4; ++e) v[j][e] = (v[j][e] - mean) * rstd * g[e] + b[e];
            *(f32x4*)(p.out + (size_t)row * 1024 + c) = dry ? orig : v[j]; }
        if (l == 0) mod_row_to_h(p, v, row, 1, lane);
    }
}

__device__ __forceinline__ void conv_unpack(const u32x4 w, float (&x)[8]) {
#pragma unroll
    for (int q = 0; q < 4; ++q) { x[2 * q] = lo_bf(w[q]); x[2 * q + 1] = hi_bf(w[q]); }
}
__device__ void rwkv_prep_phase(const Params& p, int l, LAS unsigned char* lds, int TIDX, int BIDX, const XcdBarrier& xb, int dry) {
    {
        bf16_t* XBC = (bf16_t*)(p.ws + OFF_XBC);
        const int cgp = TIDX & 127, qt = TIDX >> 7; const int q0 = BIDX * 128 + qt * 32; const int c8 = cgp * 8;
        float h1[8], h2[8], h3[8];
        if ((q0 & (SEQ - 1)) != 0) { conv_unpack(*(const u32x4*)(XBC + (size_t)(q0 - 1) * 1024 + c8), h1); conv_unpack(*(const u32x4*)(XBC + (size_t)(q0 - 2) * 1024 + c8), h2); conv_unpack(*(const u32x4*)(XBC + (size_t)(q0 - 3) * 1024 + c8), h3); }
        else {
#pragma unroll
            for (int e = 0; e < 8; ++e) h1[e] = h2[e] = h3[e] = 0.f; }
        xcd_barrier(xb);
        float cw0[8], cw1[8], cw2[8], cw3[8], cb[8];
#pragma unroll
        for (int e = 0; e < 8; ++e) { cw0[e] = p.in[I_CONVW][((size_t)l * 4 + 0) * 1024 + c8 + e]; cw1[e] = p.in[I_CONVW][((size_t)l * 4 + 1) * 1024 + c8 + e];
            cw2[e] = p.in[I_CONVW][((size_t)l * 4 + 2) * 1024 + c8 + e]; cw3[e] = p.in[I_CONVW][((size_t)l * 4 + 3) * 1024 + c8 + e]; cb[e] = p.in[I_CONVB][l * 1024 + c8 + e]; }
#pragma unroll 4
        for (int i = 0; i < 32; ++i) {
            bf16_t* ptr = XBC + (size_t)(q0 + i) * 1024 + c8;
            const u32x4 raw_ = *(const u32x4*)ptr; float x0[8]; conv_unpack(raw_, x0);
            float y[8];
#pragma unroll
            for (int e = 0; e < 8; ++e) { y[e] = siluf_(cw0[e] * h3[e] + cw1[e] * h2[e] + cw2[e] * h1[e] + cw3[e] * x0[e] + cb[e]); h3[e] = h2[e]; h2[e] = h1[e]; h1[e] = x0[e]; }
            u32x4 w; w.x = pk2(y[0], y[1]); w.y = pk2(y[2], y[3]); w.z = pk2(y[4], y[5]); w.w = pk2(y[6], y[7]);
            *(u32x4*)ptr = dry ? raw_ : w;
        }
    }
    LAS float* s = (LAS float*)lds;
    const int c = TIDX;
    float wu[64], au[64];
#pragma unroll
    for (int j = 0; j < 64; ++j) { wu[j] = p.in[I_WUP][((size_t)l * 64 + j) * 512 + c]; au[j] = p.in[I_AUP][((size_t)l * 64 + j) * 512 + c]; }
    const float w0 = p.in[I_W0][l * 512 + c], a0 = p.in[I_A0][l * 512 + c];
    const float* SM = (const float*)(p.ws + OFF_SMALL);
    const float* mu = p.in[I_MU] + l * 1664 + 1536;
    bf16_t* A = (bf16_t*)(p.ws + OFF_A); float* DEC = (float*)(p.ws + OFF_DEC);
    const int tpb = T / gridDim.x;
    for (int t0 = BIDX * tpb; t0 < (BIDX + 1) * tpb; t0 += 4) {
        { const int tt = c >> 7, j = c & 127; const int row = t0 + tt;
          const float cur = SM[(size_t)row * 160 + j]; const float prev = (row & (SEQ - 1)) ? SM[(size_t)(row - 1) * 160 + j] : 0.f;
          const float v = cur + mu[j] * (prev - cur);
          s[tt * 128 + j] = j < 64 ? tanhf(v) : v; }
        __syncthreads();
#pragma unroll
        for (int tt = 0; tt < 4; ++tt) {
            float w = w0, a = a0;
#pragma unroll
            for (int j = 0; j < 64; ++j) { w += s[tt * 128 + j] * wu[j]; a += s[tt * 128 + 64 + j] * au[j]; }
            const size_t o = (size_t)(t0 + tt) * 512 + c;
            A[o] = f2bf(sigmoidf_(a)); DEC[o] = __expf(-0.6065306597126334f * sigmoidf_(w));
        }
        __syncthreads();
    }
}

typedef float f32x2 __attribute__((ext_vector_type(2)));
template <int CTRL> __device__ __forceinline__ float dpp_f(float x) { return __builtin_bit_cast(float, __builtin_amdgcn_update_dpp(0, __builtin_bit_cast(int, x), CTRL, 0xF, 0xF, true)); }
__device__ __forceinline__ float row16_sum(float x) { x += dpp_f<0xB1>(x); x += dpp_f<0x4E>(x); x += dpp_f<0x141>(x); x += dpp_f<0x140>(x); return x; }
constexpr int RW_TC = 32, RW_VEC_B = RW_TC * 5 * 64 * 4, RW_V_B = RW_TC * 16 * 4, RW_BUF_B = RW_VEC_B + 2 * RW_V_B;
__device__ void rwkv_scan_fast(const Params& p, int l, int unit, LAS unsigned char* lds, int TIDX) {
    const int bh = unit >> 2, rq = unit & 3, b = bh >> 3, h = bh & 7, wave = TIDX >> 6, lane = TIDX & 63;
    const size_t r0 = (size_t)b * SEQ;
    bf16_t* Y = (bf16_t*)(p.ws + OFF_Y3);
    if (wave >= 4) {
        const int lw = wave - 4, sl = lane >> 3, c8 = (lane & 7) * 8, ch0 = h * 64 + c8;
        const bf16_t* RKV = (const bf16_t*)(p.ws + OFF_RKV); const bf16_t* A = (const bf16_t*)(p.ws + OFF_A); const float* DEC = (const float*)(p.ws + OFF_DEC);
        float mu_r[8], mu_k[8], mu_v[8], k_k[8], k_a[8];
#pragma unroll
        for (int e = 0; e < 8; ++e) { mu_r[e] = p.in[I_MU][l * 1664 + ch0 + e]; mu_k[e] = p.in[I_MU][l * 1664 + 512 + ch0 + e]; mu_v[e] = p.in[I_MU][l * 1664 + 1024 + ch0 + e];
            k_k[e] = p.in[I_KK][l * 512 + ch0 + e]; k_a[e] = p.in[I_KA][l * 512 + ch0 + e]; }
        u32x4 nR, nK, nV, nRp, nKp, nVp, nA; f32x4 nD0, nD1;
        auto issue = [&](int cc) {
            const size_t row = r0 + (size_t)cc * RW_TC + lw * 8 + sl;
            nR = *(const u32x4*)(RKV + row * 1536 + ch0); nK = *(const u32x4*)(RKV + row * 1536 + 512 + ch0); nV = *(const u32x4*)(RKV + row * 1536 + 1024 + ch0);
            nA = *(const u32x4*)(A + row * 512 + ch0); nD0 = *(const f32x4*)(DEC + row * 512 + ch0); nD1 = *(const f32x4*)(DEC + row * 512 + ch0 + 4);
            const size_t prow = (row & (SEQ - 1)) != 0 ? row - 1 : row;
            nRp = *(const u32x4*)(RKV + prow * 1536 + ch0); nKp = *(const u32x4*)(RKV + prow * 1536 + 512 + ch0); nVp = *(const u32x4*)(RKV + prow * 1536 + 1024 + ch0);
        };
        issue(0);
        for (int c = -1; c < SEQ / RW_TC; ++c) {
            if (c >= 1) { LAS const float* yb = (LAS const float*)(lds + ((c - 1) & 1) * RW_BUF_B + RW_VEC_B + RW_V_B);
                const int idx = (lw * 64 + lane) * 2, s = idx >> 4, i = idx & 15;
                *(unsigned*)(Y + (r0 + (size_t)(c - 1) * RW_TC + s) * 512 + h * 64 + rq * 16 + i) = pk2(yb[idx], yb[idx + 1]); }
            if (c + 1 < SEQ / RW_TC) {
                const u32x4 cR = nR, cK = nK, cV = nV, cRp = nRp, cKp = nKp, cVp = nVp, cA = nA; const f32x4 cD0 = nD0, cD1 = nD1;
                if (c + 2 < SEQ / RW_TC) issue(c + 2);
                LAS float* vec = (LAS float*)(lds + ((c + 1) & 1) * RW_BUF_B); LAS float* vb = (LAS float*)(lds + ((c + 1) & 1) * RW_BUF_B + RW_VEC_B);
                const int s = lw * 8 + sl;
                float cr[8], ck[8], cv[8], pr[8], pk[8], pv[8], ca[8];
                conv_unpack(cR, cr); conv_unpack(cK, ck); conv_unpack(cV, cv); conv_unpack(cRp, pr); conv_unpack(cKp, pk); conv_unpack(cVp, pv); conv_unpack(cA, ca);
                if ((((c + 1) * RW_TC + s) & (SEQ - 1)) == 0) {
#pragma unroll
                    for (int e = 0; e < 8; ++e) pr[e] = pk[e] = pv[e] = 0.f; }
                float rr[8], kk[8], vv[8], kkj[8]; float n2 = 0.f;
#pragma unroll
                for (int e = 0; e < 8; ++e) { rr[e] = cr[e] + mu_r[e] * (pr[e] - cr[e]); kk[e] = ck[e] + mu_k[e] * (pk[e] - ck[e]); vv[e] = cv[e] + mu_v[e] * (pv[e] - cv[e]);
                    kkj[e] = kk[e] * k_k[e]; n2 += kkj[e] * kkj[e]; }
                n2 += dpp_f<0xB1>(n2); n2 += dpp_f<0x4E>(n2); n2 += dpp_f<0x141>(n2);
                const float inv = 1.f / fmaxf(sqrtf(n2), 1e-12f);
                f32x4 o0, o1;
                LAS float* d = vec + s * 320 + c8;
                *(LAS f32x4*)(d) = cD0; *(LAS f32x4*)(d + 4) = cD1;
#pragma unroll
                for (int e = 0; e < 4; ++e) { o0[e] = kkj[e] * inv; o1[e] = kkj[4 + e] * inv; }
                *(LAS f32x4*)(d + 64) = o0; *(LAS f32x4*)(d + 68) = o1;
#pragma unroll
                for (int e = 0; e < 4; ++e) { o0[e] *= ca[e]; o1[e] *= ca[4 + e]; }
                *(LAS f32x4*)(d + 128) = o0; *(LAS f32x4*)(d + 132) = o1;
#pragma unroll
                for (int e = 0; e < 4; ++e) { o0[e] = kk[e] * (1.f + (ca[e] - 1.f) * k_a[e]); o1[e] = kk[4 + e] * (1.f + (ca[4 + e] - 1.f) * k_a[4 + e]); }
                *(LAS f32x4*)(d + 192) = o0; *(LAS f32x4*)(d + 196) = o1;
#pragma unroll
                for (int e = 0; e < 4; ++e) { o0[e] = rr[e]; o1[e] = rr[4 + e]; }
                *(LAS f32x4*)(d + 256) = o0; *(LAS f32x4*)(d + 260) = o1;
                if ((c8 >> 4) == rq) {
#pragma unroll
                    for (int e = 0; e < 4; ++e) { o0[e] = vv[e]; o1[e] = vv[4 + e]; }
                    *(LAS f32x4*)(vb + s * 16 + (c8 & 15)) = o0; *(LAS f32x4*)(vb + s * 16 + (c8 & 15) + 4) = o1; }
            }
            __syncthreads();
        }
        { constexpr int c = SEQ / RW_TC; LAS const float* yb = (LAS const float*)(lds + ((c - 1) & 1) * RW_BUF_B + RW_VEC_B + RW_V_B);
          const int idx = (lw * 64 + lane) * 2, s = idx >> 4, i = idx & 15;
          *(unsigned*)(Y + (r0 + (size_t)(c - 1) * RW_TC + s) * 512 + h * 64 + rq * 16 + i) = pk2(yb[idx], yb[idx + 1]); }
    } else {
        const int rl = wave * 4 + (lane >> 4), cq = lane & 15;
        f32x2 S0 = (f32x2){0.f, 0.f}, S1 = (f32x2){0.f, 0.f};
        __syncthreads();
        for (int c = 0; c < SEQ / RW_TC; ++c) {
            LAS const unsigned char* buf = lds + (c & 1) * RW_BUF_B;
            LAS const float* vb = (LAS const float*)(buf + RW_VEC_B); LAS float* yb = (LAS float*)(buf + RW_VEC_B + RW_V_B);
            LAS const f32x4* q = (LAS const f32x4*)buf + cq;
            f32x4 w4 = q[0], k4 = q[16], b4 = q[32], t4 = q[48], r4 = q[64]; float v = vb[rl];
            float ykeep = 0.f;
#pragma unroll
            for (int s = 0; s < RW_TC; ++s) {
                f32x4 nw = w4, nk = k4, nb = b4, nt = t4, nr = r4; float nv = v;
                if (s + 1 < RW_TC) { LAS const f32x4* qn = q + (s + 1) * 80; nw = qn[0]; nk = qn[16]; nb = qn[32]; nt = qn[48]; nr = qn[64]; nv = vb[(s + 1) * 16 + rl]; }
                f32x2 sp = S0 * (f32x2){k4[0], k4[1]} + S1 * (f32x2){k4[2], k4[3]};
                const float sa = -row16_sum(sp[0] + sp[1]);
                S0 = S0 * (f32x2){w4[0], w4[1]} + (f32x2){b4[0], b4[1]} * sa + (f32x2){t4[0], t4[1]} * v;
                S1 = S1 * (f32x2){w4[2], w4[3]} + (f32x2){b4[2], b4[3]} * sa + (f32x2){t4[2], t4[3]} * v;
                f32x2 yp = S0 * (f32x2){r4[0], r4[1]} + S1 * (f32x2){r4[2], r4[3]};
                const float y = row16_sum(yp[0] + yp[1]);
                ykeep = ((s & 15) == cq) ? y : ykeep;
                if ((s & 15) == 15) yb[((s & ~15) + cq) * 16 + rl] = ykeep;
                w4 = nw; k4 = nk; b4 = nb; t4 = nt; r4 = nr; v = nv;
            }
            __syncthreads();
        }
    }
}

__device__ __forceinline__ int tm_shift(int t) { return ((t >> 3) & 3) * 16; }
template <int K, int AM, int BMODE>
__device__ __forceinline__ f32x4 mma_t(LAS const bf16_t* A, int lda, int arow0, LAS const bf16_t* B, int ldb, int brow0, f32x4 acc, int lane) {
    const int r = lane & 15, kg = lane >> 4;
#pragma unroll
    for (int k0 = 0; k0 < K; k0 += 32) {
        bf16x8 a, b;
        if (AM == 0) a = *(LAS const bf16x8*)(A + (arow0 + r) * lda + k0 + kg * 8);
        else if (AM == 2) a = *(LAS const bf16x8*)(A + (arow0 + r) * lda + tm_shift(arow0 + r) + k0 + kg * 8);
        else { LAS const bf16_t* q = A + (k0 + kg * 8) * lda + tm_shift(k0 + kg * 8) + arow0 + r;
#pragma unroll
            for (int j = 0; j < 8; ++j) a[j] = (short)q[j * lda]; }
        if (BMODE == 0) b = *(LAS const bf16x8*)(B + (brow0 + r) * ldb + k0 + kg * 8);
        else if (BMODE == 2) b = *(LAS const bf16x8*)(B + (brow0 + r) * ldb + tm_shift(brow0 + r) + k0 + kg * 8);
        else { LAS const bf16_t* q = B + (k0 + kg * 8) * ldb + tm_shift(k0 + kg * 8) + brow0 + r;
#pragma unroll
            for (int j = 0; j < 8; ++j) b[j] = (short)q[j * ldb]; }
        acc = __builtin_amdgcn_mfma_f32_16x16x32_bf16(a, b, acc, 0, 0, 0);
    }
    return acc;
}
__device__ void mamba2_chunk(const Params& p, int l, int bh, LAS unsigned char* lds, int TIDX) {
    const int b = bh >> 3, h = bh & 7, g = h >> 2, tid = TIDX, wave = tid >> 6, lane = tid & 63, r = lane & 15, kg = lane >> 4;
    LAS bf16_t* CB = (LAS bf16_t*)lds;
    LAS bf16_t* BB = (LAS bf16_t*)(lds + 17408);
    LAS bf16_t* AY = (LAS bf16_t*)(lds + 41984);
    LAS bf16_t* SB = (LAS bf16_t*)(lds + 67584);
    LAS bf16_t* XD = (LAS bf16_t*)(lds + 84992);
    LAS bf16_t* XE = (LAS bf16_t*)(lds + 101376);
    LAS bf16_t* XS = (LAS bf16_t*)(lds + 117760);
    LAS float* F = (LAS float*)(lds + 126976);
    const bf16_t* XBC = (const bf16_t*)(p.ws + OFF_XBC); const float* SM = (const float*)(p.ws + OFF_SMALL);
    bf16_t* Z = (bf16_t*)(p.ws + OFF_Y3) + (size_t)T * 512;
    const float dtb = p.in[I_DTB][l * 8 + h], ah = -__expf(p.in[I_ALOG][l * 8 + h]), dsk = p.in[I_DSKIP][l * 8 + h];
    const size_t rbase = (size_t)b * SEQ;
    f32x4 sacc[4];
#pragma unroll
    for (int i = 0; i < 4; ++i) sacc[i] = (f32x4){0.f, 0.f, 0.f, 0.f};
    for (int i = tid; i < 64 * 128; i += 512) SB[(i >> 7) * 136 + (i & 127)] = 0;
    u32x4 rc[2], rb[2], rx; float rdt = 0.f;
    auto prefetch = [&](int c) {
        const size_t row0 = rbase + (size_t)c * 64;
#pragma unroll
        for (int i = 0; i < 2; ++i) { const int item = tid + 512 * i, ll = item >> 4, ng = item & 15;
            rc[i] = *(const u32x4*)(XBC + (row0 + ll) * 1024 + 768 + g * 128 + ng * 8); rb[i] = *(const u32x4*)(XBC + (row0 + ll) * 1024 + 512 + g * 128 + ng * 8); }
        rx = *(const u32x4*)(XBC + (row0 + (tid >> 3)) * 1024 + h * 64 + (tid & 7) * 8);
        if (tid < 64) rdt = SM[(row0 + tid) * 160 + 128 + h];
    };
    prefetch(0);
    for (int c = 0; c < SEQ / 64; ++c) {
        const size_t row0 = rbase + (size_t)c * 64;
        if (tid < 64) { const float dt = softplusf_(rdt + dtb); float x = dt * ah;
#pragma unroll
            for (int o = 1; o < 64; o <<= 1) { const float y = __shfl_up(x, o); if (lane >= o) x += y; }
            F[tid] = x; F[64 + tid] = dt; }
        __syncthreads();
        const float acs_last = F[63];
#pragma unroll
        for (int i = 0; i < 2; ++i) { const int item = tid + 512 * i, ll = item >> 4, ng = item & 15;
            *(LAS u32x4*)(CB + ll * 136 + ng * 8) = rc[i]; *(LAS u32x4*)(BB + ll * 192 + tm_shift(ll) + ng * 8) = rb[i];
            const float ea = __expf(F[ll]); float cv[8]; conv_unpack(rc[i], cv);
            u32x4 w; w.x = pk2(cv[0] * ea, cv[1] * ea); w.y = pk2(cv[2] * ea, cv[3] * ea); w.z = pk2(cv[4] * ea, cv[5] * ea); w.w = pk2(cv[6] * ea, cv[7] * ea);
            *(LAS u32x4*)(AY + ll * 200 + 64 + ng * 8) = w; }
        { const int ll = tid >> 3, pg = tid & 7; float xv[8]; conv_unpack(rx, xv); const float dtl = F[64 + ll], ee = __expf(acs_last - F[ll]);
          float xd[8];
#pragma unroll
          for (int e = 0; e < 8; ++e) xd[e] = xv[e] * dtl;
          u32x4 w; w.x = pk2(xd[0], xd[1]); w.y = pk2(xd[2], xd[3]); w.z = pk2(xd[4], xd[5]); w.w = pk2(xd[6], xd[7]);
          *(LAS u32x4*)(XD + ll * 128 + tm_shift(ll) + pg * 8) = w;
          w.x = pk2(xd[0] * ee, xd[1] * ee); w.y = pk2(xd[2] * ee, xd[3] * ee); w.z = pk2(xd[4] * ee, xd[5] * ee); w.w = pk2(xd[6] * ee, xd[7] * ee);
          *(LAS u32x4*)(XE + ll * 128 + tm_shift(ll) + pg * 8) = w;
          *(LAS u32x4*)(XS + ll * 72 + pg * 8) = rx; }
        __syncthreads();
        if (c + 1 < SEQ / 64) prefetch(c + 1);
        bf16_t zpre[2][4];
#pragma unroll
        for (int q = 0; q < 2; ++q) { const int tt = wave + 8 * q, tl = tt >> 2, tp = tt & 3;
#pragma unroll
            for (int j = 0; j < 4; ++j) zpre[q][j] = Z[(row0 + tl * 16 + kg * 4 + j) * 512 + h * 64 + tp * 16 + r]; }
#pragma unroll
        for (int q = 0; q < 2; ++q) { const int tt = wave + 8 * q, tl = tt >> 2, ts = tt & 3;
            f32x4 acc = (f32x4){0.f, 0.f, 0.f, 0.f};
            if (ts <= tl) acc = mma_t<128, 0, 2>(CB, 136, tl * 16, BB, 192, ts * 16, acc, lane);
            const int sc = ts * 16 + r; const float as = F[sc];
#pragma unroll
            for (int j = 0; j < 4; ++j) { const int ll = tl * 16 + kg * 4 + j; const float v = (sc <= ll) ? acc[j] * __expf(F[ll] - as) : 0.f; AY[ll * 200 + sc] = f2bf(v); } }
        __syncthreads();
#pragma unroll
        for (int q = 0; q < 2; ++q) { const int tt = wave + 8 * q, tl = tt >> 2, tp = tt & 3;
            f32x4 acc = (f32x4){0.f, 0.f, 0.f, 0.f};
            acc = mma_t<64, 0, 1>(AY, 200, tl * 16, XD, 128, tp * 16, acc, lane);
            acc = mma_t<128, 0, 0>(AY + 64, 200, tl * 16, SB, 136, tp * 16, acc, lane);
            const int pp = tp * 16 + r;
#pragma unroll
            for (int j = 0; j < 4; ++j) { const int ll = tl * 16 + kg * 4 + j; bf16_t* zp = Z + (row0 + ll) * 512 + h * 64 + pp;
                const float y = acc[j] + dsk * bf2f(XS[ll * 72 + pp]); *zp = f2bf(y * siluf_(bf2f(zpre[q][j]))); } }
        const float dl = __expf(acs_last);
#pragma unroll
        for (int i = 0; i < 4; ++i) { const int id = wave * 4 + i, tp = id >> 3, tn = id & 7;
            sacc[i] = sacc[i] * dl; sacc[i] = mma_t<64, 1, 1>(XE, 128, tp * 16, BB, 192, tn * 16, sacc[i], lane); }
        __syncthreads();
#pragma unroll
        for (int i = 0; i < 4; ++i) { const int id = wave * 4 + i, tp = id >> 3, tn = id & 7;
#pragma unroll
            for (int j = 0; j < 4; ++j) SB[(tp * 16 + kg * 4 + j) * 136 + tn * 16 + r] = f2bf(sacc[i][j]); }
    }
}
__device__ void gla_chunk(const Params& p, int l, int unit, LAS unsigned char* lds, int TIDX) {
    const int bh = unit >> 1, eh = unit & 1, b = bh >> 2, h = bh & 3, tid = TIDX, wave = tid >> 6, lane = tid & 63, r = lane & 15, kg = lane >> 4;
    LAS bf16_t* KG = (LAS bf16_t*)lds;
    LAS bf16_t* AY = (LAS bf16_t*)(lds + 9216);
    LAS bf16_t* SB = (LAS bf16_t*)(lds + 26624);
    LAS bf16_t* VV = (LAS bf16_t*)(lds + 35840);
    LAS bf16_t* KD = (LAS bf16_t*)(lds + 52224);
    LAS float* G = (LAS float*)(lds + 68608);
    LAS float* UP = (LAS float*)(lds + 85248);
    LAS float* GD = (LAS float*)(lds + 89344);
    LAS float* SEG = (LAS float*)(lds + 93440);
    const bf16_t* GQ = (const bf16_t*)(p.ws + OFF_GQ); const bf16_t* GK = (const bf16_t*)(p.ws + OFF_GK); const float* SM = (const float*)(p.ws + OFF_SMALL);
    bf16_t* GV = (bf16_t*)(p.ws + OFF_Y3) + (size_t)2 * T * 512;
    const size_t rbase = (size_t)b * SEQ;
    const int ll = tid >> 3, dg = tid & 7;
    for (int i = tid; i < 16 * 64; i += 512) UP[i] = p.in[I_GKUP][((size_t)l * 16 + (i >> 6)) * 256 + h * 64 + (i & 63)];
    float gkb[8];
#pragma unroll
    for (int e = 0; e < 8; ++e) gkb[e] = p.in[I_GKB][l * 256 + h * 64 + dg * 8 + e];
    f32x4 sacc[2];
    sacc[0] = sacc[1] = (f32x4){0.f, 0.f, 0.f, 0.f};
    for (int i = tid; i < 64 * 64; i += 512) SB[(i >> 6) * 72 + (i & 63)] = 0;
    u32x4 rq, rk, rv; f32x4 rg = (f32x4){0.f, 0.f, 0.f, 0.f};
    auto prefetch = [&](int c) {
        const size_t row0 = rbase + (size_t)c * 64;
        rq = *(const u32x4*)(GQ + (row0 + ll) * 256 + h * 64 + dg * 8); rk = *(const u32x4*)(GK + (row0 + ll) * 256 + h * 64 + dg * 8);
        rv = *(const u32x4*)(GV + (row0 + ll) * 512 + h * 128 + eh * 64 + dg * 8);
        if (tid < 256) rg = *(const f32x4*)(SM + (row0 + (tid >> 2)) * 160 + 136 + (tid & 3) * 4);
    };
    prefetch(0);
    for (int c = 0; c < SEQ / 64; ++c) {
        const size_t row0 = rbase + (size_t)c * 64;
        if (tid < 256) *(LAS f32x4*)(GD + (tid >> 2) * 16 + (tid & 3) * 4) = rg;
        __syncthreads();
        { float gp[8];
#pragma unroll
          for (int e = 0; e < 8; ++e) gp[e] = gkb[e];
#pragma unroll
          for (int q = 0; q < 16; ++q) { const float gd = GD[ll * 16 + q];
#pragma unroll
              for (int e = 0; e < 8; ++e) gp[e] += gd * UP[q * 64 + dg * 8 + e]; }
#pragma unroll
          for (int e = 0; e < 8; ++e) G[ll * 65 + dg * 8 + e] = (fminf(gp[e], 0.f) - __logf(1.f + __expf(-fabsf(gp[e])))) * (1.f / 16.f); }
        __syncthreads();
        { const int d = tid & 63, sg = tid >> 6; float gv[8]; float a = 0.f;
#pragma unroll
          for (int q = 0; q < 8; ++q) { a += G[(sg * 8 + q) * 65 + d]; gv[q] = a; }
          SEG[sg * 64 + d] = a;
          __syncthreads();
          float off = 0.f;
#pragma unroll
          for (int q = 0; q < 7; ++q) off += (q < sg) ? SEG[q * 64 + d] : 0.f;
#pragma unroll
          for (int q = 0; q < 8; ++q) G[(sg * 8 + q) * 65 + d] = gv[q] + off; }
        __syncthreads();
        { float qv[8], kv[8]; conv_unpack(rq, qv); conv_unpack(rk, kv);
          float qg[8], ki[8], kd[8];
#pragma unroll
          for (int e = 0; e < 8; ++e) { const int d = dg * 8 + e; const float gl = G[ll * 65 + d], glast = G[63 * 65 + d];
              qg[e] = qv[e] * 0.125f * __expf(gl); ki[e] = kv[e] * __expf(-gl); kd[e] = kv[e] * __expf(glast - gl); }
          u32x4 w; w.x = pk2(qg[0], qg[1]); w.y = pk2(qg[2], qg[3]); w.z = pk2(qg[4], qg[5]); w.w = pk2(qg[6], qg[7]);
          *(LAS u32x4*)(AY + ll * 136 + 64 + dg * 8) = w;
          w.x = pk2(ki[0], ki[1]); w.y = pk2(ki[2], ki[3]); w.z = pk2(ki[4], ki[5]); w.w = pk2(ki[6], ki[7]);
          *(LAS u32x4*)(KG + ll * 72 + dg * 8) = w;
          w.x = pk2(kd[0], kd[1]); w.y = pk2(kd[2], kd[3]); w.z = pk2(kd[4], kd[5]); w.w = pk2(kd[6], kd[7]);
          *(LAS u32x4*)(KD + ll * 128 + tm_shift(ll) + dg * 8) = w;
          *(LAS u32x4*)(VV + ll * 128 + tm_shift(ll) + dg * 8) = rv; }
        __syncthreads();
        if (c + 1 < SEQ / 64) prefetch(c + 1);
#pragma unroll
        for (int q = 0; q < 2; ++q) { const int tt = wave + 8 * q, tl = tt >> 2, ts = tt & 3;
            f32x4 acc = (f32x4){0.f, 0.f, 0.f, 0.f};
            if (ts <= tl) acc = mma_t<64, 0, 0>(AY + 64, 136, tl * 16, KG, 72, ts * 16, acc, lane);
            const int sc = ts * 16 + r;
#pragma unroll
            for (int j = 0; j < 4; ++j) { const int l2 = tl * 16 + kg * 4 + j; AY[l2 * 136 + sc] = f2bf((sc <= l2) ? acc[j] : 0.f); } }
        __syncthreads();
#pragma unroll
        for (int q = 0; q < 2; ++q) { const int tt = wave + 8 * q, tl = tt >> 2, te = tt & 3;
            f32x4 acc = (f32x4){0.f, 0.f, 0.f, 0.f};
            acc = mma_t<64, 0, 1>(AY, 136, tl * 16, VV, 128, te * 16, acc, lane);
            acc = mma_t<64, 0, 0>(AY + 64, 136, tl * 16, SB, 72, te * 16, acc, lane);
#pragma unroll
            for (int j = 0; j < 4; ++j) GV[(row0 + tl * 16 + kg * 4 + j) * 512 + h * 128 + eh * 64 + te * 16 + r] = f2bf(acc[j]); }
#pragma unroll
        for (int i = 0; i < 2; ++i) { const int id = wave * 2 + i, te = id >> 2, td = id & 3;
            const float dl = __expf(G[63 * 65 + td * 16 + r]);
            sacc[i] = sacc[i] * dl; sacc[i] = mma_t<64, 1, 1>(VV, 128, te * 16, KD, 128, td * 16, sacc[i], lane); }
        __syncthreads();
#pragma unroll
        for (int i = 0; i < 2; ++i) { const int id = wave * 2 + i, te = id >> 2, td = id & 3;
#pragma unroll
            for (int j = 0; j < 4; ++j) SB[(te * 16 + kg * 4 + j) * 72 + td * 16 + r] = f2bf(sacc[i][j]); }
    }
}
__device__ void scans_naive_phase(const Params& p, int l, LAS unsigned char* lds, int TIDX, int BIDX) {
    const int wave = TIDX >> 6;
    LAS float* wl = (LAS float*)(lds + wave * 4096);
    if (BIDX < 128) { rwkv_scan_fast(p, l, BIDX, lds, TIDX); return; }
    const int u = BIDX - 128;
    if (u < 32) mamba2_chunk(p, l, u, lds, TIDX);
    else if (u < 64) gla_chunk(p, l, u - 32, lds, TIDX);
}
__device__ void post_phase(const Params& p, int l, int TIDX, int BIDX, int dry) {
    const int lane = TIDX & 63, gw = BIDX * 8 + (TIDX >> 6), NGW = gridDim.x * 8;
    const bf16_t* RKV = (const bf16_t*)(p.ws + OFF_RKV); const bf16_t* A = (const bf16_t*)(p.ws + OFF_A);
    bf16_t* Y0 = (bf16_t*)(p.ws + OFF_Y3); bf16_t* Y1 = Y0 + (size_t)T * 512; bf16_t* Y2 = Y1 + (size_t)T * 512;
    const int c0 = lane * 8;
    float mur[8], muk[8], muv[8], kA[8], rk[8], lg[8], lb[8], nw1[8], nw2[8];
#pragma unroll
    for (int e = 0; e < 8; ++e) { const int c = c0 + e;
        mur[e] = p.in[I_MU][l * 1664 + c]; muk[e] = p.in[I_MU][l * 1664 + 512 + c]; muv[e] = p.in[I_MU][l * 1664 + 1024 + c];
        kA[e] = p.in[I_KA][l * 512 + c]; rk[e] = p.in[I_RK][l * 512 + c]; lg[e] = p.in[I_LNG][l * 512 + c]; lb[e] = p.in[I_LNB][l * 512 + c];
        nw1[e] = p.in[I_M2NW][l * 512 + c]; nw2[e] = p.in[I_GNW][l * 128 + (c & 127)]; }
    for (int row = gw; row < T; row += NGW) {
        const bool first = (row & (SEQ - 1)) == 0;
        float y[8], r[8], k[8], v[8], a[8];
        u32x4 ysave;
        { const u32x4 yy = *(const u32x4*)(Y0 + (size_t)row * 512 + c0); ysave = yy; const u32x4 aa = *(const u32x4*)(A + (size_t)row * 512 + c0);
          const u32x4 rr = *(const u32x4*)(RKV + (size_t)row * 1536 + c0), kk = *(const u32x4*)(RKV + (size_t)row * 1536 + 512 + c0), vv = *(const u32x4*)(RKV + (size_t)row * 1536 + 1024 + c0);
          u32x4 rp = (u32x4){0, 0, 0, 0}, kp = rp, vp = rp;
          if (!first) { rp = *(const u32x4*)(RKV + (size_t)(row - 1) * 1536 + c0); kp = *(const u32x4*)(RKV + (size_t)(row - 1) * 1536 + 512 + c0); vp = *(const u32x4*)(RKV + (size_t)(row - 1) * 1536 + 1024 + c0); }
#pragma unroll
          for (int q = 0; q < 4; ++q) {
              y[2 * q] = lo_bf(yy[q]); y[2 * q + 1] = hi_bf(yy[q]); a[2 * q] = lo_bf(aa[q]); a[2 * q + 1] = hi_bf(aa[q]);
              float x0 = lo_bf(rr[q]), x1 = hi_bf(rr[q]); r[2 * q] = x0 + mur[2 * q] * (lo_bf(rp[q]) - x0); r[2 * q + 1] = x1 + mur[2 * q + 1] * (hi_bf(rp[q]) - x1);
              x0 = lo_bf(kk[q]); x1 = hi_bf(kk[q]); k[2 * q] = x0 + muk[2 * q] * (lo_bf(kp[q]) - x0); k[2 * q + 1] = x1 + muk[2 * q + 1] * (hi_bf(kp[q]) - x1);
              x0 = lo_bf(vv[q]); x1 = hi_bf(vv[q]); v[2 * q] = x0 + muv[2 * q] * (lo_bf(vp[q]) - x0); v[2 * q + 1] = x1 + muv[2 * q + 1] * (hi_bf(vp[q]) - x1); } }
        float s = 0.f, bs = 0.f;
#pragma unroll
        for (int e = 0; e < 8; ++e) { s += y[e]; bs += r[e] * (k[e] * (1.f + (a[e] - 1.f) * kA[e])) * rk[e]; }
        s += __shfl_xor(s, 1); s += __shfl_xor(s, 2); s += __shfl_xor(s, 4);
        bs += __shfl_xor(bs, 1); bs += __shfl_xor(bs, 2); bs += __shfl_xor(bs, 4);
        const float mean = s * (1.f / 64.f); float s2 = 0.f;
#pragma unroll
        for (int e = 0; e < 8; ++e) { const float d = y[e] - mean; s2 += d * d; }
        s2 += __shfl_xor(s2, 1); s2 += __shfl_xor(s2, 2); s2 += __shfl_xor(s2, 4);
        const float rstd = rsqrtf(s2 * (1.f / 64.f) + 64e-5f);
        { float o[8];
#pragma unroll
          for (int e = 0; e < 8; ++e) o[e] = (y[e] - mean) * rstd * lg[e] + lb[e] + bs * v[e];
          u32x4 w; w.x = pk2(o[0], o[1]); w.y = pk2(o[2], o[3]); w.z = pk2(o[4], o[5]); w.w = pk2(o[6], o[7]);
          *(u32x4*)(Y0 + (size_t)row * 512 + c0) = dry ? ysave : w; }
        { const u32x4 yy = *(const u32x4*)(Y1 + (size_t)row * 512 + c0); float q2 = 0.f;
#pragma unroll
          for (int q = 0; q < 4; ++q) { y[2 * q] = lo_bf(yy[q]); y[2 * q + 1] = hi_bf(yy[q]); q2 += y[2 * q] * y[2 * q] + y[2 * q + 1] * y[2 * q + 1]; }
          q2 += __shfl_xor(q2, 1); q2 += __shfl_xor(q2, 2); q2 += __shfl_xor(q2, 4); q2 += __shfl_xor(q2, 8); q2 += __shfl_xor(q2, 16);
          const float rs = rsqrtf(q2 * (1.f / 256.f) + 1e-5f);
          u32x4 w; w.x = pk2(y[0] * rs * nw1[0], y[1] * rs * nw1[1]); w.y = pk2(y[2] * rs * nw1[2], y[3] * rs * nw1[3]); w.z = pk2(y[4] * rs * nw1[4], y[5] * rs * nw1[5]); w.w = pk2(y[6] * rs * nw1[6], y[7] * rs * nw1[7]);
          *(u32x4*)(Y1 + (size_t)row * 512 + c0) = dry ? yy : w; }
        { const u32x4 yy = *(const u32x4*)(Y2 + (size_t)row * 512 + c0); float q2 = 0.f;
#pragma unroll
          for (int q = 0; q < 4; ++q) { y[2 * q] = lo_bf(yy[q]); y[2 * q + 1] = hi_bf(yy[q]); q2 += y[2 * q] * y[2 * q] + y[2 * q + 1] * y[2 * q + 1]; }
          q2 += __shfl_xor(q2, 1); q2 += __shfl_xor(q2, 2); q2 += __shfl_xor(q2, 4); q2 += __shfl_xor(q2, 8);
          const float rs = rsqrtf(q2 * (1.f / 128.f) + 1e-5f);
          u32x4 w; w.x = pk2(y[0] * rs * nw2[0], y[1] * rs * nw2[1]); w.y = pk2(y[2] * rs * nw2[2], y[3] * rs * nw2[3]); w.z = pk2(y[4] * rs * nw2[4], y[5] * rs * nw2[5]); w.w = pk2(y[6] * rs * nw2[6], y[7] * rs * nw2[7]);
          *(u32x4*)(Y2 + (size_t)row * 512 + c0) = dry ? yy : w; }
    }
}

constexpr int NPHASE = 18;
#ifndef EXP_S
#define EXP_S -1
#endif
#ifndef DIAG
#define DIAG 0
#endif
#ifndef DIAG_A
#define DIAG_A(ph, s) ((ph) >= 2 && (s) == 2)
#endif
#ifndef DIAG_B
#define DIAG_B(ph, s) ((ph) >= 2 && ((s) == 0 || (s) >= 4 && (s) <= 6))
#endif
#ifndef PHM
#define PHM 1023
#endif
__global__ __launch_bounds__(512, 2) void mega(Params p) {
    extern __shared__ __attribute__((aligned(16))) unsigned char shm[];
    LAS unsigned char* lds = (LAS unsigned char*)shm;
    cg::grid_group grid = cg::this_grid();
    volatile LAS unsigned* xst = (volatile LAS unsigned*)(lds + 131072);
    if (threadIdx.x < 2) xst[threadIdx.x] = 0u;
    __syncthreads();
    const XcdBarrier xb = xcd_barrier_post((unsigned*)(p.ws + OFF_BAR), xst);
#if DIAG
    unsigned long long tA = 0, tB = 0;
#endif
    for (int ph = p.ph_lo; ph < p.ph_hi; ++ph) {
        const int TIDX = tid_opaque(), BIDX = bid_opaque();
#if DIAG
        const unsigned long long t_start = __builtin_amdgcn_s_memrealtime();
#endif
        if (ph == 0) { if (PHM & 1) { wprep(p, 0, lds, TIDX, BIDX); ada_phase(p, lds, TIDX, BIDX); } }
        else if (ph == 1) { if (PHM & 2) ln1_phase(p, 0, p.in[I_X], TIDX, BIDX); }
        else {
            const int l = (ph - 2) >> 3, s = (ph - 2) & 7;
            const float* xin = l == 0 ? p.in[I_X] : p.out;
            pg8::StaticOrder S;
            if (s == 0 && (PHM & 4)) { pg8::Gemm g{(const bf16_t*)(p.ws + OFF_H), (const bf16_t*)(p.ws + OFF_WT1), T, 4352, 1024, 1 << 30, 0};
                S.init(g.M, g.N, gridDim.x, BIDX); Epi<0> E{p.ws, nullptr, nullptr, nullptr, 0}; pg8::gemm_phase(lds, g, S, E, TIDX); }
            else if (s == 1 && (PHM & 8)) { if (EXP_S == 1) { rwkv_prep_phase(p, l, lds, TIDX, BIDX, xb, 1); xcd_barrier(xb); } rwkv_prep_phase(p, l, lds, TIDX, BIDX, xb, 0); }
            else if (s == 2 && (PHM & 16)) { scans_naive_phase(p, l, lds, TIDX, BIDX); }
            else if (s == 3 && (PHM & 32)) { if (EXP_S == 3) { post_phase(p, l, TIDX, BIDX, 1); xcd_barrier(xb); } post_phase(p, l, TIDX, BIDX, 0); }
            else if (s == 4 && (PHM & 64)) { pg8::Gemm g{(const bf16_t*)(p.ws + OFF_H), (const bf16_t*)(p.ws + OFF_WT1) + (size_t)4352 * 1024, T, 4096, 1024, 1 << 30, 0};
                S.init(g.M, g.N, gridDim.x, BIDX); Epi<1> E{p.ws, nullptr, nullptr, nullptr, 0}; if (EXP_S == s) { E.dry = 1; pg8::gemm_phase(lds, g, S, E, TIDX); xcd_barrier(xb); E.dry = 0; } pg8::gemm_phase(lds, g, S, E, TIDX); }
            else if (s == 5 && (PHM & 128)) { pg8::Gemm g{(const bf16_t*)(p.ws + OFF_Y3), (const bf16_t*)(p.ws + OFF_WT2), T, 1024, 512, 4, (size_t)T * 512 * 2};
                S.init(g.M, g.N, gridDim.x, BIDX, 3); Epi<2> E{p.ws, nullptr, nullptr, nullptr, 0}; if (EXP_S == s) { E.dry = 1; pg8::gemm_phase(lds, g, S, E, TIDX); xcd_barrier(xb); E.dry = 0; } pg8::gemm_phase(lds, g, S, E, TIDX); }
            else if (s == 6 && (PHM & 256)) { pg8::Gemm g{(const bf16_t*)(p.ws + OFF_H), (const bf16_t*)(p.ws + OFF_WT3), T, 1024, 1024, 1 << 30, 0};
                S.init(g.M, g.N, gridDim.x, BIDX); Epi<3> E{p.ws, xin, (const float*)(p.ws + OFF_MOD) + (size_t)l * 4 * 3072, p.out, 0}; if (EXP_S == s) { E.dry = 1; pg8::gemm_phase(lds, g, S, E, TIDX); xcd_barrier(xb); E.dry = 0; } pg8::gemm_phase(lds, g, S, E, TIDX); }
            else if (s == 7 && (PHM & 512)) { if (EXP_S == 7) { lnpost_phase(p, l, TIDX, BIDX, 1); if (l == 0) wprep(p, 1, lds, TIDX, BIDX); xcd_barrier(xb); } lnpost_phase(p, l, TIDX, BIDX, 0); if (l == 0) wprep(p, 1, lds, TIDX, BIDX); }
        }
        if (ph + 1 < p.ph_hi) { if (ph == p.ph_lo) grid.sync(); else xcd_barrier(xb); }
#if DIAG
        { const unsigned long long dt = __builtin_amdgcn_s_memrealtime() - t_start; const int s_ = (ph - 2) & 7;
          if (DIAG_A(ph, s_)) tA += dt; if (DIAG_B(ph, s_)) tB += dt; }
#endif
    }
#if DIAG
    grid.sync();
    if (blockIdx.x == 0) {
        const float vA = (float)tA * 10.f, vB = (float)tB * 10.f;
        for (int i = threadIdx.x; i < (1 << 20); i += 512) p.out[4096 + i] = vB;
        if (threadIdx.x == 0) p.out[0] = vA * 1000.f;
    }
#endif
}

extern "C" void kernel_launch(void* const* d_in, const int* in_sizes, int n_in, void* d_out, int out_size, void* d_ws, size_t ws_size, hipStream_t stream) {
    constexpr int LDS_BYTES = 131072 + 16;
    static int grid = 0;
    if (grid == 0) {
        if (n_in != 28 || out_size != T * DM || ws_size < WS_NEED) { fprintf(stderr, "kernel_launch: unexpected shapes / workspace (%zu < %zu)\n", ws_size, (size_t)WS_NEED); grid = -1; return; }
        int dev = 0, cus = 0, per_cu = 0;
        hipGetDevice(&dev); hipDeviceGetAttribute(&cus, hipDeviceAttributeMultiprocessorCount, dev);
        if (hipFuncSetAttribute((const void*)mega, hipFuncAttributeMaxDynamicSharedMemorySize, LDS_BYTES) != hipSuccess) { fprintf(stderr, "hipFuncSetAttribute failed\n"); grid = -1; return; }
        if (hipOccupancyMaxActiveBlocksPerMultiprocessor(&per_cu, (const void*)mega, 512, LDS_BYTES) != hipSuccess || per_cu < 1) per_cu = 1;
        (void)hipGetLastError();
        grid = cus * 1;
        if (grid != 256) { fprintf(stderr, "kernel_launch: built for 256 CUs\n"); grid = -1; return; }
    }
    if (grid < 0) return;
    if (hipMemsetAsync((char*)d_ws + OFF_BAR, 0, XCD_BAR_WORDS_B, stream) != hipSuccess) { fprintf(stderr, "kernel_launch: memset of barrier words failed\n"); return; }
    Params p{};
    for (int i = 0; i < 28; ++i) p.in[i] = (const float*)d_in[i];
    p.out = (float*)d_out; p.ws = (unsigned char*)d_ws;
#if N_LAUNCH_MODE == 1
    p.ph_lo = 0; p.ph_hi = NPHASE;
    void* args[] = {&p};
    hipError_t e = hipLaunchCooperativeKernel((const void*)mega, dim3(grid), dim3(512), args, LDS_BYTES, stream);
    if (e != hipSuccess) fprintf(stderr, "cooperative launch failed: %s (grid %d)\n", hipGetErrorString(e), grid);
#else
    for (int ph = 0; ph < NPHASE; ++ph) { p.ph_lo = ph; p.ph_hi = ph + 1; hipLaunchKernelGGL(mega, dim3(grid), dim3(512), LDS_BYTES, stream, p); }
#endif
}
```

```cpp
#include <hip/hip_runtime.h>
#include <hip/hip_cooperative_groups.h>
#include <cstdio>
namespace cg = cooperative_groups;

#ifndef N_LAUNCH_MODE
#define N_LAUNCH_MODE 1
#endif

#define LAS __attribute__((address_space(3)))
typedef unsigned short bf16_t;
typedef short bf16x8 __attribute__((ext_vector_type(8)));
typedef float f32x4 __attribute__((ext_vector_type(4)));
typedef unsigned u32x4 __attribute__((ext_vector_type(4)));
typedef unsigned u32x2 __attribute__((ext_vector_type(2)));

constexpr int T = 32768, SEQ = 8192, DM = 1024, NB = 4;
constexpr int INW = 8344;
constexpr float ALPHA_DN = 1.4142135623730951f;

constexpr size_t XCD_BAR_WORDS_B = 3456 * 4;
constexpr size_t SZ_WT1 = (size_t)8448 * 1024 * 2, SZ_WT2 = (size_t)3072 * 512 * 2, SZ_WT3 = (size_t)1024 * 3072 * 2, SZ_MOD = (size_t)2 * 4 * 3072 * 4;
constexpr size_t OFF_WT1 = 0, OFF_WT2 = OFF_WT1 + SZ_WT1, OFF_WT3 = OFF_WT2 + SZ_WT2, OFF_MOD = OFF_WT3 + SZ_WT3;
constexpr size_t OFF_H = OFF_MOD + SZ_MOD;
constexpr size_t OFF_Y3 = OFF_H + (size_t)T * 1024 * 2;
constexpr size_t OFF_RKV = OFF_Y3 + (size_t)3 * T * 512 * 2;
constexpr size_t OFF_XBC = OFF_RKV + (size_t)T * 1536 * 2;
constexpr size_t OFF_GQ = OFF_XBC + (size_t)T * 1024 * 2;
constexpr size_t OFF_GK = OFF_GQ + (size_t)T * 256 * 2;
constexpr size_t OFF_SMALL = OFF_GK + (size_t)T * 256 * 2;
constexpr size_t OFF_A = OFF_SMALL + (size_t)T * 160 * 4;
constexpr size_t OFF_DEC = OFF_A + (size_t)T * 512 * 2;
constexpr size_t WS_END = OFF_DEC + (size_t)T * 512 * 4;
constexpr size_t OFF_BAR = (WS_END + 255) & ~(size_t)255;
constexpr size_t WS_NEED = OFF_BAR + XCD_BAR_WORDS_B;
constexpr size_t OFF_GATES = OFF_RKV;
static_assert(OFF_GK + (size_t)T * 256 * 2 - OFF_RKV == (size_t)T * 3072 * 2, "gates alias");

struct Params { const float* in[28]; float* out; unsigned char* ws; int ph_lo, ph_hi; };
enum { I_X = 0, I_C, I_ADAW, I_ADAB, I_WIN, I_MU, I_W0, I_WUP, I_A0, I_AUP, I_KK, I_KA, I_RK, I_LNG, I_LNB, I_CONVW, I_CONVB, I_DTB, I_ALOG, I_DSKIP,
       I_M2NW, I_GKUP, I_GKB, I_GNW, I_WBR, I_WOUT, I_PG, I_PB };

__device__ __forceinline__ float bf2f(bf16_t v) { return __uint_as_float(((unsigned)v) << 16); }
__device__ __forceinline__ bf16_t f2bf(float f) { unsigned u = __float_as_uint(f); u += 0x7FFFu + ((u >> 16) & 1u); return (bf16_t)(u >> 16); }
__device__ __forceinline__ unsigned pk2(float lo, float hi) { return (unsigned)f2bf(lo) | ((unsigned)f2bf(hi) << 16); }
__device__ __forceinline__ float lo_bf(unsigned w) { return __uint_as_float(w << 16); }
__device__ __forceinline__ float hi_bf(unsigned w) { return __uint_as_float(w & 0xFFFF0000u); }
__device__ __forceinline__ float sigmoidf_(float x) { return __builtin_amdgcn_rcpf(1.0f + __expf(-x)); }
__device__ __forceinline__ float siluf_(float x) { return x / (1.0f + __expf(-x)); }
__device__ __forceinline__ float softplusf_(float x) { return x > 20.f ? x : log1pf(__expf(x)); }
__device__ __forceinline__ float wave_sum(float v) {
#pragma unroll
    for (int o = 1; o < 64; o <<= 1) v += __shfl_xor(v, o);
    return v;
}
__device__ __forceinline__ int tid_opaque() { int t = threadIdx.x; asm volatile("" : "+v"(t)); return t; }
__device__ __forceinline__ int bid_opaque() { int t = blockIdx.x; asm volatile("" : "+s"(t)); return t; }
#define WAVE_LDS_SYNC() do { asm volatile("s_waitcnt lgkmcnt(0)" ::: "memory"); __builtin_amdgcn_wave_barrier(); } while (0)


#define XB_TMO      128
#define XB_XCNT(j)  (256  + 64 * (j))
#define XB_XSUB(j)  (1280 + 64 * (j))
#define XB_XGEN(j)  (2304 + 64 * (j))
#define XB_TOP      3328
#define XB_TOPGEN   3392
#define XCD_BAR_WORDS 3456
#define XB_SPIN_CAP (1u << 20)
__device__ __forceinline__ unsigned xb_ld(unsigned* p)              { return __hip_atomic_load(p, __ATOMIC_RELAXED, __HIP_MEMORY_SCOPE_AGENT); }
__device__ __forceinline__ unsigned xb_add(unsigned* p, unsigned v) { return __hip_atomic_fetch_add(p, v, __ATOMIC_RELAXED, __HIP_MEMORY_SCOPE_AGENT); }
__device__ __forceinline__ unsigned xb_xcc_id() { return (unsigned)__builtin_amdgcn_s_getreg((3 << 11) | 20) & 0xFu; }
#define XB_SPIN(cond, bar) do { unsigned _sp = 0; while (cond) { __builtin_amdgcn_s_sleep(1); \
    if ((++_sp & 255u) == 0u) { if (xb_ld(&(bar)[XB_TMO])) break; if (_sp > XB_SPIN_CAP) { atomicAdd(&(bar)[XB_TMO], 1u); break; } } } } while (0)
struct XcdBarrier { unsigned* bar; unsigned x; volatile LAS unsigned* st; };
__device__ __forceinline__ XcdBarrier xcd_barrier_post(unsigned* bar, volatile LAS unsigned* st) {
    XcdBarrier b; b.bar = bar; b.x = xb_xcc_id(); b.st = st;
    if (threadIdx.x == 0) (void)xb_add(&bar[XB_XCNT(b.x)], 1u);
    return b;
}
__device__ __forceinline__ void xcd_barrier_complete(unsigned* bar, unsigned x, unsigned& nloc, unsigned& nx) {
    const unsigned G = gridDim.x * gridDim.y * gridDim.z;
    unsigned sum, cnt, mine, sp = 0u;
    for (;;) {
        sum = 0u; cnt = 0u; mine = 0u;
#pragma unroll
        for (unsigned j = 0; j < 16; ++j) { const unsigned c = xb_ld(&bar[XB_XCNT(j)]); sum += c; cnt += (c > 0u) ? 1u : 0u; mine = (j == x) ? c : mine; }
        if (sum == G) break;
        __builtin_amdgcn_s_sleep(1);
        if ((++sp & 255u) == 0u) { if (xb_ld(&bar[XB_TMO])) break; if (sp > XB_SPIN_CAP) { atomicAdd(&bar[XB_TMO], 1u); break; } }
    }
    nloc = mine > 0u ? mine : 1u; nx = cnt > 0u ? cnt : 1u;
}
__device__ __forceinline__ void xcd_barrier(const XcdBarrier& b) {
    asm volatile("s_waitcnt vmcnt(0)" ::: "memory");
    __syncthreads();
    if (threadIdx.x == 0) {
        unsigned* bar = b.bar;
        __builtin_amdgcn_s_waitcnt(0);
        unsigned nloc = b.st[0], nx = b.st[1];
        if (nloc == 0u) { xcd_barrier_complete(bar, b.x, nloc, nx); b.st[0] = nloc; b.st[1] = nx; }
        const unsigned old = xb_add(&bar[XB_XSUB(b.x)], 1u);
        const unsigned gen = old / nloc;
        if (old + 1u == (gen + 1u) * nloc) {
            __builtin_amdgcn_fence(__ATOMIC_RELEASE, "agent");
            asm volatile("s_waitcnt vmcnt(0)" ::: "memory");
            const unsigned og = xb_add(&bar[XB_TOP], 1u);
            const unsigned tg = og / nx;
            if (og + 1u == (tg + 1u) * nx) xb_add(&bar[XB_TOPGEN], 1u);
            else XB_SPIN(xb_ld(&bar[XB_TOPGEN]) == tg, bar);
            __builtin_amdgcn_fence(__ATOMIC_ACQUIRE, "agent");
            xb_add(&bar[XB_XGEN(b.x)], 1u);
            asm volatile("s_waitcnt vmcnt(0)" ::: "memory");
        } else {
            XB_SPIN(xb_ld(&bar[XB_XGEN(b.x)]) == gen, bar);
            __builtin_amdgcn_fence(__ATOMIC_ACQUIRE, "agent");
            asm volatile("s_waitcnt vmcnt(0)" ::: "memory");
        }
    }
    __syncthreads();
}
namespace pg8 {
constexpr int BM = 256, BK = 64, HALF = 128, HTB = HALF * BK * 2, STAGE_BYTES = 8 * HTB, NXCD = 8, WGM = 8;
__host__ __device__ __forceinline__ int lds_byte(int r, int c) { const int st = (r >> 4) * 2 + (c >> 5), rr = r & 15, cc = c & 31, ob = rr * 64 + cc * 2; return st * 1024 + (ob ^ (((ob >> 9) & 1) << 5)); }
__host__ __device__ __forceinline__ void stage_rc(int b, int& R, int& C) { const int st = b / 1024, sb = b % 1024, swz = sb ^ (((sb >> 9) & 1) << 5); R = (st >> 1) * 16 + swz / 64; C = (st & 1) * 32 + (swz % 64) / 2; }
__host__ __device__ __forceinline__ int perm32(int rho) { const int n = rho >> 4, i = rho & 15; return 8 * (i >> 2) + 4 * n + (i & 3); }
struct Unit { int pm, pn; };
struct Gemm { const bf16_t* A; const bf16_t* Bt; int M, N, K; int adiv; size_t astride; };
struct StaticOrder {
    int nM, nN, nwg, G, c, rep;
    __device__ void init(int M, int N, int G_, int c_, int rep_ = 1) { nM = M / BM; nN = N / BM; nwg = nM * nN; G = G_; c = c_; rep = rep_; }
    __device__ bool next(int i0, Unit& u) const {
        const int i = rep == 3 ? i0 / 3 : i0;
        const long L = (long)i * G + c; if (L >= nwg) return false;
        int wgid = (int)L; { const int q = nwg / NXCD, r = nwg % NXCD, xcd = wgid % NXCD, off = wgid / NXCD; wgid = (xcd < r ? xcd * (q + 1) : r * (q + 1) + (xcd - r) * q) + off; }
        const int nig = WGM * nN, gid = wgid / nig, fm = gid * WGM, gsz = (nM - fm) < WGM ? (nM - fm) : WGM;
        u.pm = fm + ((wgid % nig) % gsz); u.pn = (wgid % nig) / gsz; if (rep == 3) u.pn += nN * (i0 - 3 * i); return true;
    }
};
__device__ __forceinline__ unsigned cvt_pk_bf16_t(float lo, float hi) { unsigned r; asm volatile("s_nop 1\n\tv_cvt_pk_bf16_f32 %0, %1, %2" : "=v"(r) : "v"(lo), "v"(hi)); return r; }
__device__ __forceinline__ unsigned cvt_pk_bf16(float lo, float hi) { unsigned r; asm volatile("v_cvt_pk_bf16_f32 %0, %1, %2" : "=v"(r) : "v"(lo), "v"(hi)); return r; }

template <class Epi>
__device__ __forceinline__ void gemm_phase(LAS unsigned char* lds, const Gemm g, const StaticOrder& S, const Epi& E, int TIDX) {
    const int tid = TIDX, wid = __builtin_amdgcn_readfirstlane(tid >> 6), lane = tid & 63, wr = wid >> 2, wc = wid & 3, fr = lane & 15, fq = lane >> 4;
    const int K = g.K, nt = K / BK;
    unsigned voffA[2], voffB[2];
#pragma unroll
    for (int i = 0; i < 2; ++i) { int R, C; stage_rc(tid * 16 + i * 8192, R, C); const int Rb = (R & ~31) + perm32(R & 31);
        voffA[i] = (unsigned)(R * K + C) * 2u; voffB[i] = (unsigned)(Rb * K + C) * 2u; }
    const size_t kstep = (size_t)(BK * 2);
    const size_t hstep = (size_t)HALF * K * 2;
    const size_t tstep = 2 * hstep;
    const unsigned ldsw = (unsigned)wid * 1024u;
    const int aoff = lds_byte(wr * 64 + fr, fq * 8), boff = lds_byte(wc * 32 + fr, fq * 8);
#define PG8_SA(b, h) (((b) * 2 + (h)) * HTB)
#define PG8_SB(b, h) ((4 + (b) * 2 + (h)) * HTB)
#define PG8_STAGE(bufoff, gbase, voff) do { _Pragma("unroll") for (int _i = 0; _i < 2; ++_i) \
        __builtin_amdgcn_global_load_lds((const unsigned*)((const char*)(gbase) + (voff)[_i]), (LAS unsigned*)(lds + (bufoff) + ldsw + _i * 8192), 16, 0, 0); } while (0)
#define PG8_LDA(dst, b, h) do { _Pragma("unroll") for (int m = 0; m < 4; ++m) _Pragma("unroll") for (int k = 0; k < 2; ++k) dst[m][k] = *(const LAS bf16x8*)(lds + PG8_SA(b, h) + aoff + m * 2048 + k * 1024); } while (0)
#define PG8_LDB(dst, b, h) do { _Pragma("unroll") for (int n = 0; n < 2; ++n) _Pragma("unroll") for (int k = 0; k < 2; ++k) dst[n][k] = *(const LAS bf16x8*)(lds + PG8_SB(b, h) + boff + n * 2048 + k * 1024); } while (0)
#define PG8_MMA(ai, bj, At, Bt) do { __builtin_amdgcn_s_setprio(1); _Pragma("unroll") for (int m = 0; m < 4; ++m) _Pragma("unroll") for (int n = 0; n < 2; ++n) _Pragma("unroll") for (int k = 0; k < 2; ++k) \
        acc[ai][bj][m][n] = __builtin_amdgcn_mfma_f32_16x16x32_bf16(Bt[n][k], At[m][k], acc[ai][bj][m][n], 0, 0, 0); __builtin_amdgcn_s_setprio(0); } while (0)
#define PG8_WAIT_V(n) asm volatile("s_waitcnt vmcnt(" #n ")" ::: "memory")
#define PG8_WAIT_L(n) asm volatile("s_waitcnt lgkmcnt(" #n ")" ::: "memory")
#define PG8_BAR __builtin_amdgcn_s_barrier()
#define PG8_SCHED __builtin_amdgcn_sched_barrier(0)
    Unit cur, nxt; int ui = 0;
    if (!S.next(0, cur)) return;
    f32x4 acc[2][2][4][2];
#pragma unroll
    for (int a = 0; a < 2; ++a)
#pragma unroll
        for (int b = 0; b < 2; ++b)
#pragma unroll
            for (int m = 0; m < 4; ++m)
#pragma unroll
                for (int n = 0; n < 2; ++n) acc[a][b][m][n] = (f32x4){0.f, 0.f, 0.f, 0.f};
    bf16x8 At[4][2], B0[2][2], B1[2][2];
    const char* cA = (const char*)g.A + (size_t)(cur.pn / g.adiv) * g.astride + (size_t)cur.pm * tstep; const char* cB = (const char*)g.Bt + (size_t)cur.pn * tstep;
    PG8_STAGE(PG8_SB(0, 0), cB, voffB); PG8_STAGE(PG8_SA(0, 0), cA, voffA); PG8_STAGE(PG8_SB(0, 1), cB + hstep, voffB); PG8_STAGE(PG8_SA(0, 1), cA + hstep, voffA);
    if (wr == 1) PG8_BAR;
    PG8_WAIT_V(4); PG8_BAR;
    PG8_STAGE(PG8_SB(1, 0), cB + kstep, voffB); PG8_STAGE(PG8_SA(1, 0), cA + kstep, voffA); PG8_STAGE(PG8_SB(1, 1), cB + hstep + kstep, voffB);
    PG8_WAIT_V(6); PG8_BAR;
    for (;;) {
        const bool has_next = S.next(ui + 1, nxt);
        const char* nA = has_next ? (const char*)g.A + (size_t)(nxt.pn / g.adiv) * g.astride + (size_t)nxt.pm * tstep : cA; const char* nB = has_next ? (const char*)g.Bt + (size_t)nxt.pn * tstep : cB;
        for (int t = 0; t < nt; t += 2) {
            const bool last = (t == nt - 2);
            const char* a1 = cA + (size_t)(t + 1) * kstep;
            const char* a2 = last ? nA : cA + (size_t)(t + 2) * kstep; const char* b2 = last ? nB : cB + (size_t)(t + 2) * kstep;
            const char* a3 = a2 + kstep; const char* b3 = b2 + kstep;
            PG8_LDB(B0, 0, 0); PG8_SCHED; PG8_LDA(At, 0, 0); PG8_STAGE(PG8_SA(1, 1), a1 + hstep, voffA);
            PG8_WAIT_L(8); PG8_BAR; PG8_WAIT_L(0); PG8_MMA(0, 0, At, B0); PG8_BAR; PG8_SCHED;
            PG8_LDB(B1, 0, 1); PG8_STAGE(PG8_SB(0, 0), b2, voffB);
            PG8_BAR; PG8_WAIT_L(0); PG8_MMA(0, 1, At, B1); PG8_BAR;
            PG8_LDA(At, 0, 1); PG8_STAGE(PG8_SA(0, 0), a2, voffA);
            PG8_BAR; PG8_WAIT_L(0); PG8_MMA(1, 0, At, B0); PG8_BAR; PG8_SCHED;
            PG8_STAGE(PG8_SB(0, 1), b2 + hstep, voffB);
            PG8_WAIT_V(6); PG8_BAR; PG8_MMA(1, 1, At, B1); PG8_BAR;
            PG8_LDB(B0, 1, 0); PG8_SCHED; PG8_LDA(At, 1, 0); PG8_STAGE(PG8_SA(0, 1), a2 + hstep, voffA);
            PG8_WAIT_L(8); PG8_BAR; PG8_WAIT_L(0); PG8_MMA(0, 0, At, B0); PG8_BAR; PG8_SCHED;
            PG8_LDB(B1, 1, 1); PG8_STAGE(PG8_SB(1, 0), b3, voffB);
            PG8_BAR; PG8_WAIT_L(0); PG8_MMA(0, 1, At, B1); PG8_BAR;
            PG8_LDA(At, 1, 1); PG8_STAGE(PG8_SA(1, 0), a3, voffA);
            PG8_BAR; PG8_WAIT_L(0); PG8_MMA(1, 0, At, B0); PG8_BAR; PG8_SCHED;
            PG8_STAGE(PG8_SB(1, 1), b3 + hstep, voffB);
            PG8_WAIT_V(6); PG8_BAR; PG8_MMA(1, 1, At, B1); PG8_BAR;
        }
        E(acc, cur, wr, wc, fr, fq);
        if (!has_next) break;
#pragma unroll
        for (int a = 0; a < 2; ++a)
#pragma unroll
            for (int b = 0; b < 2; ++b)
#pragma unroll
                for (int m = 0; m < 4; ++m)
#pragma unroll
                    for (int n = 0; n < 2; ++n) acc[a][b][m][n] = (f32x4){0.f, 0.f, 0.f, 0.f};
        cur = nxt; cA = nA; cB = nB; ++ui;
    }
    PG8_WAIT_V(0);
    if (wr == 0) PG8_BAR;
    PG8_BAR;
#undef PG8_SA
#undef PG8_SB
#undef PG8_STAGE
#undef PG8_LDA
#undef PG8_LDB
#undef PG8_MMA
#undef PG8_WAIT_V
#undef PG8_WAIT_L
#undef PG8_BAR
#undef PG8_SCHED
}
}

template <int MODE> struct Epi {
    unsigned char* ws; const float* xin; const float* gate; float* out; int dry;
    __device__ __forceinline__ void operator()(const f32x4 (&acc)[2][2][4][2], const pg8::Unit& u, int wr, int wc, int fr, int fq) const {
        const int pn = u.pn;
        bf16_t* base = nullptr; int ld = 0, c0 = 0;
        if (MODE == 0) {
            if (pn < 6) { base = (bf16_t*)(ws + OFF_RKV); ld = 1536; c0 = pn * 256; }
            else if (pn < 10) { base = (bf16_t*)(ws + OFF_XBC); ld = 1024; c0 = (pn - 6) * 256; }
            else if (pn < 12) { base = (bf16_t*)(ws + OFF_Y3) + (size_t)T * 512; ld = 512; c0 = (pn - 10) * 256; }
            else if (pn == 12) { base = (bf16_t*)(ws + OFF_GQ); ld = 256; c0 = 0; }
            else if (pn == 13) { base = (bf16_t*)(ws + OFF_GK); ld = 256; c0 = 0; }
            else if (pn < 16) { base = (bf16_t*)(ws + OFF_Y3) + (size_t)2 * T * 512; ld = 512; c0 = (pn - 14) * 256; }
        } else if (MODE == 1) {
            if (pn < 2) { base = (bf16_t*)(ws + OFF_Y3); ld = 512; c0 = pn * 256; }
            else if (pn < 4) { base = (bf16_t*)(ws + OFF_Y3) + (size_t)2 * T * 512; ld = 512; c0 = (pn - 2) * 256; }
            else { base = (bf16_t*)(ws + OFF_GATES); ld = 3072; c0 = (pn - 4) * 256; }
        } else if (MODE == 2) { base = (bf16_t*)(ws + OFF_H); ld = 1024; c0 = (pn & 3) * 256; }
        if (MODE == 0 || (MODE == 1 && pn >= 4)) {
#pragma unroll
            for (int ai = 0; ai < 2; ++ai)
#pragma unroll
                for (int m = 0; m < 4; ++m) {
                    const int row = u.pm * 256 + ai * 128 + wr * 64 + m * 16 + fr;
#pragma unroll
                    for (int bj = 0; bj < 2; ++bj) {
                        const int cl = bj * 128 + wc * 32 + 8 * fq;
                        f32x4 v0 = acc[ai][bj][m][0], v1 = acc[ai][bj][m][1];
                        if (MODE == 0) {
                            if (pn < 16) {
                                u32x4 w; w.x = pg8::cvt_pk_bf16(v0[0], v0[1]); w.y = pg8::cvt_pk_bf16(v0[2], v0[3]); w.z = pg8::cvt_pk_bf16(v1[0], v1[1]); w.w = pg8::cvt_pk_bf16(v1[2], v1[3]);
                                *(u32x4*)(base + (size_t)row * ld + c0 + cl) = w;
                            } else if (cl < 160) {
                                float* d = (float*)(ws + OFF_SMALL) + (size_t)row * 160 + cl;
                                *(f32x4*)d = v0; *(f32x4*)(d + 4) = v1;
                            }
                        } else {
                            u32x4 w;
                            w.x = pg8::cvt_pk_bf16_t(sigmoidf_(v0[0]), sigmoidf_(v0[1])); w.y = pg8::cvt_pk_bf16_t(sigmoidf_(v0[2]), sigmoidf_(v0[3]));
                            w.z = pg8::cvt_pk_bf16_t(sigmoidf_(v1[0]), sigmoidf_(v1[1])); w.w = pg8::cvt_pk_bf16_t(sigmoidf_(v1[2]), sigmoidf_(v1[3]));
                            *(u32x4*)(base + (size_t)row * ld + c0 + cl) = w;
                        }
                    }
                }
        } else {
            f32x4 gm[2][2];
            if (MODE == 3) {
#pragma unroll
                for (int bj = 0; bj < 2; ++bj) { const int col = pn * 256 + bj * 128 + wc * 32 + 8 * fq; const int bb = (u.pm * 256) >> 13;
                    gm[bj][0] = *(const f32x4*)(gate + bb * 3072 + 2048 + col); gm[bj][1] = *(const f32x4*)(gate + bb * 3072 + 2048 + col + 4); }
            }
#pragma unroll
            for (int ai = 0; ai < 2; ++ai)
#pragma unroll
                for (int mp = 0; mp < 2; ++mp) {
                    u32x4 la[4], lb[4]; f32x4 fa[4], fb[4];
#pragma unroll
                    for (int q = 0; q < 4; ++q) { const int m = mp * 2 + (q >> 1), bj = q & 1;
                        const int row = u.pm * 256 + ai * 128 + wr * 64 + m * 16 + fr, cl = bj * 128 + wc * 32 + 8 * fq;
                        if (MODE == 1) la[q] = *(const u32x4*)(base + (size_t)row * ld + c0 + cl);
                        if (MODE == 2) { la[q] = *(const u32x4*)((const bf16_t*)(ws + OFF_GATES) + (size_t)row * 3072 + pn * 256 + cl);
                            lb[q] = (u32x4){0u, 0u, 0u, 0u}; if (pn >= 4) lb[q] = *(const u32x4*)(base + (size_t)row * ld + c0 + cl); }
                        if (MODE == 3) { const int col = pn * 256 + cl; fa[q] = *(const f32x4*)(xin + (size_t)row * 1024 + col); fb[q] = *(const f32x4*)(xin + (size_t)row * 1024 + col + 4); } }
#pragma unroll
                    for (int q = 0; q < 4; ++q) { const int m = mp * 2 + (q >> 1), bj = q & 1;
                        const int row = u.pm * 256 + ai * 128 + wr * 64 + m * 16 + fr, cl = bj * 128 + wc * 32 + 8 * fq;
                        const f32x4 v0 = acc[ai][bj][m][0], v1 = acc[ai][bj][m][1];
                        if (MODE == 1) { const u32x4 o = la[q]; u32x4 w;
                            w.x = pg8::cvt_pk_bf16(lo_bf(o.x) * siluf_(v0[0]), hi_bf(o.x) * siluf_(v0[1])); w.y = pg8::cvt_pk_bf16(lo_bf(o.y) * siluf_(v0[2]), hi_bf(o.y) * siluf_(v0[3]));
                            w.z = pg8::cvt_pk_bf16(lo_bf(o.z) * siluf_(v1[0]), hi_bf(o.z) * siluf_(v1[1])); w.w = pg8::cvt_pk_bf16(lo_bf(o.w) * siluf_(v1[2]), hi_bf(o.w) * siluf_(v1[3]));
                            *(u32x4*)(base + (size_t)row * ld + c0 + cl) = dry ? o : w; }
                        if (MODE == 2) { const u32x4 o = la[q], pm_ = lb[q]; u32x4 w;
                            w.x = pg8::cvt_pk_bf16(lo_bf(pm_.x) + lo_bf(o.x) * v0[0], hi_bf(pm_.x) + hi_bf(o.x) * v0[1]); w.y = pg8::cvt_pk_bf16(lo_bf(pm_.y) + lo_bf(o.y) * v0[2], hi_bf(pm_.y) + hi_bf(o.y) * v0[3]);
                            w.z = pg8::cvt_pk_bf16(lo_bf(pm_.z) + lo_bf(o.z) * v1[0], hi_bf(pm_.z) + hi_bf(o.z) * v1[1]); w.w = pg8::cvt_pk_bf16(lo_bf(pm_.w) + lo_bf(o.w) * v1[2], hi_bf(pm_.w) + hi_bf(o.w) * v1[3]);
                            *(u32x4*)(base + (size_t)row * ld + c0 + cl) = (dry && pn >= 4) ? pm_ : w; }
                        if (MODE == 3) { const int col = pn * 256 + cl; f32x4 r0, r1;
#pragma unroll
                            for (int j = 0; j < 4; ++j) { r0[j] = ALPHA_DN * fa[q][j] + (1.f + gm[bj][0][j]) * v0[j]; r1[j] = ALPHA_DN * fb[q][j] + (1.f + gm[bj][1][j]) * v1[j]; }
                            if (dry && xin == out) { r0 = fa[q]; r1 = fb[q]; }
                            *(f32x4*)(out + (size_t)row * 1024 + col) = r0; *(f32x4*)(out + (size_t)row * 1024 + col + 4) = r1; }
                    }
                }
        }
    }
};

__device__ __forceinline__ int wt1_src(int n) {
    if (n < 1536) return n;
    if (n < 2560) return 2176 + (n - 1536);
    if (n < 3072) return 3208 + (n - 2560);
    if (n < 3328) return 3720 + (n - 3072);
    if (n < 3584) return 3976 + (n - 3328);
    if (n < 4096) return 4232 + (n - 3584);
    if (n < 4352) { const int s = n - 4096; if (s < 128) return 1536 + s; if (s < 136) return 3200 + (s - 128); if (s < 152) return 4744 + (s - 136); return -1; }
    const int m = n - 4352;
    if (m < 512) return 1664 + m;
    if (m < 1024) return 4760 + (m - 512);
    return 5272 + (m - 1024);
}
template <bool MAP>
__device__ __forceinline__ void transpose_item(const float* W, int ldw, bf16_t* WT, int ldt, int row_off, int col_off, int nblk, LAS float* scr, int item, int lane) {
    const int kb = item / nblk, nb = item % nblk, k0 = 64 * kb, n0 = 32 * nb;
    int sc = n0 + (lane & 31); if (MAP) sc = wt1_src(sc);
#pragma unroll 8
    for (int i = 0; i < 32; ++i) { const int kk = 2 * i + (lane >> 5); scr[kk * 33 + (lane & 31)] = sc >= 0 ? W[(size_t)(k0 + kk) * ldw + sc] : 0.f; }
    WAVE_LDS_SYNC();
    const int c = lane & 7;
#pragma unroll
    for (int j = 0; j < 4; ++j) { const int n = (lane >> 3) + 8 * j; const LAS float* s = scr + (8 * c) * 33 + n;
        u32x4 o; o.x = pk2(s[0 * 33], s[1 * 33]); o.y = pk2(s[2 * 33], s[3 * 33]); o.z = pk2(s[4 * 33], s[5 * 33]); o.w = pk2(s[6 * 33], s[7 * 33]);
        *(u32x4*)(WT + (size_t)(row_off + n0 + n) * ldt + col_off + k0 + 8 * c) = o; }
    WAVE_LDS_SYNC();
}
__device__ void wprep(const Params& p, int l, LAS unsigned char* lds, int TIDX, int BIDX) {
    const int lane = TIDX & 63, wave = TIDX >> 6;
    LAS float* scr = (LAS float*)(lds + wave * 16384);
    const int gw = BIDX * 8 + wave, NGW = gridDim.x * 8;
    constexpr int I1 = (1024 / 64) * (8448 / 32), I2 = 3 * (512 / 64) * (1024 / 32), I3 = (1024 / 64) * (1024 / 32);
    bf16_t* WT1 = (bf16_t*)(p.ws + OFF_WT1); bf16_t* WT2 = (bf16_t*)(p.ws + OFF_WT2); bf16_t* WT3 = (bf16_t*)(p.ws + OFF_WT3);
    for (int it = gw; it < I1 + I2 + I3; it += NGW) {
        int r = it;
        if (r < I1) { transpose_item<true>(p.in[I_WIN] + (size_t)l * 1024 * INW, INW, WT1, 1024, 0, 0, 8448 / 32, scr, r, lane); continue; }
        r -= I1;
        if (r < I2) { const int b = r / (I2 / 3), rr = r % (I2 / 3); transpose_item<false>(p.in[I_WBR] + ((size_t)l * 3 + b) * 512 * 1024, 1024, WT2, 512, b * 1024, 0, 1024 / 32, scr, rr, lane); continue; }
        r -= I2;
        transpose_item<false>(p.in[I_WOUT] + (size_t)l * 1024 * 1024, 1024, WT3, 1024, 0, 0, 1024 / 32, scr, r, lane);
    }
}
__device__ void ada_phase(const Params& p, LAS unsigned char* lds, int TIDX, int BIDX) {
    LAS float* red = (LAS float*)lds;
    const int tid = TIDX, kg = tid >> 5, cj = tid & 31;
    float* mod = (float*)(p.ws + OFF_MOD);
    for (int it = BIDX; it < 2 * 96; it += gridDim.x) {
        const int l = it / 96, col = (it % 96) * 32 + cj;
        const float* W = p.in[I_ADAW] + (size_t)l * 1024 * 3072;
        float a0 = 0.f, a1 = 0.f, a2 = 0.f, a3 = 0.f;
        for (int k = kg * 64; k < kg * 64 + 64; ++k) {
            const float w = W[(size_t)k * 3072 + col];
            a0 += siluf_(p.in[I_C][k]) * w; a1 += siluf_(p.in[I_C][1024 + k]) * w; a2 += siluf_(p.in[I_C][2048 + k]) * w; a3 += siluf_(p.in[I_C][3072 + k]) * w;
        }
        red[(kg * 32 + cj) * 4 + 0] = a0; red[(kg * 32 + cj) * 4 + 1] = a1; red[(kg * 32 + cj) * 4 + 2] = a2; red[(kg * 32 + cj) * 4 + 3] = a3;
        __syncthreads();
        if (tid < 128) { const int c2 = tid >> 2, b = tid & 3; float s = 0.f;
            for (int g = 0; g < 16; ++g) s += red[(g * 32 + c2) * 4 + b];
            const int cc = (it % 96) * 32 + c2;
            mod[((size_t)l * 4 + b) * 3072 + cc] = s + p.in[I_ADAB][(size_t)l * 3072 + cc]; }
        __syncthreads();
    }
}
__device__ __forceinline__ void ln_stats(const f32x4 (&v)[4], float& mean, float& rstd, float eps) {
    float s = 0.f;
#pragma unroll
    for (int j = 0; j < 4; ++j) s += (v[j][0] + v[j][1]) + (v[j][2] + v[j][3]);
    mean = wave_sum(s) * (1.f / 1024.f); float s2 = 0.f;
#pragma unroll
    for (int j = 0; j < 4; ++j) { const f32x4 d = v[j] - mean; s2 += (d[0] * d[0] + d[1] * d[1]) + (d[2] * d[2] + d[3] * d[3]); }
    rstd = rsqrtf(wave_sum(s2) * (1.f / 1024.f) + eps);
}
__device__ __forceinline__ void mod_row_to_h(const Params& p, const f32x4 (&v)[4], int row, int l, int lane) {
    float mean, rstd; ln_stats(v, mean, rstd, 1e-5f);
    const float* mod = (const float*)(p.ws + OFF_MOD) + ((size_t)l * 4 + (row >> 13)) * 3072;
    bf16_t* H = (bf16_t*)(p.ws + OFF_H) + (size_t)row * 1024;
#pragma unroll
    for (int j = 0; j < 4; ++j) { const int c = 256 * j + 4 * lane;
        const f32x4 sh = *(const f32x4*)(mod + c), sc = *(const f32x4*)(mod + 1024 + c);
        f32x4 h;
#pragma unroll
        for (int e = 0; e < 4; ++e) h[e] = (v[j][e] - mean) * rstd * (1.f + sc[e]) + sh[e];
        u32x2 o; o.x = pk2(h[0], h[1]); o.y = pk2(h[2], h[3]);
        *(u32x2*)(H + c) = o; }
}
__device__ void ln1_phase(const Params& p, int l, const float* xin, int TIDX, int BIDX) {
    const int lane = TIDX & 63, gw = BIDX * 8 + (TIDX >> 6), NGW = gridDim.x * 8;
    for (int row = gw; row < T; row += NGW) {
        f32x4 v[4];
#pragma unroll
        for (int j = 0; j < 4; ++j) v[j] = *(const f32x4*)(xin + (size_t)row * 1024 + 256 * j + 4 * lane);
        mod_row_to_h(p, v, row, l, lane);
    }
}
__device__ void lnpost_phase(const Params& p, int l, int TIDX, int BIDX, int dry) {
    const int lane = TIDX & 63, gw = BIDX * 8 + (TIDX >> 6), NGW = gridDim.x * 8;
    const float* pg = p.in[I_PG] + l * 1024; const float* pb = p.in[I_PB] + l * 1024;
    for (int row = gw; row < T; row += NGW) {
        f32x4 v[4];
#pragma unroll
        for (int j = 0; j < 4; ++j) v[j] = *(const f32x4*)(p.out + (size_t)row * 1024 + 256 * j + 4 * lane);
        float mean, rstd; ln_stats(v, mean, rstd, 1e-5f);
#pragma unroll
        for (int j = 0; j < 4; ++j) { const int c = 256 * j + 4 * lane; const f32x4 g = *(const f32x4*)(pg + c), b = *(const f32x4*)(pb + c);
            const f32x4 orig = v[j];
#pragma unroll
            for (int e = 0; e < 4; ++e) v[j][e] = (v[j][e] - mean) * rstd * g[e] + b[e];
            *(f32x4*)(p.out + (size_t)row * 1024 + c) = dry ? orig : v[j]; }
        if (l == 0) mod_row_to_h(p, v, row, 1, lane);
    }
}

__device__ __forceinline__ void conv_unpack(const u32x4 w, float (&x)[8]) {
#pragma unroll
    for (int q = 0; q < 4; ++q) { x[2 * q] = lo_bf(w[q]); x[2 * q + 1] = hi_bf(w[q]); }
}
__device__ void rwkv_prep_phase(const Params& p, int l, LAS unsigned char* lds, int TIDX, int BIDX, const XcdBarrier& xb, int dry) {
    {
        bf16_t* XBC = (bf16_t*)(p.ws + OFF_XBC);
        const int cgp = TIDX & 127, qt = TIDX >> 7; const int q0 = BIDX * 128 + qt * 32; const int c8 = cgp * 8;
        float h1[8], h2[8], h3[8];
        if ((q0 & (SEQ - 1)) != 0) { conv_unpack(*(const u32x4*)(XBC + (size_t)(q0 - 1) * 1024 + c8), h1); conv_unpack(*(const u32x4*)(XBC + (size_t)(q0 - 2) * 1024 + c8), h2); conv_unpack(*(const u32x4*)(XBC + (size_t)(q0 - 3) * 1024 + c8), h3); }
        else {
#pragma unroll
            for (int e = 0; e < 8; ++e) h1[e] = h2[e] = h3[e] = 0.f; }
        xcd_barrier(xb);
        float cw0[8], cw1[8], cw2[8], cw3[8], cb[8];
#pragma unroll
        for (int e = 0; e < 8; ++e) { cw0[e] = p.in[I_CONVW][((size_t)l * 4 + 0) * 1024 + c8 + e]; cw1[e] = p.in[I_CONVW][((size_t)l * 4 + 1) * 1024 + c8 + e];
            cw2[e] = p.in[I_CONVW][((size_t)l * 4 + 2) * 1024 + c8 + e]; cw3[e] = p.in[I_CONVW][((size_t)l * 4 + 3) * 1024 + c8 + e]; cb[e] = p.in[I_CONVB][l * 1024 + c8 + e]; }
#pragma unroll 4
        for (int i = 0; i < 32; ++i) {
            bf16_t* ptr = XBC + (size_t)(q0 + i) * 1024 + c8;
            const u32x4 raw_ = *(const u32x4*)ptr; float x0[8]; conv_unpack(raw_, x0);
            float y[8];
#pragma unroll
            for (int e = 0; e < 8; ++e) { y[e] = siluf_(cw0[e] * h3[e] + cw1[e] * h2[e] + cw2[e] * h1[e] + cw3[e] * x0[e] + cb[e]); h3[e] = h2[e]; h2[e] = h1[e]; h1[e] = x0[e]; }
            u32x4 w; w.x = pk2(y[0], y[1]); w.y = pk2(y[2], y[3]); w.z = pk2(y[4], y[5]); w.w = pk2(y[6], y[7]);
            *(u32x4*)ptr = dry ? raw_ : w;
        }
    }
    {
        LAS float* S = (LAS float*)lds;
        const float* SM = (const float*)(p.ws + OFF_SMALL);
        const float* mu = p.in[I_MU] + l * 1664 + 1536;
        bf16_t* A = (bf16_t*)(p.ws + OFF_A); float* DEC = (float*)(p.ws + OFF_DEC);
        const int tbase = BIDX * 128;
        { const int tok = TIDX >> 2, part = TIDX & 3; const int row = tbase + tok; const bool first = (row & (SEQ - 1)) == 0;
#pragma unroll
          for (int q = 0; q < 8; ++q) { const int j = part * 32 + q * 4;
              const f32x4 cur = *(const f32x4*)(SM + (size_t)row * 160 + j);
              f32x4 prv = (f32x4){0.f, 0.f, 0.f, 0.f}; if (!first) prv = *(const f32x4*)(SM + (size_t)(row - 1) * 160 + j);
              const f32x4 m4 = *(const f32x4*)(mu + j);
              f32x4 v;
#pragma unroll
              for (int e = 0; e < 4; ++e) { v[e] = cur[e] + m4[e] * (prv[e] - cur[e]); if (part < 2) v[e] = tanhf(v[e]); }
              *(LAS f32x4*)(S + tok * 132 + j) = v; } }
        __syncthreads();
        const int wave = TIDX >> 6, lane = TIDX & 63, r = lane & 15, kg = lane >> 4, cbase = wave * 64;
#pragma unroll 1
        for (int pass = 0; pass < 2; ++pass) {
            const float* W = (pass ? p.in[I_AUP] : p.in[I_WUP]) + (size_t)l * 64 * 512;
            const float* bias = (pass ? p.in[I_A0] : p.in[I_W0]) + l * 512;
            float bfrag[4][16], b0[4];
#pragma unroll
            for (int ct = 0; ct < 4; ++ct) { b0[ct] = bias[cbase + ct * 16 + r];
#pragma unroll
                for (int ks = 0; ks < 16; ++ks) bfrag[ct][ks] = W[(size_t)(ks * 4 + kg) * 512 + cbase + ct * 16 + r]; }
#pragma unroll 1
            for (int tt = 0; tt < 8; ++tt) {
                f32x4 acc[4];
#pragma unroll
                for (int ct = 0; ct < 4; ++ct) acc[ct] = (f32x4){0.f, 0.f, 0.f, 0.f};
#pragma unroll
                for (int ks = 0; ks < 16; ++ks) { const float av = S[(tt * 16 + r) * 132 + pass * 64 + ks * 4 + kg];
#pragma unroll
                    for (int ct = 0; ct < 4; ++ct) acc[ct] = __builtin_amdgcn_mfma_f32_16x16x4f32(av, bfrag[ct][ks], acc[ct], 0, 0, 0); }
#pragma unroll
                for (int ct = 0; ct < 4; ++ct)
#pragma unroll
                    for (int j = 0; j < 4; ++j) { const size_t o = (size_t)(tbase + tt * 16 + kg * 4 + j) * 512 + cbase + ct * 16 + r; const float x = b0[ct] + acc[ct][j];
                        const float sg = 1.0f / (1.0f + __expf(-x));
                        if (pass) A[o] = f2bf(sg); else DEC[o] = __expf(-0.6065306597126334f * sg); }
            }
        }
        __syncthreads();
    }
}

typedef float f32x2 __attribute__((ext_vector_type(2)));
template <int CTRL> __device__ __forceinline__ float dpp_f(float x) { return __builtin_bit_cast(float, __builtin_amdgcn_update_dpp(0, __builtin_bit_cast(int, x), CTRL, 0xF, 0xF, true)); }
__device__ __forceinline__ float row16_sum(float x) { x += dpp_f<0xB1>(x); x += dpp_f<0x4E>(x); x += dpp_f<0x141>(x); x += dpp_f<0x140>(x); return x; }
constexpr int RW_TC = 32, RW_VEC_B = RW_TC * 5 * 64 * 4, RW_V_B = RW_TC * 16 * 4, RW_BUF_B = RW_VEC_B + 2 * RW_V_B;
__device__ void rwkv_scan_fast(const Params& p, int l, int unit, LAS unsigned char* lds, int TIDX) {
    const int bh = unit >> 2, rq = unit & 3, b = bh >> 3, h = bh & 7, wave = TIDX >> 6, lane = TIDX & 63;
    const size_t r0 = (size_t)b * SEQ;
    bf16_t* Y = (bf16_t*)(p.ws + OFF_Y3);
    if (wave >= 4) {
        const int lw = wave - 4, sl = lane >> 3, c8 = (lane & 7) * 8, ch0 = h * 64 + c8;
        const bf16_t* RKV = (const bf16_t*)(p.ws + OFF_RKV); const bf16_t* A = (const bf16_t*)(p.ws + OFF_A); const float* DEC = (const float*)(p.ws + OFF_DEC);
        float mu_r[8], mu_k[8], mu_v[8], k_k[8], k_a[8];
#pragma unroll
        for (int e = 0; e < 8; ++e) { mu_r[e] = p.in[I_MU][l * 1664 + ch0 + e]; mu_k[e] = p.in[I_MU][l * 1664 + 512 + ch0 + e]; mu_v[e] = p.in[I_MU][l * 1664 + 1024 + ch0 + e];
            k_k[e] = p.in[I_KK][l * 512 + ch0 + e]; k_a[e] = p.in[I_KA][l * 512 + ch0 + e]; }
        u32x4 nR, nK, nV, nRp, nKp, nVp, nA; f32x4 nD0, nD1;
        auto issue = [&](int cc) {
            const size_t row = r0 + (size_t)cc * RW_TC + lw * 8 + sl;
            nR = *(const u32x4*)(RKV + row * 1536 + ch0); nK = *(const u32x4*)(RKV + row * 1536 + 512 + ch0); nV = *(const u32x4*)(RKV + row * 1536 + 1024 + ch0);
            nA = *(const u32x4*)(A + row * 512 + ch0); nD0 = *(const f32x4*)(DEC + row * 512 + ch0); nD1 = *(const f32x4*)(DEC + row * 512 + ch0 + 4);
            const size_t prow = (row & (SEQ - 1)) != 0 ? row - 1 : row;
            nRp = *(const u32x4*)(RKV + prow * 1536 + ch0); nKp = *(const u32x4*)(RKV + prow * 1536 + 512 + ch0); nVp = *(const u32x4*)(RKV + prow * 1536 + 1024 + ch0);
        };
        issue(0);
        for (int c = -1; c < SEQ / RW_TC; ++c) {
            if (c >= 1) { LAS const float* yb = (LAS const float*)(lds + ((c - 1) & 1) * RW_BUF_B + RW_VEC_B + RW_V_B);
                const int idx = (lw * 64 + lane) * 2, s = idx >> 4, i = idx & 15;
                *(unsigned*)(Y + (r0 + (size_t)(c - 1) * RW_TC + s) * 512 + h * 64 + rq * 16 + i) = pk2(yb[idx], yb[idx + 1]); }
            if (c + 1 < SEQ / RW_TC) {
                const u32x4 cR = nR, cK = nK, cV = nV, cRp = nRp, cKp = nKp, cVp = nVp, cA = nA; const f32x4 cD0 = nD0, cD1 = nD1;
                if (c + 2 < SEQ / RW_TC) issue(c + 2);
                LAS float* vec = (LAS float*)(lds + ((c + 1) & 1) * RW_BUF_B); LAS float* vb = (LAS float*)(lds + ((c + 1) & 1) * RW_BUF_B + RW_VEC_B);
                const int s = lw * 8 + sl;
                float cr[8], ck[8], cv[8], pr[8], pk[8], pv[8], ca[8];
                conv_unpack(cR, cr); conv_unpack(cK, ck); conv_unpack(cV, cv); conv_unpack(cRp, pr); conv_unpack(cKp, pk); conv_unpack(cVp, pv); conv_unpack(cA, ca);
                if ((((c + 1) * RW_TC + s) & (SEQ - 1)) == 0) {
#pragma unroll
                    for (int e = 0; e < 8; ++e) pr[e] = pk[e] = pv[e] = 0.f; }
                float rr[8], kk[8], vv[8], kkj[8]; float n2 = 0.f;
#pragma unroll
                for (int e = 0; e < 8; ++e) { rr[e] = cr[e] + mu_r[e] * (pr[e] - cr[e]); kk[e] = ck[e] + mu_k[e] * (pk[e] - ck[e]); vv[e] = cv[e] + mu_v[e] * (pv[e] - cv[e]);
                    kkj[e] = kk[e] * k_k[e]; n2 += kkj[e] * kkj[e]; }
                n2 += dpp_f<0xB1>(n2); n2 += dpp_f<0x4E>(n2); n2 += dpp_f<0x141>(n2);
                const float inv = 1.f / fmaxf(sqrtf(n2), 1e-12f);
                f32x4 o0, o1;
                LAS float* d = vec + s * 320 + c8;
                *(LAS f32x4*)(d) = cD0; *(LAS f32x4*)(d + 4) = cD1;
#pragma unroll
                for (int e = 0; e < 4; ++e) { o0[e] = kkj[e] * inv; o1[e] = kkj[4 + e] * inv; }
                *(LAS f32x4*)(d + 64) = o0; *(LAS f32x4*)(d + 68) = o1;
#pragma unroll
                for (int e = 0; e < 4; ++e) { o0[e] *= ca[e]; o1[e] *= ca[4 + e]; }
                *(LAS f32x4*)(d + 128) = o0; *(LAS f32x4*)(d + 132) = o1;
#pragma unroll
                for (int e = 0; e < 4; ++e) { o0[e] = kk[e] * (1.f + (ca[e] - 1.f) * k_a[e]); o1[e] = kk[4 + e] * (1.f + (ca[4 + e] - 1.f) * k_a[4 + e]); }
                *(LAS f32x4*)(d + 192) = o0; *(LAS f32x4*)(d + 196) = o1;
#pragma unroll
                for (int e = 0; e < 4; ++e) { o0[e] = rr[e]; o1[e] = rr[4 + e]; }
                *(LAS f32x4*)(d + 256) = o0; *(LAS f32x4*)(d + 260) = o1;
                if ((c8 >> 4) == rq) {
#pragma unroll
                    for (int e = 0; e < 4; ++e) { o0[e] = vv[e]; o1[e] = vv[4 + e]; }
                    *(LAS f32x4*)(vb + s * 16 + (c8 & 15)) = o0; *(LAS f32x4*)(vb + s * 16 + (c8 & 15) + 4) = o1; }
            }
            __syncthreads();
        }
        { constexpr int c = SEQ / RW_TC; LAS const float* yb = (LAS const float*)(lds + ((c - 1) & 1) * RW_BUF_B + RW_VEC_B + RW_V_B);
          const int idx = (lw * 64 + lane) * 2, s = idx >> 4, i = idx & 15;
          *(unsigned*)(Y + (r0 + (size_t)(c - 1) * RW_TC + s) * 512 + h * 64 + rq * 16 + i) = pk2(yb[idx], yb[idx + 1]); }
    } else {
        const int rl = wave * 4 + (lane >> 4), cq = lane & 15;
        f32x2 S0 = (f32x2){0.f, 0.f}, S1 = (f32x2){0.f, 0.f};
        __syncthreads();
        for (int c = 0; c < SEQ / RW_TC; ++c) {
            LAS const unsigned char* buf = lds + (c & 1) * RW_BUF_B;
            LAS const float* vb = (LAS const float*)(buf + RW_VEC_B); LAS float* yb = (LAS float*)(buf + RW_VEC_B + RW_V_B);
            LAS const f32x4* q = (LAS const f32x4*)buf + cq;
            f32x4 w4 = q[0], k4 = q[16], b4 = q[32], t4 = q[48], r4 = q[64]; float v = vb[rl];
            float ykeep = 0.f;
#pragma unroll
            for (int s = 0; s < RW_TC; ++s) {
                f32x4 nw = w4, nk = k4, nb = b4, nt = t4, nr = r4; float nv = v;
                if (s + 1 < RW_TC) { LAS const f32x4* qn = q + (s + 1) * 80; nw = qn[0]; nk = qn[16]; nb = qn[32]; nt = qn[48]; nr = qn[64]; nv = vb[(s + 1) * 16 + rl]; }
                f32x2 sp = S0 * (f32x2){k4[0], k4[1]} + S1 * (f32x2){k4[2], k4[3]};
                const float sa = -row16_sum(sp[0] + sp[1]);
                S0 = S0 * (f32x2){w4[0], w4[1]} + (f32x2){b4[0], b4[1]} * sa + (f32x2){t4[0], t4[1]} * v;
                S1 = S1 * (f32x2){w4[2], w4[3]} + (f32x2){b4[2], b4[3]} * sa + (f32x2){t4[2], t4[3]} * v;
                f32x2 yp = S0 * (f32x2){r4[0], r4[1]} + S1 * (f32x2){r4[2], r4[3]};
                const float y = row16_sum(yp[0] + yp[1]);
                ykeep = ((s & 15) == cq) ? y : ykeep;
                if ((s & 15) == 15) yb[((s & ~15) + cq) * 16 + rl] = ykeep;
                w4 = nw; k4 = nk; b4 = nb; t4 = nt; r4 = nr; v = nv;
            }
            __syncthreads();
        }
    }
}

__device__ __forceinline__ int tm_shift(int t) { return ((t >> 3) & 3) * 16; }
template <int K, int AM, int BMODE>
__device__ __forceinline__ f32x4 mma_t(LAS const bf16_t* A, int lda, int arow0, LAS const bf16_t* B, int ldb, int brow0, f32x4 acc, int lane) {
    const int r = lane & 15, kg = lane >> 4;
#pragma unroll
    for (int k0 = 0; k0 < K; k0 += 32) {
        bf16x8 a, b;
        if (AM == 0) a = *(LAS const bf16x8*)(A + (arow0 + r) * lda + k0 + kg * 8);
        else if (AM == 2) a = *(LAS const bf16x8*)(A + (arow0 + r) * lda + tm_shift(arow0 + r) + k0 + kg * 8);
        else { LAS const bf16_t* q = A + (k0 + kg * 8) * lda + tm_shift(k0 + kg * 8) + arow0 + r;
#pragma unroll
            for (int j = 0; j < 8; ++j) a[j] = (short)q[j * lda]; }
        if (BMODE == 0) b = *(LAS const bf16x8*)(B + (brow0 + r) * ldb + k0 + kg * 8);
        else if (BMODE == 2) b = *(LAS const bf16x8*)(B + (brow0 + r) * ldb + tm_shift(brow0 + r) + k0 + kg * 8);
        else { LAS const bf16_t* q = B + (k0 + kg * 8) * ldb + tm_shift(k0 + kg * 8) + brow0 + r;
#pragma unroll
            for (int j = 0; j < 8; ++j) b[j] = (short)q[j * ldb]; }
        acc = __builtin_amdgcn_mfma_f32_16x16x32_bf16(a, b, acc, 0, 0, 0);
    }
    return acc;
}
__device__ void mamba2_chunk(const Params& p, int l, int bh, LAS unsigned char* lds, int TIDX) {
    const int b = bh >> 3, h = bh & 7, g = h >> 2, tid = TIDX, wave = tid >> 6, lane = tid & 63, r = lane & 15, kg = lane >> 4;
    LAS bf16_t* CB = (LAS bf16_t*)lds;
    LAS bf16_t* BB = (LAS bf16_t*)(lds + 17408);
    LAS bf16_t* AY = (LAS bf16_t*)(lds + 41984);
    LAS bf16_t* SB = (LAS bf16_t*)(lds + 67584);
    LAS bf16_t* XD = (LAS bf16_t*)(lds + 84992);
    LAS bf16_t* XE = (LAS bf16_t*)(lds + 101376);
    LAS bf16_t* XS = (LAS bf16_t*)(lds + 117760);
    LAS float* F = (LAS float*)(lds + 126976);
    const bf16_t* XBC = (const bf16_t*)(p.ws + OFF_XBC); const float* SM = (const float*)(p.ws + OFF_SMALL);
    bf16_t* Z = (bf16_t*)(p.ws + OFF_Y3) + (size_t)T * 512;
    const float dtb = p.in[I_DTB][l * 8 + h], ah = -__expf(p.in[I_ALOG][l * 8 + h]), dsk = p.in[I_DSKIP][l * 8 + h];
    const size_t rbase = (size_t)b * SEQ;
    f32x4 sacc[4];
#pragma unroll
    for (int i = 0; i < 4; ++i) sacc[i] = (f32x4){0.f, 0.f, 0.f, 0.f};
    for (int i = tid; i < 64 * 128; i += 512) SB[(i >> 7) * 136 + (i & 127)] = 0;
    u32x4 rc[2], rb[2], rx; float rdt = 0.f;
    auto prefetch = [&](int c) {
        const size_t row0 = rbase + (size_t)c * 64;
#pragma unroll
        for (int i = 0; i < 2; ++i) { const int item = tid + 512 * i, ll = item >> 4, ng = item & 15;
            rc[i] = *(const u32x4*)(XBC + (row0 + ll) * 1024 + 768 + g * 128 + ng * 8); rb[i] = *(const u32x4*)(XBC + (row0 + ll) * 1024 + 512 + g * 128 + ng * 8); }
        rx = *(const u32x4*)(XBC + (row0 + (tid >> 3)) * 1024 + h * 64 + (tid & 7) * 8);
        if (tid < 64) rdt = SM[(row0 + tid) * 160 + 128 + h];
    };
    prefetch(0);
    for (int c = 0; c < SEQ / 64; ++c) {
        const size_t row0 = rbase + (size_t)c * 64;
        if (tid < 64) { const float dt = softplusf_(rdt + dtb); float x = dt * ah;
#pragma unroll
            for (int o = 1; o < 64; o <<= 1) { const float y = __shfl_up(x, o); if (lane >= o) x += y; }
            F[tid] = x; F[64 + tid] = dt; }
        __syncthreads();
        const float acs_last = F[63];
#pragma unroll
        for (int i = 0; i < 2; ++i) { const int item = tid + 512 * i, ll = item >> 4, ng = item & 15;
            *(LAS u32x4*)(CB + ll * 136 + ng * 8) = rc[i]; *(LAS u32x4*)(BB + ll * 192 + tm_shift(ll) + ng * 8) = rb[i];
            const float ea = __expf(F[ll]); float cv[8]; conv_unpack(rc[i], cv);
            u32x4 w; w.x = pk2(cv[0] * ea, cv[1] * ea); w.y = pk2(cv[2] * ea, cv[3] * ea); w.z = pk2(cv[4] * ea, cv[5] * ea); w.w = pk2(cv[6] * ea, cv[7] * ea);
            *(LAS u32x4*)(AY + ll * 200 + 64 + ng * 8) = w; }
        { const int ll = tid >> 3, pg = tid & 7; float xv[8]; conv_unpack(rx, xv); const float dtl = F[64 + ll], ee = __expf(acs_last - F[ll]);
          float xd[8];
#pragma unroll
          for (int e = 0; e < 8; ++e) xd[e] = xv[e] * dtl;
          u32x4 w; w.x = pk2(xd[0], xd[1]); w.y = pk2(xd[2], xd[3]); w.z = pk2(xd[4], xd[5]); w.w = pk2(xd[6], xd[7]);
          *(LAS u32x4*)(XD + ll * 128 + tm_shift(ll) + pg * 8) = w;
          w.x = pk2(xd[0] * ee, xd[1] * ee); w.y = pk2(xd[2] * ee, xd[3] * ee); w.z = pk2(xd[4] * ee, xd[5] * ee); w.w = pk2(xd[6] * ee, xd[7] * ee);
          *(LAS u32x4*)(XE + ll * 128 + tm_shift(ll) + pg * 8) = w;
          *(LAS u32x4*)(XS + ll * 72 + pg * 8) = rx; }
        __syncthreads();
        if (c + 1 < SEQ / 64) prefetch(c + 1);
        bf16_t zpre[2][4];
#pragma unroll
        for (int q = 0; q < 2; ++q) { const int tt = wave + 8 * q, tl = tt >> 2, tp = tt & 3;
#pragma unroll
            for (int j = 0; j < 4; ++j) zpre[q][j] = Z[(row0 + tl * 16 + kg * 4 + j) * 512 + h * 64 + tp * 16 + r]; }
#pragma unroll
        for (int q = 0; q < 2; ++q) { const int tt = wave + 8 * q, tl = tt >> 2, ts = tt & 3;
            f32x4 acc = (f32x4){0.f, 0.f, 0.f, 0.f};
            if (ts <= tl) acc = mma_t<128, 0, 2>(CB, 136, tl * 16, BB, 192, ts * 16, acc, lane);
            const int sc = ts * 16 + r; const float as = F[sc];
#pragma unroll
            for (int j = 0; j < 4; ++j) { const int ll = tl * 16 + kg * 4 + j; const float v = (sc <= ll) ? acc[j] * __expf(F[ll] - as) : 0.f; AY[ll * 200 + sc] = f2bf(v); } }
        __syncthreads();
#pragma unroll
        for (int q = 0; q < 2; ++q) { const int tt = wave + 8 * q, tl = tt >> 2, tp = tt & 3;
            f32x4 acc = (f32x4){0.f, 0.f, 0.f, 0.f};
            acc = mma_t<64, 0, 1>(AY, 200, tl * 16, XD, 128, tp * 16, acc, lane);
            acc = mma_t<128, 0, 0>(AY + 64, 200, tl * 16, SB, 136, tp * 16, acc, lane);
            const int pp = tp * 16 + r;
#pragma unroll
            for (int j = 0; j < 4; ++j) { const int ll = tl * 16 + kg * 4 + j; bf16_t* zp = Z + (row0 + ll) * 512 + h * 64 + pp;
                const float y = acc[j] + dsk * bf2f(XS[ll * 72 + pp]); *zp = f2bf(y * siluf_(bf2f(zpre[q][j]))); } }
        const float dl = __expf(acs_last);
#pragma unroll
        for (int i = 0; i < 4; ++i) { const int id = wave * 4 + i, tp = id >> 3, tn = id & 7;
            sacc[i] = sacc[i] * dl; sacc[i] = mma_t<64, 1, 1>(XE, 128, tp * 16, BB, 192, tn * 16, sacc[i], lane); }
        __syncthreads();
#pragma unroll
        for (int i = 0; i < 4; ++i) { const int id = wave * 4 + i, tp = id >> 3, tn = id & 7;
#pragma unroll
            for (int j = 0; j < 4; ++j) SB[(tp * 16 + kg * 4 + j) * 136 + tn * 16 + r] = f2bf(sacc[i][j]); }
    }
}
__device__ void gla_chunk(const Params& p, int l, int unit, LAS unsigned char* lds, int TIDX) {
    const int bh = unit >> 1, eh = unit & 1, b = bh >> 2, h = bh & 3, tid = TIDX, wave = tid >> 6, lane = tid & 63, r = lane & 15, kg = lane >> 4;
    LAS bf16_t* KG = (LAS bf16_t*)lds;
    LAS bf16_t* AY = (LAS bf16_t*)(lds + 9216);
    LAS bf16_t* SB = (LAS bf16_t*)(lds + 26624);
    LAS bf16_t* VV = (LAS bf16_t*)(lds + 35840);
    LAS bf16_t* KD = (LAS bf16_t*)(lds + 52224);
    LAS float* G = (LAS float*)(lds + 68608);
    LAS float* UP = (LAS float*)(lds + 85248);
    LAS float* GD = (LAS float*)(lds + 89344);
    LAS float* SEG = (LAS float*)(lds + 93440);
    const bf16_t* GQ = (const bf16_t*)(p.ws + OFF_GQ); const bf16_t* GK = (const bf16_t*)(p.ws + OFF_GK); const float* SM = (const float*)(p.ws + OFF_SMALL);
    bf16_t* GV = (bf16_t*)(p.ws + OFF_Y3) + (size_t)2 * T * 512;
    const size_t rbase = (size_t)b * SEQ;
    const int ll = tid >> 3, dg = tid & 7;
    for (int i = tid; i < 16 * 64; i += 512) UP[i] = p.in[I_GKUP][((size_t)l * 16 + (i >> 6)) * 256 + h * 64 + (i & 63)];
    float gkb[8];
#pragma unroll
    for (int e = 0; e < 8; ++e) gkb[e] = p.in[I_GKB][l * 256 + h * 64 + dg * 8 + e];
    f32x4 sacc[2];
    sacc[0] = sacc[1] = (f32x4){0.f, 0.f, 0.f, 0.f};
    for (int i = tid; i < 64 * 64; i += 512) SB[(i >> 6) * 72 + (i & 63)] = 0;
    u32x4 rq, rk, rv; f32x4 rg = (f32x4){0.f, 0.f, 0.f, 0.f};
    auto prefetch = [&](int c) {
        const size_t row0 = rbase + (size_t)c * 64;
        rq = *(const u32x4*)(GQ + (row0 + ll) * 256 + h * 64 + dg * 8); rk = *(const u32x4*)(GK + (row0 + ll) * 256 + h * 64 + dg * 8);
        rv = *(const u32x4*)(GV + (row0 + ll) * 512 + h * 128 + eh * 64 + dg * 8);
        if (tid < 256) rg = *(const f32x4*)(SM + (row0 + (tid >> 2)) * 160 + 136 + (tid & 3) * 4);
    };
    prefetch(0);
    for (int c = 0; c < SEQ / 64; ++c) {
        const size_t row0 = rbase + (size_t)c * 64;
        if (tid < 256) *(LAS f32x4*)(GD + (tid >> 2) * 16 + (tid & 3) * 4) = rg;
        __syncthreads();
        { float gp[8];
#pragma unroll
          for (int e = 0; e < 8; ++e) gp[e] = gkb[e];
#pragma unroll
          for (int q = 0; q < 16; ++q) { const float gd = GD[ll * 16 + q];
#pragma unroll
              for (int e = 0; e < 8; ++e) gp[e] += gd * UP[q * 64 + dg * 8 + e]; }
#pragma unroll
          for (int e = 0; e < 8; ++e) G[ll * 65 + dg * 8 + e] = (fminf(gp[e], 0.f) - __logf(1.f + __expf(-fabsf(gp[e])))) * (1.f / 16.f); }
        __syncthreads();
        { const int d = tid & 63, sg = tid >> 6; float gv[8]; float a = 0.f;
#pragma unroll
          for (int q = 0; q < 8; ++q) { a += G[(sg * 8 + q) * 65 + d]; gv[q] = a; }
          SEG[sg * 64 + d] = a;
          __syncthreads();
          float off = 0.f;
#pragma unroll
          for (int q = 0; q < 7; ++q) off += (q < sg) ? SEG[q * 64 + d] : 0.f;
#pragma unroll
          for (int q = 0; q < 8; ++q) G[(sg * 8 + q) * 65 + d] = gv[q] + off; }
        __syncthreads();
        { float qv[8], kv[8]; conv_unpack(rq, qv); conv_unpack(rk, kv);
          float qg[8], ki[8], kd[8];
#pragma unroll
          for (int e = 0; e < 8; ++e) { const int d = dg * 8 + e; const float gl = G[ll * 65 + d], glast = G[63 * 65 + d];
              qg[e] = qv[e] * 0.125f * __expf(gl); ki[e] = kv[e] * __expf(-gl); kd[e] = kv[e] * __expf(glast - gl); }
          u32x4 w; w.x = pk2(qg[0], qg[1]); w.y = pk2(qg[2], qg[3]); w.z = pk2(qg[4], qg[5]); w.w = pk2(qg[6], qg[7]);
          *(LAS u32x4*)(AY + ll * 136 + 64 + dg * 8) = w;
          w.x = pk2(ki[0], ki[1]); w.y = pk2(ki[2], ki[3]); w.z = pk2(ki[4], ki[5]); w.w = pk2(ki[6], ki[7]);
          *(LAS u32x4*)(KG + ll * 72 + dg * 8) = w;
          w.x = pk2(kd[0], kd[1]); w.y = pk2(kd[2], kd[3]); w.z = pk2(kd[4], kd[5]); w.w = pk2(kd[6], kd[7]);
          *(LAS u32x4*)(KD + ll * 128 + tm_shift(ll) + dg * 8) = w;
          *(LAS u32x4*)(VV + ll * 128 + tm_shift(ll) + dg * 8) = rv; }
        __syncthreads();
        if (c + 1 < SEQ / 64) prefetch(c + 1);
#pragma unroll
        for (int q = 0; q < 2; ++q) { const int tt = wave + 8 * q, tl = tt >> 2, ts = tt & 3;
            f32x4 acc = (f32x4){0.f, 0.f, 0.f, 0.f};
            if (ts <= tl) acc = mma_t<64, 0, 0>(AY + 64, 136, tl * 16, KG, 72, ts * 16, acc, lane);
            const int sc = ts * 16 + r;
#pragma unroll
            for (int j = 0; j < 4; ++j) { const int l2 = tl * 16 + kg * 4 + j; AY[l2 * 136 + sc] = f2bf((sc <= l2) ? acc[j] : 0.f); } }
        __syncthreads();
#pragma unroll
        for (int q = 0; q < 2; ++q) { const int tt = wave + 8 * q, tl = tt >> 2, te = tt & 3;
            f32x4 acc = (f32x4){0.f, 0.f, 0.f, 0.f};
            acc = mma_t<64, 0, 1>(AY, 136, tl * 16, VV, 128, te * 16, acc, lane);
            acc = mma_t<64, 0, 0>(AY + 64, 136, tl * 16, SB, 72, te * 16, acc, lane);
#pragma unroll
            for (int j = 0; j < 4; ++j) GV[(row0 + tl * 16 + kg * 4 + j) * 512 + h * 128 + eh * 64 + te * 16 + r] = f2bf(acc[j]); }
#pragma unroll
        for (int i = 0; i < 2; ++i) { const int id = wave * 2 + i, te = id >> 2, td = id & 3;
            const float dl = __expf(G[63 * 65 + td * 16 + r]);
            sacc[i] = sacc[i] * dl; sacc[i] = mma_t<64, 1, 1>(VV, 128, te * 16, KD, 128, td * 16, sacc[i], lane); }
        __syncthreads();
#pragma unroll
        for (int i = 0; i < 2; ++i) { const int id = wave * 2 + i, te = id >> 2, td = id & 3;
#pragma unroll
            for (int j = 0; j < 4; ++j) SB[(te * 16 + kg * 4 + j) * 72 + td * 16 + r] = f2bf(sacc[i][j]); }
    }
}
__device__ void scans_naive_phase(const Params& p, int l, LAS unsigned char* lds, int TIDX, int BIDX) {
    const int wave = TIDX >> 6;
    LAS float* wl = (LAS float*)(lds + wave * 4096);
    if (BIDX < 128) { rwkv_scan_fast(p, l, BIDX, lds, TIDX); return; }
    const int u = BIDX - 128;
    if (u < 32) mamba2_chunk(p, l, u, lds, TIDX);
    else if (u < 64) gla_chunk(p, l, u - 32, lds, TIDX);
}
__device__ void post_phase(const Params& p, int l, int TIDX, int BIDX, int dry) {
    const int lane = TIDX & 63, gw = BIDX * 8 + (TIDX >> 6), NGW = gridDim.x * 8;
    const bf16_t* RKV = (const bf16_t*)(p.ws + OFF_RKV); const bf16_t* A = (const bf16_t*)(p.ws + OFF_A);
    bf16_t* Y0 = (bf16_t*)(p.ws + OFF_Y3); bf16_t* Y1 = Y0 + (size_t)T * 512; bf16_t* Y2 = Y1 + (size_t)T * 512;
    const int c0 = lane * 8;
    float mur[8], muk[8], muv[8], kA[8], rk[8], lg[8], lb[8], nw1[8], nw2[8];
#pragma unroll
    for (int e = 0; e < 8; ++e) { const int c = c0 + e;
        mur[e] = p.in[I_MU][l * 1664 + c]; muk[e] = p.in[I_MU][l * 1664 + 512 + c]; muv[e] = p.in[I_MU][l * 1664 + 1024 + c];
        kA[e] = p.in[I_KA][l * 512 + c]; rk[e] = p.in[I_RK][l * 512 + c]; lg[e] = p.in[I_LNG][l * 512 + c]; lb[e] = p.in[I_LNB][l * 512 + c];
        nw1[e] = p.in[I_M2NW][l * 512 + c]; nw2[e] = p.in[I_GNW][l * 128 + (c & 127)]; }
    for (int row = gw; row < T; row += NGW) {
        const bool first = (row & (SEQ - 1)) == 0;
        float y[8], r[8], k[8], v[8], a[8];
        u32x4 ysave;
        { const u32x4 yy = *(const u32x4*)(Y0 + (size_t)row * 512 + c0); ysave = yy; const u32x4 aa = *(const u32x4*)(A + (size_t)row * 512 + c0);
          const u32x4 rr = *(const u32x4*)(RKV + (size_t)row * 1536 + c0), kk = *(const u32x4*)(RKV + (size_t)row * 1536 + 512 + c0), vv = *(const u32x4*)(RKV + (size_t)row * 1536 + 1024 + c0);
          u32x4 rp = (u32x4){0, 0, 0, 0}, kp = rp, vp = rp;
          if (!first) { rp = *(const u32x4*)(RKV + (size_t)(row - 1) * 1536 + c0); kp = *(const u32x4*)(RKV + (size_t)(row - 1) * 1536 + 512 + c0); vp = *(const u32x4*)(RKV + (size_t)(row - 1) * 1536 + 1024 + c0); }
#pragma unroll
          for (int q = 0; q < 4; ++q) {
              y[2 * q] = lo_bf(yy[q]); y[2 * q + 1] = hi_bf(yy[q]); a[2 * q] = lo_bf(aa[q]); a[2 * q + 1] = hi_bf(aa[q]);
              float x0 = lo_bf(rr[q]), x1 = hi_bf(rr[q]); r[2 * q] = x0 + mur[2 * q] * (lo_bf(rp[q]) - x0); r[2 * q + 1] = x1 + mur[2 * q + 1] * (hi_bf(rp[q]) - x1);
              x0 = lo_bf(kk[q]); x1 = hi_bf(kk[q]); k[2 * q] = x0 + muk[2 * q] * (lo_bf(kp[q]) - x0); k[2 * q + 1] = x1 + muk[2 * q + 1] * (hi_bf(kp[q]) - x1);
              x0 = lo_bf(vv[q]); x1 = hi_bf(vv[q]); v[2 * q] = x0 + muv[2 * q] * (lo_bf(vp[q]) - x0); v[2 * q + 1] = x1 + muv[2 * q + 1] * (hi_bf(vp[q]) - x1); } }
        float s = 0.f, bs = 0.f;
#pragma unroll
        for (int e = 0; e < 8; ++e) { s += y[e]; bs += r[e] * (k[e] * (1.f + (a[e] - 1.f) * kA[e])) * rk[e]; }
        s += __shfl_xor(s, 1); s += __shfl_xor(s, 2); s += __shfl_xor(s, 4);
        bs += __shfl_xor(bs, 1); bs += __shfl_xor(bs, 2); bs += __shfl_xor(bs, 4);
        const float mean = s * (1.f / 64.f); float s2 = 0.f;
#pragma unroll
        for (int e = 0; e < 8; ++e) { const float d = y[e] - mean; s2 += d * d; }
        s2 += __shfl_xor(s2, 1); s2 += __shfl_xor(s2, 2); s2 += __shfl_xor(s2, 4);
        const float rstd = rsqrtf(s2 * (1.f / 64.f) + 64e-5f);
        { float o[8];
#pragma unroll
          for (int e = 0; e < 8; ++e) o[e] = (y[e] - mean) * rstd * lg[e] + lb[e] + bs * v[e];
          u32x4 w; w.x = pk2(o[0], o[1]); w.y = pk2(o[2], o[3]); w.z = pk2(o[4], o[5]); w.w = pk2(o[6], o[7]);
          *(u32x4*)(Y0 + (size_t)row * 512 + c0) = dry ? ysave : w; }
        { const u32x4 yy = *(const u32x4*)(Y1 + (size_t)row * 512 + c0); float q2 = 0.f;
#pragma unroll
          for (int q = 0; q < 4; ++q) { y[2 * q] = lo_bf(yy[q]); y[2 * q + 1] = hi_bf(yy[q]); q2 += y[2 * q] * y[2 * q] + y[2 * q + 1] * y[2 * q + 1]; }
          q2 += __shfl_xor(q2, 1); q2 += __shfl_xor(q2, 2); q2 += __shfl_xor(q2, 4); q2 += __shfl_xor(q2, 8); q2 += __shfl_xor(q2, 16);
          const float rs = rsqrtf(q2 * (1.f / 256.f) + 1e-5f);
          u32x4 w; w.x = pk2(y[0] * rs * nw1[0], y[1] * rs * nw1[1]); w.y = pk2(y[2] * rs * nw1[2], y[3] * rs * nw1[3]); w.z = pk2(y[4] * rs * nw1[4], y[5] * rs * nw1[5]); w.w = pk2(y[6] * rs * nw1[6], y[7] * rs * nw1[7]);
          *(u32x4*)(Y1 + (size_t)row * 512 + c0) = dry ? yy : w; }
        { const u32x4 yy = *(const u32x4*)(Y2 + (size_t)row * 512 + c0); float q2 = 0.f;
#pragma unroll
          for (int q = 0; q < 4; ++q) { y[2 * q] = lo_bf(yy[q]); y[2 * q + 1] = hi_bf(yy[q]); q2 += y[2 * q] * y[2 * q] + y[2 * q + 1] * y[2 * q + 1]; }
          q2 += __shfl_xor(q2, 1); q2 += __shfl_xor(q2, 2); q2 += __shfl_xor(q2, 4); q2 += __shfl_xor(q2, 8);
          const float rs = rsqrtf(q2 * (1.f / 128.f) + 1e-5f);
          u32x4 w; w.x = pk2(y[0] * rs * nw2[0], y[1] * rs * nw2[1]); w.y = pk2(y[2] * rs * nw2[2], y[3] * rs * nw2[3]); w.z = pk2(y[4] * rs * nw2[4], y[5] * rs * nw2[5]); w.w = pk2(y[6] * rs * nw2[6], y[7] * rs * nw2[7]);
          *(u32x4*)(Y2 + (size_t)row * 512 + c0) = dry ? yy : w; }
    }
}

constexpr int NPHASE = 18;
#ifndef EXP_S
#define EXP_S -1
#endif
#ifndef DIAG
#define DIAG 0
#endif
#ifndef DIAG_A
#define DIAG_A(ph, s) ((ph) >= 2 && (s) == 2)
#endif
#ifndef DIAG_B
#define DIAG_B(ph, s) ((ph) >= 2 && ((s) == 0 || (s) >= 4 && (s) <= 6))
#endif
#ifndef PHM
#define PHM 1023
#endif
__global__ __launch_bounds__(512, 2) void mega(Params p) {
    extern __shared__ __attribute__((aligned(16))) unsigned char shm[];
    LAS unsigned char* lds = (LAS unsigned char*)shm;
    cg::grid_group grid = cg::this_grid();
    volatile LAS unsigned* xst = (volatile LAS unsigned*)(lds + 131072);
    if (threadIdx.x < 2) xst[threadIdx.x] = 0u;
    __syncthreads();
    const XcdBarrier xb = xcd_barrier_post((unsigned*)(p.ws + OFF_BAR), xst);
#if DIAG
    unsigned long long tA = 0, tB = 0;
#endif
    for (int ph = p.ph_lo; ph < p.ph_hi; ++ph) {
        const int TIDX = tid_opaque(), BIDX = bid_opaque();
#if DIAG
        const unsigned long long t_start = __builtin_amdgcn_s_memrealtime();
#endif
        if (ph == 0) { if (PHM & 1) { wprep(p, 0, lds, TIDX, BIDX); ada_phase(p, lds, TIDX, BIDX); } }
        else if (ph == 1) { if (PHM & 2) ln1_phase(p, 0, p.in[I_X], TIDX, BIDX); }
        else {
            const int l = (ph - 2) >> 3, s = (ph - 2) & 7;
            const float* xin = l == 0 ? p.in[I_X] : p.out;
            pg8::StaticOrder S;
            if (s == 0 && (PHM & 4)) { pg8::Gemm g{(const bf16_t*)(p.ws + OFF_H), (const bf16_t*)(p.ws + OFF_WT1), T, 4352, 1024, 1 << 30, 0};
                S.init(g.M, g.N, gridDim.x, BIDX); Epi<0> E{p.ws, nullptr, nullptr, nullptr, 0}; pg8::gemm_phase(lds, g, S, E, TIDX); }
            else if (s == 1 && (PHM & 8)) { if (EXP_S == 1) { rwkv_prep_phase(p, l, lds, TIDX, BIDX, xb, 1); xcd_barrier(xb); } rwkv_prep_phase(p, l, lds, TIDX, BIDX, xb, 0); }
            else if (s == 2 && (PHM & 16)) { scans_naive_phase(p, l, lds, TIDX, BIDX); }
            else if (s == 3 && (PHM & 32)) { if (EXP_S == 3) { post_phase(p, l, TIDX, BIDX, 1); xcd_barrier(xb); } post_phase(p, l, TIDX, BIDX, 0); }
            else if (s == 4 && (PHM & 64)) { pg8::Gemm g{(const bf16_t*)(p.ws + OFF_H), (const bf16_t*)(p.ws + OFF_WT1) + (size_t)4352 * 1024, T, 4096, 1024, 1 << 30, 0};
                S.init(g.M, g.N, gridDim.x, BIDX); Epi<1> E{p.ws, nullptr, nullptr, nullptr, 0}; if (EXP_S == s) { E.dry = 1; pg8::gemm_phase(lds, g, S, E, TIDX); xcd_barrier(xb); E.dry = 0; } pg8::gemm_phase(lds, g, S, E, TIDX); }
            else if (s == 5 && (PHM & 128)) { pg8::Gemm g{(const bf16_t*)(p.ws + OFF_Y3), (const bf16_t*)(p.ws + OFF_WT2), T, 1024, 512, 4, (size_t)T * 512 * 2};
                S.init(g.M, g.N, gridDim.x, BIDX, 3); Epi<2> E{p.ws, nullptr, nullptr, nullptr, 0}; if (EXP_S == s) { E.dry = 1; pg8::gemm_phase(lds, g, S, E, TIDX); xcd_barrier(xb); E.dry = 0; } pg8::gemm_phase(lds, g, S, E, TIDX); }
            else if (s == 6 && (PHM & 256)) { pg8::Gemm g{(const bf16_t*)(p.ws + OFF_H), (const bf16_t*)(p.ws + OFF_WT3), T, 1024, 1024, 1 << 30, 0};
                S.init(g.M, g.N, gridDim.x, BIDX); Epi<3> E{p.ws, xin, (const float*)(p.ws + OFF_MOD) + (size_t)l * 4 * 3072, p.out, 0}; if (EXP_S == s) { E.dry = 1; pg8::gemm_phase(lds, g, S, E, TIDX); xcd_barrier(xb); E.dry = 0; } pg8::gemm_phase(lds, g, S, E, TIDX); }
            else if (s == 7 && (PHM & 512)) { if (EXP_S == 7) { lnpost_phase(p, l, TIDX, BIDX, 1); if (l == 0) wprep(p, 1, lds, TIDX, BIDX); xcd_barrier(xb); } lnpost_phase(p, l, TIDX, BIDX, 0); if (l == 0) wprep(p, 1, lds, TIDX, BIDX); }
        }
        if (ph + 1 < p.ph_hi) { if (ph == p.ph_lo) grid.sync(); else xcd_barrier(xb); }
#if DIAG
        { const unsigned long long dt = __builtin_amdgcn_s_memrealtime() - t_start; const int s_ = (ph - 2) & 7;
          if (DIAG_A(ph, s_)) tA += dt; if (DIAG_B(ph, s_)) tB += dt; }
#endif
    }
#if DIAG
    grid.sync();
    if (blockIdx.x == 0) {
        const float vA = (float)tA * 10.f, vB = (float)tB * 10.f;
        for (int i = threadIdx.x; i < (1 << 20); i += 512) p.out[4096 + i] = vB;
        if (threadIdx.x == 0) p.out[0] = vA * 1000.f;
    }
#endif
}

extern "C" void kernel_launch(void* const* d_in, const int* in_sizes, int n_in, void* d_out, int out_size, void* d_ws, size_t ws_size, hipStream_t stream) {
    constexpr int LDS_BYTES = 131072 + 16;
    static int grid = 0;
    if (grid == 0) {
        if (n_in != 28 || out_size != T * DM || ws_size < WS_NEED) { fprintf(stderr, "kernel_launch: unexpected shapes / workspace (%zu < %zu)\n", ws_size, (size_t)WS_NEED); grid = -1; return; }
        int dev = 0, cus = 0, per_cu = 0;
        hipGetDevice(&dev); hipDeviceGetAttribute(&cus, hipDeviceAttributeMultiprocessorCount, dev);
        if (hipFuncSetAttribute((const void*)mega, hipFuncAttributeMaxDynamicSharedMemorySize, LDS_BYTES) != hipSuccess) { fprintf(stderr, "hipFuncSetAttribute failed\n"); grid = -1; return; }
        if (hipOccupancyMaxActiveBlocksPerMultiprocessor(&per_cu, (const void*)mega, 512, LDS_BYTES) != hipSuccess || per_cu < 1) per_cu = 1;
        (void)hipGetLastError();
        grid = cus * 1;
        if (grid != 256) { fprintf(stderr, "kernel_launch: built for 256 CUs\n"); grid = -1; return; }
    }
    if (grid < 0) return;
    if (hipMemsetAsync((char*)d_ws + OFF_BAR, 0, XCD_BAR_WORDS_B, stream) != hipSuccess) { fprintf(stderr, "kernel_launch: memset of barrier words failed\n"); return; }
    Params p{};
    for (int i = 0; i < 28; ++i) p.in[i] = (const float*)d_in[i];
    p.out = (float*)d_out; p.ws = (unsigned char*)d_ws;
#if N_LAUNCH_MODE == 1
    p.ph_lo = 0; p.ph_hi = NPHASE;
    void* args[] = {&p};
    hipError_t e = hipLaunchCooperativeKernel((const void*)mega, dim3(grid), dim3(512), args, LDS_BYTES, stream);
    if (e != hipSuccess) fprintf(stderr, "cooperative launch failed: %s (grid %d)\n", hipGetErrorString(e), grid);
#else
    for (int ph = 0; ph < NPHASE; ++ph) { p.ph_lo = ph; p.ph_hi = ph + 1; hipLaunchKernelGGL(mega, dim3(grid), dim3(512), LDS_BYTES, stream, p); }
#endif
}
```

```cpp
#include <hip/hip_runtime.h>
#include <hip/hip_cooperative_groups.h>
#include <cstdio>
namespace cg = cooperative_groups;

#ifndef N_LAUNCH_MODE
#define N_LAUNCH_MODE 1
#endif

#define LAS __attribute__((address_space(3)))
typedef unsigned short bf16_t;
typedef short bf16x8 __attribute__((ext_vector_type(8)));
typedef float f32x4 __attribute__((ext_vector_type(4)));
typedef unsigned u32x4 __attribute__((ext_vector_type(4)));
typedef unsigned u32x2 __attribute__((ext_vector_type(2)));

constexpr int T = 32768, SEQ = 8192, DM = 1024, NB = 4;
constexpr int INW = 8344;
constexpr float ALPHA_DN = 1.4142135623730951f;

constexpr size_t XCD_BAR_WORDS_B = 3456 * 4;
constexpr size_t SZ_WT1 = (size_t)8448 * 1024 * 2, SZ_WT2 = (size_t)3072 * 512 * 2, SZ_WT3 = (size_t)1024 * 3072 * 2, SZ_MOD = (size_t)2 * 4 * 3072 * 4;
constexpr size_t OFF_WT1 = 0, OFF_WT2 = OFF_WT1 + SZ_WT1, OFF_WT3 = OFF_WT2 + SZ_WT2, OFF_MOD = OFF_WT3 + SZ_WT3;
constexpr size_t OFF_H = OFF_MOD + SZ_MOD;
constexpr size_t OFF_Y3 = OFF_H + (size_t)T * 1024 * 2;
constexpr size_t OFF_RKV = OFF_Y3 + (size_t)3 * T * 512 * 2;
constexpr size_t OFF_XBC = OFF_RKV + (size_t)T * 1536 * 2;
constexpr size_t OFF_GQ = OFF_XBC + (size_t)T * 1024 * 2;
constexpr size_t OFF_GK = OFF_GQ + (size_t)T * 256 * 2;
constexpr size_t OFF_SMALL = OFF_GK + (size_t)T * 256 * 2;
constexpr size_t OFF_A = OFF_SMALL + (size_t)T * 160 * 4;
constexpr size_t OFF_DEC = OFF_A + (size_t)T * 512 * 2;
constexpr size_t WS_END = OFF_DEC + (size_t)T * 512 * 4;
constexpr size_t OFF_BAR = (WS_END + 255) & ~(size_t)255;
constexpr size_t WS_NEED = OFF_BAR + XCD_BAR_WORDS_B;
constexpr size_t OFF_GATES = OFF_RKV;
static_assert(OFF_GK + (size_t)T * 256 * 2 - OFF_RKV == (size_t)T * 3072 * 2, "gates alias");

struct Params { const float* in[28]; float* out; unsigned char* ws; int ph_lo, ph_hi; };
enum { I_X = 0, I_C, I_ADAW, I_ADAB, I_WIN, I_MU, I_W0, I_WUP, I_A0, I_AUP, I_KK, I_KA, I_RK, I_LNG, I_LNB, I_CONVW, I_CONVB, I_DTB, I_ALOG, I_DSKIP,
       I_M2NW, I_GKUP, I_GKB, I_GNW, I_WBR, I_WOUT, I_PG, I_PB };

__device__ __forceinline__ float bf2f(bf16_t v) { return __uint_as_float(((unsigned)v) << 16); }
__device__ __forceinline__ bf16_t f2bf(float f) { unsigned u = __float_as_uint(f); u += 0x7FFFu + ((u >> 16) & 1u); return (bf16_t)(u >> 16); }
__device__ __forceinline__ unsigned pk2(float lo, float hi) { return (unsigned)f2bf(lo) | ((unsigned)f2bf(hi) << 16); }
__device__ __forceinline__ float lo_bf(unsigned w) { return __uint_as_float(w << 16); }
__device__ __forceinline__ float hi_bf(unsigned w) { return __uint_as_float(w & 0xFFFF0000u); }
__device__ __forceinline__ float sigmoidf_(float x) { return __builtin_amdgcn_rcpf(1.0f + __expf(-x)); }
__device__ __forceinline__ float siluf_(float x) { return x / (1.0f + __expf(-x)); }
__device__ __forceinline__ float softplusf_(float x) { return x > 20.f ? x : log1pf(__expf(x)); }
__device__ __forceinline__ float wave_sum(float v) {
#pragma unroll
    for (int o = 1; o < 64; o <<= 1) v += __shfl_xor(v, o);
    return v;
}
__device__ __forceinline__ int tid_opaque() { int t = threadIdx.x; asm volatile("" : "+v"(t)); return t; }
__device__ __forceinline__ int bid_opaque() { int t = blockIdx.x; asm volatile("" : "+s"(t)); return t; }
#define WAVE_LDS_SYNC() do { asm volatile("s_waitcnt lgkmcnt(0)" ::: "memory"); __builtin_amdgcn_wave_barrier(); } while (0)


#define XB_TMO      128
#define XB_XCNT(j)  (256  + 64 * (j))
#define XB_XSUB(j)  (1280 + 64 * (j))
#define XB_XGEN(j)  (2304 + 64 * (j))
#define XB_TOP      3328
#define XB_TOPGEN   3392
#define XCD_BAR_WORDS 3456
#define XB_SPIN_CAP (1u << 20)
__device__ __forceinline__ unsigned xb_ld(unsigned* p)              { return __hip_atomic_load(p, __ATOMIC_RELAXED, __HIP_MEMORY_SCOPE_AGENT); }
__device__ __forceinline__ unsigned xb_add(unsigned* p, unsigned v) { return __hip_atomic_fetch_add(p, v, __ATOMIC_RELAXED, __HIP_MEMORY_SCOPE_AGENT); }
__device__ __forceinline__ unsigned xb_xcc_id() { return (unsigned)__builtin_amdgcn_s_getreg((3 << 11) | 20) & 0xFu; }
#define XB_SPIN(cond, bar) do { unsigned _sp = 0; while (cond) { __builtin_amdgcn_s_sleep(1); \
    if ((++_sp & 255u) == 0u) { if (xb_ld(&(bar)[XB_TMO])) break; if (_sp > XB_SPIN_CAP) { atomicAdd(&(bar)[XB_TMO], 1u); break; } } } } while (0)
struct XcdBarrier { unsigned* bar; unsigned x; volatile LAS unsigned* st; };
__device__ __forceinline__ XcdBarrier xcd_barrier_post(unsigned* bar, volatile LAS unsigned* st) {
    XcdBarrier b; b.bar = bar; b.x = xb_xcc_id(); b.st = st;
    if (threadIdx.x == 0) (void)xb_add(&bar[XB_XCNT(b.x)], 1u);
    return b;
}
__device__ __forceinline__ void xcd_barrier_complete(unsigned* bar, unsigned x, unsigned& nloc, unsigned& nx) {
    const unsigned G = gridDim.x * gridDim.y * gridDim.z;
    unsigned sum, cnt, mine, sp = 0u;
    for (;;) {
        sum = 0u; cnt = 0u; mine = 0u;
#pragma unroll
        for (unsigned j = 0; j < 16; ++j) { const unsigned c = xb_ld(&bar[XB_XCNT(j)]); sum += c; cnt += (c > 0u) ? 1u : 0u; mine = (j == x) ? c : mine; }
        if (sum == G) break;
        __builtin_amdgcn_s_sleep(1);
        if ((++sp & 255u) == 0u) { if (xb_ld(&bar[XB_TMO])) break; if (sp > XB_SPIN_CAP) { atomicAdd(&bar[XB_TMO], 1u); break; } }
    }
    nloc = mine > 0u ? mine : 1u; nx = cnt > 0u ? cnt : 1u;
}
__device__ __forceinline__ void xcd_barrier(const XcdBarrier& b) {
    asm volatile("s_waitcnt vmcnt(0)" ::: "memory");
    __syncthreads();
    if (threadIdx.x == 0) {
        unsigned* bar = b.bar;
        __builtin_amdgcn_s_waitcnt(0);
        unsigned nloc = b.st[0], nx = b.st[1];
        if (nloc == 0u) { xcd_barrier_complete(bar, b.x, nloc, nx); b.st[0] = nloc; b.st[1] = nx; }
        const unsigned old = xb_add(&bar[XB_XSUB(b.x)], 1u);
        const unsigned gen = old / nloc;
        if (old + 1u == (gen + 1u) * nloc) {
            __builtin_amdgcn_fence(__ATOMIC_RELEASE, "agent");
            asm volatile("s_waitcnt vmcnt(0)" ::: "memory");
            const unsigned og = xb_add(&bar[XB_TOP], 1u);
            const unsigned tg = og / nx;
            if (og + 1u == (tg + 1u) * nx) xb_add(&bar[XB_TOPGEN], 1u);
            else XB_SPIN(xb_ld(&bar[XB_TOPGEN]) == tg, bar);
            __builtin_amdgcn_fence(__ATOMIC_ACQUIRE, "agent");
            xb_add(&bar[XB_XGEN(b.x)], 1u);
            asm volatile("s_waitcnt vmcnt(0)" ::: "memory");
        } else {
            XB_SPIN(xb_ld(&bar[XB_XGEN(b.x)]) == gen, bar);
            __builtin_amdgcn_fence(__ATOMIC_ACQUIRE, "agent");
            asm volatile("s_waitcnt vmcnt(0)" ::: "memory");
        }
    }
    __syncthreads();
}
namespace pg8 {
constexpr int BM = 256, BK = 64, HALF = 128, HTB = HALF * BK * 2, STAGE_BYTES = 8 * HTB, NXCD = 8, WGM = 8;
__host__ __device__ __forceinline__ int lds_byte(int r, int c) { const int st = (r >> 4) * 2 + (c >> 5), rr = r & 15, cc = c & 31, ob = rr * 64 + cc * 2; return st * 1024 + (ob ^ (((ob >> 9) & 1) << 5)); }
__host__ __device__ __forceinline__ void stage_rc(int b, int& R, int& C) { const int st = b / 1024, sb = b % 1024, swz = sb ^ (((sb >> 9) & 1) << 5); R = (st >> 1) * 16 + swz / 64; C = (st & 1) * 32 + (swz % 64) / 2; }
__host__ __device__ __forceinline__ int perm32(int rho) { const int n = rho >> 4, i = rho & 15; return 8 * (i >> 2) + 4 * n + (i & 3); }
struct Unit { int pm, pn; };
struct Gemm { const bf16_t* A; const bf16_t* Bt; int M, N, K; int adiv; size_t astride; };
struct StaticOrder {
    int nM, nN, nwg, G, c, rep;
    __device__ void init(int M, int N, int G_, int c_, int rep_ = 1) { nM = M / BM; nN = N / BM; nwg = nM * nN; G = G_; c = c_; rep = rep_; }
    __device__ bool next(int i0, Unit& u) const {
        const int i = rep == 3 ? i0 / 3 : i0;
        const long L = (long)i * G + c; if (L >= nwg) return false;
        int wgid = (int)L; { const int q = nwg / NXCD, r = nwg % NXCD, xcd = wgid % NXCD, off = wgid / NXCD; wgid = (xcd < r ? xcd * (q + 1) : r * (q + 1) + (xcd - r) * q) + off; }
        const int nig = WGM * nN, gid = wgid / nig, fm = gid * WGM, gsz = (nM - fm) < WGM ? (nM - fm) : WGM;
        u.pm = fm + ((wgid % nig) % gsz); u.pn = (wgid % nig) / gsz; if (rep == 3) u.pn += nN * (i0 - 3 * i); return true;
    }
};
__device__ __forceinline__ unsigned cvt_pk_bf16_t(float lo, float hi) { unsigned r; asm volatile("s_nop 1\n\tv_cvt_pk_bf16_f32 %0, %1, %2" : "=v"(r) : "v"(lo), "v"(hi)); return r; }
__device__ __forceinline__ unsigned cvt_pk_bf16(float lo, float hi) { unsigned r; asm volatile("v_cvt_pk_bf16_f32 %0, %1, %2" : "=v"(r) : "v"(lo), "v"(hi)); return r; }

template <class Epi>
__device__ __forceinline__ void gemm_phase(LAS unsigned char* lds, const Gemm g, const StaticOrder& S, const Epi& E, int TIDX) {
    const int tid = TIDX, wid = __builtin_amdgcn_readfirstlane(tid >> 6), lane = tid & 63, wr = wid >> 2, wc = wid & 3, fr = lane & 15, fq = lane >> 4;
    const int K = g.K, nt = K / BK;
    unsigned voffA[2], voffB[2];
#pragma unroll
    for (int i = 0; i < 2; ++i) { int R, C; stage_rc(tid * 16 + i * 8192, R, C); const int Rb = (R & ~31) + perm32(R & 31);
        voffA[i] = (unsigned)(R * K + C) * 2u; voffB[i] = (unsigned)(Rb * K + C) * 2u; }
    const size_t kstep = (size_t)(BK * 2);
    const size_t hstep = (size_t)HALF * K * 2;
    const size_t tstep = 2 * hstep;
    const unsigned ldsw = (unsigned)wid * 1024u;
    const int aoff = lds_byte(wr * 64 + fr, fq * 8), boff = lds_byte(wc * 32 + fr, fq * 8);
#define PG8_SA(b, h) (((b) * 2 + (h)) * HTB)
#define PG8_SB(b, h) ((4 + (b) * 2 + (h)) * HTB)
#define PG8_STAGE(bufoff, gbase, voff) do { _Pragma("unroll") for (int _i = 0; _i < 2; ++_i) \
        __builtin_amdgcn_global_load_lds((const unsigned*)((const char*)(gbase) + (voff)[_i]), (LAS unsigned*)(lds + (bufoff) + ldsw + _i * 8192), 16, 0, 0); } while (0)
#define PG8_LDA(dst, b, h) do { _Pragma("unroll") for (int m = 0; m < 4; ++m) _Pragma("unroll") for (int k = 0; k < 2; ++k) dst[m][k] = *(const LAS bf16x8*)(lds + PG8_SA(b, h) + aoff + m * 2048 + k * 1024); } while (0)
#define PG8_LDB(dst, b, h) do { _Pragma("unroll") for (int n = 0; n < 2; ++n) _Pragma("unroll") for (int k = 0; k < 2; ++k) dst[n][k] = *(const LAS bf16x8*)(lds + PG8_SB(b, h) + boff + n * 2048 + k * 1024); } while (0)
#define PG8_MMA(ai, bj, At, Bt) do { __builtin_amdgcn_s_setprio(1); _Pragma("unroll") for (int m = 0; m < 4; ++m) _Pragma("unroll") for (int n = 0; n < 2; ++n) _Pragma("unroll") for (int k = 0; k < 2; ++k) \
        acc[ai][bj][m][n] = __builtin_amdgcn_mfma_f32_16x16x32_bf16(Bt[n][k], At[m][k], acc[ai][bj][m][n], 0, 0, 0); __builtin_amdgcn_s_setprio(0); } while (0)
#define PG8_WAIT_V(n) asm volatile("s_waitcnt vmcnt(" #n ")" ::: "memory")
#define PG8_WAIT_L(n) asm volatile("s_waitcnt lgkmcnt(" #n ")" ::: "memory")
#define PG8_BAR __builtin_amdgcn_s_barrier()
#define PG8_SCHED __builtin_amdgcn_sched_barrier(0)
    Unit cur, nxt; int ui = 0;
    if (!S.next(0, cur)) return;
    f32x4 acc[2][2][4][2];
#pragma unroll
    for (int a = 0; a < 2; ++a)
#pragma unroll
        for (int b = 0; b < 2; ++b)
#pragma unroll
            for (int m = 0; m < 4; ++m)
#pragma unroll
                for (int n = 0; n < 2; ++n) acc[a][b][m][n] = (f32x4){0.f, 0.f, 0.f, 0.f};
    bf16x8 At[4][2], B0[2][2], B1[2][2];
    const char* cA = (const char*)g.A + (size_t)(cur.pn / g.adiv) * g.astride + (size_t)cur.pm * tstep; const char* cB = (const char*)g.Bt + (size_t)cur.pn * tstep;
    PG8_STAGE(PG8_SB(0, 0), cB, voffB); PG8_STAGE(PG8_SA(0, 0), cA, voffA); PG8_STAGE(PG8_SB(0, 1), cB + hstep, voffB); PG8_STAGE(PG8_SA(0, 1), cA + hstep, voffA);
    if (wr == 1) PG8_BAR;
    PG8_WAIT_V(4); PG8_BAR;
    PG8_STAGE(PG8_SB(1, 0), cB + kstep, voffB); PG8_STAGE(PG8_SA(1, 0), cA + kstep, voffA); PG8_STAGE(PG8_SB(1, 1), cB + hstep + kstep, voffB);
    PG8_WAIT_V(6); PG8_BAR;
    for (;;) {
        const bool has_next = S.next(ui + 1, nxt);
        const char* nA = has_next ? (const char*)g.A + (size_t)(nxt.pn / g.adiv) * g.astride + (size_t)nxt.pm * tstep : cA; const char* nB = has_next ? (const char*)g.Bt + (size_t)nxt.pn * tstep : cB;
        for (int t = 0; t < nt; t += 2) {
            const bool last = (t == nt - 2);
            const char* a1 = cA + (size_t)(t + 1) * kstep;
            const char* a2 = last ? nA : cA + (size_t)(t + 2) * kstep; const char* b2 = last ? nB : cB + (size_t)(t + 2) * kstep;
            const char* a3 = a2 + kstep; const char* b3 = b2 + kstep;
            PG8_LDB(B0, 0, 0); PG8_SCHED; PG8_LDA(At, 0, 0); PG8_STAGE(PG8_SA(1, 1), a1 + hstep, voffA);
            PG8_WAIT_L(8); PG8_BAR; PG8_WAIT_L(0); PG8_MMA(0, 0, At, B0); PG8_BAR; PG8_SCHED;
            PG8_LDB(B1, 0, 1); PG8_STAGE(PG8_SB(0, 0), b2, voffB);
            PG8_BAR; PG8_WAIT_L(0); PG8_MMA(0, 1, At, B1); PG8_BAR;
            PG8_LDA(At, 0, 1); PG8_STAGE(PG8_SA(0, 0), a2, voffA);
            PG8_BAR; PG8_WAIT_L(0); PG8_MMA(1, 0, At, B0); PG8_BAR; PG8_SCHED;
            PG8_STAGE(PG8_SB(0, 1), b2 + hstep, voffB);
            PG8_WAIT_V(6); PG8_BAR; PG8_MMA(1, 1, At, B1); PG8_BAR;
            PG8_LDB(B0, 1, 0); PG8_SCHED; PG8_LDA(At, 1, 0); PG8_STAGE(PG8_SA(0, 1), a2 + hstep, voffA);
            PG8_WAIT_L(8); PG8_BAR; PG8_WAIT_L(0); PG8_MMA(0, 0, At, B0); PG8_BAR; PG8_SCHED;
            PG8_LDB(B1, 1, 1); PG8_STAGE(PG8_SB(1, 0), b3, voffB);
            PG8_BAR; PG8_WAIT_L(0); PG8_MMA(0, 1, At, B1); PG8_BAR;
            PG8_LDA(At, 1, 1); PG8_STAGE(PG8_SA(1, 0), a3, voffA);
            PG8_BAR; PG8_WAIT_L(0); PG8_MMA(1, 0, At, B0); PG8_BAR; PG8_SCHED;
            PG8_STAGE(PG8_SB(1, 1), b3 + hstep, voffB);
            PG8_WAIT_V(6); PG8_BAR; PG8_MMA(1, 1, At, B1); PG8_BAR;
        }
        E(acc, cur, wr, wc, fr, fq);
        if (!has_next) break;
#pragma unroll
        for (int a = 0; a < 2; ++a)
#pragma unroll
            for (int b = 0; b < 2; ++b)
#pragma unroll
                for (int m = 0; m < 4; ++m)
#pragma unroll
                    for (int n = 0; n < 2; ++n) acc[a][b][m][n] = (f32x4){0.f, 0.f, 0.f, 0.f};
        cur = nxt; cA = nA; cB = nB; ++ui;
    }
    PG8_WAIT_V(0);
    if (wr == 0) PG8_BAR;
    PG8_BAR;
#undef PG8_SA
#undef PG8_SB
#undef PG8_STAGE
#undef PG8_LDA
#undef PG8_LDB
#undef PG8_MMA
#undef PG8_WAIT_V
#undef PG8_WAIT_L
#undef PG8_BAR
#undef PG8_SCHED
}
}

template <int MODE> struct Epi {
    unsigned char* ws; const float* xin; const float* gate; float* out; int dry;
    __device__ __forceinline__ void operator()(const f32x4 (&acc)[2][2][4][2], const pg8::Unit& u, int wr, int wc, int fr, int fq) const {
        const int pn = u.pn;
        bf16_t* base = nullptr; int ld = 0, c0 = 0;
        if (MODE == 0) {
            if (pn < 6) { base = (bf16_t*)(ws + OFF_RKV); ld = 1536; c0 = pn * 256; }
            else if (pn < 10) { base = (bf16_t*)(ws + OFF_XBC); ld = 1024; c0 = (pn - 6) * 256; }
            else if (pn < 12) { base = (bf16_t*)(ws + OFF_Y3) + (size_t)T * 512; ld = 512; c0 = (pn - 10) * 256; }
            else if (pn == 12) { base = (bf16_t*)(ws + OFF_GQ); ld = 256; c0 = 0; }
            else if (pn == 13) { base = (bf16_t*)(ws + OFF_GK); ld = 256; c0 = 0; }
            else if (pn < 16) { base = (bf16_t*)(ws + OFF_Y3) + (size_t)2 * T * 512; ld = 512; c0 = (pn - 14) * 256; }
        } else if (MODE == 1) {
            if (pn < 2) { base = (bf16_t*)(ws + OFF_Y3); ld = 512; c0 = pn * 256; }
            else if (pn < 4) { base = (bf16_t*)(ws + OFF_Y3) + (size_t)2 * T * 512; ld = 512; c0 = (pn - 2) * 256; }
            else { base = (bf16_t*)(ws + OFF_GATES); ld = 3072; c0 = (pn - 4) * 256; }
        } else if (MODE == 2) { base = (bf16_t*)(ws + OFF_H); ld = 1024; c0 = (pn & 3) * 256; }
        if (MODE == 0 || (MODE == 1 && pn >= 4)) {
#pragma unroll
            for (int ai = 0; ai < 2; ++ai)
#pragma unroll
                for (int m = 0; m < 4; ++m) {
                    const int row = u.pm * 256 + ai * 128 + wr * 64 + m * 16 + fr;
#pragma unroll
                    for (int bj = 0; bj < 2; ++bj) {
                        const int cl = bj * 128 + wc * 32 + 8 * fq;
                        f32x4 v0 = acc[ai][bj][m][0], v1 = acc[ai][bj][m][1];
                        if (MODE == 0) {
                            if (pn < 16) {
                                u32x4 w; w.x = pg8::cvt_pk_bf16(v0[0], v0[1]); w.y = pg8::cvt_pk_bf16(v0[2], v0[3]); w.z = pg8::cvt_pk_bf16(v1[0], v1[1]); w.w = pg8::cvt_pk_bf16(v1[2], v1[3]);
                                *(u32x4*)(base + (size_t)row * ld + c0 + cl) = w;
                            } else if (cl < 160) {
                                float* d = (float*)(ws + OFF_SMALL) + (size_t)row * 160 + cl;
                                *(f32x4*)d = v0; *(f32x4*)(d + 4) = v1;
                            }
                        } else {
                            u32x4 w;
                            w.x = pg8::cvt_pk_bf16_t(sigmoidf_(v0[0]), sigmoidf_(v0[1])); w.y = pg8::cvt_pk_bf16_t(sigmoidf_(v0[2]), sigmoidf_(v0[3]));
                            w.z = pg8::cvt_pk_bf16_t(sigmoidf_(v1[0]), sigmoidf_(v1[1])); w.w = pg8::cvt_pk_bf16_t(sigmoidf_(v1[2]), sigmoidf_(v1[3]));
                            *(u32x4*)(base + (size_t)row * ld + c0 + cl) = w;
                        }
                    }
                }
        } else {
            f32x4 gm[2][2];
            if (MODE == 3) {
#pragma unroll
                for (int bj = 0; bj < 2; ++bj) { const int col = pn * 256 + bj * 128 + wc * 32 + 8 * fq; const int bb = (u.pm * 256) >> 13;
                    gm[bj][0] = *(const f32x4*)(gate + bb * 3072 + 2048 + col); gm[bj][1] = *(const f32x4*)(gate + bb * 3072 + 2048 + col + 4); }
            }
#pragma unroll
            for (int ai = 0; ai < 2; ++ai)
#pragma unroll
                for (int mp = 0; mp < 2; ++mp) {
                    u32x4 la[4], lb[4]; f32x4 fa[4], fb[4];
#pragma unroll
                    for (int q = 0; q < 4; ++q) { const int m = mp * 2 + (q >> 1), bj = q & 1;
                        const int row = u.pm * 256 + ai * 128 + wr * 64 + m * 16 + fr, cl = bj * 128 + wc * 32 + 8 * fq;
                        if (MODE == 1) la[q] = *(const u32x4*)(base + (size_t)row * ld + c0 + cl);
                        if (MODE == 2) { la[q] = *(const u32x4*)((const bf16_t*)(ws + OFF_GATES) + (size_t)row * 3072 + pn * 256 + cl);
                            lb[q] = (u32x4){0u, 0u, 0u, 0u}; if (pn >= 4) lb[q] = *(const u32x4*)(base + (size_t)row * ld + c0 + cl); }
                        if (MODE == 3) { const int col = pn * 256 + cl; fa[q] = *(const f32x4*)(xin + (size_t)row * 1024 + col); fb[q] = *(const f32x4*)(xin + (size_t)row * 1024 + col + 4); } }
#pragma unroll
                    for (int q = 0; q < 4; ++q) { const int m = mp * 2 + (q >> 1), bj = q & 1;
                        const int row = u.pm * 256 + ai * 128 + wr * 64 + m * 16 + fr, cl = bj * 128 + wc * 32 + 8 * fq;
                        const f32x4 v0 = acc[ai][bj][m][0], v1 = acc[ai][bj][m][1];
                        if (MODE == 1) { const u32x4 o = la[q]; u32x4 w;
                            w.x = pg8::cvt_pk_bf16(lo_bf(o.x) * siluf_(v0[0]), hi_bf(o.x) * siluf_(v0[1])); w.y = pg8::cvt_pk_bf16(lo_bf(o.y) * siluf_(v0[2]), hi_bf(o.y) * siluf_(v0[3]));
                            w.z = pg8::cvt_pk_bf16(lo_bf(o.z) * siluf_(v1[0]), hi_bf(o.z) * siluf_(v1[1])); w.w = pg8::cvt_pk_bf16(lo_bf(o.w) * siluf_(v1[2]), hi_bf(o.w) * siluf_(v1[3]));
                            *(u32x4*)(base + (size_t)row * ld + c0 + cl) = dry ? o : w; }
                        if (MODE == 2) { const u32x4 o = la[q], pm_ = lb[q]; u32x4 w;
                            w.x = pg8::cvt_pk_bf16(lo_bf(pm_.x) + lo_bf(o.x) * v0[0], hi_bf(pm_.x) + hi_bf(o.x) * v0[1]); w.y = pg8::cvt_pk_bf16(lo_bf(pm_.y) + lo_bf(o.y) * v0[2], hi_bf(pm_.y) + hi_bf(o.y) * v0[3]);
                            w.z = pg8::cvt_pk_bf16(lo_bf(pm_.z) + lo_bf(o.z) * v1[0], hi_bf(pm_.z) + hi_bf(o.z) * v1[1]); w.w = pg8::cvt_pk_bf16(lo_bf(pm_.w) + lo_bf(o.w) * v1[2], hi_bf(pm_.w) + hi_bf(o.w) * v1[3]);
                            *(u32x4*)(base + (size_t)row * ld + c0 + cl) = (dry && pn >= 4) ? pm_ : w; }
                        if (MODE == 3) { const int col = pn * 256 + cl; f32x4 r0, r1;
#pragma unroll
                            for (int j = 0; j < 4; ++j) { r0[j] = ALPHA_DN * fa[q][j] + (1.f + gm[bj][0][j]) * v0[j]; r1[j] = ALPHA_DN * fb[q][j] + (1.f + gm[bj][1][j]) * v1[j]; }
                            if (dry && xin == out) { r0 = fa[q]; r1 = fb[q]; }
                            *(f32x4*)(out + (size_t)row * 1024 + col) = r0; *(f32x4*)(out + (size_t)row * 1024 + col + 4) = r1; }
                    }
                }
        }
    }
};

__device__ __forceinline__ int wt1_src(int n) {
    if (n < 1536) return n;
    if (n < 2560) return 2176 + (n - 1536);
    if (n < 3072) return 3208 + (n - 2560);
    if (n < 3328) return 3720 + (n - 3072);
    if (n < 3584) return 3976 + (n - 3328);
    if (n < 4096) return 4232 + (n - 3584);
    if (n < 4352) { const int s = n - 4096; if (s < 128) return 1536 + s; if (s < 136) return 3200 + (s - 128); if (s < 152) return 4744 + (s - 136); return -1; }
    const int m = n - 4352;
    if (m < 512) return 1664 + m;
    if (m < 1024) return 4760 + (m - 512);
    return 5272 + (m - 1024);
}
template <bool MAP>
__device__ __forceinline__ void transpose_item(const float* W, int ldw, bf16_t* WT, int ldt, int row_off, int col_off, int nblk, LAS float* scr, int item, int lane) {
    const int kb = item / nblk, nb = item % nblk, k0 = 64 * kb, n0 = 32 * nb;
    int sc = n0 + (lane & 31); if (MAP) sc = wt1_src(sc);
#pragma unroll 8
    for (int i = 0; i < 32; ++i) { const int kk = 2 * i + (lane >> 5); scr[kk * 33 + (lane & 31)] = sc >= 0 ? W[(size_t)(k0 + kk) * ldw + sc] : 0.f; }
    WAVE_LDS_SYNC();
    const int c = lane & 7;
#pragma unroll
    for (int j = 0; j < 4; ++j) { const int n = (lane >> 3) + 8 * j; const LAS float* s = scr + (8 * c) * 33 + n;
        u32x4 o; o.x = pk2(s[0 * 33], s[1 * 33]); o.y = pk2(s[2 * 33], s[3 * 33]); o.z = pk2(s[4 * 33], s[5 * 33]); o.w = pk2(s[6 * 33], s[7 * 33]);
        *(u32x4*)(WT + (size_t)(row_off + n0 + n) * ldt + col_off + k0 + 8 * c) = o; }
    WAVE_LDS_SYNC();
}
__device__ void wprep(const Params& p, int l, LAS unsigned char* lds, int TIDX, int BIDX) {
    const int lane = TIDX & 63, wave = TIDX >> 6;
    LAS float* scr = (LAS float*)(lds + wave * 16384);
    const int gw = BIDX * 8 + wave, NGW = gridDim.x * 8;
    constexpr int I1 = (1024 / 64) * (8448 / 32), I2 = 3 * (512 / 64) * (1024 / 32), I3 = (1024 / 64) * (1024 / 32);
    bf16_t* WT1 = (bf16_t*)(p.ws + OFF_WT1); bf16_t* WT2 = (bf16_t*)(p.ws + OFF_WT2); bf16_t* WT3 = (bf16_t*)(p.ws + OFF_WT3);
    for (int it = gw; it < I1 + I2 + I3; it += NGW) {
        int r = it;
        if (r < I1) { transpose_item<true>(p.in[I_WIN] + (size_t)l * 1024 * INW, INW, WT1, 1024, 0, 0, 8448 / 32, scr, r, lane); continue; }
        r -= I1;
        if (r < I2) { const int b = r / (I2 / 3), rr = r % (I2 / 3); transpose_item<false>(p.in[I_WBR] + ((size_t)l * 3 + b) * 512 * 1024, 1024, WT2, 512, b * 1024, 0, 1024 / 32, scr, rr, lane); continue; }
        r -= I2;
        transpose_item<false>(p.in[I_WOUT] + (size_t)l * 1024 * 1024, 1024, WT3, 1024, 0, 0, 1024 / 32, scr, r, lane);
    }
}
__device__ void ada_phase(const Params& p, LAS unsigned char* lds, int TIDX, int BIDX) {
    LAS float* red = (LAS float*)lds;
    const int tid = TIDX, kg = tid >> 5, cj = tid & 31;
    float* mod = (float*)(p.ws + OFF_MOD);
    for (int it = BIDX; it < 2 * 96; it += gridDim.x) {
        const int l = it / 96, col = (it % 96) * 32 + cj;
        const float* W = p.in[I_ADAW] + (size_t)l * 1024 * 3072;
        float a0 = 0.f, a1 = 0.f, a2 = 0.f, a3 = 0.f;
        for (int k = kg * 64; k < kg * 64 + 64; ++k) {
            const float w = W[(size_t)k * 3072 + col];
            a0 += siluf_(p.in[I_C][k]) * w; a1 += siluf_(p.in[I_C][1024 + k]) * w; a2 += siluf_(p.in[I_C][2048 + k]) * w; a3 += siluf_(p.in[I_C][3072 + k]) * w;
        }
        red[(kg * 32 + cj) * 4 + 0] = a0; red[(kg * 32 + cj) * 4 + 1] = a1; red[(kg * 32 + cj) * 4 + 2] = a2; red[(kg * 32 + cj) * 4 + 3] = a3;
        __syncthreads();
        if (tid < 128) { const int c2 = tid >> 2, b = tid & 3; float s = 0.f;
            for (int g = 0; g < 16; ++g) s += red[(g * 32 + c2) * 4 + b];
            const int cc = (it % 96) * 32 + c2;
            mod[((size_t)l * 4 + b) * 3072 + cc] = s + p.in[I_ADAB][(size_t)l * 3072 + cc]; }
        __syncthreads();
    }
}
__device__ __forceinline__ void ln_stats(const f32x4 (&v)[4], float& mean, float& rstd, float eps) {
    float s = 0.f;
#pragma unroll
    for (int j = 0; j < 4; ++j) s += (v[j][0] + v[j][1]) + (v[j][2] + v[j][3]);
    mean = wave_sum(s) * (1.f / 1024.f); float s2 = 0.f;
#pragma unroll
    for (int j = 0; j < 4; ++j) { const f32x4 d = v[j] - mean; s2 += (d[0] * d[0] + d[1] * d[1]) + (d[2] * d[2] + d[3] * d[3]); }
    rstd = rsqrtf(wave_sum(s2) * (1.f / 1024.f) + eps);
}
__device__ __forceinline__ void mod_row_to_h(const Params& p, const f32x4 (&v)[4], int row, int l, int lane) {
    float mean, rstd; ln_stats(v, mean, rstd, 1e-5f);
    const float* mod = (const float*)(p.ws + OFF_MOD) + ((size_t)l * 4 + (row >> 13)) * 3072;
    bf16_t* H = (bf16_t*)(p.ws + OFF_H) + (size_t)row * 1024;
#pragma unroll
    for (int j = 0; j < 4; ++j) { const int c = 256 * j + 4 * lane;
        const f32x4 sh = *(const f32x4*)(mod + c), sc = *(const f32x4*)(mod + 1024 + c);
        f32x4 h;
#pragma unroll
        for (int e = 0; e < 4; ++e) h[e] = (v[j][e] - mean) * rstd * (1.f + sc[e]) + sh[e];
        u32x2 o; o.x = pk2(h[0], h[1]); o.y = pk2(h[2], h[3]);
        *(u32x2*)(H + c) = o; }
}
__device__ void ln1_phase(const Params& p, int l, const float* xin, int TIDX, int BIDX) {
    const int lane = TIDX & 63, gw = BIDX * 8 + (TIDX >> 6), NGW = gridDim.x * 8;
    for (int row = gw; row < T; row += NGW) {
        f32x4 v[4];
#pragma unroll
        for (int j = 0; j < 4; ++j) v[j] = *(const f32x4*)(xin + (size_t)row * 1024 + 256 * j + 4 * lane);
        mod_row_to_h(p, v, row, l, lane);
    }
}
__device__ void lnpost_phase(const Params& p, int l, int TIDX, int BIDX, int dry) {
    const int lane = TIDX & 63, gw = BIDX * 8 + (TIDX >> 6), NGW = gridDim.x * 8;
    const float* pg = p.in[I_PG] + l * 1024; const float* pb = p.in[I_PB] + l * 1024;
    for (int row = gw; row < T; row += NGW) {
        f32x4 v[4];
#pragma unroll
        for (int j = 0; j < 4; ++j) v[j] = *(const f32x4*)(p.out + (size_t)row * 1024 + 256 * j + 4 * lane);
        float mean, rstd; ln_stats(v, mean, rstd, 1e-5f);
#pragma unroll
        for (int j = 0; j < 4; ++j) { const int c = 256 * j + 4 * lane; const f32x4 g = *(const f32x4*)(pg + c), b = *(const f32x4*)(pb + c);
            const f32x4 orig = v[j];
#pragma unroll
            for (int e = 0; e < 4; ++e) v[j][e] = (v[j][e] - mean) * rstd * g[e] + b[e];
            *(f32x4*)(p.out + (size_t)row * 1024 + c) = dry ? orig : v[j]; }
        if (l == 0) mod_row_to_h(p, v, row, 1, lane);
    }
}

__device__ __forceinline__ void conv_unpack(const u32x4 w, float (&x)[8]) {
#pragma unroll
    for (int q = 0; q < 4; ++q) { x[2 * q] = lo_bf(w[q]); x[2 * q + 1] = hi_bf(w[q]); }
}
__device__ void rwkv_prep_phase(const Params& p, int l, LAS unsigned char* lds, int TIDX, int BIDX, const XcdBarrier& xb, int dry) {
    {
        bf16_t* XBC = (bf16_t*)(p.ws + OFF_XBC);
        const int cgp = TIDX & 127, qt = TIDX >> 7; const int q0 = BIDX * 128 + qt * 32; const int c8 = cgp * 8;
        float h1[8], h2[8], h3[8];
        if ((q0 & (SEQ - 1)) != 0) { conv_unpack(*(const u32x4*)(XBC + (size_t)(q0 - 1) * 1024 + c8), h1); conv_unpack(*(const u32x4*)(XBC + (size_t)(q0 - 2) * 1024 + c8), h2); conv_unpack(*(const u32x4*)(XBC + (size_t)(q0 - 3) * 1024 + c8), h3); }
        else {
#pragma unroll
            for (int e = 0; e < 8; ++e) h1[e] = h2[e] = h3[e] = 0.f; }
        xcd_barrier(xb);
        float cw0[8], cw1[8], cw2[8], cw3[8], cb[8];
#pragma unroll
        for (int e = 0; e < 8; ++e) { cw0[e] = p.in[I_CONVW][((size_t)l * 4 + 0) * 1024 + c8 + e]; cw1[e] = p.in[I_CONVW][((size_t)l * 4 + 1) * 1024 + c8 + e];
            cw2[e] = p.in[I_CONVW][((size_t)l * 4 + 2) * 1024 + c8 + e]; cw3[e] = p.in[I_CONVW][((size_t)l * 4 + 3) * 1024 + c8 + e]; cb[e] = p.in[I_CONVB][l * 1024 + c8 + e]; }
#pragma unroll 4
        for (int i = 0; i < 32; ++i) {
            bf16_t* ptr = XBC + (size_t)(q0 + i) * 1024 + c8;
            const u32x4 raw_ = *(const u32x4*)ptr; float x0[8]; conv_unpack(raw_, x0);
            float y[8];
#pragma unroll
            for (int e = 0; e < 8; ++e) { y[e] = siluf_(cw0[e] * h3[e] + cw1[e] * h2[e] + cw2[e] * h1[e] + cw3[e] * x0[e] + cb[e]); h3[e] = h2[e]; h2[e] = h1[e]; h1[e] = x0[e]; }
            u32x4 w; w.x = pk2(y[0], y[1]); w.y = pk2(y[2], y[3]); w.z = pk2(y[4], y[5]); w.w = pk2(y[6], y[7]);
            *(u32x4*)ptr = dry ? raw_ : w;
        }
    }
    {
        LAS float* S = (LAS float*)lds;
        const float* SM = (const float*)(p.ws + OFF_SMALL);
        const float* mu = p.in[I_MU] + l * 1664 + 1536;
        bf16_t* A = (bf16_t*)(p.ws + OFF_A); float* DEC = (float*)(p.ws + OFF_DEC);
        const int tbase = BIDX * 128;
        { const int tok = TIDX >> 2, part = TIDX & 3; const int row = tbase + tok; const bool first = (row & (SEQ - 1)) == 0;
#pragma unroll
          for (int q = 0; q < 8; ++q) { const int j = part * 32 + q * 4;
              const f32x4 cur = *(const f32x4*)(SM + (size_t)row * 160 + j);
              f32x4 prv = (f32x4){0.f, 0.f, 0.f, 0.f}; if (!first) prv = *(const f32x4*)(SM + (size_t)(row - 1) * 160 + j);
              const f32x4 m4 = *(const f32x4*)(mu + j);
              f32x4 v;
#pragma unroll
              for (int e = 0; e < 4; ++e) { v[e] = cur[e] + m4[e] * (prv[e] - cur[e]); if (part < 2) v[e] = tanhf(v[e]); }
              *(LAS f32x4*)(S + tok * 132 + j) = v; } }
        __syncthreads();
        const int wave = TIDX >> 6, lane = TIDX & 63, r = lane & 15, kg = lane >> 4, cbase = wave * 64;
#pragma unroll 1
        for (int pass = 0; pass < 2; ++pass) {
            const float* W = (pass ? p.in[I_AUP] : p.in[I_WUP]) + (size_t)l * 64 * 512;
            const float* bias = (pass ? p.in[I_A0] : p.in[I_W0]) + l * 512;
            float bfrag[4][16], b0[4];
#pragma unroll
            for (int ct = 0; ct < 4; ++ct) { b0[ct] = bias[cbase + ct * 16 + r];
#pragma unroll
                for (int ks = 0; ks < 16; ++ks) bfrag[ct][ks] = W[(size_t)(ks * 4 + kg) * 512 + cbase + ct * 16 + r]; }
#pragma unroll 1
            for (int tt = 0; tt < 8; ++tt) {
                f32x4 acc[4];
#pragma unroll
                for (int ct = 0; ct < 4; ++ct) acc[ct] = (f32x4){0.f, 0.f, 0.f, 0.f};
#pragma unroll
                for (int ks = 0; ks < 16; ++ks) { const float av = S[(tt * 16 + r) * 132 + pass * 64 + ks * 4 + kg];
#pragma unroll
                    for (int ct = 0; ct < 4; ++ct) acc[ct] = __builtin_amdgcn_mfma_f32_16x16x4f32(av, bfrag[ct][ks], acc[ct], 0, 0, 0); }
#pragma unroll
                for (int ct = 0; ct < 4; ++ct)
#pragma unroll
                    for (int j = 0; j < 4; ++j) { const size_t o = (size_t)(tbase + tt * 16 + kg * 4 + j) * 512 + cbase + ct * 16 + r; const float x = b0[ct] + acc[ct][j];
                        const float sg = 1.0f / (1.0f + __expf(-x));
                        if (pass) A[o] = f2bf(sg); else DEC[o] = __expf(-0.6065306597126334f * sg); }
            }
        }
        __syncthreads();
    }
}

typedef float f32x2 __attribute__((ext_vector_type(2)));
template <int CTRL> __device__ __forceinline__ float dpp_f(float x) { return __builtin_bit_cast(float, __builtin_amdgcn_update_dpp(0, __builtin_bit_cast(int, x), CTRL, 0xF, 0xF, true)); }
__device__ __forceinline__ float row16_sum(float x) { x += dpp_f<0xB1>(x); x += dpp_f<0x4E>(x); x += dpp_f<0x141>(x); x += dpp_f<0x140>(x); return x; }
constexpr int RW_TC = 32, RW_VEC_B = RW_TC * 5 * 64 * 4, RW_V_B = RW_TC * 16 * 4, RW_BUF_B = RW_VEC_B + 2 * RW_V_B;
__device__ void rwkv_scan_fast(const Params& p, int l, int unit, LAS unsigned char* lds, int TIDX) {
    const int bh = unit >> 2, rq = unit & 3, b = bh >> 3, h = bh & 7, wave = TIDX >> 6, lane = TIDX & 63;
    const size_t r0 = (size_t)b * SEQ;
    bf16_t* Y = (bf16_t*)(p.ws + OFF_Y3);
    if (wave >= 4) {
        const int lw = wave - 4, sl = lane >> 3, c8 = (lane & 7) * 8, ch0 = h * 64 + c8;
        const bf16_t* RKV = (const bf16_t*)(p.ws + OFF_RKV); const bf16_t* A = (const bf16_t*)(p.ws + OFF_A); const float* DEC = (const float*)(p.ws + OFF_DEC);
        float mu_r[8], mu_k[8], mu_v[8], k_k[8], k_a[8];
#pragma unroll
        for (int e = 0; e < 8; ++e) { mu_r[e] = p.in[I_MU][l * 1664 + ch0 + e]; mu_k[e] = p.in[I_MU][l * 1664 + 512 + ch0 + e]; mu_v[e] = p.in[I_MU][l * 1664 + 1024 + ch0 + e];
            k_k[e] = p.in[I_KK][l * 512 + ch0 + e]; k_a[e] = p.in[I_KA][l * 512 + ch0 + e]; }
        u32x4 nR, nK, nV, nRp, nKp, nVp, nA; f32x4 nD0, nD1;
        auto issue = [&](int cc) {
            const size_t row = r0 + (size_t)cc * RW_TC + lw * 8 + sl;
            nR = *(const u32x4*)(RKV + row * 1536 + ch0); nK = *(const u32x4*)(RKV + row * 1536 + 512 + ch0); nV = *(const u32x4*)(RKV + row * 1536 + 1024 + ch0);
            nA = *(const u32x4*)(A + row * 512 + ch0); nD0 = *(const f32x4*)(DEC + row * 512 + ch0); nD1 = *(const f32x4*)(DEC + row * 512 + ch0 + 4);
            const size_t prow = (row & (SEQ - 1)) != 0 ? row - 1 : row;
            nRp = *(const u32x4*)(RKV + prow * 1536 + ch0); nKp = *(const u32x4*)(RKV + prow * 1536 + 512 + ch0); nVp = *(const u32x4*)(RKV + prow * 1536 + 1024 + ch0);
        };
        issue(0);
        for (int c = -1; c < SEQ / RW_TC; ++c) {
            if (c >= 1) { LAS const float* yb = (LAS const float*)(lds + ((c - 1) & 1) * RW_BUF_B + RW_VEC_B + RW_V_B);
                const int idx = (lw * 64 + lane) * 2, s = idx >> 4, i = idx & 15;
                *(unsigned*)(Y + (r0 + (size_t)(c - 1) * RW_TC + s) * 512 + h * 64 + rq * 16 + i) = pk2(yb[idx], yb[idx + 1]); }
            if (c + 1 < SEQ / RW_TC) {
                const u32x4 cR = nR, cK = nK, cV = nV, cRp = nRp, cKp = nKp, cVp = nVp, cA = nA; const f32x4 cD0 = nD0, cD1 = nD1;
                if (c + 2 < SEQ / RW_TC) issue(c + 2);
                LAS float* vec = (LAS float*)(lds + ((c + 1) & 1) * RW_BUF_B); LAS float* vb = (LAS float*)(lds + ((c + 1) & 1) * RW_BUF_B + RW_VEC_B);
                const int s = lw * 8 + sl;
                float cr[8], ck[8], cv[8], pr[8], pk[8], pv[8], ca[8];
                conv_unpack(cR, cr); conv_unpack(cK, ck); conv_unpack(cV, cv); conv_unpack(cRp, pr); conv_unpack(cKp, pk); conv_unpack(cVp, pv); conv_unpack(cA, ca);
                if ((((c + 1) * RW_TC + s) & (SEQ - 1)) == 0) {
#pragma unroll
                    for (int e = 0; e < 8; ++e) pr[e] = pk[e] = pv[e] = 0.f; }
                float rr[8], kk[8], vv[8], kkj[8]; float n2 = 0.f;
#pragma unroll
                for (int e = 0; e < 8; ++e) { rr[e] = cr[e] + mu_r[e] * (pr[e] - cr[e]); kk[e] = ck[e] + mu_k[e] * (pk[e] - ck[e]); vv[e] = cv[e] + mu_v[e] * (pv[e] - cv[e]);
                    kkj[e] = kk[e] * k_k[e]; n2 += kkj[e] * kkj[e]; }
                n2 += dpp_f<0xB1>(n2); n2 += dpp_f<0x4E>(n2); n2 += dpp_f<0x141>(n2);
                const float inv = 1.f / fmaxf(sqrtf(n2), 1e-12f);
                f32x4 o0, o1;
                LAS float* d = vec + s * 320 + c8;
                *(LAS f32x4*)(d) = cD0; *(LAS f32x4*)(d + 4) = cD1;
#pragma unroll
                for (int e = 0; e < 4; ++e) { o0[e] = kkj[e] * inv; o1[e] = kkj[4 + e] * inv; }
                *(LAS f32x4*)(d + 64) = o0; *(LAS f32x4*)(d + 68) = o1;
#pragma unroll
                for (int e = 0; e < 4; ++e) { o0[e] *= ca[e]; o1[e] *= ca[4 + e]; }
                *(LAS f32x4*)(d + 128) = o0; *(LAS f32x4*)(d + 132) = o1;
#pragma unroll
                for (int e = 0; e < 4; ++e) { o0[e] = kk[e] * (1.f + (ca[e] - 1.f) * k_a[e]); o1[e] = kk[4 + e] * (1.f + (ca[4 + e] - 1.f) * k_a[4 + e]); }
                *(LAS f32x4*)(d + 192) = o0; *(LAS f32x4*)(d + 196) = o1;
#pragma unroll
                for (int e = 0; e < 4; ++e) { o0[e] = rr[e]; o1[e] = rr[4 + e]; }
                *(LAS f32x4*)(d + 256) = o0; *(LAS f32x4*)(d + 260) = o1;
                if ((c8 >> 4) == rq) {
#pragma unroll
                    for (int e = 0; e < 4; ++e) { o0[e] = vv[e]; o1[e] = vv[4 + e]; }
                    *(LAS f32x4*)(vb + s * 16 + (c8 & 15)) = o0; *(LAS f32x4*)(vb + s * 16 + (c8 & 15) + 4) = o1; }
            }
            __syncthreads();
        }
        { constexpr int c = SEQ / RW_TC; LAS const float* yb = (LAS const float*)(lds + ((c - 1) & 1) * RW_BUF_B + RW_VEC_B + RW_V_B);
          const int idx = (lw * 64 + lane) * 2, s = idx >> 4, i = idx & 15;
          *(unsigned*)(Y + (r0 + (size_t)(c - 1) * RW_TC + s) * 512 + h * 64 + rq * 16 + i) = pk2(yb[idx], yb[idx + 1]); }
    } else {
        const int rl = wave * 4 + (lane >> 4), cq = lane & 15;
        const bool c1 = cq < 8, c2 = (cq & 4) == 0, c3 = (cq & 2) == 0, c4 = (cq & 1) == 0;
        f32x2 S0 = (f32x2){0.f, 0.f}, S1 = (f32x2){0.f, 0.f};
        __syncthreads();
        for (int c = 0; c < SEQ / RW_TC; ++c) {
            LAS const unsigned char* buf = lds + (c & 1) * RW_BUF_B;
            LAS const float* vb = (LAS const float*)(buf + RW_VEC_B); LAS float* yb = (LAS float*)(buf + RW_VEC_B + RW_V_B);
            LAS const f32x4* q = (LAS const f32x4*)buf + cq;
            f32x4 w4 = q[0], k4 = q[16], b4 = q[32], t4 = q[48], r4 = q[64]; float v = vb[rl];
            float yv[16];
#pragma unroll
            for (int s = 0; s < RW_TC; ++s) {
                f32x4 nw = w4, nk = k4, nb = b4, nt = t4, nr = r4; float nv = v;
                if (s + 1 < RW_TC) { LAS const f32x4* qn = q + (s + 1) * 80; nw = qn[0]; nk = qn[16]; nb = qn[32]; nt = qn[48]; nr = qn[64]; nv = vb[(s + 1) * 16 + rl]; }
                f32x2 sp = S0 * (f32x2){k4[0], k4[1]} + S1 * (f32x2){k4[2], k4[3]};
                const float sa = -row16_sum(sp[0] + sp[1]);
                S0 = S0 * (f32x2){w4[0], w4[1]} + (f32x2){b4[0], b4[1]} * sa + (f32x2){t4[0], t4[1]} * v;
                S1 = S1 * (f32x2){w4[2], w4[3]} + (f32x2){b4[2], b4[3]} * sa + (f32x2){t4[2], t4[3]} * v;
                f32x2 yp = S0 * (f32x2){r4[0], r4[1]} + S1 * (f32x2){r4[2], r4[3]};
                yv[s & 15] = yp[0] + yp[1];
                if ((s & 15) == 15) {
                    float w8[8], w4[4], w2[2];
#pragma unroll
                    for (int i = 0; i < 8; ++i) { const float kp = c1 ? yv[i] : yv[8 + i], sd = c1 ? yv[8 + i] : yv[i]; w8[i] = kp + dpp_f<0x140>(sd); }
#pragma unroll
                    for (int i = 0; i < 4; ++i) { const float kp = c2 ? w8[i] : w8[4 + i], sd = c2 ? w8[4 + i] : w8[i]; w4[i] = kp + dpp_f<0x141>(sd); }
#pragma unroll
                    for (int i = 0; i < 2; ++i) { const float kp = c3 ? w4[i] : w4[2 + i], sd = c3 ? w4[2 + i] : w4[i]; w2[i] = kp + dpp_f<0x1B>(sd); }
                    const float kp = c4 ? w2[0] : w2[1], sd = c4 ? w2[1] : w2[0];
                    yb[((s & ~15) + cq) * 16 + rl] = kp + dpp_f<0xB1>(sd);
                }
                w4 = nw; k4 = nk; b4 = nb; t4 = nt; r4 = nr; v = nv;
            }
            __syncthreads();
        }
    }
}

__device__ __forceinline__ int tm_shift(int t) { return ((t >> 3) & 3) * 16; }
template <int K, int AM, int BMODE>
__device__ __forceinline__ f32x4 mma_t(LAS const bf16_t* A, int lda, int arow0, LAS const bf16_t* B, int ldb, int brow0, f32x4 acc, int lane) {
    const int r = lane & 15, kg = lane >> 4;
#pragma unroll
    for (int k0 = 0; k0 < K; k0 += 32) {
        bf16x8 a, b;
        if (AM == 0) a = *(LAS const bf16x8*)(A + (arow0 + r) * lda + k0 + kg * 8);
        else if (AM == 2) a = *(LAS const bf16x8*)(A + (arow0 + r) * lda + tm_shift(arow0 + r) + k0 + kg * 8);
        else { LAS const bf16_t* q = A + (k0 + kg * 8) * lda + tm_shift(k0 + kg * 8) + arow0 + r;
#pragma unroll
            for (int j = 0; j < 8; ++j) a[j] = (short)q[j * lda]; }
        if (BMODE == 0) b = *(LAS const bf16x8*)(B + (brow0 + r) * ldb + k0 + kg * 8);
        else if (BMODE == 2) b = *(LAS const bf16x8*)(B + (brow0 + r) * ldb + tm_shift(brow0 + r) + k0 + kg * 8);
        else { LAS const bf16_t* q = B + (k0 + kg * 8) * ldb + tm_shift(k0 + kg * 8) + brow0 + r;
#pragma unroll
            for (int j = 0; j < 8; ++j) b[j] = (short)q[j * ldb]; }
        acc = __builtin_amdgcn_mfma_f32_16x16x32_bf16(a, b, acc, 0, 0, 0);
    }
    return acc;
}
__device__ void mamba2_chunk(const Params& p, int l, int bh, LAS unsigned char* lds, int TIDX) {
    const int b = bh >> 3, h = bh & 7, g = h >> 2, tid = TIDX, wave = tid >> 6, lane = tid & 63, r = lane & 15, kg = lane >> 4;
    LAS bf16_t* CB = (LAS bf16_t*)lds;
    LAS bf16_t* BB = (LAS bf16_t*)(lds + 17408);
    LAS bf16_t* AY = (LAS bf16_t*)(lds + 41984);
    LAS bf16_t* SB = (LAS bf16_t*)(lds + 67584);
    LAS bf16_t* XD = (LAS bf16_t*)(lds + 84992);
    LAS bf16_t* XE = (LAS bf16_t*)(lds + 101376);
    LAS bf16_t* XS = (LAS bf16_t*)(lds + 117760);
    LAS float* F = (LAS float*)(lds + 126976);
    const bf16_t* XBC = (const bf16_t*)(p.ws + OFF_XBC); const float* SM = (const float*)(p.ws + OFF_SMALL);
    bf16_t* Z = (bf16_t*)(p.ws + OFF_Y3) + (size_t)T * 512;
    const float dtb = p.in[I_DTB][l * 8 + h], ah = -__expf(p.in[I_ALOG][l * 8 + h]), dsk = p.in[I_DSKIP][l * 8 + h];
    const size_t rbase = (size_t)b * SEQ;
    f32x4 sacc[4];
#pragma unroll
    for (int i = 0; i < 4; ++i) sacc[i] = (f32x4){0.f, 0.f, 0.f, 0.f};
    for (int i = tid; i < 64 * 128; i += 512) SB[(i >> 7) * 136 + (i & 127)] = 0;
    u32x4 rc[2], rb[2], rx; float rdt = 0.f;
    auto prefetch = [&](int c) {
        const size_t row0 = rbase + (size_t)c * 64;
#pragma unroll
        for (int i = 0; i < 2; ++i) { const int item = tid + 512 * i, ll = item >> 4, ng = item & 15;
            rc[i] = *(const u32x4*)(XBC + (row0 + ll) * 1024 + 768 + g * 128 + ng * 8); rb[i] = *(const u32x4*)(XBC + (row0 + ll) * 1024 + 512 + g * 128 + ng * 8); }
        rx = *(const u32x4*)(XBC + (row0 + (tid >> 3)) * 1024 + h * 64 + (tid & 7) * 8);
        if (tid < 64) rdt = SM[(row0 + tid) * 160 + 128 + h];
    };
    prefetch(0);
    for (int c = 0; c < SEQ / 64; ++c) {
        const size_t row0 = rbase + (size_t)c * 64;
        if (tid < 64) { const float dt = softplusf_(rdt + dtb); float x = dt * ah;
#pragma unroll
            for (int o = 1; o < 64; o <<= 1) { const float y = __shfl_up(x, o); if (lane >= o) x += y; }
            F[tid] = x; F[64 + tid] = dt; }
        __syncthreads();
        const float acs_last = F[63];
#pragma unroll
        for (int i = 0; i < 2; ++i) { const int item = tid + 512 * i, ll = item >> 4, ng = item & 15;
            *(LAS u32x4*)(CB + ll * 136 + ng * 8) = rc[i]; *(LAS u32x4*)(BB + ll * 192 + tm_shift(ll) + ng * 8) = rb[i];
            const float ea = __expf(F[ll]); float cv[8]; conv_unpack(rc[i], cv);
            u32x4 w; w.x = pk2(cv[0] * ea, cv[1] * ea); w.y = pk2(cv[2] * ea, cv[3] * ea); w.z = pk2(cv[4] * ea, cv[5] * ea); w.w = pk2(cv[6] * ea, cv[7] * ea);
            *(LAS u32x4*)(AY + ll * 200 + 64 + ng * 8) = w; }
        { const int ll = tid >> 3, pg = tid & 7; float xv[8]; conv_unpack(rx, xv); const float dtl = F[64 + ll], ee = __expf(acs_last - F[ll]);
          float xd[8];
#pragma unroll
          for (int e = 0; e < 8; ++e) xd[e] = xv[e] * dtl;
          u32x4 w; w.x = pk2(xd[0], xd[1]); w.y = pk2(xd[2], xd[3]); w.z = pk2(xd[4], xd[5]); w.w = pk2(xd[6], xd[7]);
          *(LAS u32x4*)(XD + ll * 128 + tm_shift(ll) + pg * 8) = w;
          w.x = pk2(xd[0] * ee, xd[1] * ee); w.y = pk2(xd[2] * ee, xd[3] * ee); w.z = pk2(xd[4] * ee, xd[5] * ee); w.w = pk2(xd[6] * ee, xd[7] * ee);
          *(LAS u32x4*)(XE + ll * 128 + tm_shift(ll) + pg * 8) = w;
          *(LAS u32x4*)(XS + ll * 72 + pg * 8) = rx; }
        __syncthreads();
        if (c + 1 < SEQ / 64) prefetch(c + 1);
        bf16_t zpre[2][4];
#pragma unroll
        for (int q = 0; q < 2; ++q) { const int tt = wave + 8 * q, tl = tt >> 2, tp = tt & 3;
#pragma unroll
            for (int j = 0; j < 4; ++j) zpre[q][j] = Z[(row0 + tl * 16 + kg * 4 + j) * 512 + h * 64 + tp * 16 + r]; }
#pragma unroll
        for (int q = 0; q < 2; ++q) { const int tt = wave + 8 * q, tl = tt >> 2, ts = tt & 3;
            f32x4 acc = (f32x4){0.f, 0.f, 0.f, 0.f};
            if (ts <= tl) acc = mma_t<128, 0, 2>(CB, 136, tl * 16, BB, 192, ts * 16, acc, lane);
            const int sc = ts * 16 + r; const float as = F[sc];
#pragma unroll
            for (int j = 0; j < 4; ++j) { const int ll = tl * 16 + kg * 4 + j; const float v = (sc <= ll) ? acc[j] * __expf(F[ll] - as) : 0.f; AY[ll * 200 + sc] = f2bf(v); } }
        __syncthreads();
#pragma unroll
        for (int q = 0; q < 2; ++q) { const int tt = wave + 8 * q, tl = tt >> 2, tp = tt & 3;
            f32x4 acc = (f32x4){0.f, 0.f, 0.f, 0.f};
            acc = mma_t<64, 0, 1>(AY, 200, tl * 16, XD, 128, tp * 16, acc, lane);
            acc = mma_t<128, 0, 0>(AY + 64, 200, tl * 16, SB, 136, tp * 16, acc, lane);
            const int pp = tp * 16 + r;
#pragma unroll
            for (int j = 0; j < 4; ++j) { const int ll = tl * 16 + kg * 4 + j; bf16_t* zp = Z + (row0 + ll) * 512 + h * 64 + pp;
                const float y = acc[j] + dsk * bf2f(XS[ll * 72 + pp]); *zp = f2bf(y * siluf_(bf2f(zpre[q][j]))); } }
        const float dl = __expf(acs_last);
#pragma unroll
        for (int i = 0; i < 4; ++i) { const int id = wave * 4 + i, tp = id >> 3, tn = id & 7;
            sacc[i] = sacc[i] * dl; sacc[i] = mma_t<64, 1, 1>(XE, 128, tp * 16, BB, 192, tn * 16, sacc[i], lane); }
        __syncthreads();
#pragma unroll
        for (int i = 0; i < 4; ++i) { const int id = wave * 4 + i, tp = id >> 3, tn = id & 7;
#pragma unroll
            for (int j = 0; j < 4; ++j) SB[(tp * 16 + kg * 4 + j) * 136 + tn * 16 + r] = f2bf(sacc[i][j]); }
    }
}
__device__ void gla_chunk(const Params& p, int l, int unit, LAS unsigned char* lds, int TIDX) {
    const int bh = unit >> 1, eh = unit & 1, b = bh >> 2, h = bh & 3, tid = TIDX, wave = tid >> 6, lane = tid & 63, r = lane & 15, kg = lane >> 4;
    LAS bf16_t* KG = (LAS bf16_t*)lds;
    LAS bf16_t* AY = (LAS bf16_t*)(lds + 9216);
    LAS bf16_t* SB = (LAS bf16_t*)(lds + 26624);
    LAS bf16_t* VV = (LAS bf16_t*)(lds + 35840);
    LAS bf16_t* KD = (LAS bf16_t*)(lds + 52224);
    LAS float* G = (LAS float*)(lds + 68608);
    LAS float* UP = (LAS float*)(lds + 85248);
    LAS float* GD = (LAS float*)(lds + 89344);
    LAS float* SEG = (LAS float*)(lds + 93440);
    const bf16_t* GQ = (const bf16_t*)(p.ws + OFF_GQ); const bf16_t* GK = (const bf16_t*)(p.ws + OFF_GK); const float* SM = (const float*)(p.ws + OFF_SMALL);
    bf16_t* GV = (bf16_t*)(p.ws + OFF_Y3) + (size_t)2 * T * 512;
    const size_t rbase = (size_t)b * SEQ;
    const int ll = tid >> 3, dg = tid & 7;
    for (int i = tid; i < 16 * 64; i += 512) UP[i] = p.in[I_GKUP][((size_t)l * 16 + (i >> 6)) * 256 + h * 64 + (i & 63)];
    float gkb[8];
#pragma unroll
    for (int e = 0; e < 8; ++e) gkb[e] = p.in[I_GKB][l * 256 + h * 64 + dg * 8 + e];
    f32x4 sacc[2];
    sacc[0] = sacc[1] = (f32x4){0.f, 0.f, 0.f, 0.f};
    for (int i = tid; i < 64 * 64; i += 512) SB[(i >> 6) * 72 + (i & 63)] = 0;
    u32x4 rq, rk, rv; f32x4 rg = (f32x4){0.f, 0.f, 0.f, 0.f};
    auto prefetch = [&](int c) {
        const size_t row0 = rbase + (size_t)c * 64;
        rq = *(const u32x4*)(GQ + (row0 + ll) * 256 + h * 64 + dg * 8); rk = *(const u32x4*)(GK + (row0 + ll) * 256 + h * 64 + dg * 8);
        rv = *(const u32x4*)(GV + (row0 + ll) * 512 + h * 128 + eh * 64 + dg * 8);
        if (tid < 256) rg = *(const f32x4*)(SM + (row0 + (tid >> 2)) * 160 + 136 + (tid & 3) * 4);
    };
    prefetch(0);
    for (int c = 0; c < SEQ / 64; ++c) {
        const size_t row0 = rbase + (size_t)c * 64;
        if (tid < 256) *(LAS f32x4*)(GD + (tid >> 2) * 16 + (tid & 3) * 4) = rg;
        __syncthreads();
        { float gp[8];
#pragma unroll
          for (int e = 0; e < 8; ++e) gp[e] = gkb[e];
#pragma unroll
          for (int q = 0; q < 16; ++q) { const float gd = GD[ll * 16 + q];
#pragma unroll
              for (int e = 0; e < 8; ++e) gp[e] += gd * UP[q * 64 + dg * 8 + e]; }
#pragma unroll
          for (int e = 0; e < 8; ++e) G[ll * 65 + dg * 8 + e] = (fminf(gp[e], 0.f) - __logf(1.f + __expf(-fabsf(gp[e])))) * (1.f / 16.f); }
        __syncthreads();
        { const int d = tid & 63, sg = tid >> 6; float gv[8]; float a = 0.f;
#pragma unroll
          for (int q = 0; q < 8; ++q) { a += G[(sg * 8 + q) * 65 + d]; gv[q] = a; }
          SEG[sg * 64 + d] = a;
          __syncthreads();
          float off = 0.f;
#pragma unroll
          for (int q = 0; q < 7; ++q) off += (q < sg) ? SEG[q * 64 + d] : 0.f;
#pragma unroll
          for (int q = 0; q < 8; ++q) G[(sg * 8 + q) * 65 + d] = gv[q] + off; }
        __syncthreads();
        { float qv[8], kv[8]; conv_unpack(rq, qv); conv_unpack(rk, kv);
          float qg[8], ki[8], kd[8];
#pragma unroll
          for (int e = 0; e < 8; ++e) { const int d = dg * 8 + e; const float gl = G[ll * 65 + d], glast = G[63 * 65 + d];
              qg[e] = qv[e] * 0.125f * __expf(gl); ki[e] = kv[e] * __expf(-gl); kd[e] = kv[e] * __expf(glast - gl); }
          u32x4 w; w.x = pk2(qg[0], qg[1]); w.y = pk2(qg[2], qg[3]); w.z = pk2(qg[4], qg[5]); w.w = pk2(qg[6], qg[7]);
          *(LAS u32x4*)(AY + ll * 136 + 64 + dg * 8) = w;
          w.x = pk2(ki[0], ki[1]); w.y = pk2(ki[2], ki[3]); w.z = pk2(ki[4], ki[5]); w.w = pk2(ki[6], ki[7]);
          *(LAS u32x4*)(KG + ll * 72 + dg * 8) = w;
          w.x = pk2(kd[0], kd[1]); w.y = pk2(kd[2], kd[3]); w.z = pk2(kd[4], kd[5]); w.w = pk2(kd[6], kd[7]);
          *(LAS u32x4*)(KD + ll * 128 + tm_shift(ll) + dg * 8) = w;
          *(LAS u32x4*)(VV + ll * 128 + tm_shift(ll) + dg * 8) = rv; }
        __syncthreads();
        if (c + 1 < SEQ / 64) prefetch(c + 1);
#pragma unroll
        for (int q = 0; q < 2; ++q) { const int tt = wave + 8 * q, tl = tt >> 2, ts = tt & 3;
            f32x4 acc = (f32x4){0.f, 0.f, 0.f, 0.f};
            if (ts <= tl) acc = mma_t<64, 0, 0>(AY + 64, 136, tl * 16, KG, 72, ts * 16, acc, lane);
            const int sc = ts * 16 + r;
#pragma unroll
            for (int j = 0; j < 4; ++j) { const int l2 = tl * 16 + kg * 4 + j; AY[l2 * 136 + sc] = f2bf((sc <= l2) ? acc[j] : 0.f); } }
        __syncthreads();
#pragma unroll
        for (int q = 0; q < 2; ++q) { const int tt = wave + 8 * q, tl = tt >> 2, te = tt & 3;
            f32x4 acc = (f32x4){0.f, 0.f, 0.f, 0.f};
            acc = mma_t<64, 0, 1>(AY, 136, tl * 16, VV, 128, te * 16, acc, lane);
            acc = mma_t<64, 0, 0>(AY + 64, 136, tl * 16, SB, 72, te * 16, acc, lane);
#pragma unroll
            for (int j = 0; j < 4; ++j) GV[(row0 + tl * 16 + kg * 4 + j) * 512 + h * 128 + eh * 64 + te * 16 + r] = f2bf(acc[j]); }
#pragma unroll
        for (int i = 0; i < 2; ++i) { const int id = wave * 2 + i, te = id >> 2, td = id & 3;
            const float dl = __expf(G[63 * 65 + td * 16 + r]);
            sacc[i] = sacc[i] * dl; sacc[i] = mma_t<64, 1, 1>(VV, 128, te * 16, KD, 128, td * 16, sacc[i], lane); }
        __syncthreads();
#pragma unroll
        for (int i = 0; i < 2; ++i) { const int id = wave * 2 + i, te = id >> 2, td = id & 3;
#pragma unroll
            for (int j = 0; j < 4; ++j) SB[(te * 16 + kg * 4 + j) * 72 + td * 16 + r] = f2bf(sacc[i][j]); }
    }
}
__device__ void scans_naive_phase(const Params& p, int l, LAS unsigned char* lds, int TIDX, int BIDX) {
    const int wave = TIDX >> 6;
    LAS float* wl = (LAS float*)(lds + wave * 4096);
    if (BIDX < 128) { rwkv_scan_fast(p, l, BIDX, lds, TIDX); return; }
    const int u = BIDX - 128;
    if (u < 32) mamba2_chunk(p, l, u, lds, TIDX);
    else if (u < 64) gla_chunk(p, l, u - 32, lds, TIDX);
}
__device__ void post_phase(const Params& p, int l, int TIDX, int BIDX, int dry) {
    const int lane = TIDX & 63, gw = BIDX * 8 + (TIDX >> 6), NGW = gridDim.x * 8;
    const bf16_t* RKV = (const bf16_t*)(p.ws + OFF_RKV); const bf16_t* A = (const bf16_t*)(p.ws + OFF_A);
    bf16_t* Y0 = (bf16_t*)(p.ws + OFF_Y3); bf16_t* Y1 = Y0 + (size_t)T * 512; bf16_t* Y2 = Y1 + (size_t)T * 512;
    const int c0 = lane * 8;
    float mur[8], muk[8], muv[8], kA[8], rk[8], lg[8], lb[8], nw1[8], nw2[8];
#pragma unroll
    for (int e = 0; e < 8; ++e) { const int c = c0 + e;
        mur[e] = p.in[I_MU][l * 1664 + c]; muk[e] = p.in[I_MU][l * 1664 + 512 + c]; muv[e] = p.in[I_MU][l * 1664 + 1024 + c];
        kA[e] = p.in[I_KA][l * 512 + c]; rk[e] = p.in[I_RK][l * 512 + c]; lg[e] = p.in[I_LNG][l * 512 + c]; lb[e] = p.in[I_LNB][l * 512 + c];
        nw1[e] = p.in[I_M2NW][l * 512 + c]; nw2[e] = p.in[I_GNW][l * 128 + (c & 127)]; }
    for (int row = gw; row < T; row += NGW) {
        const bool first = (row & (SEQ - 1)) == 0;
        float y[8], r[8], k[8], v[8], a[8];
        u32x4 ysave;
        { const u32x4 yy = *(const u32x4*)(Y0 + (size_t)row * 512 + c0); ysave = yy; const u32x4 aa = *(const u32x4*)(A + (size_t)row * 512 + c0);
          const u32x4 rr = *(const u32x4*)(RKV + (size_t)row * 1536 + c0), kk = *(const u32x4*)(RKV + (size_t)row * 1536 + 512 + c0), vv = *(const u32x4*)(RKV + (size_t)row * 1536 + 1024 + c0);
          u32x4 rp = (u32x4){0, 0, 0, 0}, kp = rp, vp = rp;
          if (!first) { rp = *(const u32x4*)(RKV + (size_t)(row - 1) * 1536 + c0); kp = *(const u32x4*)(RKV + (size_t)(row - 1) * 1536 + 512 + c0); vp = *(const u32x4*)(RKV + (size_t)(row - 1) * 1536 + 1024 + c0); }
#pragma unroll
          for (int q = 0; q < 4; ++q) {
              y[2 * q] = lo_bf(yy[q]); y[2 * q + 1] = hi_bf(yy[q]); a[2 * q] = lo_bf(aa[q]); a[2 * q + 1] = hi_bf(aa[q]);
              float x0 = lo_bf(rr[q]), x1 = hi_bf(rr[q]); r[2 * q] = x0 + mur[2 * q] * (lo_bf(rp[q]) - x0); r[2 * q + 1] = x1 + mur[2 * q + 1] * (hi_bf(rp[q]) - x1);
              x0 = lo_bf(kk[q]); x1 = hi_bf(kk[q]); k[2 * q] = x0 + muk[2 * q] * (lo_bf(kp[q]) - x0); k[2 * q + 1] = x1 + muk[2 * q + 1] * (hi_bf(kp[q]) - x1);
              x0 = lo_bf(vv[q]); x1 = hi_bf(vv[q]); v[2 * q] = x0 + muv[2 * q] * (lo_bf(vp[q]) - x0); v[2 * q + 1] = x1 + muv[2 * q + 1] * (hi_bf(vp[q]) - x1); } }
        float s = 0.f, bs = 0.f;
#pragma unroll
        for (int e = 0; e < 8; ++e) { s += y[e]; bs += r[e] * (k[e] * (1.f + (a[e] - 1.f) * kA[e])) * rk[e]; }
        s += __shfl_xor(s, 1); s += __shfl_xor(s, 2); s += __shfl_xor(s, 4);
        bs += __shfl_xor(bs, 1); bs += __shfl_xor(bs, 2); bs += __shfl_xor(bs, 4);
        const float mean = s * (1.f / 64.f); float s2 = 0.f;
#pragma unroll
        for (int e = 0; e < 8; ++e) { const float d = y[e] - mean; s2 += d * d; }
        s2 += __shfl_xor(s2, 1); s2 += __shfl_xor(s2, 2); s2 += __shfl_xor(s2, 4);
        const float rstd = rsqrtf(s2 * (1.f / 64.f) + 64e-5f);
        { float o[8];
#pragma unroll
          for (int e = 0; e < 8; ++e) o[e] = (y[e] - mean) * rstd * lg[e] + lb[e] + bs * v[e];
          u32x4 w; w.x = pk2(o[0], o[1]); w.y = pk2(o[2], o[3]); w.z = pk2(o[4], o[5]); w.w = pk2(o[6], o[7]);
          *(u32x4*)(Y0 + (size_t)row * 512 + c0) = dry ? ysave : w; }
        { const u32x4 yy = *(const u32x4*)(Y1 + (size_t)row * 512 + c0); float q2 = 0.f;
#pragma unroll
          for (int q = 0; q < 4; ++q) { y[2 * q] = lo_bf(yy[q]); y[2 * q + 1] = hi_bf(yy[q]); q2 += y[2 * q] * y[2 * q] + y[2 * q + 1] * y[2 * q + 1]; }
          q2 += __shfl_xor(q2, 1); q2 += __shfl_xor(q2, 2); q2 += __shfl_xor(q2, 4); q2 += __shfl_xor(q2, 8); q2 += __shfl_xor(q2, 16);
          const float rs = rsqrtf(q2 * (1.f / 256.f) + 1e-5f);
          u32x4 w; w.x = pk2(y[0] * rs * nw1[0], y[1] * rs * nw1[1]); w.y = pk2(y[2] * rs * nw1[2], y[3] * rs * nw1[3]); w.z = pk2(y[4] * rs * nw1[4], y[5] * rs * nw1[5]); w.w = pk2(y[6] * rs * nw1[6], y[7] * rs * nw1[7]);
          *(u32x4*)(Y1 + (size_t)row * 512 + c0) = dry ? yy : w; }
        { const u32x4 yy = *(const u32x4*)(Y2 + (size_t)row * 512 + c0); float q2 = 0.f;
#pragma unroll
          for (int q = 0; q < 4; ++q) { y[2 * q] = lo_bf(yy[q]); y[2 * q + 1] = hi_bf(yy[q]); q2 += y[2 * q] * y[2 * q] + y[2 * q + 1] * y[2 * q + 1]; }
          q2 += __shfl_xor(q2, 1); q2 += __shfl_xor(q2, 2); q2 += __shfl_xor(q2, 4); q2 += __shfl_xor(q2, 8);
          const float rs = rsqrtf(q2 * (1.f / 128.f) + 1e-5f);
          u32x4 w; w.x = pk2(y[0] * rs * nw2[0], y[1] * rs * nw2[1]); w.y = pk2(y[2] * rs * nw2[2], y[3] * rs * nw2[3]); w.z = pk2(y[4] * rs * nw2[4], y[5] * rs * nw2[5]); w.w = pk2(y[6] * rs * nw2[6], y[7] * rs * nw2[7]);
          *(u32x4*)(Y2 + (size_t)row * 512 + c0) = dry ? yy : w; }
    }
}

constexpr int NPHASE = 18;
#ifndef EXP_S
#define EXP_S -1
#endif
#ifndef DIAG
#define DIAG 0
#endif
#ifndef DIAG_A
#define DIAG_A(ph, s) ((ph) >= 2 && (s) == 2)
#endif
#ifndef DIAG_B
#define DIAG_B(ph, s) ((ph) >= 2 && ((s) == 0 || (s) >= 4 && (s) <= 6))
#endif
#ifndef PHM
#define PHM 1023
#endif
__global__ __launch_bounds__(512, 2) void mega(Params p) {
    extern __shared__ __attribute__((aligned(16))) unsigned char shm[];
    LAS unsigned char* lds = (LAS unsigned char*)shm;
    cg::grid_group grid = cg::this_grid();
    volatile LAS unsigned* xst = (volatile LAS unsigned*)(lds + 131072);
    if (threadIdx.x < 2) xst[threadIdx.x] = 0u;
    __syncthreads();
    const XcdBarrier xb = xcd_barrier_post((unsigned*)(p.ws + OFF_BAR), xst);
#if DIAG
    unsigned long long tA = 0, tB = 0;
#endif
    for (int ph = p.ph_lo; ph < p.ph_hi; ++ph) {
        const int TIDX = tid_opaque(), BIDX = bid_opaque();
#if DIAG
        const unsigned long long t_start = __builtin_amdgcn_s_memrealtime();
#endif
        if (ph == 0) { if (PHM & 1) { wprep(p, 0, lds, TIDX, BIDX); ada_phase(p, lds, TIDX, BIDX); } }
        else if (ph == 1) { if (PHM & 2) ln1_phase(p, 0, p.in[I_X], TIDX, BIDX); }
        else {
            const int l = (ph - 2) >> 3, s = (ph - 2) & 7;
            const float* xin = l == 0 ? p.in[I_X] : p.out;
            pg8::StaticOrder S;
            if (s == 0 && (PHM & 4)) { pg8::Gemm g{(const bf16_t*)(p.ws + OFF_H), (const bf16_t*)(p.ws + OFF_WT1), T, 4352, 1024, 1 << 30, 0};
                S.init(g.M, g.N, gridDim.x, BIDX); Epi<0> E{p.ws, nullptr, nullptr, nullptr, 0}; pg8::gemm_phase(lds, g, S, E, TIDX); }
            else if (s == 1 && (PHM & 8)) { if (EXP_S == 1) { rwkv_prep_phase(p, l, lds, TIDX, BIDX, xb, 1); xcd_barrier(xb); } rwkv_prep_phase(p, l, lds, TIDX, BIDX, xb, 0); }
            else if (s == 2 && (PHM & 16)) { scans_naive_phase(p, l, lds, TIDX, BIDX); }
            else if (s == 3 && (PHM & 32)) { if (EXP_S == 3) { post_phase(p, l, TIDX, BIDX, 1); xcd_barrier(xb); } post_phase(p, l, TIDX, BIDX, 0); }
            else if (s == 4 && (PHM & 64)) { pg8::Gemm g{(const bf16_t*)(p.ws + OFF_H), (const bf16_t*)(p.ws + OFF_WT1) + (size_t)4352 * 1024, T, 4096, 1024, 1 << 30, 0};
                S.init(g.M, g.N, gridDim.x, BIDX); Epi<1> E{p.ws, nullptr, nullptr, nullptr, 0}; if (EXP_S == s) { E.dry = 1; pg8::gemm_phase(lds, g, S, E, TIDX); xcd_barrier(xb); E.dry = 0; } pg8::gemm_phase(lds, g, S, E, TIDX); }
            else if (s == 5 && (PHM & 128)) { pg8::Gemm g{(const bf16_t*)(p.ws + OFF_Y3), (const bf16_t*)(p.ws + OFF_WT2), T, 1024, 512, 4, (size_t)T * 512 * 2};
                S.init(g.M, g.N, gridDim.x, BIDX, 3); Epi<2> E{p.ws, nullptr, nullptr, nullptr, 0}; if (EXP_S == s) { E.dry = 1; pg8::gemm_phase(lds, g, S, E, TIDX); xcd_barrier(xb); E.dry = 0; } pg8::gemm_phase(lds, g, S, E, TIDX); }
            else if (s == 6 && (PHM & 256)) { pg8::Gemm g{(const bf16_t*)(p.ws + OFF_H), (const bf16_t*)(p.ws + OFF_WT3), T, 1024, 1024, 1 << 30, 0};
                S.init(g.M, g.N, gridDim.x, BIDX); Epi<3> E{p.ws, xin, (const float*)(p.ws + OFF_MOD) + (size_t)l * 4 * 3072, p.out, 0}; if (EXP_S == s) { E.dry = 1; pg8::gemm_phase(lds, g, S, E, TIDX); xcd_barrier(xb); E.dry = 0; } pg8::gemm_phase(lds, g, S, E, TIDX); }
            else if (s == 7 && (PHM & 512)) { if (EXP_S == 7) { lnpost_phase(p, l, TIDX, BIDX, 1); if (l == 0) wprep(p, 1, lds, TIDX, BIDX); xcd_barrier(xb); } lnpost_phase(p, l, TIDX, BIDX, 0); if (l == 0) wprep(p, 1, lds, TIDX, BIDX); }
        }
        if (ph + 1 < p.ph_hi) { if (ph == p.ph_lo) grid.sync(); else xcd_barrier(xb); }
#if DIAG
        { const unsigned long long dt = __builtin_amdgcn_s_memrealtime() - t_start; const int s_ = (ph - 2) & 7;
          if (DIAG_A(ph, s_)) tA += dt; if (DIAG_B(ph, s_)) tB += dt; }
#endif
    }
#if DIAG
    grid.sync();
    if (blockIdx.x == 0) {
        const float vA = (float)tA * 10.f, vB = (float)tB * 10.f;
        for (int i = threadIdx.x; i < (1 << 20); i += 512) p.out[4096 + i] = vB;
        if (threadIdx.x == 0) p.out[0] = vA * 1000.f;
    }
#endif
}

extern "C" void kernel_launch(void* const* d_in, const int* in_sizes, int n_in, void* d_out, int out_size, void* d_ws, size_t ws_size, hipStream_t stream) {
    constexpr int LDS_BYTES = 131072 + 16;
    static int grid = 0;
    if (grid == 0) {
        if (n_in != 28 || out_size != T * DM || ws_size < WS_NEED) { fprintf(stderr, "kernel_launch: unexpected shapes / workspace (%zu < %zu)\n", ws_size, (size_t)WS_NEED); grid = -1; return; }
        int dev = 0, cus = 0, per_cu = 0;
        hipGetDevice(&dev); hipDeviceGetAttribute(&cus, hipDeviceAttributeMultiprocessorCount, dev);
        if (hipFuncSetAttribute((const void*)mega, hipFuncAttributeMaxDynamicSharedMemorySize, LDS_BYTES) != hipSuccess) { fprintf(stderr, "hipFuncSetAttribute failed\n"); grid = -1; return; }
        if (hipOccupancyMaxActiveBlocksPerMultiprocessor(&per_cu, (const void*)mega, 512, LDS_BYTES) != hipSuccess || per_cu < 1) per_cu = 1;
        (void)hipGetLastError();
        grid = cus * 1;
        if (grid != 256) { fprintf(stderr, "kernel_launch: built for 256 CUs\n"); grid = -1; return; }
    }
    if (grid < 0) return;
    if (hipMemsetAsync((char*)d_ws + OFF_BAR, 0, XCD_BAR_WORDS_B, stream) != hipSuccess) { fprintf(stderr, "kernel_launch: memset of barrier words failed\n"); return; }
    Params p{};
    for (int i = 0; i < 28; ++i) p.in[i] = (const float*)d_in[i];
    p.out = (float*)d_out; p.ws = (unsigned char*)d_ws;
#if N_LAUNCH_MODE == 1
    p.ph_lo = 0; p.ph_hi = NPHASE;
    void* args[] = {&p};
    hipError_t e = hipLaunchCooperativeKernel((const void*)mega, dim3(grid), dim3(512), args, LDS_BYTES, stream);
    if (e != hipSuccess) fprintf(stderr, "cooperative launch failed: %s (grid %d)\n", hipGetErrorString(e), grid);
#else
    for (int ph = 0; ph < NPHASE; ++ph) { p.ph_lo = ph; p.ph_hi = ph + 1; hipLaunchKernelGGL(mega, dim3(grid), dim3(512), LDS_BYTES, stream, p); }
#endif
}
```
